# Optimizing an MI355X kernel written in HIP

```python
import math
import jax, jax.numpy as jnp
from jax import lax
import numpy as np

D_MODEL = 2048
BATCH = 2
SEQ = 4096
DEPTH = 2

MEM_LEN = 256
MEM_HEADS = 4
MEM_HEAD_DIM = D_MODEL // MEM_HEADS

SC_W = D_MODEL // 4
SC_K = 3

RW_HEAD_DIM = 64
RW_W = D_MODEL // 4
RW_HEADS = RW_W // RW_HEAD_DIM
RW_LORA_W = 96
RW_LORA_A = 96
RW_LORA_G = 256
RW_DECAY_SCALE = math.exp(-0.5)
RW_LN_EPS = 64e-5

RET_HEADS = 4
RET_DK = 128
RET_DV = 2 * RET_DK
RET_CHUNK = 128
RET_LN_EPS = 1e-5

NSA_HEADS = 8
NSA_KV_HEADS = 2
NSA_DH = 64
NSA_GROUP = NSA_HEADS // NSA_KV_HEADS
CMP_LEN = 32
CMP_STRIDE = 16
CMP_HIDDEN = 256
SEL_BLOCK = 64
SEL_TOP = 16
WINDOW = 512
Q_BLOCK = 128

FFN_DIM = 5632
FFN_K = 3

ROPE_THETA = 10000.0
EPS = 1e-6
N_BRANCH = 4

SC_SIZES = (SC_W, SC_W, SC_W)
RW_SIZES = (RW_W, RW_W, RW_W, RW_LORA_W, RW_LORA_A, RW_LORA_G)
RET_SIZES = (RET_HEADS * RET_DK, RET_HEADS * RET_DK, RET_HEADS * RET_DV, RET_HEADS * RET_DV)
NSA_SIZES = (NSA_HEADS * NSA_DH,) + (NSA_KV_HEADS * NSA_DH,) * 6 + (NSA_HEADS * 3,)
GATE_SIZES = (D_MODEL,) * N_BRANCH
GROUP_SIZES = (sum(SC_SIZES), sum(RW_SIZES), sum(RET_SIZES), sum(NSA_SIZES), sum(GATE_SIZES))
N_IN = sum(GROUP_SIZES)
RW_TOTAL = sum(RW_SIZES)
BR_SIZES = (SC_W, RW_W, RET_HEADS * RET_DV, NSA_HEADS * NSA_DH)
N_BR = sum(BR_SIZES)

kernel_name = "hybrid_gated_parallel_mixer_trunk"


def _split(x, sizes, axis=-1):
    return jnp.split(x, [int(c) for c in np.cumsum(sizes)[:-1]], axis=axis)


def rms_norm(x, g):
    xf = x.astype(jnp.float32)
    y = xf * lax.rsqrt(jnp.mean(xf * xf, axis=-1, keepdims=True) + EPS)
    return (y * g.astype(jnp.float32)).astype(x.dtype)


def head_norm(x, eps):
    xf = x.astype(jnp.float32)
    mu = jnp.mean(xf, axis=-1, keepdims=True)
    var = jnp.mean(jnp.square(xf - mu), axis=-1, keepdims=True)
    return (xf - mu) * lax.rsqrt(var + eps)


def causal_dwconv(x, w):
    k_w = w.shape[0]
    s = x.shape[1]
    xp = jnp.pad(x, ((0, 0), (k_w - 1, 0), (0, 0)))
    y = w[0] * xp[:, 0:s]
    for j in range(1, k_w):
        y = y + w[j] * xp[:, j:j + s]
    return y


def rope_freqs(d):
    return ROPE_THETA ** (-jnp.arange(0, d, 2, dtype=jnp.float32) / d)


def retnet_freqs(d):
    return 1.0 / (ROPE_THETA ** jnp.linspace(0.0, 1.0, d // 2, dtype=jnp.float32))


def rope(x, pos, inv_freq):
    ang = pos.astype(jnp.float32)[..., None] * inv_freq
    cos = jnp.cos(ang)[:, :, None, :].astype(x.dtype)
    sin = jnp.sin(ang)[:, :, None, :].astype(x.dtype)
    x1, x2 = jnp.split(x, 2, axis=-1)
    return jnp.concatenate([x1 * cos - x2 * sin, x2 * cos + x1 * sin], axis=-1)


def masked_softmax(s, mask):
    s = jnp.where(mask, s.astype(jnp.float32), -jnp.inf)
    m = jnp.max(s, axis=-1, keepdims=True)
    m = jnp.where(jnp.isfinite(m), m, 0.0)
    e = jnp.where(mask, jnp.exp(s - m), 0.0)
    return e / jnp.maximum(jnp.sum(e, axis=-1, keepdims=True), 1e-30)


def short_conv_mixer(b_gate, c_gate, xin, w_conv):
    return b_gate * causal_dwconv(c_gate * xin, w_conv)


def wkv7_scan(r, w, k, v, kk, a):
    bsz, _, nh, nd = r.shape
    xs = tuple(jnp.moveaxis(t, 1, 0) for t in (r, w, k, v, kk, a))

    def step(state, inp):
        r_t, w_t, k_t, v_t, kk_t, a_t = inp
        sa = jnp.einsum('bhvk,bhk->bhv', state, -kk_t)
        state = (state * w_t[:, :, None, :]
                 + sa[..., None] * (kk_t * a_t)[:, :, None, :]
                 + v_t[..., None] * k_t[:, :, None, :])
        return state, jnp.einsum('bhvk,bhk->bhv', state, r_t)

    s0 = jnp.zeros((bsz, nh, nd, nd), jnp.float32)
    _, y = lax.scan(step, s0, xs)
    return jnp.moveaxis(y, 0, 1)


def rwkv7_mixer(z, mu, w0, w_w2, a0, w_a2, w_g2, k_k, k_a, r_k, lnx_g, lnx_b):
    bsz, s, _ = z.shape
    z_prev = jnp.pad(z, ((0, 0), (1, 0), (0, 0)))[:, :-1]
    z = z + (z_prev - z) * mu
    r, k, v, zw, za, zg = _split(z, RW_SIZES)
    d = w0 + jnp.tanh(zw) @ w_w2
    w = jnp.exp(-RW_DECAY_SCALE * jax.nn.sigmoid(d.astype(jnp.float32)))
    a = jax.nn.sigmoid(a0 + za @ w_a2)
    g = jax.nn.sigmoid(zg) @ w_g2
    heads = lambda t: t.reshape(bsz, s, RW_HEADS, RW_HEAD_DIM).astype(jnp.float32)
    kk = heads(k * k_k)
    kk = kk / jnp.maximum(jnp.sqrt(jnp.sum(kk * kk, axis=-1, keepdims=True)), 1e-12)
    k = k * (1.0 + (a - 1.0) * k_a)
    rh, kh, vh, ah, wh = heads(r), heads(k), heads(v), heads(a), heads(w)
    y = wkv7_scan(rh, wh, kh, vh, kk, ah)
    y = head_norm(y, RW_LN_EPS) * lnx_g.reshape(RW_HEADS, RW_HEAD_DIM) + lnx_b.reshape(RW_HEADS, RW_HEAD_DIM)
    bonus = jnp.sum(rh * kh * r_k, axis=-1, keepdims=True) * vh
    return (y + bonus).reshape(bsz, s, RW_W).astype(z.dtype) * g


def retention_mixer(q, k, v, gate, positions):
    bsz, s, _ = q.shape
    nh, dk, dv, c = RET_HEADS, RET_DK, RET_DV, RET_CHUNK
    n = s // c
    inv = retnet_freqs(dk)
    q = rope(q.reshape(bsz, s, nh, dk), positions, inv)
    k = rope(k.reshape(bsz, s, nh, dk), positions, inv) * (dk ** -0.5)
    v = v.reshape(bsz, s, nh, dv)
    chunk = lambda t: t.reshape(bsz, n, c, nh, t.shape[-1]).transpose(0, 3, 1, 2, 4)
    qc, kc, vc = chunk(q), chunk(k), chunk(v)
    lg = jnp.log(1.0 - 2.0 ** (-5.0 - jnp.arange(nh, dtype=jnp.float32)))
    idx = jnp.arange(c, dtype=jnp.float32)
    diff = idx[:, None] - idx[None, :]
    decay_in = jnp.where(diff >= 0, jnp.exp(jnp.maximum(diff, 0.0) * lg[:, None, None]), 0.0)
    scores = jnp.einsum('bhncd,bhnmd->bhncm', qc, kc) * decay_in[:, None]
    o_inner = jnp.einsum('bhncm,bhnme->bhnce', scores, vc)
    zeta = jnp.exp((c - 1 - idx)[None, :] * lg[:, None])
    xi = jnp.exp((idx + 1.0)[None, :] * lg[:, None])
    u = jnp.einsum('bhnmd,bhnme->bhnde', kc * zeta[:, None, :, None], vc)
    chunk_decay = jnp.exp(c * lg)[:, None, None]

    def step(state, u_i):
        return state * chunk_decay + u_i, state

    _, r_prev = lax.scan(step, jnp.zeros((bsz, nh, dk, dv), u.dtype), jnp.moveaxis(u, 2, 0))
    r_prev = jnp.moveaxis(r_prev, 0, 2)
    o_cross = jnp.einsum('bhncd,bhnde->bhnce', qc * xi[:, None, :, None], r_prev)
    o = (o_inner + o_cross).transpose(0, 2, 3, 1, 4).reshape(bsz, s, nh, dv)
    o = head_norm(o, RET_LN_EPS).reshape(bsz, s, nh * dv).astype(gate.dtype)
    return o * jax.nn.silu(gate)


def nsa_mixer(q, kc, vc, ks, vs, kw, vw, gates, positions, cmp_pos, cmp_w1, cmp_w2):
    bsz, s, _ = q.shape
    nh, ng, hpg, dh = NSA_HEADS, NSA_KV_HEADS, NSA_GROUP, NSA_DH
    inv = rope_freqs(dh)
    scale = dh ** -0.5
    q = rope(q.reshape(bsz, s, nh, dh), positions, inv)
    kv_shape = (bsz, s, ng, dh)
    kc, vc, vs, vw = kc.reshape(kv_shape), vc.reshape(kv_shape), vs.reshape(kv_shape), vw.reshape(kv_shape)
    ks = rope(ks.reshape(kv_shape), positions, inv)
    kw = rope(kw.reshape(kv_shape), positions, inv)

    n_cmp = (s - CMP_LEN) // CMP_STRIDE + 1
    starts = np.arange(n_cmp) * CMP_STRIDE
    tok = starts[:, None] + np.arange(CMP_LEN)[None, :]
    cmp_end = starts + CMP_LEN - 1

    def compress(t, pos_emb, w1, w2):
        blk = t[:, tok] + pos_emb[:, None, :]
        blk = blk.transpose(0, 1, 3, 2, 4).reshape(bsz, n_cmp, ng, CMP_LEN * dh)
        return jax.nn.gelu(blk @ w1) @ w2

    k_cmp = rope(compress(kc, cmp_pos[0], cmp_w1[0], cmp_w2[0]), positions[:, cmp_end], inv)
    v_cmp = compress(vc, cmp_pos[1], cmp_w1[1], cmp_w2[1])
    qg = q.reshape(bsz, s, ng, hpg, dh)
    t_idx = np.arange(s)
    cmask = cmp_end[None, :] <= t_idx[:, None]
    s_cmp = jnp.einsum('bsgqd,bcgd->bgqsc', qg, k_cmp) * scale
    p_cmp = masked_softmax(s_cmp, cmask)
    o_cmp = jnp.einsum('bgqsc,bcgd->bsgqd', p_cmp.astype(v_cmp.dtype), v_cmp).reshape(bsz, s, nh, dh)

    n_sel = s // SEL_BLOCK
    jb = np.arange(n_sel)
    overlap = ((starts[:, None] < (jb[None, :] + 1) * SEL_BLOCK)
               & (starts[:, None] + CMP_LEN > jb[None, :] * SEL_BLOCK)).astype(np.float32)
    imp = jnp.einsum('bgqsc,cj->bgsj', p_cmp, overlap)
    cur = t_idx // SEL_BLOCK
    valid = jb[None, :] <= cur[:, None]
    forced = (jb[None, :] == 0) | (jb[None, :] == cur[:, None]) | (jb[None, :] == cur[:, None] - 1)
    imp = jnp.where(forced, jnp.inf, jnp.where(valid, imp, -jnp.inf))
    n_top = min(SEL_TOP, n_sel)
    _, sel_idx = lax.top_k(imp, n_top)

    qh = qg.transpose(0, 2, 3, 1, 4) * scale
    ks_blk = ks.transpose(0, 2, 1, 3).reshape(bsz, ng, n_sel, SEL_BLOCK, dh)
    vs_blk = vs.transpose(0, 2, 1, 3).reshape(bsz, ng, n_sel, SEL_BLOCK, dh)
    pad = ((0, 0), (0, 0), (WINDOW, 0), (0, 0))
    kw_pad = jnp.pad(kw.transpose(0, 2, 1, 3), pad)
    vw_pad = jnp.pad(vw.transpose(0, 2, 1, 3), pad)
    b_ix = jnp.arange(bsz)[:, None, None, None]
    g_ix = jnp.arange(ng)[None, :, None, None]

    def block(qb):
        q0 = qb * Q_BLOCK
        qblk = lax.dynamic_slice_in_dim(qh, q0, Q_BLOCK, axis=3)
        tq = q0 + jnp.arange(Q_BLOCK)
        idx = lax.dynamic_slice_in_dim(sel_idx, q0, Q_BLOCK, axis=2)
        kg = ks_blk[b_ix, g_ix, idx]
        vg = vs_blk[b_ix, g_ix, idx]
        tok_pos = idx[..., None] * SEL_BLOCK + jnp.arange(SEL_BLOCK)
        smask = (tok_pos <= tq[:, None, None]).reshape(bsz, ng, 1, Q_BLOCK, n_top * SEL_BLOCK)
        s_sel = jnp.einsum('bgqtd,bgtkld->bgqtkl', qblk, kg).reshape(bsz, ng, hpg, Q_BLOCK, n_top * SEL_BLOCK)
        p_sel = masked_softmax(s_sel, smask).reshape(bsz, ng, hpg, Q_BLOCK, n_top, SEL_BLOCK)
        o_sel = jnp.einsum('bgqtkl,bgtkld->bgqtd', p_sel.astype(vg.dtype), vg)
        kwb = lax.dynamic_slice_in_dim(kw_pad, q0, Q_BLOCK + WINDOW, axis=2)
        vwb = lax.dynamic_slice_in_dim(vw_pad, q0, Q_BLOCK + WINDOW, axis=2)
        kpos = q0 - WINDOW + jnp.arange(Q_BLOCK + WINDOW)
        dlt = tq[:, None] - kpos[None, :]
        wmask = (dlt >= 0) & (dlt < WINDOW) & (kpos[None, :] >= 0)
        s_win = jnp.einsum('bgqtd,bgkd->bgqtk', qblk, kwb)
        p_win = masked_softmax(s_win, wmask)
        o_win = jnp.einsum('bgqtk,bgkd->bgqtd', p_win.astype(vwb.dtype), vwb)
        return o_sel, o_win

    o_sel, o_win = lax.map(block, jnp.arange(s // Q_BLOCK))
    unblock = lambda o: o.transpose(1, 0, 4, 2, 3, 5).reshape(bsz, s, nh, dh)
    o_sel, o_win = unblock(o_sel), unblock(o_win)
    gt = jax.nn.sigmoid(gates.reshape(bsz, s, nh, 3))
    o = gt[..., 0:1] * o_cmp + gt[..., 1:2] * o_sel + gt[..., 2:3] * o_win
    return o.reshape(bsz, s, nh * dh)


def hybrid_mixer(h, positions, w_in, sc_conv, rw_mu, rw_w0, rw_w2, rw_a0, rw_a2, rw_g2,
                 rw_k_k, rw_k_a, rw_r_k, rw_lnx_g, rw_lnx_b, nsa_cmp_pos, nsa_cmp_w1, nsa_cmp_w2,
                 w_branch, w_out):
    z = h @ w_in
    z_sc, z_rw, z_ret, z_nsa, z_gate = _split(z, GROUP_SIZES)
    o_a = short_conv_mixer(*_split(z_sc, SC_SIZES), sc_conv)
    o_b = rwkv7_mixer(z_rw, rw_mu, rw_w0, rw_w2, rw_a0, rw_a2, rw_g2, rw_k_k, rw_k_a, rw_r_k, rw_lnx_g, rw_lnx_b)
    o_c = retention_mixer(*_split(z_ret, RET_SIZES), positions)
    o_d = nsa_mixer(*_split(z_nsa, NSA_SIZES), positions, nsa_cmp_pos, nsa_cmp_w1, nsa_cmp_w2)
    g_a, g_b, g_c, g_d = [jax.nn.sigmoid(g) for g in _split(z_gate, GATE_SIZES)]
    w_a, w_b, w_c, w_d = _split(w_branch, BR_SIZES, axis=0)
    merged = g_a * (o_a @ w_a) + g_b * (o_b @ w_b) + g_c * (o_c @ w_c) + g_d * (o_d @ w_d)
    return merged @ w_out


def memory_cross_attention(h, mem_n, wq, wkv, wo):
    bsz, s, _ = h.shape
    m = mem_n.shape[1]
    q = (h @ wq).reshape(bsz, s, MEM_HEADS, MEM_HEAD_DIM)
    k, v = jnp.split(mem_n @ wkv, 2, axis=-1)
    k = k.reshape(bsz, m, MEM_HEADS, MEM_HEAD_DIM)
    v = v.reshape(bsz, m, MEM_HEADS, MEM_HEAD_DIM)
    sc = jnp.einsum('bshd,bmhd->bhsm', q, k) * (MEM_HEAD_DIM ** -0.5)
    p = jax.nn.softmax(sc.astype(jnp.float32), axis=-1).astype(v.dtype)
    o = jnp.einsum('bhsm,bmhd->bshd', p, v).reshape(bsz, s, D_MODEL)
    return o @ wo


def conv_ffn(h, w_up, w_conv, b_conv, w_down):
    u = causal_dwconv(h @ w_up, w_conv) + b_conv
    a, b = jnp.split(u, 2, axis=-1)
    return (jax.nn.gelu(a, approximate=True) * b) @ w_down


def setup_inputs(seed: int = 0) -> dict:
    key = jax.random.key(seed)
    ks = iter(jax.random.split(key, 40))
    nrm = lambda shape, sc: sc * jax.random.normal(next(ks), shape, jnp.float32)
    gain = lambda shape: 1.0 + nrm(shape, 0.05)
    L = DEPTH
    return {
        "x": nrm((BATCH, SEQ, D_MODEL), 1.0),
        "mem": nrm((BATCH, MEM_LEN, D_MODEL), 1.0),
        "positions": jnp.tile(jnp.arange(SEQ, dtype=jnp.int32)[None, :], (BATCH, 1)),
        "ln_mix_pre": gain((L, D_MODEL)),
        "ln_mix_post": gain((L, D_MODEL)),
        "ln_mem_q": gain((L, D_MODEL)),
        "ln_mem_kv": gain((L, D_MODEL)),
        "ln_mem_post": gain((L, D_MODEL)),
        "ln_ffn_pre": gain((L, D_MODEL)),
        "ln_ffn_post": gain((L, D_MODEL)),
        "w_in": nrm((L, D_MODEL, N_IN), D_MODEL ** -0.5),
        "sc_conv": nrm((L, SC_K, SC_W), SC_K ** -0.5),
        "rw_mu": jax.random.uniform(next(ks), (L, RW_TOTAL), jnp.float32),
        "rw_w0": nrm((L, RW_W), 1.0),
        "rw_w2": nrm((L, RW_LORA_W, RW_W), 0.1),
        "rw_a0": nrm((L, RW_W), 0.5),
        "rw_a2": nrm((L, RW_LORA_A, RW_W), 0.5 * RW_LORA_A ** -0.5),
        "rw_g2": nrm((L, RW_LORA_G, RW_W), RW_LORA_G ** -0.5),
        "rw_k_k": 0.85 + nrm((L, RW_W), 0.05),
        "rw_k_a": 1.0 + nrm((L, RW_W), 0.05),
        "rw_r_k": nrm((L, RW_HEADS, RW_HEAD_DIM), 0.1),
        "rw_lnx_g": gain((L, RW_W)),
        "rw_lnx_b": nrm((L, RW_W), 0.01),
        "nsa_cmp_pos": nrm((L, 2, CMP_LEN, NSA_DH), 0.1),
        "nsa_cmp_w1": nrm((L, 2, CMP_LEN * NSA_DH, CMP_HIDDEN), (CMP_LEN * NSA_DH) ** -0.5),
        "nsa_cmp_w2": nrm((L, 2, CMP_HIDDEN, NSA_DH), CMP_HIDDEN ** -0.5),
        "w_branch": nrm((L, N_BR, D_MODEL), SC_W ** -0.5),
        "w_out": nrm((L, D_MODEL, D_MODEL), D_MODEL ** -0.5),
        "mem_wq": nrm((L, D_MODEL, D_MODEL), D_MODEL ** -0.5),
        "mem_wkv": nrm((L, D_MODEL, 2 * D_MODEL), D_MODEL ** -0.5),
        "mem_wo": nrm((L, D_MODEL, D_MODEL), D_MODEL ** -0.5),
        "ffn_w_up": nrm((L, D_MODEL, 2 * FFN_DIM), D_MODEL ** -0.5),
        "ffn_conv_w": nrm((L, FFN_K, 2 * FFN_DIM), FFN_K ** -0.5),
        "ffn_conv_b": nrm((L, 2 * FFN_DIM), 0.01),
        "ffn_w_down": nrm((L, FFN_DIM, D_MODEL), FFN_DIM ** -0.5),
    }


def reference(x, mem, positions, ln_mix_pre, ln_mix_post, ln_mem_q, ln_mem_kv, ln_mem_post,
              ln_ffn_pre, ln_ffn_post, w_in, sc_conv, rw_mu, rw_w0, rw_w2, rw_a0, rw_a2, rw_g2,
              rw_k_k, rw_k_a, rw_r_k, rw_lnx_g, rw_lnx_b, nsa_cmp_pos, nsa_cmp_w1, nsa_cmp_w2,
              w_branch, w_out, mem_wq, mem_wkv, mem_wo, ffn_w_up, ffn_conv_w, ffn_conv_b, ffn_w_down):
    for l in range(DEPTH):
        h = rms_norm(x, ln_mix_pre[l])
        y = hybrid_mixer(h, positions, w_in[l], sc_conv[l], rw_mu[l], rw_w0[l], rw_w2[l], rw_a0[l],
                         rw_a2[l], rw_g2[l], rw_k_k[l], rw_k_a[l], rw_r_k[l], rw_lnx_g[l], rw_lnx_b[l],
                         nsa_cmp_pos[l], nsa_cmp_w1[l], nsa_cmp_w2[l], w_branch[l], w_out[l])
        x = x + rms_norm(y, ln_mix_post[l])
        h = rms_norm(x, ln_mem_q[l])
        y = memory_cross_attention(h, rms_norm(mem, ln_mem_kv[l]), mem_wq[l], mem_wkv[l], mem_wo[l])
        x = x + rms_norm(y, ln_mem_post[l])
        h = rms_norm(x, ln_ffn_pre[l])
        y = conv_ffn(h, ffn_w_up[l], ffn_conv_w[l], ffn_conv_b[l], ffn_w_down[l])
        x = x + rms_norm(y, ln_ffn_post[l])
    return x
```

```cpp
#include <hip/hip_runtime.h>
#include <cstdio>
#include <cstdint>
#include <cstring>

#define LAS __attribute__((address_space(3)))
typedef unsigned short bf16_t;
typedef short bf16x8 __attribute__((ext_vector_type(8)));
typedef float f32x4 __attribute__((ext_vector_type(4)));
typedef float f32x2 __attribute__((ext_vector_type(2)));
typedef unsigned u32x4 __attribute__((ext_vector_type(4)));
typedef unsigned u32x2 __attribute__((ext_vector_type(2)));
typedef unsigned long long u64;

constexpr int D = 2048, BATCH = 2, SEQ = 4096, M = BATCH * SEQ, DEPTH = 2;
constexpr int NZ = 16384;
constexpr int N_IN = 16088;
constexpr int ZC_SC_B = 0, ZC_SC_C = 512, ZC_SC_X = 1024;
constexpr int ZC_RW = 1536;
constexpr int ZC_RW_R = 1536, ZC_RW_K = 2048, ZC_RW_V = 2560, ZC_RW_ZW = 3072, ZC_RW_ZA = 3168, ZC_RW_ZG = 3264;
constexpr int ZC_RET_Q = 3584, ZC_RET_K = 4096, ZC_RET_V = 4608, ZC_RET_G = 5632;
constexpr int ZC_NSA_Q = 6656, ZC_NSA_KC = 7168, ZC_NSA_VC = 7296, ZC_NSA_KS = 7424, ZC_NSA_VS = 7552, ZC_NSA_KW = 7680, ZC_NSA_VW = 7808, ZC_NSA_GT = 7936;
constexpr int ZC_GATE = 8192;
constexpr int NBR = 2560;
constexpr int FFN = 5632, FFN2 = 11264;
constexpr int MEM = 256;

constexpr size_t MiB = 1u << 20;
constexpr size_t WS_CTL = 0;
constexpr size_t WS_W_IN = 1 * MiB, WS_W_BR = 65 * MiB, WS_W_OUT = 75 * MiB, WS_W_Q = 83 * MiB, WS_W_KV = 91 * MiB, WS_W_O = 107 * MiB;
constexpr size_t WS_W_UP = 115 * MiB, WS_W_DN = 159 * MiB, WS_W_LORA = 181 * MiB, WS_W_C1 = 183 * MiB;
constexpr size_t WS_CBIAS = 185 * MiB, WS_MEMN = 186 * MiB, WS_KMEM = 188 * MiB, WS_VTM = 190 * MiB;
constexpr size_t WS_H = 192 * MiB, WS_Z = 224 * MiB, WS_OALL = 480 * MiB, WS_MERGED = 520 * MiB, WS_MERGEDB = 584 * MiB, WS_Y = 616 * MiB;
constexpr size_t WS_T = 680 * MiB;
constexpr size_t WS_ALORA = WS_T, WS_LO = WS_T + 8 * MiB, WS_RWOPS = WS_T + 56 * MiB, WS_YSCAN = WS_T + 152 * MiB;
constexpr size_t WS_QR = WS_T + 168 * MiB, WS_KR = WS_T + 176 * MiB, WS_UBUF = WS_T + 184 * MiB, WS_RPREV = WS_T + 216 * MiB;
constexpr size_t WS_QN = WS_T + 232 * MiB, WS_KVG = WS_T + 240 * MiB, WS_HID = WS_T + 253 * MiB, WS_KCMP = WS_T + 254 * MiB, WS_VCMPT = WS_T + 254 * MiB + 512 * 1024;
constexpr size_t WS_OCMP = WS_T + 255 * MiB, WS_SELM = WS_T + 263 * MiB;
constexpr size_t WS_END = WS_T + 264 * MiB;
constexpr size_t WS_QX = WS_Z, WS_SC = WS_Z + 32 * MiB, WS_PB = WS_Z + 64 * MiB, WS_OX = WS_Z + 80 * MiB;
constexpr size_t WS_U = WS_Z, WS_GACT = WS_T;
constexpr size_t KVG_SLAB = (size_t)BATCH * 2 * SEQ * 64;

constexpr int LDS_BYTES = 147456;

struct Params {
    const float* in[35];
    float* out;
    unsigned char* ws;
};

__device__ __forceinline__ int otid() { int t = (int)threadIdx.x; asm volatile("" : "+v"(t)); return t; }
__device__ __forceinline__ float bf2f(bf16_t v) { return __uint_as_float((unsigned)v << 16); }
__device__ __forceinline__ unsigned cvt_pk_bf16(float lo, float hi) { unsigned r; asm volatile("v_cvt_pk_bf16_f32 %0, %1, %2" : "=v"(r) : "v"(lo), "v"(hi)); return r; }
__device__ __forceinline__ bf16_t f2bf(float f) { return (bf16_t)(cvt_pk_bf16(f, 0.f) & 0xffffu); }
__device__ __forceinline__ float wave_sum(float v) {
#pragma unroll
    for (int o = 1; o < 64; o <<= 1) v += __shfl_xor(v, o);
    return v;
}
__device__ __forceinline__ float sigmoidf_(float x) { return 1.f / (1.f + __expf(-x)); }
__device__ __forceinline__ float gelu_tanh(float x) { const float u = 1.5957691216057308f * (x + 0.044715f * x * x * x); return x / (1.f + __expf(-u)); }
__device__ __forceinline__ f32x4 mma16(f32x4 acc, bf16x8 a_rowfrag, bf16x8 b_colfrag) {
    return __builtin_amdgcn_mfma_f32_16x16x32_bf16(b_colfrag, a_rowfrag, acc, 0, 0, 0);
}
__device__ __forceinline__ bf16x8 ldfrag(const bf16_t* p) { return *(const bf16x8*)p; }

namespace pg8 {
constexpr int BM = 256, BK = 64, HALF = 128, HTB = HALF * BK * 2, STAGE_BYTES = 8 * HTB, NXCD = 8, WGM = 8;
__host__ __device__ __forceinline__ int lds_byte(int r, int c) { const int st = (r >> 4) * 2 + (c >> 5), rr = r & 15, cc = c & 31, ob = rr * 64 + cc * 2; return st * 1024 + (ob ^ (((ob >> 9) & 1) << 5)); }
__host__ __device__ __forceinline__ void stage_rc(int b, int& R, int& C) { const int st = b / 1024, sb = b % 1024, swz = sb ^ (((sb >> 9) & 1) << 5); R = (st >> 1) * 16 + swz / 64; C = (st & 1) * 32 + (swz % 64) / 2; }
__host__ __device__ __forceinline__ int perm32(int rho) { const int n = rho >> 4, i = rho & 15; return 8 * (i >> 2) + 4 * n + (i & 3); }

struct Unit { const char* A; const char* B; size_t ooff; int pm, pn, z; };

struct GSched {
    const char* A; const char* B;
    long a_pm, b_pn;
    long a_z1, a_z2, b_z1, b_z2;
    long o_pm, o_pn, o_z1, o_z2;
    int nM, nN, nZ1, nZ2, G, c;
    __device__ __forceinline__ bool next(int i, Unit& u) const {
        const int per = nM * nN; const long L = (long)i * G + c; if (L >= (long)per * nZ1 * nZ2) return false;
        const int zz = (int)(L / per); int wgid = (int)(L % per);
        { const int q = per / NXCD, r = per % NXCD, xcd = wgid % NXCD, off = wgid / NXCD; wgid = (xcd < r ? xcd * (q + 1) : r * (q + 1) + (xcd - r) * q) + off; }
        const int nig = WGM * nN, gid = wgid / nig, fm = gid * WGM, gsz = (nM - fm) < WGM ? (nM - fm) : WGM;
        const int pm = fm + ((wgid % nig) % gsz), pn = (wgid % nig) / gsz;
        const int z1 = zz / nZ2, z2 = zz % nZ2;
        u.pm = pm; u.pn = pn; u.z = zz;
        u.A = A + z1 * a_z1 + z2 * a_z2 + pm * a_pm; u.B = B + z1 * b_z1 + z2 * b_z2 + pn * b_pn;
        u.ooff = (size_t)(z1 * o_z1 + z2 * o_z2 + pm * o_pm + pn * o_pn);
        return true;
    }
};
__device__ __forceinline__ GSched make_sched(const void* A, int lda, const void* B, int ldb, int nM, int nN, long ldc, int bi, int nb) {
    GSched s; s.A = (const char*)A; s.B = (const char*)B; s.a_pm = (long)BM * lda * 2; s.b_pn = (long)BM * ldb * 2; s.a_z1 = s.a_z2 = s.b_z1 = s.b_z2 = 0;
    s.o_pm = (long)BM * ldc; s.o_pn = BM; s.o_z1 = s.o_z2 = 0; s.nM = nM; s.nN = nN; s.nZ1 = 1; s.nZ2 = 1; s.G = nb; s.c = bi; return s;
}

template <class Epi, class Sched>
__device__ __forceinline__ void gemm_phase(LAS unsigned char* lds, const int lda, const int ldb, const int K, const Sched& S, const Epi& E) {
    const int tid = otid(), wid = __builtin_amdgcn_readfirstlane(tid >> 6), lane = tid & 63, wr = wid >> 2, wc = wid & 3, fr = lane & 15, fq = lane >> 4;
    const int nt = K / BK;
    unsigned voffA[2], voffB[2];
#pragma unroll
    for (int i = 0; i < 2; ++i) { int R, C; stage_rc(tid * 16 + i * 8192, R, C); const int Rb = Epi::PERM ? ((R & ~31) + perm32(R & 31)) : R;
        voffA[i] = (unsigned)(R * lda + C) * 2u; voffB[i] = (unsigned)(Rb * ldb + C) * 2u; }
    const size_t kstep = (size_t)(BK * 2);
    const size_t hstepA = (size_t)HALF * lda * 2, hstepB = (size_t)HALF * ldb * 2;
    const unsigned ldsw = (unsigned)wid * 1024u;
    const int aoff = lds_byte(wr * 64 + fr, fq * 8), boff = lds_byte(wc * 32 + fr, fq * 8);
#define PG8_SA(b, h) (((b) * 2 + (h)) * HTB)
#define PG8_SB(b, h) ((4 + (b) * 2 + (h)) * HTB)
#define PG8_STAGE(bufoff, gbase, voff) do { _Pragma("unroll") for (int _i = 0; _i < 2; ++_i) \
        __builtin_amdgcn_global_load_lds((const unsigned*)((const char*)(gbase) + (voff)[_i]), (LAS unsigned*)(lds + (bufoff) + ldsw + _i * 8192), 16, 0, 0); } while (0)
#define PG8_LDA(dst, b, h) do { _Pragma("unroll") for (int m = 0; m < 4; ++m) _Pragma("unroll") for (int k = 0; k < 2; ++k) dst[m][k] = *(const LAS bf16x8*)(lds + PG8_SA(b, h) + aoff + m * 2048 + k * 1024); } while (0)
#define PG8_LDB(dst, b, h) do { _Pragma("unroll") for (int n = 0; n < 2; ++n) _Pragma("unroll") for (int k = 0; k < 2; ++k) dst[n][k] = *(const LAS bf16x8*)(lds + PG8_SB(b, h) + boff + n * 2048 + k * 1024); } while (0)
#define PG8_MMA(ai, bj, At, Bt) do { __builtin_amdgcn_s_setprio(1); _Pragma("unroll") for (int m = 0; m < 4; ++m) _Pragma("unroll") for (int n = 0; n < 2; ++n) _Pragma("unroll") for (int k = 0; k < 2; ++k) \
        acc[ai][bj][m][n] = __builtin_amdgcn_mfma_f32_16x16x32_bf16(Bt[n][k], At[m][k], acc[ai][bj][m][n], 0, 0, 0); __builtin_amdgcn_s_setprio(0); } while (0)
#define PG8_WAIT_V(n) asm volatile("s_waitcnt vmcnt(" #n ")" ::: "memory")
#define PG8_WAIT_L(n) asm volatile("s_waitcnt lgkmcnt(" #n ")" ::: "memory")
#define PG8_BAR __builtin_amdgcn_s_barrier()
#define PG8_SCHED __builtin_amdgcn_sched_barrier(0)
    Unit cur, nxt; int ui = 0;
    if (!S.next(0, cur)) return;
    f32x4 acc[2][2][4][2];
#pragma unroll
    for (int a = 0; a < 2; ++a)
#pragma unroll
        for (int b = 0; b < 2; ++b)
#pragma unroll
            for (int m = 0; m < 4; ++m)
#pragma unroll
                for (int n = 0; n < 2; ++n) acc[a][b][m][n] = (f32x4){0.f, 0.f, 0.f, 0.f};
    bf16x8 At[4][2], B0[2][2], B1[2][2];
    const char* cA = cur.A; const char* cB = cur.B;
    PG8_STAGE(PG8_SB(0, 0), cB, voffB); PG8_STAGE(PG8_SB(0, 1), cB + hstepB, voffB); PG8_STAGE(PG8_SA(0, 0), cA, voffA); PG8_STAGE(PG8_SA(0, 1), cA + hstepA, voffA);
    if (wr == 1) PG8_BAR;
    PG8_WAIT_V(2); PG8_BAR;
    PG8_STAGE(PG8_SB(1, 0), cB + kstep, voffB); PG8_STAGE(PG8_SA(1, 0), cA + kstep, voffA); PG8_STAGE(PG8_SB(1, 1), cB + hstepB + kstep, voffB);
    PG8_WAIT_V(6); PG8_BAR;
    for (;;) {
        const bool has_next = S.next(ui + 1, nxt);
        const char* nA = has_next ? nxt.A : cA; const char* nB = has_next ? nxt.B : cB;
        for (int t = 0; t < nt; t += 2) {
            const bool last = (t == nt - 2);
            const char* a1 = cA + (size_t)(t + 1) * kstep;
            const char* a2 = last ? nA : cA + (size_t)(t + 2) * kstep; const char* b2 = last ? nB : cB + (size_t)(t + 2) * kstep;
            const char* a3 = a2 + kstep; const char* b3 = b2 + kstep;
            PG8_LDB(B0, 0, 0); PG8_LDB(B1, 0, 1); PG8_SCHED; PG8_LDA(At, 0, 0); PG8_STAGE(PG8_SA(1, 1), a1 + hstepA, voffA);
            PG8_WAIT_V(8); PG8_WAIT_L(0); PG8_BAR; PG8_MMA(0, 0, At, B0); PG8_MMA(0, 1, At, B1); PG8_BAR; PG8_SCHED;
            PG8_LDA(At, 0, 1); PG8_STAGE(PG8_SB(0, 0), b2, voffB); PG8_STAGE(PG8_SB(0, 1), b2 + hstepB, voffB); PG8_STAGE(PG8_SA(0, 0), a2, voffA);
            PG8_WAIT_V(8); PG8_WAIT_L(0); PG8_BAR; PG8_MMA(1, 0, At, B0); PG8_MMA(1, 1, At, B1); PG8_BAR; PG8_SCHED;
            PG8_LDB(B0, 1, 0); PG8_LDB(B1, 1, 1); PG8_SCHED; PG8_LDA(At, 1, 0); PG8_STAGE(PG8_SA(0, 1), a2 + hstepA, voffA);
            PG8_WAIT_V(8); PG8_WAIT_L(0); PG8_BAR; PG8_MMA(0, 0, At, B0); PG8_MMA(0, 1, At, B1); PG8_BAR; PG8_SCHED;
            PG8_LDA(At, 1, 1); PG8_STAGE(PG8_SB(1, 0), b3, voffB); PG8_STAGE(PG8_SB(1, 1), b3 + hstepB, voffB); PG8_STAGE(PG8_SA(1, 0), a3, voffA);
            PG8_WAIT_V(8); PG8_WAIT_L(0); PG8_BAR; PG8_MMA(1, 0, At, B0); PG8_MMA(1, 1, At, B1); PG8_BAR; PG8_SCHED;
        }
        if (wr == 0) PG8_BAR;
        E(acc, cur, wr, wc, fr, fq);
        if (!has_next) break;
#pragma unroll
        for (int a = 0; a < 2; ++a)
#pragma unroll
            for (int b = 0; b < 2; ++b)
#pragma unroll
                for (int m = 0; m < 4; ++m)
#pragma unroll
                    for (int n = 0; n < 2; ++n) acc[a][b][m][n] = (f32x4){0.f, 0.f, 0.f, 0.f};
        cur = nxt; cA = nA; cB = nB; ++ui;
        if (wr == 1) PG8_BAR;
    }
    PG8_WAIT_V(0);
    PG8_BAR;
#undef PG8_SA
#undef PG8_SB
#undef PG8_STAGE
#undef PG8_LDA
#undef PG8_LDB
#undef PG8_MMA
#undef PG8_WAIT_V
#undef PG8_WAIT_L
#undef PG8_BAR
#undef PG8_SCHED
}

template <int ACT> struct EpiBf16 {
    static constexpr bool PERM = true;
    bf16_t* O; int ldc; const float* bias;
    __device__ __forceinline__ void operator()(const f32x4 (&acc)[2][2][4][2], const Unit& u, int wr, int wc, int fr, int fq) const {
        bf16_t* base = O + u.ooff; const int col0 = wc * 32 + 8 * fq;
#pragma unroll
        for (int ai = 0; ai < 2; ++ai)
#pragma unroll
            for (int m = 0; m < 4; ++m) { bf16_t* rowp = base + (size_t)(ai * HALF + wr * 64 + m * 16 + fr) * ldc + col0;
#pragma unroll
                for (int bj = 0; bj < 2; ++bj) { f32x4 v0 = acc[ai][bj][m][0], v1 = acc[ai][bj][m][1];
                    if (ACT == 1) { const float* bp = bias + u.pn * BM + col0 + bj * HALF; const f32x4 b0 = *(const f32x4*)bp, b1 = *(const f32x4*)(bp + 4);
                        v0 += b0; v1 += b1;
#pragma unroll
                        for (int j = 0; j < 4; ++j) { v0[j] = gelu_tanh(v0[j]); v1[j] = gelu_tanh(v1[j]); } }
                    u32x4 w; w.x = cvt_pk_bf16(v0[0], v0[1]); w.y = cvt_pk_bf16(v0[2], v0[3]); w.z = cvt_pk_bf16(v1[0], v1[1]); w.w = cvt_pk_bf16(v1[2], v1[3]);
                    *(u32x4*)(rowp + bj * HALF) = w; } }
    }
};
struct EpiF32 {
    static constexpr bool PERM = false;
    float* C; int ldc; float scale;
    __device__ __forceinline__ void operator()(const f32x4 (&acc)[2][2][4][2], const Unit& u, int wr, int wc, int fr, int fq) const {
        float* base = C + u.ooff; const int col0 = wc * 32 + 4 * fq;
#pragma unroll
        for (int ai = 0; ai < 2; ++ai)
#pragma unroll
            for (int m = 0; m < 4; ++m) { float* rowp = base + (size_t)(ai * HALF + wr * 64 + m * 16 + fr) * ldc + col0;
#pragma unroll
                for (int bj = 0; bj < 2; ++bj)
#pragma unroll
                    for (int n = 0; n < 2; ++n) *(f32x4*)(rowp + bj * HALF + n * 16) = acc[ai][bj][m][n] * scale; }
    }
};
struct EpiBranch {
    static constexpr bool PERM = false;
    float* merged; bf16_t* mergedb; const bf16_t* gate; int first, last;
    __device__ __forceinline__ void operator()(const f32x4 (&acc)[2][2][4][2], const Unit& u, int wr, int wc, int fr, int fq) const {
        const int col0 = u.pn * BM + wc * 32 + 4 * fq;
#pragma unroll
        for (int ai = 0; ai < 2; ++ai)
#pragma unroll
            for (int m = 0; m < 4; ++m) { const size_t row = (size_t)(u.pm * BM + ai * HALF + wr * 64 + m * 16 + fr);
#pragma unroll
                for (int bj = 0; bj < 2; ++bj)
#pragma unroll
                    for (int n = 0; n < 2; ++n) { const int col = col0 + bj * HALF + n * 16;
                        const u32x2 gw = *(const u32x2*)(gate + row * NZ + col);
                        f32x4 g; g[0] = sigmoidf_(__uint_as_float(gw.x << 16)); g[1] = sigmoidf_(__uint_as_float(gw.x & 0xffff0000u)); g[2] = sigmoidf_(__uint_as_float(gw.y << 16)); g[3] = sigmoidf_(__uint_as_float(gw.y & 0xffff0000u));
                        f32x4 v = acc[ai][bj][m][n] * g;
                        if (!first) v += *(const f32x4*)(merged + row * D + col);
                        if (last) { u32x2 w; w.x = cvt_pk_bf16(v[0], v[1]); w.y = cvt_pk_bf16(v[2], v[3]); *(u32x2*)(mergedb + row * D + col) = w; }
                        else *(f32x4*)(merged + row * D + col) = v; } }
    }
};
struct EpiC1 { static constexpr bool PERM = true; bf16_t* O; const float* bias;
    __device__ __forceinline__ void operator()(const f32x4 (&acc)[2][2][4][2], const Unit& u, int wr, int wc, int fr, int fq) const { EpiBf16<1> e{O, 256, bias + (u.z >> 2) * 256}; e(acc, u, wr, wc, fr, fq); } };
}

__device__ __forceinline__ void ph_norm_rows(const float* x, const float* g, bf16_t* out, int rows, int bi, int nb) {
    const int tid_ = otid(), lane = tid_ & 63, gw = bi * 8 + (tid_ >> 6), NGW = nb * 8;
    for (int m = gw; m < rows; m += NGW) {
        const f32x4* xr = (const f32x4*)(x + (size_t)m * D) + lane; f32x4 v[8]; float s = 0.f;
#pragma unroll
        for (int j = 0; j < 8; ++j) { v[j] = xr[64 * j]; s += v[j][0] * v[j][0] + v[j][1] * v[j][1] + v[j][2] * v[j][2] + v[j][3] * v[j][3]; }
        const float rstd = rsqrtf(wave_sum(s) * (1.f / D) + 1e-6f);
        u32x2* o = (u32x2*)(out + (size_t)m * D) + lane;
#pragma unroll
        for (int j = 0; j < 8; ++j) { const f32x4 gg = ((const f32x4*)g)[lane + 64 * j]; u32x2 w; w.x = cvt_pk_bf16(v[j][0] * rstd * gg[0], v[j][1] * rstd * gg[1]); w.y = cvt_pk_bf16(v[j][2] * rstd * gg[2], v[j][3] * rstd * gg[3]); o[64 * j] = w; }
    }
}
__device__ __forceinline__ void ph_finish(const float* xin, const float* y, const float* g1, const float* g2, float* xout, bf16_t* h, int bi, int nb) {
    const int tid_ = otid(), lane = tid_ & 63, gw = bi * 8 + (tid_ >> 6), NGW = nb * 8;
    for (int m = gw; m < M; m += NGW) {
        const f32x4* yr = (const f32x4*)(y + (size_t)m * D) + lane; const f32x4* xr = (const f32x4*)(xin + (size_t)m * D) + lane; f32x4 v[8]; float s = 0.f;
#pragma unroll
        for (int j = 0; j < 8; ++j) { v[j] = yr[64 * j]; s += v[j][0] * v[j][0] + v[j][1] * v[j][1] + v[j][2] * v[j][2] + v[j][3] * v[j][3]; }
        const float rstd = rsqrtf(wave_sum(s) * (1.f / D) + 1e-6f); float s2 = 0.f;
        f32x4* xo = (f32x4*)(xout + (size_t)m * D) + lane;
#pragma unroll
        for (int j = 0; j < 8; ++j) { const f32x4 gg = ((const f32x4*)g1)[lane + 64 * j]; const f32x4 xv = xr[64 * j];
            v[j] = xv + v[j] * rstd * gg; xo[64 * j] = v[j]; s2 += v[j][0] * v[j][0] + v[j][1] * v[j][1] + v[j][2] * v[j][2] + v[j][3] * v[j][3]; }
        if (g2) { const float r2 = rsqrtf(wave_sum(s2) * (1.f / D) + 1e-6f); u32x2* o = (u32x2*)(h + (size_t)m * D) + lane;
#pragma unroll
            for (int j = 0; j < 8; ++j) { const f32x4 gg = ((const f32x4*)g2)[lane + 64 * j]; u32x2 w; w.x = cvt_pk_bf16(v[j][0] * r2 * gg[0], v[j][1] * r2 * gg[1]); w.y = cvt_pk_bf16(v[j][2] * r2 * gg[2], v[j][3] * r2 * gg[3]); o[64 * j] = w; } }
    }
}

enum { MAP_ID = 0, MAP_WIN = 1, MAP_UP = 2 };
__device__ __forceinline__ int cmap(int kind, int n) {
    if (kind == MAP_ID) return n;
    if (kind == MAP_WIN) { if (n < 3520) return n; if (n < 3584) return -1; if (n < 6656) return n - 64; if (n < 7960) return n - 64; if (n < 8192) return -1; return n - 296; }
    const int j = n >> 8, s = n & 255; return s < 128 ? 128 * j + s : FFN + 128 * j + (s - 128);
}
__device__ __forceinline__ void transpose_item(const float* W, int K, int Nsrc, bf16_t* WT, int kind, LAS float* scr, int item, int nblk, int lane) {
    const int kb = item / nblk, nb_ = item % nblk, k0 = 64 * kb, n0 = 32 * nb_;
    const int src = cmap(kind, n0 + (lane & 31));
#pragma unroll 8
    for (int i = 0; i < 32; ++i) { const int kk = 2 * i + (lane >> 5); scr[kk * 33 + (lane & 31)] = src >= 0 ? W[(size_t)(k0 + kk) * Nsrc + src] : 0.f; }
    asm volatile("s_waitcnt lgkmcnt(0)" ::: "memory");
    const int c = lane & 7;
#pragma unroll
    for (int j = 0; j < 4; ++j) { const int n = (lane >> 3) + 8 * j; const LAS float* s = scr + (8 * c) * 33 + n;
        u32x4 o; o.x = cvt_pk_bf16(s[0 * 33], s[1 * 33]); o.y = cvt_pk_bf16(s[2 * 33], s[3 * 33]); o.z = cvt_pk_bf16(s[4 * 33], s[5 * 33]); o.w = cvt_pk_bf16(s[6 * 33], s[7 * 33]);
        *(u32x4*)(WT + (size_t)(n0 + n) * K + k0 + 8 * c) = o; }
    asm volatile("s_waitcnt lgkmcnt(0)" ::: "memory");
}
__device__ __forceinline__ unsigned char* ws_lds() {
    volatile LAS unsigned* q = (volatile LAS unsigned*)(LDS_BYTES - 8); unsigned lo = q[0], hi = q[1];
    lo = (unsigned)__builtin_amdgcn_readfirstlane((int)lo); hi = (unsigned)__builtin_amdgcn_readfirstlane((int)hi); return (unsigned char*)(((u64)hi << 32) | (u64)lo); }
#define PROLOG unsigned char* const wsl = ws_lds()
#define WS_PTRTAB 256
#define inp(p_, i) (((const float* const*)(wsl + WS_PTRTAB))[i])
#define OUTP ((float*)(((const float* const*)(wsl + WS_PTRTAB))[35]))
#define WSP(T, off) ((T*)(wsl + (off)))
#define INL(i, per) (inp(p, i) + (size_t)l * (per))

__device__ __forceinline__ void ph_convert(const Params& p, int l, LAS unsigned char* lds, int bi, int nb) {
    PROLOG;
    const int tid_ = otid(), lane = tid_ & 63, wave = tid_ >> 6, gw = bi * 8 + wave, NGW = nb * 8;
    LAS float* scr = (LAS float*)(lds + wave * 16384);
    const int I0 = 32 * 512, I1 = 40 * 64, I2 = 32 * 64, I3 = 32 * 128, I4 = 32 * 352, I5 = 88 * 64, I6 = 32 * 8;
    const int NIT = I0 + I1 + 3 * I2 + I3 + I4 + I5 + 2 * I6;
    for (int it = gw; it < NIT; it += NGW) {
        int r = it;
        if (r < I0) { transpose_item(INL(10, (size_t)D * N_IN), D, N_IN, WSP(bf16_t, WS_W_IN), MAP_WIN, scr, r, 512, lane); continue; } r -= I0;
        if (r < I1) { transpose_item(INL(26, (size_t)NBR * D), NBR, D, WSP(bf16_t, WS_W_BR), MAP_ID, scr, r, 64, lane); continue; } r -= I1;
        if (r < I2) { transpose_item(INL(27, (size_t)D * D), D, D, WSP(bf16_t, WS_W_OUT), MAP_ID, scr, r, 64, lane); continue; } r -= I2;
        if (r < I2) { transpose_item(INL(28, (size_t)D * D), D, D, WSP(bf16_t, WS_W_Q), MAP_ID, scr, r, 64, lane); continue; } r -= I2;
        if (r < I2) { transpose_item(INL(30, (size_t)D * D), D, D, WSP(bf16_t, WS_W_O), MAP_ID, scr, r, 64, lane); continue; } r -= I2;
        if (r < I3) { transpose_item(INL(29, (size_t)D * 2 * D), D, 2 * D, WSP(bf16_t, WS_W_KV), MAP_ID, scr, r, 128, lane); continue; } r -= I3;
        if (r < I4) { transpose_item(INL(31, (size_t)D * FFN2), D, FFN2, WSP(bf16_t, WS_W_UP), MAP_UP, scr, r, 352, lane); continue; } r -= I4;
        if (r < I5) { transpose_item(INL(34, (size_t)FFN * D), FFN, D, WSP(bf16_t, WS_W_DN), MAP_ID, scr, r, 64, lane); continue; } r -= I5;
        if (r < I6) { transpose_item(INL(24, (size_t)2 * 2048 * 256), 2048, 256, WSP(bf16_t, WS_W_C1), MAP_ID, scr, r, 8, lane); continue; } r -= I6;
        transpose_item(INL(24, (size_t)2 * 2048 * 256) + (size_t)2048 * 256, 2048, 256, WSP(bf16_t, WS_W_C1) + (size_t)256 * 2048, MAP_ID, scr, r, 8, lane);
    }
    const int gt = bi * 512 + otid(), NT = nb * 512;
    bf16_t* wl = WSP(bf16_t, WS_W_LORA);
    const float* w2 = INL(14, 96 * 512); const float* a2 = INL(16, 96 * 512); const float* g2 = INL(17, 256 * 512);
    for (int i = gt; i < 1536 * 512; i += NT) { const int n = i >> 9, k = i & 511; float v = 0.f;
        if (n < 512) { if (k < 96) v = w2[k * 512 + n]; } else if (n < 1024) { if (k >= 128 && k < 224) v = a2[(k - 128) * 512 + (n - 512)]; } else { if (k >= 256) v = g2[(k - 256) * 512 + (n - 1024)]; }
        wl[i] = f2bf(v); }
    float* cb = WSP(float, WS_CBIAS);
    for (int i = gt; i < 512; i += NT) { const int ii = i >> 8, n = i & 255; const float* pos = INL(23, 2 * 32 * 64) + ii * 2048; const float* w1 = INL(24, (size_t)2 * 2048 * 256) + (size_t)ii * 2048 * 256; float s = 0.f;
        for (int k = 0; k < 2048; ++k) s += pos[k] * w1[(size_t)k * 256 + n]; cb[i] = s; }
    ph_norm_rows(inp(p, 1), INL(6, D), WSP(bf16_t, WS_MEMN), BATCH * MEM, bi, nb);
}

__device__ __forceinline__ float zf(const bf16_t* zr, int c) { return bf2f(zr[c]); }
__device__ __forceinline__ void ph_mix_prep(const Params& p, int l, int bi, int nb) {
    PROLOG;
    const int tid_ = otid(), lane = tid_ & 63, gw = bi * 8 + (tid_ >> 6), NGW = nb * 8;
    const bf16_t* z = WSP(bf16_t, WS_Z); bf16_t* oall = WSP(bf16_t, WS_OALL); bf16_t* alora = WSP(bf16_t, WS_ALORA);
    bf16_t* qr = WSP(bf16_t, WS_QR); bf16_t* kr = WSP(bf16_t, WS_KR); bf16_t* qn = WSP(bf16_t, WS_QN); bf16_t* kvg = WSP(bf16_t, WS_KVG);
    const float* scw = INL(11, 3 * 512); const float* mu = INL(12, 1984); const int* posi = (const int*)inp(p, 2);
    for (int m = gw; m < M; m += NGW) {
        const int b = m >> 12, t = m & 4095; const bf16_t* zr = z + (size_t)m * NZ; const bf16_t* z1 = zr - NZ; const bf16_t* z2 = zr - 2 * NZ;
        const float pos = (float)posi[m];
        for (int c = lane; c < 512; c += 64) {
            float s = scw[2 * 512 + c] * zf(zr, ZC_SC_C + c) * zf(zr, ZC_SC_X + c);
            if (t >= 1) s += scw[1 * 512 + c] * zf(z1, ZC_SC_C + c) * zf(z1, ZC_SC_X + c);
            if (t >= 2) s += scw[0 * 512 + c] * zf(z2, ZC_SC_C + c) * zf(z2, ZC_SC_X + c);
            oall[(size_t)m * NBR + c] = f2bf(zf(zr, ZC_SC_B + c) * s);
        }
        for (int c = lane; c < 512; c += 64) {
            int src = -1, kind = 0;
            if (c < 96) { src = ZC_RW_ZW + c; kind = 1; } else if (c >= 128 && c < 224) { src = ZC_RW_ZA + (c - 128); kind = 0; } else if (c >= 256) { src = ZC_RW_ZG + (c - 256); kind = 2; }
            float v = 0.f;
            if (src >= 0) { const float a = zf(zr, src), pv = t >= 1 ? zf(z1, src) : 0.f; v = a + (pv - a) * mu[src - ZC_RW]; v = kind == 1 ? tanhf(v) : (kind == 2 ? sigmoidf_(v) : v); }
            alora[(size_t)m * 512 + c] = f2bf(v);
        }
        for (int i = lane; i < 256; i += 64) { const int hh = i >> 6, ii = i & 63; const float inv = __expf(-(float)ii * (9.210340371976184f / 63.f)); float sn, cs; sincosf(pos * inv, &sn, &cs);
            const float q1 = zf(zr, ZC_RET_Q + hh * 128 + ii), q2 = zf(zr, ZC_RET_Q + hh * 128 + 64 + ii), k1 = zf(zr, ZC_RET_K + hh * 128 + ii), k2 = zf(zr, ZC_RET_K + hh * 128 + 64 + ii);
            const float ksc = 0.08838834764831845f;
            qr[(size_t)m * 512 + hh * 128 + ii] = f2bf(q1 * cs - q2 * sn); qr[(size_t)m * 512 + hh * 128 + 64 + ii] = f2bf(q2 * cs + q1 * sn);
            kr[(size_t)m * 512 + hh * 128 + ii] = f2bf((k1 * cs - k2 * sn) * ksc); kr[(size_t)m * 512 + hh * 128 + 64 + ii] = f2bf((k2 * cs + k1 * sn) * ksc); }
        for (int i = lane; i < 256; i += 64) { const int hh = i >> 5, ii = i & 31; const float inv = __expf(-(float)ii * (9.210340371976184f / 32.f)); float sn, cs; sincosf(pos * inv, &sn, &cs);
            const float q1 = zf(zr, ZC_NSA_Q + hh * 64 + ii), q2 = zf(zr, ZC_NSA_Q + hh * 64 + 32 + ii);
            qn[(size_t)m * 512 + hh * 64 + ii] = f2bf(q1 * cs - q2 * sn); qn[(size_t)m * 512 + hh * 64 + 32 + ii] = f2bf(q2 * cs + q1 * sn); }
        { const int g = lane >> 5, ii = lane & 31; const float inv = __expf(-(float)ii * (9.210340371976184f / 32.f)); float sn, cs; sincosf(pos * inv, &sn, &cs);
            const size_t rowo = ((size_t)(b * 2 + g) * SEQ + t) * 64;
            { const float k1 = zf(zr, ZC_NSA_KS + g * 64 + ii), k2 = zf(zr, ZC_NSA_KS + g * 64 + 32 + ii); kvg[2 * KVG_SLAB + rowo + ii] = f2bf(k1 * cs - k2 * sn); kvg[2 * KVG_SLAB + rowo + 32 + ii] = f2bf(k2 * cs + k1 * sn); }
            { const float k1 = zf(zr, ZC_NSA_KW + g * 64 + ii), k2 = zf(zr, ZC_NSA_KW + g * 64 + 32 + ii); kvg[4 * KVG_SLAB + rowo + ii] = f2bf(k1 * cs - k2 * sn); kvg[4 * KVG_SLAB + rowo + 32 + ii] = f2bf(k2 * cs + k1 * sn); } }
        for (int i = lane; i < 128; i += 64) { const int g = i >> 6, d = i & 63; const size_t rowo = ((size_t)(b * 2 + g) * SEQ + t) * 64; const size_t tro = ((size_t)(b * 2 + g) * 64 + d) * SEQ + t;
            kvg[0 * KVG_SLAB + rowo + d] = zr[ZC_NSA_KC + i]; kvg[1 * KVG_SLAB + rowo + d] = zr[ZC_NSA_VC + i];
            kvg[3 * KVG_SLAB + tro] = zr[ZC_NSA_VS + i]; kvg[5 * KVG_SLAB + tro] = zr[ZC_NSA_VW + i]; }
    }
}

__device__ __forceinline__ void ph_rw_prep2(const Params& p, int l, int bi, int nb) {
    PROLOG;
    const int tid_ = otid(), lane = tid_ & 63, gw = bi * 8 + (tid_ >> 6), NGW = nb * 8;
    const bf16_t* z = WSP(bf16_t, WS_Z); const float* lo = WSP(float, WS_LO); float* ops = WSP(float, WS_RWOPS);
    const float* mu = INL(12, 1984); const float* w0 = INL(13, 512); const float* a0 = INL(15, 512); const float* kkw = INL(18, 512); const float* kaw = INL(19, 512);
    constexpr size_t AS = (size_t)M * 512;
    for (int it = gw; it < M * 8; it += NGW) {
        const int m = it >> 3, hh = it & 7, t = m & 4095, c = hh * 64 + lane; const bf16_t* zr = z + (size_t)m * NZ; const bf16_t* z1 = zr - NZ;
        float r = zf(zr, ZC_RW_R + c), k = zf(zr, ZC_RW_K + c), v = zf(zr, ZC_RW_V + c);
        const float pr = t >= 1 ? zf(z1, ZC_RW_R + c) : 0.f, pk = t >= 1 ? zf(z1, ZC_RW_K + c) : 0.f, pv = t >= 1 ? zf(z1, ZC_RW_V + c) : 0.f;
        r += (pr - r) * mu[c]; k += (pk - k) * mu[512 + c]; v += (pv - v) * mu[1024 + c];
        const float dd = w0[c] + lo[(size_t)m * 1536 + c]; const float w = __expf(-0.6065306597126334f * sigmoidf_(dd));
        const float a = sigmoidf_(a0[c] + lo[(size_t)m * 1536 + 512 + c]);
        float kk = k * kkw[c]; const float nrm = sqrtf(wave_sum(kk * kk)); kk = kk / fmaxf(nrm, 1e-12f);
        const float k2 = k * (1.f + (a - 1.f) * kaw[c]);
        const size_t o = (size_t)m * 512 + c;
        ops[0 * AS + o] = r; ops[1 * AS + o] = w; ops[2 * AS + o] = k2; ops[3 * AS + o] = v; ops[4 * AS + o] = kk; ops[5 * AS + o] = kk * a;
    }
}
#define DPP_ROR_ADD(x, n) (x) += __int_as_float(__builtin_amdgcn_update_dpp(0, __float_as_int(x), 0x120 + (n), 0xf, 0xf, false))
__device__ __forceinline__ float row_allreduce16(float x) { DPP_ROR_ADD(x, 8); DPP_ROR_ADD(x, 4); DPP_ROR_ADD(x, 2); DPP_ROR_ADD(x, 1); return x; }
__device__ __forceinline__ void ph_rw_scan(const Params& p, LAS unsigned char* lds, int bi, int nb) {
    PROLOG;
    const float* ops = WSP(float, WS_RWOPS); float* ys = WSP(float, WS_YSCAN); constexpr size_t AS = (size_t)M * 512; constexpr int TC = 32;
    LAS float* lop = (LAS float*)lds;
    LAS float* ybuf = (LAS float*)(lds + 6 * TC * 64 * 4);
    const int tid = otid(), wave = tid >> 6, lane = tid & 63, Rg = wave * 4 + (lane >> 4), Pc = lane & 15;
    for (int task = bi; task < 16; task += nb) {
        const int b = task >> 3, hh = task & 7;
        float s[4][4];
#pragma unroll
        for (int i = 0; i < 4; ++i)
#pragma unroll
            for (int j = 0; j < 4; ++j) s[i][j] = 0.f;
        for (int t0 = 0; t0 < SEQ; t0 += TC) {
            for (int idx = tid; idx < 6 * TC * 16; idx += 512) { const int arr = idx / (TC * 16), rem = idx % (TC * 16), tt = rem >> 4, c4 = rem & 15;
                *(LAS f32x4*)(lop + (arr * TC + tt) * 64 + c4 * 4) = *(const f32x4*)(ops + arr * AS + (size_t)(b * SEQ + t0 + tt) * 512 + hh * 64 + c4 * 4); }
            __syncthreads();
            if (wave < 4) {
                for (int tt = 0; tt < TC; ++tt) {
                    const f32x4 r4 = *(const LAS f32x4*)(lop + (0 * TC + tt) * 64 + Pc * 4), w4 = *(const LAS f32x4*)(lop + (1 * TC + tt) * 64 + Pc * 4), k4 = *(const LAS f32x4*)(lop + (2 * TC + tt) * 64 + Pc * 4);
                    const f32x4 v4 = *(const LAS f32x4*)(lop + (3 * TC + tt) * 64 + Rg * 4), kk4 = *(const LAS f32x4*)(lop + (4 * TC + tt) * 64 + Pc * 4), b4 = *(const LAS f32x4*)(lop + (5 * TC + tt) * 64 + Pc * 4);
                    float sa[4];
#pragma unroll
                    for (int i = 0; i < 4; ++i) { float x = -(s[i][0] * kk4[0] + s[i][1] * kk4[1] + s[i][2] * kk4[2] + s[i][3] * kk4[3]); sa[i] = row_allreduce16(x); }
                    float y[4];
#pragma unroll
                    for (int i = 0; i < 4; ++i) { float acc = 0.f;
#pragma unroll
                        for (int j = 0; j < 4; ++j) { s[i][j] = s[i][j] * w4[j] + sa[i] * b4[j] + v4[i] * k4[j]; acc += s[i][j] * r4[j]; }
                        y[i] = row_allreduce16(acc); }
                    if (Pc == 0) *(LAS f32x4*)(ybuf + tt * 64 + Rg * 4) = (f32x4){y[0], y[1], y[2], y[3]};
                }
            }
            __syncthreads();
            { const int tt = tid >> 4, c4 = tid & 15; *(f32x4*)(ys + (size_t)(b * SEQ + t0 + tt) * 512 + hh * 64 + c4 * 4) = *(const LAS f32x4*)(ybuf + tt * 64 + c4 * 4); }
        }
        __syncthreads();
    }
}
__device__ __forceinline__ void ph_rw_post(const Params& p, int l, int bi, int nb) {
    PROLOG;
    const int tid_ = otid(), lane = tid_ & 63, gw = bi * 8 + (tid_ >> 6), NGW = nb * 8;
    const float* ops = WSP(float, WS_RWOPS); const float* ys = WSP(float, WS_YSCAN); const float* lo = WSP(float, WS_LO); bf16_t* oall = WSP(bf16_t, WS_OALL);
    const float* rk = INL(20, 512); const float* lg = INL(21, 512); const float* lb = INL(22, 512); constexpr size_t AS = (size_t)M * 512;
    for (int it = gw; it < M * 8; it += NGW) {
        const int m = it >> 3, hh = it & 7, c = hh * 64 + lane; const size_t o = (size_t)m * 512 + c;
        const float y = ys[o], r = ops[o], k2 = ops[2 * AS + o], v = ops[3 * AS + o];
        const float mean = wave_sum(y) * (1.f / 64.f); const float dv = y - mean; const float var = wave_sum(dv * dv) * (1.f / 64.f);
        const float yn = dv * rsqrtf(var + 64e-5f) * lg[c] + lb[c];
        const float bonus = wave_sum(r * k2 * rk[c]) * v;
        const float g = lo[(size_t)m * 1536 + 1024 + c];
        oall[(size_t)m * NBR + 512 + c] = f2bf((yn + bonus) * g);
    }
}

__device__ __forceinline__ float ret_lg(int hh) { return logf(1.f - exp2f(-5.f - (float)hh)); }
__device__ __forceinline__ void ph_ret_u(const Params& p, LAS unsigned char* lds, int bi, int nb) {
    PROLOG;
    const bf16_t* z = WSP(bf16_t, WS_Z); const bf16_t* kr = WSP(bf16_t, WS_KR); float* ub = WSP(float, WS_UBUF);
    LAS bf16_t* Vt = (LAS bf16_t*)lds;
    LAS bf16_t* Kt = (LAS bf16_t*)(lds + 256 * 136 * 2);
    const int tid = otid(), wave = tid >> 6, lane = tid & 63, r = lane & 15, q = lane >> 4;
    for (int task = bi; task < 256; task += nb) {
        const int b = task >> 7, hh = (task >> 5) & 3, n = task & 31; const float lgh = ret_lg(hh); const size_t m0 = (size_t)b * SEQ + n * 128;
        __syncthreads();
        for (int idx = tid; idx < 128 * 32; idx += 512) { const int mm = idx & 127, ch = idx >> 7; const u32x4 w = *(const u32x4*)(z + (m0 + mm) * NZ + ZC_RET_V + hh * 256 + ch * 8);
            const unsigned ww[4] = {w.x, w.y, w.z, w.w};
#pragma unroll
            for (int i = 0; i < 4; ++i) { Vt[(ch * 8 + 2 * i) * 136 + mm] = (bf16_t)(ww[i] & 0xffffu); Vt[(ch * 8 + 2 * i + 1) * 136 + mm] = (bf16_t)(ww[i] >> 16); } }
        for (int idx = tid; idx < 128 * 16; idx += 512) { const int mm = idx & 127, ch = idx >> 7; const float zeta = __expf((float)(127 - mm) * lgh);
            const u32x4 w = *(const u32x4*)(kr + (m0 + mm) * 512 + hh * 128 + ch * 8); const unsigned ww[4] = {w.x, w.y, w.z, w.w};
#pragma unroll
            for (int i = 0; i < 4; ++i) { Kt[(ch * 8 + 2 * i) * 136 + mm] = f2bf(__uint_as_float(ww[i] << 16) * zeta); Kt[(ch * 8 + 2 * i + 1) * 136 + mm] = f2bf(__uint_as_float(ww[i] & 0xffff0000u) * zeta); } }
        __syncthreads();
        float* uo = ub + (size_t)task * 256 * 128;
#pragma unroll
        for (int et = 0; et < 2; ++et) { const int e0 = 16 * (2 * wave + et); bf16x8 a[4];
#pragma unroll
            for (int ks = 0; ks < 4; ++ks) a[ks] = *(const LAS bf16x8*)(Vt + (e0 + r) * 136 + 32 * ks + 8 * q);
#pragma unroll
            for (int dt = 0; dt < 8; ++dt) { f32x4 acc = {0.f, 0.f, 0.f, 0.f};
#pragma unroll
                for (int ks = 0; ks < 4; ++ks) { const bf16x8 bb = *(const LAS bf16x8*)(Kt + (16 * dt + r) * 136 + 32 * ks + 8 * q); acc = mma16(acc, a[ks], bb); }
                *(f32x4*)(uo + (size_t)(e0 + r) * 128 + 16 * dt + 4 * q) = acc; } }
    }
}
__device__ __forceinline__ void ph_ret_scan(const Params& p, int bi, int nb) {
    PROLOG;
    const float* ub = WSP(float, WS_UBUF); bf16_t* rp = WSP(bf16_t, WS_RPREV);
    const int gt = bi * 512 + otid(), NT = nb * 512;
    for (int i = gt; i < 8 * 8192; i += NT) { const int bh = i >> 13, e4 = i & 8191, hh = bh & 3; const float cd = __expf(128.f * ret_lg(hh)); f32x4 st = {0.f, 0.f, 0.f, 0.f};
        for (int n = 0; n < 32; ++n) { const size_t o = ((size_t)(bh * 32 + n) * 8192 + e4) * 4; u32x2 w; w.x = cvt_pk_bf16(st[0], st[1]); w.y = cvt_pk_bf16(st[2], st[3]); *(u32x2*)(rp + o) = w;
            st = st * cd + *(const f32x4*)(ub + o); } }
}
__device__ __forceinline__ void ph_ret_out(const Params& p, LAS unsigned char* lds, int bi, int nb) {
    PROLOG;
    const bf16_t* z = WSP(bf16_t, WS_Z); const bf16_t* qr = WSP(bf16_t, WS_QR); const bf16_t* kr = WSP(bf16_t, WS_KR); const bf16_t* rp = WSP(bf16_t, WS_RPREV); bf16_t* oall = WSP(bf16_t, WS_OALL);
    LAS bf16_t* Vt = (LAS bf16_t*)lds;
    const int tid = otid(), wave = tid >> 6, lane = tid & 63, r = lane & 15, q = lane >> 4;
    LAS bf16_t* Sc = (LAS bf16_t*)(lds + 256 * 136 * 2) + wave * 16 * 136;
    for (int task = bi; task < 256; task += nb) {
        const int b = task >> 7, hh = (task >> 5) & 3, n = task & 31; const float lgh = ret_lg(hh); const size_t m0 = (size_t)b * SEQ + n * 128;
        __syncthreads();
        for (int idx = tid; idx < 128 * 32; idx += 512) { const int mm = idx & 127, ch = idx >> 7; const u32x4 w = *(const u32x4*)(z + (m0 + mm) * NZ + ZC_RET_V + hh * 256 + ch * 8);
            const unsigned ww[4] = {w.x, w.y, w.z, w.w};
#pragma unroll
            for (int i = 0; i < 4; ++i) { Vt[(ch * 8 + 2 * i) * 136 + mm] = (bf16_t)(ww[i] & 0xffffu); Vt[(ch * 8 + 2 * i + 1) * 136 + mm] = (bf16_t)(ww[i] >> 16); } }
        __syncthreads();
        const int c = 16 * wave + r; const size_t mrow = m0 + c;
        bf16x8 qa[4];
#pragma unroll
        for (int ks = 0; ks < 4; ++ks) qa[ks] = ldfrag(qr + mrow * 512 + hh * 128 + 32 * ks + 8 * q);
#pragma unroll
        for (int mt = 0; mt < 8; ++mt) { f32x4 s = {0.f, 0.f, 0.f, 0.f};
#pragma unroll
            for (int ks = 0; ks < 4; ++ks) s = mma16(s, qa[ks], ldfrag(kr + (m0 + 16 * mt + r) * 512 + hh * 128 + 32 * ks + 8 * q));
            float v[4];
#pragma unroll
            for (int j = 0; j < 4; ++j) { const int mm = 16 * mt + 4 * q + j; v[j] = (c >= mm) ? s[j] * __expf((float)(c - mm) * lgh) : 0.f; }
            u32x2 w; w.x = cvt_pk_bf16(v[0], v[1]); w.y = cvt_pk_bf16(v[2], v[3]); *(LAS u32x2*)(Sc + r * 136 + 16 * mt + 4 * q) = w; }
        asm volatile("s_waitcnt lgkmcnt(0)" ::: "memory");
        const float xi = __expf((float)(c + 1) * lgh);
        const bf16_t* rpc = rp + (size_t)task * 256 * 128;
        f32x4 acc[16]; bf16x8 sa[4];
#pragma unroll
        for (int ks = 0; ks < 4; ++ks) sa[ks] = *(const LAS bf16x8*)(Sc + r * 136 + 32 * ks + 8 * q);
#pragma unroll
        for (int et = 0; et < 16; ++et) { f32x4 a = {0.f, 0.f, 0.f, 0.f};
#pragma unroll
            for (int ks = 0; ks < 4; ++ks) a = mma16(a, qa[ks], ldfrag(rpc + (size_t)(16 * et + r) * 128 + 32 * ks + 8 * q));
            a = a * xi;
#pragma unroll
            for (int ks = 0; ks < 4; ++ks) a = mma16(a, sa[ks], *(const LAS bf16x8*)(Vt + (16 * et + r) * 136 + 32 * ks + 8 * q));
            acc[et] = a; }
        float s1 = 0.f;
#pragma unroll
        for (int et = 0; et < 16; ++et) s1 += acc[et][0] + acc[et][1] + acc[et][2] + acc[et][3];
        s1 += __shfl_xor(s1, 16); s1 += __shfl_xor(s1, 32); const float mean = s1 * (1.f / 256.f); float s2 = 0.f;
#pragma unroll
        for (int et = 0; et < 16; ++et) { acc[et] = acc[et] - mean; s2 += acc[et][0] * acc[et][0] + acc[et][1] * acc[et][1] + acc[et][2] * acc[et][2] + acc[et][3] * acc[et][3]; }
        s2 += __shfl_xor(s2, 16); s2 += __shfl_xor(s2, 32); const float rstd = rsqrtf(s2 * (1.f / 256.f) + 1e-5f);
#pragma unroll
        for (int et = 0; et < 16; ++et) { const int e = 16 * et + 4 * q; const u32x2 gw = *(const u32x2*)(z + mrow * NZ + ZC_RET_G + hh * 256 + e);
            const float g0 = __uint_as_float(gw.x << 16), g1 = __uint_as_float(gw.x & 0xffff0000u), g2 = __uint_as_float(gw.y << 16), g3 = __uint_as_float(gw.y & 0xffff0000u);
            u32x2 w; w.x = cvt_pk_bf16(acc[et][0] * rstd * g0 * sigmoidf_(g0), acc[et][1] * rstd * g1 * sigmoidf_(g1)); w.y = cvt_pk_bf16(acc[et][2] * rstd * g2 * sigmoidf_(g2), acc[et][3] * rstd * g3 * sigmoidf_(g3));
            *(u32x2*)(oall + mrow * NBR + 1024 + hh * 256 + e) = w; }
    }
}

__device__ __forceinline__ void ph_cmp2(const Params& p, int l, int bi, int nb) {
    PROLOG;
    const bf16_t* hid = WSP(bf16_t, WS_HID); bf16_t* kc = WSP(bf16_t, WS_KCMP); bf16_t* vt = WSP(bf16_t, WS_VCMPT); const int* posi = (const int*)inp(p, 2);
    const float* w2 = INL(25, 2 * 256 * 64);
    const int gt = bi * 512 + otid(), NT = nb * 512;
    for (int i = gt; i < 4 * 256 * 64; i += NT) { const int bg = i >> 14, c = (i >> 6) & 255, d = i & 63;
        { float s = 0.f; if (c < 255) { const bf16_t* hr = hid + ((size_t)(4 + bg) * 256 + c) * 256; for (int k = 0; k < 256; ++k) s += bf2f(hr[k]) * w2[256 * 64 + k * 64 + d]; }
          vt[((size_t)bg * 64 + d) * 256 + c] = f2bf(s); }
        if (d < 32) { float s1 = 0.f, s2 = 0.f;
            if (c < 255) { const bf16_t* hr = hid + ((size_t)bg * 256 + c) * 256; for (int k = 0; k < 256; ++k) { const float hv = bf2f(hr[k]); s1 += hv * w2[k * 64 + d]; s2 += hv * w2[k * 64 + 32 + d]; }
                const float pos = (float)posi[(bg >> 1) * SEQ + 16 * c + 31]; const float inv = __expf(-(float)d * (9.210340371976184f / 32.f)); float sn, cs; sincosf(pos * inv, &sn, &cs);
                const float a = s1 * cs - s2 * sn, bq = s2 * cs + s1 * sn; s1 = a; s2 = bq; }
            kc[((size_t)bg * 256 + c) * 64 + d] = f2bf(s1); kc[((size_t)bg * 256 + c) * 64 + 32 + d] = f2bf(s2); }
    }
}
__device__ __forceinline__ void ph_nsa_cmp(const Params& p, LAS unsigned char* lds, int bi, int nb) {
    PROLOG;
    const bf16_t* qn = WSP(bf16_t, WS_QN); const bf16_t* kc = WSP(bf16_t, WS_KCMP); const bf16_t* vt = WSP(bf16_t, WS_VCMPT); bf16_t* ocmp = WSP(bf16_t, WS_OCMP); u64* selm = WSP(u64, WS_SELM);
    const int tid = otid(), wave = tid >> 6, lane = tid & 63, r = lane & 15, q = lane >> 4, gw = bi * 8 + wave, NGW = nb * 8;
    LAS bf16_t* Pl = (LAS bf16_t*)(lds + wave * 16384);
    LAS float* Il = (LAS float*)(lds + wave * 16384 + 16 * 264 * 2);
    for (int task = gw; task < 1024; task += NGW) {
        const int bg = task >> 8, b = bg >> 1, g = bg & 1, tt = task & 255, t0 = 16 * tt, t = t0 + r; const size_t mrow = (size_t)b * SEQ + t;
        const int cmax = t >= 31 ? (t - 31) >> 4 : -1;
#pragma unroll
        for (int ct = 0; ct < 16; ++ct) Il[r * 64 + 4 * ct + q] = 0.f;
        for (int hh = 0; hh < 4; ++hh) {
            const int hd = (g * 4 + hh) * 64;
            bf16x8 qa[2]; qa[0] = ldfrag(qn + mrow * 512 + hd + 8 * q); qa[1] = ldfrag(qn + mrow * 512 + hd + 32 + 8 * q);
            f32x4 s[16]; float mx = -1e30f;
#pragma unroll
            for (int ct = 0; ct < 16; ++ct) { f32x4 a = {0.f, 0.f, 0.f, 0.f}; const bf16_t* kp = kc + ((size_t)bg * 256 + 16 * ct + r) * 64 + 8 * q;
                a = mma16(a, qa[0], ldfrag(kp)); a = mma16(a, qa[1], ldfrag(kp + 32));
#pragma unroll
                for (int j = 0; j < 4; ++j) { const int c = 16 * ct + 4 * q + j; a[j] = (c <= cmax) ? a[j] * 0.125f : -1e30f; mx = fmaxf(mx, a[j]); }
                s[ct] = a; }
            mx = fmaxf(mx, __shfl_xor(mx, 16)); mx = fmaxf(mx, __shfl_xor(mx, 32));
            float sum = 0.f;
#pragma unroll
            for (int ct = 0; ct < 16; ++ct)
#pragma unroll
                for (int j = 0; j < 4; ++j) { const int c = 16 * ct + 4 * q + j; const float e = (c <= cmax) ? __expf(s[ct][j] - mx) : 0.f; s[ct][j] = e; sum += e; }
            sum += __shfl_xor(sum, 16); sum += __shfl_xor(sum, 32);
            const float rinv = 1.f / fmaxf(sum, 1e-30f);
            float yprev = 0.f;
#pragma unroll
            for (int ct = 0; ct < 16; ++ct) { s[ct] = s[ct] * rinv;
                const float y = __shfl(s[ct][3], (lane + 48) & 63);
                const float prev = q > 0 ? y : yprev; yprev = y;
                Il[r * 64 + 4 * ct + q] += (s[ct][0] + s[ct][1]) + (s[ct][2] + s[ct][3]) + prev;
                u32x2 w; w.x = cvt_pk_bf16(s[ct][0], s[ct][1]); w.y = cvt_pk_bf16(s[ct][2], s[ct][3]); *(LAS u32x2*)(Pl + r * 264 + 16 * ct + 4 * q) = w; }
            asm volatile("s_waitcnt lgkmcnt(0)" ::: "memory");
            f32x4 o[4];
#pragma unroll
            for (int dt = 0; dt < 4; ++dt) o[dt] = (f32x4){0.f, 0.f, 0.f, 0.f};
#pragma unroll
            for (int ks = 0; ks < 8; ++ks) { const bf16x8 pa = *(const LAS bf16x8*)(Pl + r * 264 + 32 * ks + 8 * q);
#pragma unroll
                for (int dt = 0; dt < 4; ++dt) o[dt] = mma16(o[dt], pa, ldfrag(vt + ((size_t)bg * 64 + 16 * dt + r) * 256 + 32 * ks + 8 * q)); }
#pragma unroll
            for (int dt = 0; dt < 4; ++dt) { u32x2 w; w.x = cvt_pk_bf16(o[dt][0], o[dt][1]); w.y = cvt_pk_bf16(o[dt][2], o[dt][3]); *(u32x2*)(ocmp + mrow * 512 + hd + 16 * dt + 4 * q) = w; }
        }
        asm volatile("s_waitcnt lgkmcnt(0)" ::: "memory");
        for (int rr = 0; rr < 16; ++rr) {
            const int tq = t0 + rr, cur = tq >> 6; const float v = Il[rr * 64 + lane];
            const bool valid = lane <= cur; const bool forced = (lane == 0) || (lane == cur) || (lane == cur - 1);
            const float key = forced ? __builtin_inff() : v; int rank = 0;
            for (int i = 0; i <= cur; ++i) { const float ki = __int_as_float(__builtin_amdgcn_readlane(__float_as_int(key), i)); rank += (ki > key || (ki == key && i < lane)) ? 1 : 0; }
            const u64 msk = __ballot(valid && rank < 16);
            if (lane == 0) selm[(size_t)bg * SEQ + tq] = msk;
        }
        asm volatile("s_waitcnt lgkmcnt(0)" ::: "memory");
    }
}
__device__ __forceinline__ void ph_nsa_attn(const Params& p, LAS unsigned char* lds, int bi, int nb) {
    PROLOG;
    const bf16_t* z = WSP(bf16_t, WS_Z); const bf16_t* qn = WSP(bf16_t, WS_QN); const bf16_t* kvg = WSP(bf16_t, WS_KVG); const bf16_t* ocmp = WSP(bf16_t, WS_OCMP); const u64* selm = WSP(u64, WS_SELM); bf16_t* oall = WSP(bf16_t, WS_OALL);
    const int tid = otid(), wave = tid >> 6, lane = tid & 63, r = lane & 15, q = lane >> 4, gw = bi * 8 + wave, NGW = nb * 8;
    LAS bf16_t* Pl = (LAS bf16_t*)(lds + wave * 4096);
    for (int task = gw; task < 4096; task += NGW) {
        int tt, sub; if (task < 2048) { tt = 255 - (task >> 4); sub = task & 15; } else { tt = (task - 2048) >> 4; sub = task & 15; }
        const int bg = sub >> 2, hh = sub & 3, b = bg >> 1, g = bg & 1, t0 = 16 * tt, t = t0 + r, cur = t0 >> 6; const size_t mrow = (size_t)b * SEQ + t;
        const int hd = (g * 4 + hh) * 64;
        bf16x8 qa[2]; qa[0] = ldfrag(qn + mrow * 512 + hd + 8 * q); qa[1] = ldfrag(qn + mrow * 512 + hd + 32 + 8 * q);
        const u64 mymask = selm[(size_t)bg * SEQ + t];
        unsigned mlo = (unsigned)mymask, mhi = (unsigned)(mymask >> 32);
#pragma unroll
        for (int o = 1; o < 16; o <<= 1) { mlo |= __shfl_xor(mlo, o); mhi |= __shfl_xor(mhi, o); }
        const u64 umask = ((u64)__builtin_amdgcn_readfirstlane(mhi) << 32) | (u64)__builtin_amdgcn_readfirstlane(mlo);
        f32x4 res[4];
#pragma unroll
        for (int br = 0; br < 2; ++br) {
            const bf16_t* Kb = kvg + (br == 0 ? 2 : 4) * KVG_SLAB + (size_t)bg * SEQ * 64;
            const bf16_t* Vtb = kvg + (br == 0 ? 3 : 5) * KVG_SLAB + (size_t)bg * 64 * SEQ;
            const int j0 = br == 0 ? 0 : ((t0 >= 511) ? ((t0 - 511) >> 6) : 0);
            float mrun = -1e30f, lrun = 0.f; f32x4 o[4];
#pragma unroll
            for (int dt = 0; dt < 4; ++dt) o[dt] = (f32x4){0.f, 0.f, 0.f, 0.f};
            for (int j = j0; j <= cur; ++j) {
                if (br == 0 && !((umask >> j) & 1ull)) continue;
                const int k0 = 64 * j; const bool rowsel = br == 0 ? (((mymask >> j) & 1ull) != 0) : true;
                f32x4 s[4]; float mx = -1e30f;
#pragma unroll
                for (int ct = 0; ct < 4; ++ct) { f32x4 a = {0.f, 0.f, 0.f, 0.f}; const bf16_t* kp = Kb + (size_t)(k0 + 16 * ct + r) * 64 + 8 * q;
                    a = mma16(a, qa[0], ldfrag(kp)); a = mma16(a, qa[1], ldfrag(kp + 32));
#pragma unroll
                    for (int jj = 0; jj < 4; ++jj) { const int key = k0 + 16 * ct + 4 * q + jj; const bool ok = rowsel && key <= t && (br == 0 || t - key < 512); a[jj] = ok ? a[jj] * 0.125f : -1e30f; mx = fmaxf(mx, a[jj]); }
                    s[ct] = a; }
                mx = fmaxf(mx, __shfl_xor(mx, 16)); mx = fmaxf(mx, __shfl_xor(mx, 32));
                const float mnew = fmaxf(mrun, mx), alpha = __expf(mrun - mnew); float sum = 0.f;
#pragma unroll
                for (int ct = 0; ct < 4; ++ct) {
#pragma unroll
                    for (int jj = 0; jj < 4; ++jj) { const float e = (s[ct][jj] > -1e29f) ? __expf(s[ct][jj] - mnew) : 0.f; s[ct][jj] = e; sum += e; }
                    u32x2 w; w.x = cvt_pk_bf16(s[ct][0], s[ct][1]); w.y = cvt_pk_bf16(s[ct][2], s[ct][3]); *(LAS u32x2*)(Pl + r * 72 + 16 * ct + 4 * q) = w; }
                sum += __shfl_xor(sum, 16); sum += __shfl_xor(sum, 32);
                lrun = lrun * alpha + sum; mrun = mnew;
                asm volatile("s_waitcnt lgkmcnt(0)" ::: "memory");
                const bf16x8 pa0 = *(const LAS bf16x8*)(Pl + r * 72 + 8 * q), pa1 = *(const LAS bf16x8*)(Pl + r * 72 + 32 + 8 * q);
#pragma unroll
                for (int dt = 0; dt < 4; ++dt) { const bf16_t* vp = Vtb + (size_t)(16 * dt + r) * SEQ + k0 + 8 * q; f32x4 a = o[dt] * alpha; a = mma16(a, pa0, ldfrag(vp)); a = mma16(a, pa1, ldfrag(vp + 32)); o[dt] = a; }
                asm volatile("s_waitcnt lgkmcnt(0)" ::: "memory");
            }
            const float rinv = 1.f / fmaxf(lrun, 1e-30f);
            const float gt = sigmoidf_(zf(z + mrow * NZ, ZC_NSA_GT + (g * 4 + hh) * 3 + 1 + br));
#pragma unroll
            for (int dt = 0; dt < 4; ++dt) { if (br == 0) res[dt] = o[dt] * (rinv * gt); else res[dt] += o[dt] * (rinv * gt); }
        }
        const float g0 = sigmoidf_(zf(z + mrow * NZ, ZC_NSA_GT + (g * 4 + hh) * 3));
#pragma unroll
        for (int dt = 0; dt < 4; ++dt) { const u32x2 cw = *(const u32x2*)(ocmp + mrow * 512 + hd + 16 * dt + 4 * q);
            const float c0 = __uint_as_float(cw.x << 16), c1 = __uint_as_float(cw.x & 0xffff0000u), c2 = __uint_as_float(cw.y << 16), c3 = __uint_as_float(cw.y & 0xffff0000u);
            u32x2 w; w.x = cvt_pk_bf16(res[dt][0] + g0 * c0, res[dt][1] + g0 * c1); w.y = cvt_pk_bf16(res[dt][2] + g0 * c2, res[dt][3] + g0 * c3);
            *(u32x2*)(oall + mrow * NBR + 2048 + hd + 16 * dt + 4 * q) = w; }
    }
}

__device__ __forceinline__ void ph_xsoftmax(const Params& p, int bi, int nb) {
    PROLOG;
    const float* sc = WSP(float, WS_SC); bf16_t* pb = WSP(bf16_t, WS_PB);
    const int tid_ = otid(), lane = tid_ & 63, gw = bi * 8 + (tid_ >> 6), NGW = nb * 8;
    for (int it = gw; it < M * 4; it += NGW) { const f32x4 v = *(const f32x4*)(sc + (size_t)it * 256 + lane * 4);
        float mx = fmaxf(fmaxf(v[0], v[1]), fmaxf(v[2], v[3]));
#pragma unroll
        for (int o = 1; o < 64; o <<= 1) mx = fmaxf(mx, __shfl_xor(mx, o));
        const float e0 = __expf(v[0] - mx), e1 = __expf(v[1] - mx), e2 = __expf(v[2] - mx), e3 = __expf(v[3] - mx);
        const float rinv = 1.f / wave_sum((e0 + e1) + (e2 + e3));
        u32x2 w; w.x = cvt_pk_bf16(e0 * rinv, e1 * rinv); w.y = cvt_pk_bf16(e2 * rinv, e3 * rinv); *(u32x2*)(pb + (size_t)it * 256 + lane * 4) = w; }
}
__device__ __forceinline__ void ph_convact(const Params& p, int l, int bi, int nb) {
    PROLOG;
    const bf16_t* u = WSP(bf16_t, WS_U); bf16_t* ga = WSP(bf16_t, WS_GACT); const float* cw = INL(32, 3 * FFN2); const float* cb = INL(33, FFN2);
    const int gt = bi * 512 + otid(), NT = nb * 512;
    for (int i = gt; i < M * (FFN / 4); i += NT) { const int m = i / (FFN / 4), c4 = (i % (FFN / 4)) * 4, t = m & 4095; const int ua = 256 * (c4 >> 7) + (c4 & 127), ub = ua + 128;
        float va[4], vb[4];
#pragma unroll
        for (int j = 0; j < 4; ++j) { va[j] = cb[c4 + j]; vb[j] = cb[FFN + c4 + j]; }
#pragma unroll
        for (int k = 0; k < 3; ++k) { if (t - 2 + k < 0) continue; const bf16_t* ur = u + (size_t)(m - 2 + k) * FFN2; const u32x2 wa = *(const u32x2*)(ur + ua), wb = *(const u32x2*)(ur + ub);
            const float xa[4] = {__uint_as_float(wa.x << 16), __uint_as_float(wa.x & 0xffff0000u), __uint_as_float(wa.y << 16), __uint_as_float(wa.y & 0xffff0000u)};
            const float xb[4] = {__uint_as_float(wb.x << 16), __uint_as_float(wb.x & 0xffff0000u), __uint_as_float(wb.y << 16), __uint_as_float(wb.y & 0xffff0000u)};
#pragma unroll
            for (int j = 0; j < 4; ++j) { va[j] += cw[k * FFN2 + c4 + j] * xa[j]; vb[j] += cw[k * FFN2 + FFN + c4 + j] * xb[j]; } }
        u32x2 w; w.x = cvt_pk_bf16(gelu_tanh(va[0]) * vb[0], gelu_tanh(va[1]) * vb[1]); w.y = cvt_pk_bf16(gelu_tanh(va[2]) * vb[2], gelu_tanh(va[3]) * vb[3]);
        *(u32x2*)(ga + (size_t)m * FFN + c4) = w; }
}


#define XB_TMO      128
#define XB_XCNT(j)  (256  + 64 * (j))
#define XB_XSUB(j)  (1280 + 64 * (j))
#define XB_XGEN(j)  (2304 + 64 * (j))
#define XB_TOP      3328
#define XB_TOPGEN   3392
#define XCD_BAR_WORDS 3456
#define XB_SPIN_CAP (1u << 18)
__device__ __forceinline__ unsigned xb_ld(unsigned* p)              { return __hip_atomic_load(p, __ATOMIC_RELAXED, __HIP_MEMORY_SCOPE_AGENT); }
__device__ __forceinline__ unsigned xb_add(unsigned* p, unsigned v) { return __hip_atomic_fetch_add(p, v, __ATOMIC_RELAXED, __HIP_MEMORY_SCOPE_AGENT); }
__device__ __forceinline__ unsigned xb_xcc_id() { return (unsigned)__builtin_amdgcn_s_getreg((3 << 11) | 20) & 0xFu; }
#define XB_SPIN(cond, bar) do { unsigned _sp = 0; while (cond) { __builtin_amdgcn_s_sleep(1); \
    if ((++_sp & 255u) == 0u) { if (xb_ld(&(bar)[XB_TMO])) break; if (_sp > XB_SPIN_CAP) { atomicAdd(&(bar)[XB_TMO], 1u); break; } } } } while (0)
struct XcdBarrier { unsigned* bar; unsigned x; volatile LAS unsigned* st; };
__device__ __forceinline__ XcdBarrier xcd_barrier_post(unsigned* bar, volatile LAS unsigned* st) {
    XcdBarrier b; b.bar = bar; b.x = xb_xcc_id(); b.st = st;
    if (threadIdx.x == 0) (void)xb_add(&bar[XB_XCNT(b.x)], 1u);
    return b;
}
__device__ __forceinline__ void xcd_barrier_complete(unsigned* bar, unsigned x, unsigned& nloc, unsigned& nx) {
    const unsigned G = gridDim.x * gridDim.y * gridDim.z;
    unsigned sum, cnt, mine, sp = 0u;
    for (;;) {
        sum = 0u; cnt = 0u; mine = 0u;
#pragma unroll
        for (unsigned j = 0; j < 16; ++j) { const unsigned c = xb_ld(&bar[XB_XCNT(j)]); sum += c; cnt += (c > 0u) ? 1u : 0u; mine = (j == x) ? c : mine; }
        if (sum == G) break;
        __builtin_amdgcn_s_sleep(1);
        if ((++sp & 255u) == 0u) { if (xb_ld(&bar[XB_TMO])) break; if (sp > XB_SPIN_CAP) { atomicAdd(&bar[XB_TMO], 1u); break; } }
    }
    nloc = mine > 0u ? mine : 1u; nx = cnt > 0u ? cnt : 1u;
}
__device__ __forceinline__ void xcd_barrier(const XcdBarrier& b) {
    asm volatile("s_waitcnt vmcnt(0)" ::: "memory");
    __syncthreads();
    if (threadIdx.x == 0) {
        unsigned* bar = (unsigned*)(ws_lds() + WS_CTL) + 1024;
        __builtin_amdgcn_s_waitcnt(0);
        unsigned nloc = b.st[0], nx = b.st[1];
        if (nloc == 0u) { xcd_barrier_complete(bar, b.x, nloc, nx); b.st[0] = nloc; b.st[1] = nx; }
        const unsigned old = xb_add(&bar[XB_XSUB(b.x)], 1u);
        const unsigned gen = old / nloc;
        if (old + 1u == (gen + 1u) * nloc) {
            __builtin_amdgcn_fence(__ATOMIC_RELEASE, "agent");
            asm volatile("s_waitcnt vmcnt(0)" ::: "memory");
            const unsigned og = xb_add(&bar[XB_TOP], 1u);
            const unsigned tg = og / nx;
            if (og + 1u == (tg + 1u) * nx) xb_add(&bar[XB_TOPGEN], 1u);
            else XB_SPIN(xb_ld(&bar[XB_TOPGEN]) == tg, bar);
            __builtin_amdgcn_fence(__ATOMIC_ACQUIRE, "agent");
            xb_add(&bar[XB_XGEN(b.x)], 1u);
            asm volatile("s_waitcnt vmcnt(0)" ::: "memory");
        } else {
            XB_SPIN(xb_ld(&bar[XB_XGEN(b.x)]) == gen, bar);
            __builtin_amdgcn_fence(__ATOMIC_ACQUIRE, "agent");
            asm volatile("s_waitcnt vmcnt(0)" ::: "memory");
        }
    }
    __syncthreads();
}

enum { PH_CONVERT = 0, PH_MEMKV, PH_NORM1, PH_INPROJ, PH_MIXPREP, PH_LORA_CMP1, PH_RWPREP2_CMP2_RETU, PH_RWSCAN, PH_RETSCAN, PH_NSACMP, PH_RWPOST_RETOUT, PH_NSAATTN,
       PH_BRANCH, PH_OUTPROJ, PH_FINISH1, PH_QPROJ, PH_XSCORE, PH_XSOFTMAX, PH_XPV, PH_XO, PH_FINISH2, PH_UP, PH_CONVACT, PH_DOWN, PH_FINISH3, PH_COUNT };

template <int PH> __device__ __forceinline__ void run_phase(const Params& p, int l, LAS unsigned char* lds, int bi, int nb) {
    using namespace pg8;
    PROLOG;
    if constexpr (PH == PH_CONVERT) ph_convert(p, l, lds, bi, nb);
    else if constexpr (PH == PH_MEMKV) {
        { GSched s = make_sched(WSP(bf16_t, WS_MEMN), D, WSP(bf16_t, WS_W_KV), D, 2, 8, D, bi, nb); EpiBf16<0> e{WSP(bf16_t, WS_KMEM), D, nullptr}; gemm_phase(lds, D, D, D, s, e); }
        { GSched s = make_sched(WSP(bf16_t, WS_W_KV) + (size_t)D * D, D, WSP(bf16_t, WS_MEMN), D, 8, 2, 512, bi, nb); EpiBf16<0> e{WSP(bf16_t, WS_VTM), 512, nullptr}; gemm_phase(lds, D, D, D, s, e); }
    }
    else if constexpr (PH == PH_NORM1) ph_norm_rows(l == 0 ? inp(p, 0) : (const float*)OUTP, INL(3, D), WSP(bf16_t, WS_H), M, bi, nb);
    else if constexpr (PH == PH_INPROJ) { GSched s = make_sched(WSP(bf16_t, WS_H), D, WSP(bf16_t, WS_W_IN), D, 32, 64, NZ, bi, nb); EpiBf16<0> e{WSP(bf16_t, WS_Z), NZ, nullptr}; gemm_phase(lds, D, D, D, s, e); }
    else if constexpr (PH == PH_MIXPREP) ph_mix_prep(p, l, bi, nb);
    else if constexpr (PH == PH_LORA_CMP1) {
        { GSched s = make_sched(WSP(bf16_t, WS_ALORA), 512, WSP(bf16_t, WS_W_LORA), 512, 32, 6, 1536, bi, nb); EpiF32 e{WSP(float, WS_LO), 1536, 1.f}; gemm_phase(lds, 512, 512, 512, s, e); }
        { GSched s = make_sched(WSP(bf16_t, WS_KVG), 1024, WSP(bf16_t, WS_W_C1), 2048, 1, 1, 256, bi, nb); s.nZ1 = 2; s.nZ2 = 4; s.a_z1 = (long)KVG_SLAB * 2; s.a_z2 = (long)SEQ * 64 * 2; s.b_z1 = (long)256 * 2048 * 2; s.b_z2 = 0;
          s.o_z1 = 4 * 256 * 256; s.o_z2 = 256 * 256;
          EpiC1 e{WSP(bf16_t, WS_HID), WSP(float, WS_CBIAS)}; gemm_phase(lds, 1024, 2048, 2048, s, e); }
    }
    else if constexpr (PH == PH_RWPREP2_CMP2_RETU) { ph_rw_prep2(p, l, bi, nb); ph_cmp2(p, l, bi, nb); ph_ret_u(p, lds, bi, nb); }
    else if constexpr (PH == PH_RWSCAN) ph_rw_scan(p, lds, bi, nb);
    else if constexpr (PH == PH_RETSCAN) ph_ret_scan(p, bi, nb);
    else if constexpr (PH == PH_NSACMP) ph_nsa_cmp(p, lds, bi, nb);
    else if constexpr (PH == PH_RWPOST_RETOUT) { ph_rw_post(p, l, bi, nb); ph_ret_out(p, lds, bi, nb); }
    else if constexpr (PH == PH_NSAATTN) ph_nsa_attn(p, lds, bi, nb);
    else if constexpr (PH == PH_BRANCH) {
        const int koff[4] = {0, 512, 1024, 2048}, kk[4] = {512, 512, 1024, 512};
#pragma unroll
        for (int br = 0; br < 4; ++br) { GSched s = make_sched(WSP(bf16_t, WS_OALL) + koff[br], NBR, WSP(bf16_t, WS_W_BR) + koff[br], NBR, 32, 8, D, bi, nb);
            EpiBranch e{WSP(float, WS_MERGED), WSP(bf16_t, WS_MERGEDB), WSP(bf16_t, WS_Z) + ZC_GATE + br * D, br == 0, br == 3}; gemm_phase(lds, NBR, NBR, kk[br], s, e); }
    }
    else if constexpr (PH == PH_OUTPROJ) { GSched s = make_sched(WSP(bf16_t, WS_MERGEDB), D, WSP(bf16_t, WS_W_OUT), D, 32, 8, D, bi, nb); EpiF32 e{WSP(float, WS_Y), D, 1.f}; gemm_phase(lds, D, D, D, s, e); }
    else if constexpr (PH == PH_FINISH1) ph_finish(l == 0 ? inp(p, 0) : (const float*)OUTP, WSP(float, WS_Y), INL(4, D), INL(5, D), OUTP, WSP(bf16_t, WS_H), bi, nb);
    else if constexpr (PH == PH_QPROJ) { GSched s = make_sched(WSP(bf16_t, WS_H), D, WSP(bf16_t, WS_W_Q), D, 32, 8, D, bi, nb); EpiBf16<0> e{WSP(bf16_t, WS_QX), D, nullptr}; gemm_phase(lds, D, D, D, s, e); }
    else if constexpr (PH == PH_XSCORE) {
        GSched s = make_sched(WSP(bf16_t, WS_QX), D, WSP(bf16_t, WS_KMEM), D, 16, 1, 1024, bi, nb); s.nZ1 = 2; s.nZ2 = 4; s.a_z1 = (long)SEQ * D * 2; s.a_z2 = 512 * 2; s.b_z1 = (long)MEM * D * 2; s.b_z2 = 512 * 2; s.o_z1 = (long)SEQ * 1024; s.o_z2 = 256;
        EpiF32 e{WSP(float, WS_SC), 1024, 0.04419417382415922f}; gemm_phase(lds, D, D, 512, s, e); }
    else if constexpr (PH == PH_XSOFTMAX) ph_xsoftmax(p, bi, nb);
    else if constexpr (PH == PH_XPV) {
        GSched s = make_sched(WSP(bf16_t, WS_PB), 1024, WSP(bf16_t, WS_VTM), 512, 16, 2, D, bi, nb); s.nZ1 = 2; s.nZ2 = 4; s.a_z1 = (long)SEQ * 1024 * 2; s.a_z2 = 256 * 2; s.b_z1 = 256 * 2; s.b_z2 = (long)512 * 512 * 2; s.o_z1 = (long)SEQ * D; s.o_z2 = 512;
        EpiBf16<0> e{WSP(bf16_t, WS_OX), D, nullptr}; gemm_phase(lds, 1024, 512, 256, s, e); }
    else if constexpr (PH == PH_XO) { GSched s = make_sched(WSP(bf16_t, WS_OX), D, WSP(bf16_t, WS_W_O), D, 32, 8, D, bi, nb); EpiF32 e{WSP(float, WS_Y), D, 1.f}; gemm_phase(lds, D, D, D, s, e); }
    else if constexpr (PH == PH_FINISH2) ph_finish(OUTP, WSP(float, WS_Y), INL(7, D), INL(8, D), OUTP, WSP(bf16_t, WS_H), bi, nb);
    else if constexpr (PH == PH_UP) { GSched s = make_sched(WSP(bf16_t, WS_H), D, WSP(bf16_t, WS_W_UP), D, 32, 44, FFN2, bi, nb); EpiBf16<0> e{WSP(bf16_t, WS_U), FFN2, nullptr}; gemm_phase(lds, D, D, D, s, e); }
    else if constexpr (PH == PH_CONVACT) ph_convact(p, l, bi, nb);
    else if constexpr (PH == PH_DOWN) { GSched s = make_sched(WSP(bf16_t, WS_GACT), FFN, WSP(bf16_t, WS_W_DN), FFN, 32, 8, D, bi, nb); EpiF32 e{WSP(float, WS_Y), D, 1.f}; gemm_phase(lds, FFN, FFN, FFN, s, e); }
    else if constexpr (PH == PH_FINISH3) ph_finish(OUTP, WSP(float, WS_Y), INL(9, D), (l + 1 < DEPTH) ? (inp(p, 3) + (size_t)(l + 1) * D) : nullptr, OUTP, WSP(bf16_t, WS_H), bi, nb);
}

__global__ void __launch_bounds__(512, 2) mega_fwd(Params p) {
    extern __shared__ __attribute__((aligned(16))) unsigned char lds_raw[];
    LAS unsigned char* lds = (LAS unsigned char*)lds_raw;
    volatile LAS unsigned* st = (volatile LAS unsigned*)(lds + LDS_BYTES - 16);
    if (threadIdx.x == 0) { st[0] = 0u; st[1] = 0u; st[2] = (unsigned)(u64)p.ws; st[3] = (unsigned)((u64)p.ws >> 32); }
    __syncthreads();
    if (threadIdx.x == 0) { const float** tab = (const float**)(p.ws + WS_PTRTAB);
#pragma unroll
        for (int i = 0; i < 35; ++i) tab[i] = p.in[i];
        tab[35] = p.out; }
    __syncthreads();
    XcdBarrier bar = xcd_barrier_post((unsigned*)(p.ws + WS_CTL) + 1024, st);
    const int bi = (int)blockIdx.x, nb = (int)gridDim.x;
#define PHASE(PH) do { int l_ = l, bi_ = bi; asm volatile("" : "+s"(l_), "+s"(bi_)); run_phase<PH>(p, l_, lds, bi_, nb); xcd_barrier(bar); } while (0)
    for (int l = 0; l < DEPTH; ++l) {
        PHASE(PH_CONVERT);
        PHASE(PH_MEMKV);
        if (l == 0) PHASE(PH_NORM1);
        PHASE(PH_INPROJ);
        PHASE(PH_MIXPREP);
        PHASE(PH_LORA_CMP1);
        PHASE(PH_RWPREP2_CMP2_RETU);
        PHASE(PH_RWSCAN);
        PHASE(PH_RETSCAN);
        PHASE(PH_NSACMP);
        PHASE(PH_RWPOST_RETOUT);
        PHASE(PH_NSAATTN);
        PHASE(PH_BRANCH);
        PHASE(PH_OUTPROJ);
        PHASE(PH_FINISH1);
        PHASE(PH_QPROJ);
        PHASE(PH_XSCORE);
        PHASE(PH_XSOFTMAX);
        PHASE(PH_XPV);
        PHASE(PH_XO);
        PHASE(PH_FINISH2);
        PHASE(PH_UP);
        PHASE(PH_CONVACT);
        PHASE(PH_DOWN);
        PHASE(PH_FINISH3);
    }
#undef PHASE
}

extern "C" void kernel_launch(void* const* d_in, const int* in_sizes, int n_in, void* d_out, int out_size, void* d_ws, size_t ws_size, hipStream_t stream) {
    if (n_in != 35 || ws_size < WS_END) { fprintf(stderr, "kernel_launch: unexpected n_in %d / ws_size %zu (need %zu)\n", n_in, ws_size, (size_t)WS_END); return; }
    static int grid = 0;
    if (grid == 0) {
        int dev = 0, cus = 0, per_cu = 0;
        (void)hipGetDevice(&dev); (void)hipDeviceGetAttribute(&cus, hipDeviceAttributeMultiprocessorCount, dev);
        (void)hipFuncSetAttribute((const void*)mega_fwd, hipFuncAttributeMaxDynamicSharedMemorySize, LDS_BYTES);
        if (hipOccupancyMaxActiveBlocksPerMultiprocessor(&per_cu, (const void*)mega_fwd, 512, LDS_BYTES) != hipSuccess || per_cu < 1) fprintf(stderr, "kernel_launch: occupancy query says %d blocks per CU\n", per_cu);
        (void)hipGetLastError();
        grid = cus > 0 ? cus : 256;
    }
    (void)hipMemsetAsync((char*)d_ws + WS_CTL, 0, 1 * MiB, stream);
    Params p; memset(&p, 0, sizeof(p));
    for (int i = 0; i < 35; ++i) p.in[i] = (const float*)d_in[i];
    p.out = (float*)d_out; p.ws = (unsigned char*)d_ws;
    hipLaunchKernelGGL(mega_fwd, dim3(grid), dim3(512), LDS_BYTES, stream, p);
}
```

```cpp
#include <hip/hip_runtime.h>
#ifndef DUP
#define DUP 0
#endif
#include <cstdio>
#include <cstdint>
#include <cstring>

#define LAS __attribute__((address_space(3)))
typedef unsigned short bf16_t;
typedef short bf16x8 __attribute__((ext_vector_type(8)));
typedef float f32x4 __attribute__((ext_vector_type(4)));
typedef float f32x2 __attribute__((ext_vector_type(2)));
typedef unsigned u32x4 __attribute__((ext_vector_type(4)));
typedef unsigned u32x2 __attribute__((ext_vector_type(2)));
typedef unsigned long long u64;

constexpr int D = 2048, BATCH = 2, SEQ = 4096, M = BATCH * SEQ, DEPTH = 2;
constexpr int NZ = 16384;
constexpr int N_IN = 16088;
constexpr int ZC_SC_B = 0, ZC_SC_C = 512, ZC_SC_X = 1024;
constexpr int ZC_RW = 1536;
constexpr int ZC_RW_R = 1536, ZC_RW_K = 2048, ZC_RW_V = 2560, ZC_RW_ZW = 3072, ZC_RW_ZA = 3168, ZC_RW_ZG = 3264;
constexpr int ZC_RET_Q = 3584, ZC_RET_K = 4096, ZC_RET_V = 4608, ZC_RET_G = 5632;
constexpr int ZC_NSA_Q = 6656, ZC_NSA_KC = 7168, ZC_NSA_VC = 7296, ZC_NSA_KS = 7424, ZC_NSA_VS = 7552, ZC_NSA_KW = 7680, ZC_NSA_VW = 7808, ZC_NSA_GT = 7936;
constexpr int ZC_GATE = 8192;
constexpr int NBR = 2560;
constexpr int FFN = 5632, FFN2 = 11264;
constexpr int MEM = 256;

constexpr size_t MiB = 1u << 20;
constexpr size_t WS_CTL = 0;
constexpr size_t WS_W_IN = 1 * MiB, WS_W_BR = 65 * MiB, WS_W_OUT = 75 * MiB, WS_W_Q = 83 * MiB, WS_W_KV = 91 * MiB, WS_W_O = 107 * MiB;
constexpr size_t WS_W_UP = 115 * MiB, WS_W_DN = 159 * MiB, WS_W_LORA = 181 * MiB, WS_W_C1 = 183 * MiB;
constexpr size_t WS_CBIAS = 185 * MiB, WS_MEMN = 186 * MiB, WS_KMEM = 188 * MiB, WS_VTM = 190 * MiB;
constexpr size_t WS_H = 192 * MiB, WS_Z = 224 * MiB, WS_OALL = 480 * MiB, WS_MERGED = 520 * MiB, WS_MERGEDB = 584 * MiB, WS_Y = 616 * MiB;
constexpr size_t WS_T = 680 * MiB;
constexpr size_t WS_ALORA = WS_T, WS_LO = WS_T + 8 * MiB, WS_RWOPS = WS_T + 56 * MiB, WS_YSCAN = WS_T + 152 * MiB;
constexpr size_t WS_QR = WS_T + 168 * MiB, WS_KR = WS_T + 176 * MiB, WS_UBUF = WS_T + 184 * MiB, WS_RPREV = WS_T + 216 * MiB;
constexpr size_t WS_QN = WS_T + 232 * MiB, WS_KVG = WS_T + 240 * MiB, WS_HID = WS_T + 253 * MiB, WS_KCMP = WS_T + 254 * MiB, WS_VCMPT = WS_T + 254 * MiB + 512 * 1024;
constexpr size_t WS_OCMP = WS_T + 255 * MiB, WS_SELM = WS_T + 263 * MiB;
constexpr size_t WS_END = WS_T + 264 * MiB;
constexpr size_t WS_QX = WS_Z, WS_SC = WS_Z + 32 * MiB, WS_PB = WS_Z + 64 * MiB, WS_OX = WS_Z + 80 * MiB;
constexpr size_t WS_U = WS_Z, WS_GACT = WS_T;
constexpr size_t WS_RW_PF = WS_MERGED, WS_RW_QF = WS_MERGED + 32 * MiB, WS_RW_RF = WS_MERGED + 96 * MiB, WS_RW_Y0F = WS_MERGED + 104 * MiB;
constexpr size_t KVG_SLAB = (size_t)BATCH * 2 * SEQ * 64;

constexpr int LDS_BYTES = 147456;

struct Params {
    const float* in[35];
    float* out;
    unsigned char* ws;
};

__device__ __forceinline__ int otid() { int t = (int)threadIdx.x; asm volatile("" : "+v"(t)); return t; }
__device__ __forceinline__ float bf2f(bf16_t v) { return __uint_as_float((unsigned)v << 16); }
typedef __bf16 bf16x2_t __attribute__((ext_vector_type(2)));
__device__ __forceinline__ unsigned cvt_pk_bf16(float lo, float hi) { const f32x2 v = {lo, hi}; const bf16x2_t b = __builtin_convertvector(v, bf16x2_t); return __builtin_bit_cast(unsigned, b); }
__device__ __forceinline__ bf16_t f2bf(float f) { return (bf16_t)(cvt_pk_bf16(f, 0.f) & 0xffffu); }
__device__ __forceinline__ float wave_sum(float v) {
#pragma unroll
    for (int o = 1; o < 64; o <<= 1) v += __shfl_xor(v, o);
    return v;
}
__device__ __forceinline__ float sigmoidf_(float x) { return 1.f / (1.f + __expf(-x)); }
__device__ __forceinline__ float gelu_tanh(float x) { const float u = 1.5957691216057308f * (x + 0.044715f * x * x * x); return x / (1.f + __expf(-u)); }
__device__ __forceinline__ f32x4 mma16(f32x4 acc, bf16x8 a_rowfrag, bf16x8 b_colfrag) {
    return __builtin_amdgcn_mfma_f32_16x16x32_bf16(b_colfrag, a_rowfrag, acc, 0, 0, 0);
}
__device__ __forceinline__ bf16x8 ldfrag(const bf16_t* p) { return *(const bf16x8*)p; }

namespace pg8 {
constexpr int BM = 256, BK = 64, HALF = 128, HTB = HALF * BK * 2, STAGE_BYTES = 8 * HTB, NXCD = 8, WGM = 8;
__host__ __device__ __forceinline__ int lds_byte(int r, int c) { const int st = (r >> 4) * 2 + (c >> 5), rr = r & 15, cc = c & 31, ob = rr * 64 + cc * 2; return st * 1024 + (ob ^ (((ob >> 9) & 1) << 5)); }
__host__ __device__ __forceinline__ void stage_rc(int b, int& R, int& C) { const int st = b / 1024, sb = b % 1024, swz = sb ^ (((sb >> 9) & 1) << 5); R = (st >> 1) * 16 + swz / 64; C = (st & 1) * 32 + (swz % 64) / 2; }
__host__ __device__ __forceinline__ int perm32(int rho) { const int n = rho >> 4, i = rho & 15; return 8 * (i >> 2) + 4 * n + (i & 3); }

struct Unit { const char* A; const char* B; size_t ooff; int pm, pn, z; };

struct GSched {
    const char* A; const char* B;
    long a_pm, b_pn;
    long a_z1, a_z2, b_z1, b_z2;
    long o_pm, o_pn, o_z1, o_z2;
    int nM, nN, nZ1, nZ2, G, c;
    __device__ __forceinline__ bool next(int i, Unit& u) const {
        const int per = nM * nN; const long L = (long)i * G + c; if (L >= (long)per * nZ1 * nZ2) return false;
        const int zz = (int)(L / per); int wgid = (int)(L % per);
        { const int q = per / NXCD, r = per % NXCD, xcd = wgid % NXCD, off = wgid / NXCD; wgid = (xcd < r ? xcd * (q + 1) : r * (q + 1) + (xcd - r) * q) + off; }
        const int nig = WGM * nN, gid = wgid / nig, fm = gid * WGM, gsz = (nM - fm) < WGM ? (nM - fm) : WGM;
        const int pm = fm + ((wgid % nig) % gsz), pn = (wgid % nig) / gsz;
        const int z1 = zz / nZ2, z2 = zz % nZ2;
        u.pm = pm; u.pn = pn; u.z = zz;
        u.A = A + z1 * a_z1 + z2 * a_z2 + pm * a_pm; u.B = B + z1 * b_z1 + z2 * b_z2 + pn * b_pn;
        u.ooff = (size_t)(z1 * o_z1 + z2 * o_z2 + pm * o_pm + pn * o_pn);
        return true;
    }
};
__device__ __forceinline__ GSched make_sched(const void* A, int lda, const void* B, int ldb, int nM, int nN, long ldc, int bi, int nb) {
    GSched s; s.A = (const char*)A; s.B = (const char*)B; s.a_pm = (long)BM * lda * 2; s.b_pn = (long)BM * ldb * 2; s.a_z1 = s.a_z2 = s.b_z1 = s.b_z2 = 0;
    s.o_pm = (long)BM * ldc; s.o_pn = BM; s.o_z1 = s.o_z2 = 0; s.nM = nM; s.nN = nN; s.nZ1 = 1; s.nZ2 = 1; s.G = nb; s.c = bi; return s;
}

template <class Epi, class Sched>
__device__ __forceinline__ void gemm_phase(LAS unsigned char* lds, const int lda, const int ldb, const int K, const Sched& S, const Epi& E) {
    const int tid = otid(), wid = __builtin_amdgcn_readfirstlane(tid >> 6), lane = tid & 63, wr = wid >> 2, wc = wid & 3, fr = lane & 15, fq = lane >> 4;
    const int nt = K / BK;
    unsigned voffA[2], voffB[2];
#pragma unroll
    for (int i = 0; i < 2; ++i) { int R, C; stage_rc(tid * 16 + i * 8192, R, C); const int Rb = Epi::PERM ? ((R & ~31) + perm32(R & 31)) : R;
        voffA[i] = (unsigned)(R * lda + C) * 2u; voffB[i] = (unsigned)(Rb * ldb + C) * 2u; }
    const size_t kstep = (size_t)(BK * 2);
    const size_t hstepA = (size_t)HALF * lda * 2, hstepB = (size_t)HALF * ldb * 2;
    const unsigned ldsw = (unsigned)wid * 1024u;
    const int aoff = lds_byte(wr * 64 + fr, fq * 8), boff = lds_byte(wc * 32 + fr, fq * 8);
#define PG8_SA(b, h) (((b) * 2 + (h)) * HTB)
#define PG8_SB(b, h) ((4 + (b) * 2 + (h)) * HTB)
#define PG8_STAGE(bufoff, gbase, voff) do { _Pragma("unroll") for (int _i = 0; _i < 2; ++_i) \
        __builtin_amdgcn_global_load_lds((const unsigned*)((const char*)(gbase) + (voff)[_i]), (LAS unsigned*)(lds + (bufoff) + ldsw + _i * 8192), 16, 0, 0); } while (0)
#define PG8_LDA(dst, b, h) do { _Pragma("unroll") for (int m = 0; m < 4; ++m) _Pragma("unroll") for (int k = 0; k < 2; ++k) dst[m][k] = *(const LAS bf16x8*)(lds + PG8_SA(b, h) + aoff + m * 2048 + k * 1024); } while (0)
#define PG8_LDB(dst, b, h) do { _Pragma("unroll") for (int n = 0; n < 2; ++n) _Pragma("unroll") for (int k = 0; k < 2; ++k) dst[n][k] = *(const LAS bf16x8*)(lds + PG8_SB(b, h) + boff + n * 2048 + k * 1024); } while (0)
#define PG8_MMA(ai, bj, At, Bt) do { __builtin_amdgcn_s_setprio(1); _Pragma("unroll") for (int m = 0; m < 4; ++m) _Pragma("unroll") for (int n = 0; n < 2; ++n) _Pragma("unroll") for (int k = 0; k < 2; ++k) \
        acc[ai][bj][m][n] = __builtin_amdgcn_mfma_f32_16x16x32_bf16(Bt[n][k], At[m][k], acc[ai][bj][m][n], 0, 0, 0); __builtin_amdgcn_s_setprio(0); } while (0)
#define PG8_WAIT_V(n) asm volatile("s_waitcnt vmcnt(" #n ")" ::: "memory")
#define PG8_WAIT_L(n) asm volatile("s_waitcnt lgkmcnt(" #n ")" ::: "memory")
#define PG8_BAR __builtin_amdgcn_s_barrier()
#define PG8_SCHED __builtin_amdgcn_sched_barrier(0)
    Unit cur, nxt; int ui = 0;
    if (!S.next(0, cur)) return;
    f32x4 acc[2][2][4][2];
#pragma unroll
    for (int a = 0; a < 2; ++a)
#pragma unroll
        for (int b = 0; b < 2; ++b)
#pragma unroll
            for (int m = 0; m < 4; ++m)
#pragma unroll
                for (int n = 0; n < 2; ++n) acc[a][b][m][n] = (f32x4){0.f, 0.f, 0.f, 0.f};
    bf16x8 At[4][2], B0[2][2], B1[2][2];
    const char* cA = cur.A; const char* cB = cur.B;
    PG8_STAGE(PG8_SB(0, 0), cB, voffB); PG8_STAGE(PG8_SB(0, 1), cB + hstepB, voffB); PG8_STAGE(PG8_SA(0, 0), cA, voffA); PG8_STAGE(PG8_SA(0, 1), cA + hstepA, voffA);
    if (wr == 1) PG8_BAR;
    PG8_WAIT_V(2); PG8_BAR;
    PG8_STAGE(PG8_SB(1, 0), cB + kstep, voffB); PG8_STAGE(PG8_SA(1, 0), cA + kstep, voffA); PG8_STAGE(PG8_SB(1, 1), cB + hstepB + kstep, voffB);
    PG8_WAIT_V(6); PG8_BAR;
    for (;;) {
        const bool has_next = S.next(ui + 1, nxt);
        const char* nA = has_next ? nxt.A : cA; const char* nB = has_next ? nxt.B : cB;
        for (int t = 0; t < nt; t += 2) {
            const bool last = (t == nt - 2);
            const char* a1 = cA + (size_t)(t + 1) * kstep;
            const char* a2 = last ? nA : cA + (size_t)(t + 2) * kstep; const char* b2 = last ? nB : cB + (size_t)(t + 2) * kstep;
            const char* a3 = a2 + kstep; const char* b3 = b2 + kstep;
            PG8_LDB(B0, 0, 0); PG8_LDB(B1, 0, 1); PG8_SCHED; PG8_LDA(At, 0, 0); PG8_STAGE(PG8_SA(1, 1), a1 + hstepA, voffA);
            PG8_WAIT_V(8); PG8_WAIT_L(0); PG8_BAR; PG8_MMA(0, 0, At, B0); PG8_MMA(0, 1, At, B1); PG8_BAR; PG8_SCHED;
            PG8_LDA(At, 0, 1); PG8_STAGE(PG8_SB(0, 0), b2, voffB); PG8_STAGE(PG8_SB(0, 1), b2 + hstepB, voffB); PG8_STAGE(PG8_SA(0, 0), a2, voffA);
            PG8_WAIT_V(8); PG8_WAIT_L(0); PG8_BAR; PG8_MMA(1, 0, At, B0); PG8_MMA(1, 1, At, B1); PG8_BAR; PG8_SCHED;
            PG8_LDB(B0, 1, 0); PG8_LDB(B1, 1, 1); PG8_SCHED; PG8_LDA(At, 1, 0); PG8_STAGE(PG8_SA(0, 1), a2 + hstepA, voffA);
            PG8_WAIT_V(8); PG8_WAIT_L(0); PG8_BAR; PG8_MMA(0, 0, At, B0); PG8_MMA(0, 1, At, B1); PG8_BAR; PG8_SCHED;
            PG8_LDA(At, 1, 1); PG8_STAGE(PG8_SB(1, 0), b3, voffB); PG8_STAGE(PG8_SB(1, 1), b3 + hstepB, voffB); PG8_STAGE(PG8_SA(1, 0), a3, voffA);
            PG8_WAIT_V(8); PG8_WAIT_L(0); PG8_BAR; PG8_MMA(1, 0, At, B0); PG8_MMA(1, 1, At, B1); PG8_BAR; PG8_SCHED;
        }
        if (wr == 0) PG8_BAR;
        E(acc, cur, wr, wc, fr, fq);
        if (!has_next) break;
#pragma unroll
        for (int a = 0; a < 2; ++a)
#pragma unroll
            for (int b = 0; b < 2; ++b)
#pragma unroll
                for (int m = 0; m < 4; ++m)
#pragma unroll
                    for (int n = 0; n < 2; ++n) acc[a][b][m][n] = (f32x4){0.f, 0.f, 0.f, 0.f};
        cur = nxt; cA = nA; cB = nB; ++ui;
        if (wr == 1) PG8_BAR;
    }
    PG8_WAIT_V(0);
    PG8_BAR;
#undef PG8_SA
#undef PG8_SB
#undef PG8_STAGE
#undef PG8_LDA
#undef PG8_LDB
#undef PG8_MMA
#undef PG8_WAIT_V
#undef PG8_WAIT_L
#undef PG8_BAR
#undef PG8_SCHED
}

template <int ACT> struct EpiBf16 {
    static constexpr bool PERM = true;
    bf16_t* O; int ldc; const float* bias;
    __device__ __forceinline__ void operator()(const f32x4 (&acc)[2][2][4][2], const Unit& u, int wr, int wc, int fr, int fq) const {
        bf16_t* base = O + u.ooff; const int col0 = wc * 32 + 8 * fq;
#pragma unroll
        for (int ai = 0; ai < 2; ++ai)
#pragma unroll
            for (int m = 0; m < 4; ++m) { bf16_t* rowp = base + (size_t)(ai * HALF + wr * 64 + m * 16 + fr) * ldc + col0;
#pragma unroll
                for (int bj = 0; bj < 2; ++bj) { f32x4 v0 = acc[ai][bj][m][0], v1 = acc[ai][bj][m][1];
                    if (ACT == 1) { const float* bp = bias + u.pn * BM + col0 + bj * HALF; const f32x4 b0 = *(const f32x4*)bp, b1 = *(const f32x4*)(bp + 4);
                        v0 += b0; v1 += b1;
#pragma unroll
                        for (int j = 0; j < 4; ++j) { v0[j] = gelu_tanh(v0[j]); v1[j] = gelu_tanh(v1[j]); } }
                    u32x4 w; w.x = cvt_pk_bf16(v0[0], v0[1]); w.y = cvt_pk_bf16(v0[2], v0[3]); w.z = cvt_pk_bf16(v1[0], v1[1]); w.w = cvt_pk_bf16(v1[2], v1[3]);
                    *(u32x4*)(rowp + bj * HALF) = w; } }
    }
};
struct EpiF32 {
    static constexpr bool PERM = false;
    float* C; int ldc; float scale;
    __device__ __forceinline__ void operator()(const f32x4 (&acc)[2][2][4][2], const Unit& u, int wr, int wc, int fr, int fq) const {
        float* base = C + u.ooff; const int col0 = wc * 32 + 4 * fq;
#pragma unroll
        for (int ai = 0; ai < 2; ++ai)
#pragma unroll
            for (int m = 0; m < 4; ++m) { float* rowp = base + (size_t)(ai * HALF + wr * 64 + m * 16 + fr) * ldc + col0;
#pragma unroll
                for (int bj = 0; bj < 2; ++bj)
#pragma unroll
                    for (int n = 0; n < 2; ++n) *(f32x4*)(rowp + bj * HALF + n * 16) = acc[ai][bj][m][n] * scale; }
    }
};
struct EpiBranch {
    static constexpr bool PERM = false;
    float* merged; bf16_t* mergedb; const bf16_t* gate; int first, last;
    __device__ __forceinline__ void operator()(const f32x4 (&acc)[2][2][4][2], const Unit& u, int wr, int wc, int fr, int fq) const {
        const int col0 = u.pn * BM + wc * 32 + 4 * fq;
#pragma unroll
        for (int ai = 0; ai < 2; ++ai)
#pragma unroll
            for (int m = 0; m < 4; ++m) { const size_t row = (size_t)(u.pm * BM + ai * HALF + wr * 64 + m * 16 + fr);
#pragma unroll
                for (int bj = 0; bj < 2; ++bj)
#pragma unroll
                    for (int n = 0; n < 2; ++n) { const int col = col0 + bj * HALF + n * 16;
                        const u32x2 gw = *(const u32x2*)(gate + row * NZ + col);
                        f32x4 g; g[0] = sigmoidf_(__uint_as_float(gw.x << 16)); g[1] = sigmoidf_(__uint_as_float(gw.x & 0xffff0000u)); g[2] = sigmoidf_(__uint_as_float(gw.y << 16)); g[3] = sigmoidf_(__uint_as_float(gw.y & 0xffff0000u));
                        f32x4 v = acc[ai][bj][m][n] * g;
                        if (!first) v += *(const f32x4*)(merged + row * D + col);
                        if (last) { u32x2 w; w.x = cvt_pk_bf16(v[0], v[1]); w.y = cvt_pk_bf16(v[2], v[3]); *(u32x2*)(mergedb + row * D + col) = w; }
                        else *(f32x4*)(merged + row * D + col) = v; } }
    }
};
struct EpiC1 { static constexpr bool PERM = true; bf16_t* O; const float* bias;
    __device__ __forceinline__ void operator()(const f32x4 (&acc)[2][2][4][2], const Unit& u, int wr, int wc, int fr, int fq) const { EpiBf16<1> e{O, 256, bias + (u.z >> 2) * 256}; e(acc, u, wr, wc, fr, fq); } };
}

__device__ __forceinline__ void ph_norm_rows(const float* x, const float* g, bf16_t* out, int rows, int bi, int nb) {
    const int tid_ = otid(), lane = tid_ & 63, gw = bi * 8 + (tid_ >> 6), NGW = nb * 8;
    for (int m = gw; m < rows; m += NGW) {
        const f32x4* xr = (const f32x4*)(x + (size_t)m * D) + lane; f32x4 v[8]; float s = 0.f;
#pragma unroll
        for (int j = 0; j < 8; ++j) { v[j] = xr[64 * j]; s += v[j][0] * v[j][0] + v[j][1] * v[j][1] + v[j][2] * v[j][2] + v[j][3] * v[j][3]; }
        const float rstd = rsqrtf(wave_sum(s) * (1.f / D) + 1e-6f);
        u32x2* o = (u32x2*)(out + (size_t)m * D) + lane;
#pragma unroll
        for (int j = 0; j < 8; ++j) { const f32x4 gg = ((const f32x4*)g)[lane + 64 * j]; u32x2 w; w.x = cvt_pk_bf16(v[j][0] * rstd * gg[0], v[j][1] * rstd * gg[1]); w.y = cvt_pk_bf16(v[j][2] * rstd * gg[2], v[j][3] * rstd * gg[3]); o[64 * j] = w; }
    }
}
__device__ __forceinline__ void ph_finish(const float* xin, const float* y, const float* g1, const float* g2, float* xout, bf16_t* h, int bi, int nb) {
    const int tid_ = otid(), lane = tid_ & 63, gw = bi * 8 + (tid_ >> 6), NGW = nb * 8;
    for (int m = gw; m < M; m += NGW) {
        const f32x4* yr = (const f32x4*)(y + (size_t)m * D) + lane; const f32x4* xr = (const f32x4*)(xin + (size_t)m * D) + lane; f32x4 v[8]; float s = 0.f;
#pragma unroll
        for (int j = 0; j < 8; ++j) { v[j] = yr[64 * j]; s += v[j][0] * v[j][0] + v[j][1] * v[j][1] + v[j][2] * v[j][2] + v[j][3] * v[j][3]; }
        const float rstd = rsqrtf(wave_sum(s) * (1.f / D) + 1e-6f); float s2 = 0.f;
        f32x4* xo = (f32x4*)(xout + (size_t)m * D) + lane;
#pragma unroll
        for (int j = 0; j < 8; ++j) { const f32x4 gg = ((const f32x4*)g1)[lane + 64 * j]; const f32x4 xv = xr[64 * j];
            v[j] = xv + v[j] * rstd * gg; xo[64 * j] = v[j]; s2 += v[j][0] * v[j][0] + v[j][1] * v[j][1] + v[j][2] * v[j][2] + v[j][3] * v[j][3]; }
        if (g2) { const float r2 = rsqrtf(wave_sum(s2) * (1.f / D) + 1e-6f); u32x2* o = (u32x2*)(h + (size_t)m * D) + lane;
#pragma unroll
            for (int j = 0; j < 8; ++j) { const f32x4 gg = ((const f32x4*)g2)[lane + 64 * j]; u32x2 w; w.x = cvt_pk_bf16(v[j][0] * r2 * gg[0], v[j][1] * r2 * gg[1]); w.y = cvt_pk_bf16(v[j][2] * r2 * gg[2], v[j][3] * r2 * gg[3]); o[64 * j] = w; } }
    }
}

enum { MAP_ID = 0, MAP_WIN = 1, MAP_UP = 2 };
__device__ __forceinline__ int cmap(int kind, int n) {
    if (kind == MAP_ID) return n;
    if (kind == MAP_WIN) { if (n < 3520) return n; if (n < 3584) return -1; if (n < 6656) return n - 64; if (n < 7960) return n - 64; if (n < 8192) return -1; return n - 296; }
    const int j = n >> 8, s = n & 255; return s < 128 ? 128 * j + s : FFN + 128 * j + (s - 128);
}
__device__ __forceinline__ void transpose_item(const float* W, int K, int Nsrc, bf16_t* WT, int kind, LAS float* scr, int item, int nblk, int lane) {
    const int kb = item / nblk, nb_ = item % nblk, k0 = 64 * kb, n0 = 32 * nb_;
    const int src = cmap(kind, n0 + (lane & 31));
#pragma unroll 8
    for (int i = 0; i < 32; ++i) { const int kk = 2 * i + (lane >> 5); scr[kk * 33 + (lane & 31)] = src >= 0 ? W[(size_t)(k0 + kk) * Nsrc + src] : 0.f; }
    asm volatile("s_waitcnt lgkmcnt(0)" ::: "memory");
    const int c = lane & 7;
#pragma unroll
    for (int j = 0; j < 4; ++j) { const int n = (lane >> 3) + 8 * j; const LAS float* s = scr + (8 * c) * 33 + n;
        u32x4 o; o.x = cvt_pk_bf16(s[0 * 33], s[1 * 33]); o.y = cvt_pk_bf16(s[2 * 33], s[3 * 33]); o.z = cvt_pk_bf16(s[4 * 33], s[5 * 33]); o.w = cvt_pk_bf16(s[6 * 33], s[7 * 33]);
        *(u32x4*)(WT + (size_t)(n0 + n) * K + k0 + 8 * c) = o; }
    asm volatile("s_waitcnt lgkmcnt(0)" ::: "memory");
}
__device__ __forceinline__ unsigned char* ws_lds() {
    volatile LAS unsigned* q = (volatile LAS unsigned*)(LDS_BYTES - 8); unsigned lo = q[0], hi = q[1];
    lo = (unsigned)__builtin_amdgcn_readfirstlane((int)lo); hi = (unsigned)__builtin_amdgcn_readfirstlane((int)hi); return (unsigned char*)(((u64)hi << 32) | (u64)lo); }
#define PROLOG unsigned char* const wsl = ws_lds()
#define WS_PTRTAB 256
#define inp(p_, i) (((const float* const*)(wsl + WS_PTRTAB))[i])
#define OUTP ((float*)(((const float* const*)(wsl + WS_PTRTAB))[35]))
#define WSP(T, off) ((T*)(wsl + (off)))
#define INL(i, per) (inp(p, i) + (size_t)l * (per))

__device__ __forceinline__ void ph_convert(const Params& p, int l, LAS unsigned char* lds, int bi, int nb) {
    PROLOG;
    const int tid_ = otid(), lane = tid_ & 63, wave = tid_ >> 6, gw = bi * 8 + wave, NGW = nb * 8;
    LAS float* scr = (LAS float*)(lds + wave * 16384);
    const int I0 = 32 * 512, I1 = 40 * 64, I2 = 32 * 64, I3 = 32 * 128, I4 = 32 * 352, I5 = 88 * 64, I6 = 32 * 8;
    const int NIT = I0 + I1 + 3 * I2 + I3 + I4 + I5 + 2 * I6;
    for (int it = gw; it < NIT; it += NGW) {
        int r = it;
        if (r < I0) { transpose_item(INL(10, (size_t)D * N_IN), D, N_IN, WSP(bf16_t, WS_W_IN), MAP_WIN, scr, r, 512, lane); continue; } r -= I0;
        if (r < I1) { transpose_item(INL(26, (size_t)NBR * D), NBR, D, WSP(bf16_t, WS_W_BR), MAP_ID, scr, r, 64, lane); continue; } r -= I1;
        if (r < I2) { transpose_item(INL(27, (size_t)D * D), D, D, WSP(bf16_t, WS_W_OUT), MAP_ID, scr, r, 64, lane); continue; } r -= I2;
        if (r < I2) { transpose_item(INL(28, (size_t)D * D), D, D, WSP(bf16_t, WS_W_Q), MAP_ID, scr, r, 64, lane); continue; } r -= I2;
        if (r < I2) { transpose_item(INL(30, (size_t)D * D), D, D, WSP(bf16_t, WS_W_O), MAP_ID, scr, r, 64, lane); continue; } r -= I2;
        if (r < I3) { transpose_item(INL(29, (size_t)D * 2 * D), D, 2 * D, WSP(bf16_t, WS_W_KV), MAP_ID, scr, r, 128, lane); continue; } r -= I3;
        if (r < I4) { transpose_item(INL(31, (size_t)D * FFN2), D, FFN2, WSP(bf16_t, WS_W_UP), MAP_UP, scr, r, 352, lane); continue; } r -= I4;
        if (r < I5) { transpose_item(INL(34, (size_t)FFN * D), FFN, D, WSP(bf16_t, WS_W_DN), MAP_ID, scr, r, 64, lane); continue; } r -= I5;
        if (r < I6) { transpose_item(INL(24, (size_t)2 * 2048 * 256), 2048, 256, WSP(bf16_t, WS_W_C1), MAP_ID, scr, r, 8, lane); continue; } r -= I6;
        transpose_item(INL(24, (size_t)2 * 2048 * 256) + (size_t)2048 * 256, 2048, 256, WSP(bf16_t, WS_W_C1) + (size_t)256 * 2048, MAP_ID, scr, r, 8, lane);
    }
    const int gt = bi * 512 + otid(), NT = nb * 512;
    bf16_t* wl = WSP(bf16_t, WS_W_LORA);
    const float* w2 = INL(14, 96 * 512); const float* a2 = INL(16, 96 * 512); const float* g2 = INL(17, 256 * 512);
    for (int i = gt; i < 1536 * 512; i += NT) { const int n = i >> 9, k = i & 511; float v = 0.f;
        if (n < 512) { if (k < 96) v = w2[k * 512 + n]; } else if (n < 1024) { if (k >= 128 && k < 224) v = a2[(k - 128) * 512 + (n - 512)]; } else { if (k >= 256) v = g2[(k - 256) * 512 + (n - 1024)]; }
        wl[i] = f2bf(v); }
    float* cb = WSP(float, WS_CBIAS);
    for (int i = gt; i < 512; i += NT) { const int ii = i >> 8, n = i & 255; const float* pos = INL(23, 2 * 32 * 64) + ii * 2048; const float* w1 = INL(24, (size_t)2 * 2048 * 256) + (size_t)ii * 2048 * 256; float s = 0.f;
        for (int k = 0; k < 2048; ++k) s += pos[k] * w1[(size_t)k * 256 + n]; cb[i] = s; }
    ph_norm_rows(inp(p, 1), INL(6, D), WSP(bf16_t, WS_MEMN), BATCH * MEM, bi, nb);
}

__device__ __forceinline__ float zf(const bf16_t* zr, int c) { return bf2f(zr[c]); }
__device__ __forceinline__ void ph_mix_prep(const Params& p, int l, int bi, int nb) {
    PROLOG;
    const int tid_ = otid(), lane = tid_ & 63, gw = bi * 8 + (tid_ >> 6), NGW = nb * 8;
    const bf16_t* z = WSP(bf16_t, WS_Z); bf16_t* oall = WSP(bf16_t, WS_OALL); bf16_t* alora = WSP(bf16_t, WS_ALORA);
    bf16_t* qr = WSP(bf16_t, WS_QR); bf16_t* kr = WSP(bf16_t, WS_KR); bf16_t* qn = WSP(bf16_t, WS_QN); bf16_t* kvg = WSP(bf16_t, WS_KVG);
    const float* scw = INL(11, 3 * 512); const float* mu = INL(12, 1984); const int* posi = (const int*)inp(p, 2);
    for (int m = gw; m < M; m += NGW) {
        const int b = m >> 12, t = m & 4095; const bf16_t* zr = z + (size_t)m * NZ; const bf16_t* z1 = zr - NZ; const bf16_t* z2 = zr - 2 * NZ;
        const float pos = (float)posi[m];
        for (int c = lane; c < 512; c += 64) {
            float s = scw[2 * 512 + c] * zf(zr, ZC_SC_C + c) * zf(zr, ZC_SC_X + c);
            if (t >= 1) s += scw[1 * 512 + c] * zf(z1, ZC_SC_C + c) * zf(z1, ZC_SC_X + c);
            if (t >= 2) s += scw[0 * 512 + c] * zf(z2, ZC_SC_C + c) * zf(z2, ZC_SC_X + c);
            oall[(size_t)m * NBR + c] = f2bf(zf(zr, ZC_SC_B + c) * s);
        }
        for (int c = lane; c < 512; c += 64) {
            int src = -1, kind = 0;
            if (c < 96) { src = ZC_RW_ZW + c; kind = 1; } else if (c >= 128 && c < 224) { src = ZC_RW_ZA + (c - 128); kind = 0; } else if (c >= 256) { src = ZC_RW_ZG + (c - 256); kind = 2; }
            float v = 0.f;
            if (src >= 0) { const float a = zf(zr, src), pv = t >= 1 ? zf(z1, src) : 0.f; v = a + (pv - a) * mu[src - ZC_RW]; v = kind == 1 ? tanhf(v) : (kind == 2 ? sigmoidf_(v) : v); }
            alora[(size_t)m * 512 + c] = f2bf(v);
        }
        for (int i = lane; i < 256; i += 64) { const int hh = i >> 6, ii = i & 63; const float inv = __expf(-(float)ii * (9.210340371976184f / 63.f)); float sn, cs; sincosf(pos * inv, &sn, &cs);
            const float q1 = zf(zr, ZC_RET_Q + hh * 128 + ii), q2 = zf(zr, ZC_RET_Q + hh * 128 + 64 + ii), k1 = zf(zr, ZC_RET_K + hh * 128 + ii), k2 = zf(zr, ZC_RET_K + hh * 128 + 64 + ii);
            const float ksc = 0.08838834764831845f;
            qr[(size_t)m * 512 + hh * 128 + ii] = f2bf(q1 * cs - q2 * sn); qr[(size_t)m * 512 + hh * 128 + 64 + ii] = f2bf(q2 * cs + q1 * sn);
            kr[(size_t)m * 512 + hh * 128 + ii] = f2bf((k1 * cs - k2 * sn) * ksc); kr[(size_t)m * 512 + hh * 128 + 64 + ii] = f2bf((k2 * cs + k1 * sn) * ksc); }
        for (int i = lane; i < 256; i += 64) { const int hh = i >> 5, ii = i & 31; const float inv = __expf(-(float)ii * (9.210340371976184f / 32.f)); float sn, cs; sincosf(pos * inv, &sn, &cs);
            const float q1 = zf(zr, ZC_NSA_Q + hh * 64 + ii), q2 = zf(zr, ZC_NSA_Q + hh * 64 + 32 + ii);
            qn[(size_t)m * 512 + hh * 64 + ii] = f2bf(q1 * cs - q2 * sn); qn[(size_t)m * 512 + hh * 64 + 32 + ii] = f2bf(q2 * cs + q1 * sn); }
        { const int g = lane >> 5, ii = lane & 31; const float inv = __expf(-(float)ii * (9.210340371976184f / 32.f)); float sn, cs; sincosf(pos * inv, &sn, &cs);
            const size_t rowo = ((size_t)(b * 2 + g) * SEQ + t) * 64;
            { const float k1 = zf(zr, ZC_NSA_KS + g * 64 + ii), k2 = zf(zr, ZC_NSA_KS + g * 64 + 32 + ii); kvg[2 * KVG_SLAB + rowo + ii] = f2bf(k1 * cs - k2 * sn); kvg[2 * KVG_SLAB + rowo + 32 + ii] = f2bf(k2 * cs + k1 * sn); }
            { const float k1 = zf(zr, ZC_NSA_KW + g * 64 + ii), k2 = zf(zr, ZC_NSA_KW + g * 64 + 32 + ii); kvg[4 * KVG_SLAB + rowo + ii] = f2bf(k1 * cs - k2 * sn); kvg[4 * KVG_SLAB + rowo + 32 + ii] = f2bf(k2 * cs + k1 * sn); } }
        for (int i = lane; i < 128; i += 64) { const int g = i >> 6, d = i & 63; const size_t rowo = ((size_t)(b * 2 + g) * SEQ + t) * 64; const size_t tro = ((size_t)(b * 2 + g) * 64 + d) * SEQ + t;
            kvg[0 * KVG_SLAB + rowo + d] = zr[ZC_NSA_KC + i]; kvg[1 * KVG_SLAB + rowo + d] = zr[ZC_NSA_VC + i];
            kvg[3 * KVG_SLAB + tro] = zr[ZC_NSA_VS + i]; kvg[5 * KVG_SLAB + tro] = zr[ZC_NSA_VW + i]; }
    }
}

__device__ __forceinline__ void ph_rw_prep2(const Params& p, int l, int bi, int nb) {
    PROLOG;
    const int tid_ = otid(), lane = tid_ & 63, gw = bi * 8 + (tid_ >> 6), NGW = nb * 8;
    const bf16_t* z = WSP(bf16_t, WS_Z); const float* lo = WSP(float, WS_LO); float* ops = WSP(float, WS_RWOPS);
    const float* mu = INL(12, 1984); const float* w0 = INL(13, 512); const float* a0 = INL(15, 512); const float* kkw = INL(18, 512); const float* kaw = INL(19, 512);
    constexpr size_t AS = (size_t)M * 512;
    for (int it = gw; it < M * 8; it += NGW) {
        const int m = it >> 3, hh = it & 7, t = m & 4095, c = hh * 64 + lane; const bf16_t* zr = z + (size_t)m * NZ; const bf16_t* z1 = zr - NZ;
        float r = zf(zr, ZC_RW_R + c), k = zf(zr, ZC_RW_K + c), v = zf(zr, ZC_RW_V + c);
        const float pr = t >= 1 ? zf(z1, ZC_RW_R + c) : 0.f, pk = t >= 1 ? zf(z1, ZC_RW_K + c) : 0.f, pv = t >= 1 ? zf(z1, ZC_RW_V + c) : 0.f;
        r += (pr - r) * mu[c]; k += (pk - k) * mu[512 + c]; v += (pv - v) * mu[1024 + c];
        const float dd = w0[c] + lo[(size_t)m * 1536 + c]; const float w = __expf(-0.6065306597126334f * sigmoidf_(dd));
        const float a = sigmoidf_(a0[c] + lo[(size_t)m * 1536 + 512 + c]);
        float kk = k * kkw[c]; const float nrm = sqrtf(wave_sum(kk * kk)); kk = kk / fmaxf(nrm, 1e-12f);
        const float k2 = k * (1.f + (a - 1.f) * kaw[c]);
        const size_t o = (size_t)m * 512 + c;
        ops[0 * AS + o] = r; ops[1 * AS + o] = w; ops[2 * AS + o] = k2; ops[3 * AS + o] = v; ops[4 * AS + o] = kk; ops[5 * AS + o] = kk * a;
    }
}
#define DPP_ROR_ADD(x, n) (x) += __int_as_float(__builtin_amdgcn_update_dpp(0, __float_as_int(x), 0x120 + (n), 0xf, 0xf, false))
__device__ __forceinline__ float row_allreduce16(float x) { DPP_ROR_ADD(x, 8); DPP_ROR_ADD(x, 4); DPP_ROR_ADD(x, 2); DPP_ROR_ADD(x, 1); return x; }
__device__ __forceinline__ void ph_rw_scan(const Params& p, LAS unsigned char* lds, int bi, int nb) {
    PROLOG;
    const float* ops = WSP(float, WS_RWOPS); float* ys = WSP(float, WS_YSCAN); constexpr size_t AS = (size_t)M * 512; constexpr int TC = 32;
    LAS float* lop = (LAS float*)lds;
    LAS float* ybuf = (LAS float*)(lds + 6 * TC * 64 * 4);
    const int tid = otid(), wave = tid >> 6, lane = tid & 63, Rg = wave * 4 + (lane >> 4), Pc = lane & 15;
    for (int task = bi; task < 16; task += nb) {
        const int b = task >> 3, hh = task & 7;
        float s[4][4];
#pragma unroll
        for (int i = 0; i < 4; ++i)
#pragma unroll
            for (int j = 0; j < 4; ++j) s[i][j] = 0.f;
        for (int t0 = 0; t0 < SEQ; t0 += TC) {
            for (int idx = tid; idx < 6 * TC * 16; idx += 512) { const int arr = idx / (TC * 16), rem = idx % (TC * 16), tt = rem >> 4, c4 = rem & 15;
                *(LAS f32x4*)(lop + (arr * TC + tt) * 64 + c4 * 4) = *(const f32x4*)(ops + arr * AS + (size_t)(b * SEQ + t0 + tt) * 512 + hh * 64 + c4 * 4); }
            __syncthreads();
            if (wave < 4) {
                for (int tt = 0; tt < TC; ++tt) {
                    const f32x4 r4 = *(const LAS f32x4*)(lop + (0 * TC + tt) * 64 + Pc * 4), w4 = *(const LAS f32x4*)(lop + (1 * TC + tt) * 64 + Pc * 4), k4 = *(const LAS f32x4*)(lop + (2 * TC + tt) * 64 + Pc * 4);
                    const f32x4 v4 = *(const LAS f32x4*)(lop + (3 * TC + tt) * 64 + Rg * 4), kk4 = *(const LAS f32x4*)(lop + (4 * TC + tt) * 64 + Pc * 4), b4 = *(const LAS f32x4*)(lop + (5 * TC + tt) * 64 + Pc * 4);
                    float sa[4];
#pragma unroll
                    for (int i = 0; i < 4; ++i) { float x = -(s[i][0] * kk4[0] + s[i][1] * kk4[1] + s[i][2] * kk4[2] + s[i][3] * kk4[3]); sa[i] = row_allreduce16(x); }
                    float y[4];
#pragma unroll
                    for (int i = 0; i < 4; ++i) { float acc = 0.f;
#pragma unroll
                        for (int j = 0; j < 4; ++j) { s[i][j] = s[i][j] * w4[j] + sa[i] * b4[j] + v4[i] * k4[j]; acc += s[i][j] * r4[j]; }
                        y[i] = row_allreduce16(acc); }
                    if (Pc == 0) *(LAS f32x4*)(ybuf + tt * 64 + Rg * 4) = (f32x4){y[0], y[1], y[2], y[3]};
                }
            }
            __syncthreads();
            { const int tt = tid >> 4, c4 = tid & 15; *(f32x4*)(ys + (size_t)(b * SEQ + t0 + tt) * 512 + hh * 64 + c4 * 4) = *(const LAS f32x4*)(ybuf + tt * 64 + c4 * 4); }
        }
        __syncthreads();
    }
}

typedef short bf16x8s __attribute__((ext_vector_type(8)));
__device__ __forceinline__ bf16x8 zfrag() { return (bf16x8){0, 0, 0, 0, 0, 0, 0, 0}; }
__device__ __forceinline__ bf16x8 pack8(f32x4 a, f32x4 b) { u32x4 w; w.x = cvt_pk_bf16(a[0], a[1]); w.y = cvt_pk_bf16(a[2], a[3]); w.z = cvt_pk_bf16(b[0], b[1]); w.w = cvt_pk_bf16(b[2], b[3]); return __builtin_bit_cast(bf16x8, w); }
__device__ __forceinline__ void ph_rw_chunk(const Params& p, LAS unsigned char* lds, int bi, int nb) {
    PROLOG;
    const float* ops = WSP(float, WS_RWOPS); constexpr size_t AS = (size_t)M * 512;
    unsigned char* PFg = WSP(unsigned char, WS_RW_PF); unsigned char* QFg = WSP(unsigned char, WS_RW_QF); unsigned char* RFg = WSP(unsigned char, WS_RW_RF); unsigned char* Y0g = WSP(unsigned char, WS_RW_Y0F);
    const int tid = otid(), wave = tid >> 6, lane = tid & 63, r = lane & 15, q = lane >> 4;
    if (wave >= 4) return;
    LAS unsigned char* L = lds + wave * 30720;
    LAS bf16_t* BE = (LAS bf16_t*)(L);
    LAS bf16_t* KA = (LAS bf16_t*)(L + 2048);
    LAS bf16_t* AL = (LAS bf16_t*)(L + 4096);
    LAS bf16_t* RHO = (LAS bf16_t*)(L + 6144);
    LAS bf16_t* ALT = (LAS bf16_t*)(L + 8192);
    LAS bf16_t* BEPT = (LAS bf16_t*)(L + 10240);
    LAS bf16_t* KAPT = (LAS bf16_t*)(L + 12288);
    LAS bf16_t* VT = (LAS bf16_t*)(L + 14336);
    LAS bf16_t* RHOT = (LAS bf16_t*)(L + 16384);
    LAS bf16_t* OM = (LAS bf16_t*)(L + 18432);
    LAS bf16_t* VBm = (LAS bf16_t*)(L + 20480);
    LAS bf16_t* MU = (LAS bf16_t*)(L + 22528);
    LAS float* Af = (LAS float*)(L + 24576);
    LAS bf16_t* NT = (LAS bf16_t*)(L + 25600);
    LAS bf16_t* BmT = (LAS bf16_t*)(L + 26112);
    LAS bf16_t* CbT = (LAS bf16_t*)(L + 26624);
    LAS bf16_t* CkT = (LAS bf16_t*)(L + 27136);
    LAS float* GT = (LAS float*)(L + 27648);
    const int gw = bi * 4 + wave, NGW = nb * 4;
    for (int task = gw; task < 4096; task += NGW) {
        const int bh = task >> 8, n = task & 255, b = bh >> 3, hh = bh & 7; const size_t i0 = ((size_t)b * SEQ + 16 * n) * 512 + hh * 64 + lane;
        { float g = 1.f; float be[16], ka[16];
#pragma unroll
          for (int t = 0; t < 16; ++t) { const size_t ix = i0 + (size_t)t * 512;
              const float rr = ops[ix], ww = ops[AS + ix], k2 = ops[2 * AS + ix], vv = ops[3 * AS + ix], kk = ops[4 * AS + ix], bb = ops[5 * AS + ix];
              const float gprev = g; g *= ww; const float al = gprev * kk, rg = 1.f / g; be[t] = bb * rg; ka[t] = k2 * rg; const float rho = g * rr;
              BE[t * 64 + lane] = f2bf(be[t]); KA[t * 64 + lane] = f2bf(ka[t]); AL[t * 64 + lane] = f2bf(al); RHO[t * 64 + lane] = f2bf(rho);
              ALT[lane * 16 + t] = f2bf(al); VT[lane * 16 + t] = f2bf(vv); RHOT[lane * 16 + t] = f2bf(rho); }
          GT[lane] = g;
#pragma unroll
          for (int t = 0; t < 16; ++t) { BEPT[lane * 16 + t] = f2bf(be[t] * g); KAPT[lane * 16 + t] = f2bf(ka[t] * g); } }
        asm volatile("s_waitcnt lgkmcnt(0)" ::: "memory");
        { bf16x8 xb[2], xk[2], ya[2], yr[2];
#pragma unroll
          for (int ks = 0; ks < 2; ++ks) { xb[ks] = *(const LAS bf16x8*)(BE + r * 64 + 32 * ks + 8 * q); xk[ks] = *(const LAS bf16x8*)(KA + r * 64 + 32 * ks + 8 * q);
              ya[ks] = *(const LAS bf16x8*)(AL + r * 64 + 32 * ks + 8 * q); yr[ks] = *(const LAS bf16x8*)(RHO + r * 64 + 32 * ks + 8 * q); }
          f32x4 A = {0.f, 0.f, 0.f, 0.f}, Bm = A, Cb = A, Ck = A;
#pragma unroll
          for (int ks = 0; ks < 2; ++ks) { A = mma16(A, xb[ks], ya[ks]); Bm = mma16(Bm, xk[ks], ya[ks]); Cb = mma16(Cb, xb[ks], yr[ks]); Ck = mma16(Ck, xk[ks], yr[ks]); }
#pragma unroll
          for (int jj = 0; jj < 4; ++jj) { const int c = 4 * q + jj; const bool lt = r < c, le = r <= c;
              A[jj] = lt ? A[jj] : 0.f; BmT[c * 16 + r] = f2bf(lt ? Bm[jj] : 0.f); CbT[c * 16 + r] = f2bf(le ? Cb[jj] : 0.f); CkT[c * 16 + r] = f2bf(le ? Ck[jj] : 0.f); }
          *(LAS f32x4*)(Af + r * 16 + 4 * q) = A; }
        asm volatile("s_waitcnt lgkmcnt(0)" ::: "memory");
        { float nrow[16];
#pragma unroll
          for (int i = 0; i < 16; ++i) { float sacc = (i == r) ? 1.f : 0.f;
#pragma unroll
              for (int j = 0; j < i; ++j) sacc -= nrow[j] * Af[j * 16 + i];
              nrow[i] = sacc; }
          if (q == 0) {
#pragma unroll
              for (int i = 0; i < 16; ++i) NT[i * 16 + r] = f2bf(nrow[i]); } }
        asm volatile("s_waitcnt lgkmcnt(0)" ::: "memory");
        const bool lo = q < 2; const int q2 = q & 1;
        { const bf16x8 bN = lo ? *(const LAS bf16x8*)(NT + r * 16 + 8 * q2) : zfrag(); const bf16x8 bB = lo ? *(const LAS bf16x8*)(BmT + r * 16 + 8 * q2) : zfrag();
#pragma unroll
          for (int mt = 0; mt < 4; ++mt) { const int row = 16 * mt + r;
              const bf16x8 aA = lo ? *(const LAS bf16x8*)(ALT + row * 16 + 8 * q2) : zfrag(); const bf16x8 aV = lo ? *(const LAS bf16x8*)(VT + row * 16 + 8 * q2) : zfrag();
              f32x4 om = mma16((f32x4){0.f, 0.f, 0.f, 0.f}, aA, bN), vb = mma16((f32x4){0.f, 0.f, 0.f, 0.f}, aV, bB);
              u32x2 w; w.x = cvt_pk_bf16(-om[0], -om[1]); w.y = cvt_pk_bf16(-om[2], -om[3]); *(LAS u32x2*)(OM + row * 16 + 4 * q) = w;
              w.x = cvt_pk_bf16(vb[0], vb[1]); w.y = cvt_pk_bf16(vb[2], vb[3]); *(LAS u32x2*)(VBm + row * 16 + 4 * q) = w; }
          asm volatile("s_waitcnt lgkmcnt(0)" ::: "memory");
#pragma unroll
          for (int mt = 0; mt < 4; ++mt) { const int row = 16 * mt + r; const bf16x8 aB = lo ? *(const LAS bf16x8*)(VBm + row * 16 + 8 * q2) : zfrag();
              f32x4 mu = mma16((f32x4){0.f, 0.f, 0.f, 0.f}, aB, bN);
              u32x2 w; w.x = cvt_pk_bf16(-mu[0], -mu[1]); w.y = cvt_pk_bf16(-mu[2], -mu[3]); *(LAS u32x2*)(MU + row * 16 + 4 * q) = w; } }
        asm volatile("s_waitcnt lgkmcnt(0)" ::: "memory");
        const size_t rec = (size_t)bh * 256 + n;
        { bf16x8 bO[4];
#pragma unroll
          for (int nt = 0; nt < 4; ++nt) bO[nt] = lo ? *(const LAS bf16x8*)(OM + (16 * nt + r) * 16 + 8 * q2) : zfrag();
#pragma unroll
          for (int mt = 0; mt < 4; ++mt) { const bf16x8 a = lo ? *(const LAS bf16x8*)(BEPT + (16 * mt + r) * 16 + 8 * q2) : zfrag(); f32x4 acc[4];
#pragma unroll
              for (int nt = 0; nt < 4; ++nt) acc[nt] = mma16((f32x4){0.f, 0.f, 0.f, 0.f}, a, bO[nt]);
              { const float gd = GT[16 * mt + r];
#pragma unroll
                for (int jj = 0; jj < 4; ++jj) if (4 * q + jj == r) acc[mt][jj] += gd; }
#pragma unroll
              for (int ks = 0; ks < 2; ++ks) *(bf16x8*)(PFg + rec * 8192 + (size_t)((mt * 2 + ks) * 64 + lane) * 16) = pack8(acc[2 * ks], acc[2 * ks + 1]); }
          { bf16x8 a; if (lo) a = *(const LAS bf16x8*)(CbT + r * 16 + 8 * q2); else { a = zfrag();
#pragma unroll
                for (int e = 0; e < 8; ++e) if (8 * q2 + e == r) a[e] = (short)0x3f80; }
            f32x4 acc[4];
#pragma unroll
            for (int nt = 0; nt < 4; ++nt) { const bf16x8 bb = lo ? bO[nt] : *(const LAS bf16x8*)(RHOT + (16 * nt + r) * 16 + 8 * q2); acc[nt] = mma16((f32x4){0.f, 0.f, 0.f, 0.f}, a, bb); }
#pragma unroll
            for (int ks = 0; ks < 2; ++ks) *(bf16x8*)(RFg + rec * 2048 + (size_t)(ks * 64 + lane) * 16) = pack8(acc[2 * ks], acc[2 * ks + 1]); } }
        { bf16x8 bQ[4];
#pragma unroll
          for (int nt = 0; nt < 4; ++nt) bQ[nt] = *(const LAS bf16x8*)((lo ? BEPT : KAPT) + (16 * nt + r) * 16 + 8 * q2);
          const bf16x8 bY = *(const LAS bf16x8*)((lo ? CbT : CkT) + r * 16 + 8 * q2);
#pragma unroll
          for (int mt = 0; mt < 4; ++mt) { const bf16x8 a = *(const LAS bf16x8*)((lo ? MU : VT) + (16 * mt + r) * 16 + 8 * q2);
#pragma unroll
              for (int nt = 0; nt < 4; ++nt) { const f32x4 acc = mma16((f32x4){0.f, 0.f, 0.f, 0.f}, a, bQ[nt]); *(f32x4*)(QFg + rec * 16384 + (size_t)((mt * 4 + nt) * 64 + lane) * 16) = acc; }
              const f32x4 y0 = mma16((f32x4){0.f, 0.f, 0.f, 0.f}, a, bY); *(f32x4*)(Y0g + rec * 4096 + (size_t)(mt * 64 + lane) * 16) = y0; } }
        asm volatile("s_waitcnt lgkmcnt(0)" ::: "memory");
    }
}
__device__ __forceinline__ void ph_rw_serial(const Params& p, LAS unsigned char* lds, int bi, int nb) {
    PROLOG;
    constexpr int NS = 8, DD = 6, SLOT = 16384;
    const unsigned char* PFg = WSP(unsigned char, WS_RW_PF); const unsigned char* QFg = WSP(unsigned char, WS_RW_QF); const unsigned char* RFg = WSP(unsigned char, WS_RW_RF); const unsigned char* Y0g = WSP(unsigned char, WS_RW_Y0F);
    float* ys = WSP(float, WS_YSCAN);
    const int tid = otid(), wave = __builtin_amdgcn_readfirstlane(tid >> 6), lane = tid & 63, l15 = lane & 15, q = lane >> 4;
    for (int task = bi; task < 64; task += nb) {
        const int bh = task >> 2, w = task & 3, b = bh >> 3, hh = bh & 7;
        const unsigned char* gp[3]; size_t gs[3];
#pragma unroll
        for (int k = 0; k < 3; ++k) { const int pc = 3 * (wave - 1) + k;
            if (pc < 8) { gp[k] = PFg + (size_t)bh * 256 * 8192 + pc * 1024; gs[k] = 8192; }
            else if (pc < 12) { gp[k] = QFg + (size_t)bh * 256 * 16384 + w * 4096 + (pc - 8) * 1024; gs[k] = 16384; }
            else if (pc < 14) { gp[k] = RFg + (size_t)bh * 256 * 2048 + (pc - 12) * 1024; gs[k] = 2048; }
            else { gp[k] = Y0g + (size_t)bh * 256 * 4096 + w * 1024; gs[k] = 4096; } }
        const bool loader = wave >= 1 && wave <= 5; const int pofs = 3 * (wave - 1) * 1024;
#define RW_ISSUE(step) do { const int c_ = (step) < 256 ? (step) : 255; LAS unsigned char* sl_ = lds + ((step) % NS) * SLOT + pofs; \
        __builtin_amdgcn_global_load_lds((const unsigned*)(gp[0] + (size_t)c_ * gs[0] + lane * 16), (LAS unsigned*)(sl_), 16, 0, 0); \
        __builtin_amdgcn_global_load_lds((const unsigned*)(gp[1] + (size_t)c_ * gs[1] + lane * 16), (LAS unsigned*)(sl_ + 1024), 16, 0, 0); \
        __builtin_amdgcn_global_load_lds((const unsigned*)(gp[2] + (size_t)c_ * gs[2] + lane * 16), (LAS unsigned*)(sl_ + 2048), 16, 0, 0); \
        asm volatile("" ::: "memory"); } while (0)
        do { asm volatile("" ::: "memory"); __builtin_amdgcn_s_barrier(); asm volatile("" ::: "memory"); } while (0);
        if (loader) { for (int s0 = 0; s0 < DD; ++s0) RW_ISSUE(s0);
            asm volatile("s_waitcnt vmcnt(15)" ::: "memory"); }
        do { asm volatile("" ::: "memory"); __builtin_amdgcn_s_barrier(); asm volatile("" ::: "memory"); } while (0);
        f32x4 S[4];
#pragma unroll
        for (int mt = 0; mt < 4; ++mt) S[mt] = (f32x4){0.f, 0.f, 0.f, 0.f};
        for (int n = 0; n < 256; ++n) {
            if (loader) { RW_ISSUE(n + DD); asm volatile("s_waitcnt vmcnt(15)" ::: "memory"); }
            else if (wave == 0) {
                const LAS unsigned char* sl = lds + (n % NS) * SLOT;
                bf16x8 sf[2]; sf[0] = pack8(S[0], S[1]); sf[1] = pack8(S[2], S[3]);
                f32x4 y = *(const LAS f32x4*)(sl + 14336 + lane * 16);
#pragma unroll
                for (int ks = 0; ks < 2; ++ks) y = __builtin_amdgcn_mfma_f32_16x16x32_bf16(*(const LAS bf16x8*)(sl + 12288 + (ks * 64 + lane) * 16), sf[ks], y, 0, 0, 0);
#pragma unroll
                for (int mt = 0; mt < 4; ++mt) { f32x4 a = *(const LAS f32x4*)(sl + 8192 + (mt * 64 + lane) * 16);
#pragma unroll
                    for (int ks = 0; ks < 2; ++ks) a = __builtin_amdgcn_mfma_f32_16x16x32_bf16(*(const LAS bf16x8*)(sl + ((mt * 2 + ks) * 64 + lane) * 16), sf[ks], a, 0, 0, 0);
                    S[mt] = a; }
                float* yo = ys + ((size_t)b * SEQ + 16 * n + 4 * q) * 512 + hh * 64 + 16 * w + l15;
#pragma unroll
                for (int jj = 0; jj < 4; ++jj) yo[(size_t)jj * 512] = y[jj];
                asm volatile("s_waitcnt lgkmcnt(0)" ::: "memory");
            }
            do { asm volatile("" ::: "memory"); __builtin_amdgcn_s_barrier(); asm volatile("" ::: "memory"); } while (0);
        }
        asm volatile("s_waitcnt vmcnt(0)" ::: "memory");
        do { asm volatile("" ::: "memory"); __builtin_amdgcn_s_barrier(); asm volatile("" ::: "memory"); } while (0);
#undef RW_ISSUE
    }
}

__device__ __forceinline__ void ph_rw_post(const Params& p, int l, int bi, int nb) {
    PROLOG;
    const int tid_ = otid(), lane = tid_ & 63, gw = bi * 8 + (tid_ >> 6), NGW = nb * 8;
    const float* ops = WSP(float, WS_RWOPS); const float* ys = WSP(float, WS_YSCAN); const float* lo = WSP(float, WS_LO); bf16_t* oall = WSP(bf16_t, WS_OALL);
    const float* rk = INL(20, 512); const float* lg = INL(21, 512); const float* lb = INL(22, 512); constexpr size_t AS = (size_t)M * 512;
    for (int it = gw; it < M * 8; it += NGW) {
        const int m = it >> 3, hh = it & 7, c = hh * 64 + lane; const size_t o = (size_t)m * 512 + c;
        const float y = ys[o], r = ops[o], k2 = ops[2 * AS + o], v = ops[3 * AS + o];
        const float mean = wave_sum(y) * (1.f / 64.f); const float dv = y - mean; const float var = wave_sum(dv * dv) * (1.f / 64.f);
        const float yn = dv * rsqrtf(var + 64e-5f) * lg[c] + lb[c];
        const float bonus = wave_sum(r * k2 * rk[c]) * v;
        const float g = lo[(size_t)m * 1536 + 1024 + c];
        oall[(size_t)m * NBR + 512 + c] = f2bf((yn + bonus) * g);
    }
}

__device__ __forceinline__ float ret_lg(int hh) { return logf(1.f - exp2f(-5.f - (float)hh)); }
__device__ __forceinline__ void ph_ret_u(const Params& p, LAS unsigned char* lds, int bi, int nb) {
    PROLOG;
    const bf16_t* z = WSP(bf16_t, WS_Z); const bf16_t* kr = WSP(bf16_t, WS_KR); float* ub = WSP(float, WS_UBUF);
    LAS bf16_t* Vt = (LAS bf16_t*)lds;
    LAS bf16_t* Kt = (LAS bf16_t*)(lds + 256 * 136 * 2);
    const int tid = otid(), wave = tid >> 6, lane = tid & 63, r = lane & 15, q = lane >> 4;
    for (int task = bi; task < 256; task += nb) {
        const int b = task >> 7, hh = (task >> 5) & 3, n = task & 31; const float lgh = ret_lg(hh); const size_t m0 = (size_t)b * SEQ + n * 128;
        __syncthreads();
        for (int idx = tid; idx < 128 * 32; idx += 512) { const int mm = idx & 127, ch = idx >> 7; const u32x4 w = *(const u32x4*)(z + (m0 + mm) * NZ + ZC_RET_V + hh * 256 + ch * 8);
            const unsigned ww[4] = {w.x, w.y, w.z, w.w};
#pragma unroll
            for (int i = 0; i < 4; ++i) { Vt[(ch * 8 + 2 * i) * 136 + mm] = (bf16_t)(ww[i] & 0xffffu); Vt[(ch * 8 + 2 * i + 1) * 136 + mm] = (bf16_t)(ww[i] >> 16); } }
        for (int idx = tid; idx < 128 * 16; idx += 512) { const int mm = idx & 127, ch = idx >> 7; const float zeta = __expf((float)(127 - mm) * lgh);
            const u32x4 w = *(const u32x4*)(kr + (m0 + mm) * 512 + hh * 128 + ch * 8); const unsigned ww[4] = {w.x, w.y, w.z, w.w};
#pragma unroll
            for (int i = 0; i < 4; ++i) { Kt[(ch * 8 + 2 * i) * 136 + mm] = f2bf(__uint_as_float(ww[i] << 16) * zeta); Kt[(ch * 8 + 2 * i + 1) * 136 + mm] = f2bf(__uint_as_float(ww[i] & 0xffff0000u) * zeta); } }
        __syncthreads();
        float* uo = ub + (size_t)task * 256 * 128;
#pragma unroll
        for (int et = 0; et < 2; ++et) { const int e0 = 16 * (2 * wave + et); bf16x8 a[4];
#pragma unroll
            for (int ks = 0; ks < 4; ++ks) a[ks] = *(const LAS bf16x8*)(Vt + (e0 + r) * 136 + 32 * ks + 8 * q);
#pragma unroll
            for (int dt = 0; dt < 8; ++dt) { f32x4 acc = {0.f, 0.f, 0.f, 0.f};
#pragma unroll
                for (int ks = 0; ks < 4; ++ks) { const bf16x8 bb = *(const LAS bf16x8*)(Kt + (16 * dt + r) * 136 + 32 * ks + 8 * q); acc = mma16(acc, a[ks], bb); }
                *(f32x4*)(uo + (size_t)(e0 + r) * 128 + 16 * dt + 4 * q) = acc; } }
    }
}
__device__ __forceinline__ void ph_ret_scan(const Params& p, int bi, int nb) {
    PROLOG;
    const float* ub = WSP(float, WS_UBUF); bf16_t* rp = WSP(bf16_t, WS_RPREV);
    const int gt = bi * 512 + otid(), NT = nb * 512;
    for (int i = gt; i < 8 * 8192; i += NT) { const int bh = i >> 13, e4 = i & 8191, hh = bh & 3; const float cd = __expf(128.f * ret_lg(hh)); f32x4 st = {0.f, 0.f, 0.f, 0.f};
        for (int n = 0; n < 32; ++n) { const size_t o = ((size_t)(bh * 32 + n) * 8192 + e4) * 4; u32x2 w; w.x = cvt_pk_bf16(st[0], st[1]); w.y = cvt_pk_bf16(st[2], st[3]); *(u32x2*)(rp + o) = w;
            st = st * cd + *(const f32x4*)(ub + o); } }
}
__device__ __forceinline__ void ph_ret_out(const Params& p, LAS unsigned char* lds, int bi, int nb) {
    PROLOG;
    const bf16_t* z = WSP(bf16_t, WS_Z); const bf16_t* qr = WSP(bf16_t, WS_QR); const bf16_t* kr = WSP(bf16_t, WS_KR); const bf16_t* rp = WSP(bf16_t, WS_RPREV); bf16_t* oall = WSP(bf16_t, WS_OALL);
    LAS bf16_t* Vt = (LAS bf16_t*)lds;
    const int tid = otid(), wave = tid >> 6, lane = tid & 63, r = lane & 15, q = lane >> 4;
    LAS bf16_t* Sc = (LAS bf16_t*)(lds + 256 * 136 * 2) + wave * 16 * 136;
    for (int task = bi; task < 256; task += nb) {
        const int b = task >> 7, hh = (task >> 5) & 3, n = task & 31; const float lgh = ret_lg(hh); const size_t m0 = (size_t)b * SEQ + n * 128;
        __syncthreads();
        for (int idx = tid; idx < 128 * 32; idx += 512) { const int mm = idx & 127, ch = idx >> 7; const u32x4 w = *(const u32x4*)(z + (m0 + mm) * NZ + ZC_RET_V + hh * 256 + ch * 8);
            const unsigned ww[4] = {w.x, w.y, w.z, w.w};
#pragma unroll
            for (int i = 0; i < 4; ++i) { Vt[(ch * 8 + 2 * i) * 136 + mm] = (bf16_t)(ww[i] & 0xffffu); Vt[(ch * 8 + 2 * i + 1) * 136 + mm] = (bf16_t)(ww[i] >> 16); } }
        __syncthreads();
        const int c = 16 * wave + r; const size_t mrow = m0 + c;
        bf16x8 qa[4];
#pragma unroll
        for (int ks = 0; ks < 4; ++ks) qa[ks] = ldfrag(qr + mrow * 512 + hh * 128 + 32 * ks + 8 * q);
#pragma unroll
        for (int mt = 0; mt < 8; ++mt) { f32x4 s = {0.f, 0.f, 0.f, 0.f};
#pragma unroll
            for (int ks = 0; ks < 4; ++ks) s = mma16(s, qa[ks], ldfrag(kr + (m0 + 16 * mt + r) * 512 + hh * 128 + 32 * ks + 8 * q));
            float v[4];
#pragma unroll
            for (int j = 0; j < 4; ++j) { const int mm = 16 * mt + 4 * q + j; v[j] = (c >= mm) ? s[j] * __expf((float)(c - mm) * lgh) : 0.f; }
            u32x2 w; w.x = cvt_pk_bf16(v[0], v[1]); w.y = cvt_pk_bf16(v[2], v[3]); *(LAS u32x2*)(Sc + r * 136 + 16 * mt + 4 * q) = w; }
        asm volatile("s_waitcnt lgkmcnt(0)" ::: "memory");
        const float xi = __expf((float)(c + 1) * lgh);
        const bf16_t* rpc = rp + (size_t)task * 256 * 128;
        f32x4 acc[16]; bf16x8 sa[4];
#pragma unroll
        for (int ks = 0; ks < 4; ++ks) sa[ks] = *(const LAS bf16x8*)(Sc + r * 136 + 32 * ks + 8 * q);
#pragma unroll
        for (int et = 0; et < 16; ++et) { f32x4 a = {0.f, 0.f, 0.f, 0.f};
#pragma unroll
            for (int ks = 0; ks < 4; ++ks) a = mma16(a, qa[ks], ldfrag(rpc + (size_t)(16 * et + r) * 128 + 32 * ks + 8 * q));
            a = a * xi;
#pragma unroll
            for (int ks = 0; ks < 4; ++ks) a = mma16(a, sa[ks], *(const LAS bf16x8*)(Vt + (16 * et + r) * 136 + 32 * ks + 8 * q));
            acc[et] = a; }
        float s1 = 0.f;
#pragma unroll
        for (int et = 0; et < 16; ++et) s1 += acc[et][0] + acc[et][1] + acc[et][2] + acc[et][3];
        s1 += __shfl_xor(s1, 16); s1 += __shfl_xor(s1, 32); const float mean = s1 * (1.f / 256.f); float s2 = 0.f;
#pragma unroll
        for (int et = 0; et < 16; ++et) { acc[et] = acc[et] - mean; s2 += acc[et][0] * acc[et][0] + acc[et][1] * acc[et][1] + acc[et][2] * acc[et][2] + acc[et][3] * acc[et][3]; }
        s2 += __shfl_xor(s2, 16); s2 += __shfl_xor(s2, 32); const float rstd = rsqrtf(s2 * (1.f / 256.f) + 1e-5f);
#pragma unroll
        for (int et = 0; et < 16; ++et) { const int e = 16 * et + 4 * q; const u32x2 gw = *(const u32x2*)(z + mrow * NZ + ZC_RET_G + hh * 256 + e);
            const float g0 = __uint_as_float(gw.x << 16), g1 = __uint_as_float(gw.x & 0xffff0000u), g2 = __uint_as_float(gw.y << 16), g3 = __uint_as_float(gw.y & 0xffff0000u);
            u32x2 w; w.x = cvt_pk_bf16(acc[et][0] * rstd * g0 * sigmoidf_(g0), acc[et][1] * rstd * g1 * sigmoidf_(g1)); w.y = cvt_pk_bf16(acc[et][2] * rstd * g2 * sigmoidf_(g2), acc[et][3] * rstd * g3 * sigmoidf_(g3));
            *(u32x2*)(oall + mrow * NBR + 1024 + hh * 256 + e) = w; }
    }
}

__device__ __forceinline__ void ph_cmp2(const Params& p, int l, int bi, int nb) {
    PROLOG;
    const bf16_t* hid = WSP(bf16_t, WS_HID); bf16_t* kc = WSP(bf16_t, WS_KCMP); bf16_t* vt = WSP(bf16_t, WS_VCMPT); const int* posi = (const int*)inp(p, 2);
    const float* w2 = INL(25, 2 * 256 * 64);
    const int gt = bi * 512 + otid(), NT = nb * 512;
    for (int i = gt; i < 4 * 256 * 64; i += NT) { const int bg = i >> 14, c = (i >> 6) & 255, d = i & 63;
        { float s = 0.f; if (c < 255) { const bf16_t* hr = hid + ((size_t)(4 + bg) * 256 + c) * 256; for (int k = 0; k < 256; ++k) s += bf2f(hr[k]) * w2[256 * 64 + k * 64 + d]; }
          vt[((size_t)bg * 64 + d) * 256 + c] = f2bf(s); }
        if (d < 32) { float s1 = 0.f, s2 = 0.f;
            if (c < 255) { const bf16_t* hr = hid + ((size_t)bg * 256 + c) * 256; for (int k = 0; k < 256; ++k) { const float hv = bf2f(hr[k]); s1 += hv * w2[k * 64 + d]; s2 += hv * w2[k * 64 + 32 + d]; }
                const float pos = (float)posi[(bg >> 1) * SEQ + 16 * c + 31]; const float inv = __expf(-(float)d * (9.210340371976184f / 32.f)); float sn, cs; sincosf(pos * inv, &sn, &cs);
                const float a = s1 * cs - s2 * sn, bq = s2 * cs + s1 * sn; s1 = a; s2 = bq; }
            kc[((size_t)bg * 256 + c) * 64 + d] = f2bf(s1); kc[((size_t)bg * 256 + c) * 64 + 32 + d] = f2bf(s2); }
    }
}
__device__ __forceinline__ void ph_nsa_cmp(const Params& p, LAS unsigned char* lds, int bi, int nb) {
    PROLOG;
    const bf16_t* qn = WSP(bf16_t, WS_QN); const bf16_t* kc = WSP(bf16_t, WS_KCMP); const bf16_t* vt = WSP(bf16_t, WS_VCMPT); bf16_t* ocmp = WSP(bf16_t, WS_OCMP); u64* selm = WSP(u64, WS_SELM);
    const int tid = otid(), wave = tid >> 6, lane = tid & 63, r = lane & 15, q = lane >> 4, gw = bi * 8 + wave, NGW = nb * 8;
    LAS bf16_t* Pl = (LAS bf16_t*)(lds + wave * 16384);
    LAS float* Il = (LAS float*)(lds + wave * 16384 + 16 * 264 * 2);
    for (int task = gw; task < 1024; task += NGW) {
        const int bg = task >> 8, b = bg >> 1, g = bg & 1, tt = task & 255, t0 = 16 * tt, t = t0 + r; const size_t mrow = (size_t)b * SEQ + t;
        const int cmax = t >= 31 ? (t - 31) >> 4 : -1;
#pragma unroll
        for (int ct = 0; ct < 16; ++ct) Il[r * 64 + 4 * ct + q] = 0.f;
        for (int hh = 0; hh < 4; ++hh) {
            const int hd = (g * 4 + hh) * 64;
            bf16x8 qa[2]; qa[0] = ldfrag(qn + mrow * 512 + hd + 8 * q); qa[1] = ldfrag(qn + mrow * 512 + hd + 32 + 8 * q);
            f32x4 s[16]; float mx = -1e30f;
#pragma unroll
            for (int ct = 0; ct < 16; ++ct) { f32x4 a = {0.f, 0.f, 0.f, 0.f}; const bf16_t* kp = kc + ((size_t)bg * 256 + 16 * ct + r) * 64 + 8 * q;
                a = mma16(a, qa[0], ldfrag(kp)); a = mma16(a, qa[1], ldfrag(kp + 32));
#pragma unroll
                for (int j = 0; j < 4; ++j) { const int c = 16 * ct + 4 * q + j; a[j] = (c <= cmax) ? a[j] * 0.125f : -1e30f; mx = fmaxf(mx, a[j]); }
                s[ct] = a; }
            mx = fmaxf(mx, __shfl_xor(mx, 16)); mx = fmaxf(mx, __shfl_xor(mx, 32));
            float sum = 0.f;
#pragma unroll
            for (int ct = 0; ct < 16; ++ct)
#pragma unroll
                for (int j = 0; j < 4; ++j) { const int c = 16 * ct + 4 * q + j; const float e = (c <= cmax) ? __expf(s[ct][j] - mx) : 0.f; s[ct][j] = e; sum += e; }
            sum += __shfl_xor(sum, 16); sum += __shfl_xor(sum, 32);
            const float rinv = 1.f / fmaxf(sum, 1e-30f);
            float yprev = 0.f;
#pragma unroll
            for (int ct = 0; ct < 16; ++ct) { s[ct] = s[ct] * rinv;
                const float y = __shfl(s[ct][3], (lane + 48) & 63);
                const float prev = q > 0 ? y : yprev; yprev = y;
                Il[r * 64 + 4 * ct + q] += (s[ct][0] + s[ct][1]) + (s[ct][2] + s[ct][3]) + prev;
                u32x2 w; w.x = cvt_pk_bf16(s[ct][0], s[ct][1]); w.y = cvt_pk_bf16(s[ct][2], s[ct][3]); *(LAS u32x2*)(Pl + r * 264 + 16 * ct + 4 * q) = w; }
            asm volatile("s_waitcnt lgkmcnt(0)" ::: "memory");
            f32x4 o[4];
#pragma unroll
            for (int dt = 0; dt < 4; ++dt) o[dt] = (f32x4){0.f, 0.f, 0.f, 0.f};
#pragma unroll
            for (int ks = 0; ks < 8; ++ks) { const bf16x8 pa = *(const LAS bf16x8*)(Pl + r * 264 + 32 * ks + 8 * q);
#pragma unroll
                for (int dt = 0; dt < 4; ++dt) o[dt] = mma16(o[dt], pa, ldfrag(vt + ((size_t)bg * 64 + 16 * dt + r) * 256 + 32 * ks + 8 * q)); }
#pragma unroll
            for (int dt = 0; dt < 4; ++dt) { u32x2 w; w.x = cvt_pk_bf16(o[dt][0], o[dt][1]); w.y = cvt_pk_bf16(o[dt][2], o[dt][3]); *(u32x2*)(ocmp + mrow * 512 + hd + 16 * dt + 4 * q) = w; }
        }
        asm volatile("s_waitcnt lgkmcnt(0)" ::: "memory");
        for (int rr = 0; rr < 16; ++rr) {
            const int tq = t0 + rr, cur = tq >> 6; const float v = Il[rr * 64 + lane];
            const bool valid = lane <= cur; const bool forced = (lane == 0) || (lane == cur) || (lane == cur - 1);
            const float key = forced ? __builtin_inff() : v; int rank = 0;
            for (int i = 0; i <= cur; ++i) { const float ki = __int_as_float(__builtin_amdgcn_readlane(__float_as_int(key), i)); rank += (ki > key || (ki == key && i < lane)) ? 1 : 0; }
            const u64 msk = __ballot(valid && rank < 16);
            if (lane == 0) selm[(size_t)bg * SEQ + tq] = msk;
        }
        asm volatile("s_waitcnt lgkmcnt(0)" ::: "memory");
    }
}
__device__ __forceinline__ void ph_nsa_attn(const Params& p, LAS unsigned char* lds, int bi, int nb) {
    PROLOG;
    const bf16_t* z = WSP(bf16_t, WS_Z); const bf16_t* qn = WSP(bf16_t, WS_QN); const bf16_t* kvg = WSP(bf16_t, WS_KVG); const bf16_t* ocmp = WSP(bf16_t, WS_OCMP); const u64* selm = WSP(u64, WS_SELM); bf16_t* oall = WSP(bf16_t, WS_OALL);
    const int tid = otid(), wave = tid >> 6, lane = tid & 63, r = lane & 15, q = lane >> 4, gw = bi * 8 + wave, NGW = nb * 8;
    LAS bf16_t* Pl = (LAS bf16_t*)(lds + wave * 4096);
    for (int task = gw; task < 4096; task += NGW) {
        int tt, sub; if (task < 2048) { tt = 255 - (task >> 4); sub = task & 15; } else { tt = (task - 2048) >> 4; sub = task & 15; }
        const int bg = sub >> 2, hh = sub & 3, b = bg >> 1, g = bg & 1, t0 = 16 * tt, t = t0 + r, cur = t0 >> 6; const size_t mrow = (size_t)b * SEQ + t;
        const int hd = (g * 4 + hh) * 64;
        bf16x8 qa[2]; qa[0] = ldfrag(qn + mrow * 512 + hd + 8 * q); qa[1] = ldfrag(qn + mrow * 512 + hd + 32 + 8 * q);
        const u64 mymask = selm[(size_t)bg * SEQ + t];
        unsigned mlo = (unsigned)mymask, mhi = (unsigned)(mymask >> 32);
#pragma unroll
        for (int o = 1; o < 16; o <<= 1) { mlo |= __shfl_xor(mlo, o); mhi |= __shfl_xor(mhi, o); }
        const u64 umask = ((u64)__builtin_amdgcn_readfirstlane(mhi) << 32) | (u64)__builtin_amdgcn_readfirstlane(mlo);
        f32x4 res[4];
#pragma unroll
        for (int br = 0; br < 2; ++br) {
            const bf16_t* Kb = kvg + (br == 0 ? 2 : 4) * KVG_SLAB + (size_t)bg * SEQ * 64;
            const bf16_t* Vtb = kvg + (br == 0 ? 3 : 5) * KVG_SLAB + (size_t)bg * 64 * SEQ;
            const int j0 = br == 0 ? 0 : ((t0 >= 511) ? ((t0 - 511) >> 6) : 0);
            float mrun = -1e30f, lrun = 0.f; f32x4 o[4];
#pragma unroll
            for (int dt = 0; dt < 4; ++dt) o[dt] = (f32x4){0.f, 0.f, 0.f, 0.f};
            for (int j = j0; j <= cur; ++j) {
                if (br == 0 && !((umask >> j) & 1ull)) continue;
                const int k0 = 64 * j; const bool rowsel = br == 0 ? (((mymask >> j) & 1ull) != 0) : true;
                f32x4 s[4]; float mx = -1e30f;
#pragma unroll
                for (int ct = 0; ct < 4; ++ct) { f32x4 a = {0.f, 0.f, 0.f, 0.f}; const bf16_t* kp = Kb + (size_t)(k0 + 16 * ct + r) * 64 + 8 * q;
                    a = mma16(a, qa[0], ldfrag(kp)); a = mma16(a, qa[1], ldfrag(kp + 32));
#pragma unroll
                    for (int jj = 0; jj < 4; ++jj) { const int key = k0 + 16 * ct + 4 * q + jj; const bool ok = rowsel && key <= t && (br == 0 || t - key < 512); a[jj] = ok ? a[jj] * 0.125f : -1e30f; mx = fmaxf(mx, a[jj]); }
                    s[ct] = a; }
                mx = fmaxf(mx, __shfl_xor(mx, 16)); mx = fmaxf(mx, __shfl_xor(mx, 32));
                const float mnew = fmaxf(mrun, mx), alpha = __expf(mrun - mnew); float sum = 0.f;
#pragma unroll
                for (int ct = 0; ct < 4; ++ct) {
#pragma unroll
                    for (int jj = 0; jj < 4; ++jj) { const float e = (s[ct][jj] > -1e29f) ? __expf(s[ct][jj] - mnew) : 0.f; s[ct][jj] = e; sum += e; }
                    u32x2 w; w.x = cvt_pk_bf16(s[ct][0], s[ct][1]); w.y = cvt_pk_bf16(s[ct][2], s[ct][3]); *(LAS u32x2*)(Pl + r * 72 + 16 * ct + 4 * q) = w; }
                sum += __shfl_xor(sum, 16); sum += __shfl_xor(sum, 32);
                lrun = lrun * alpha + sum; mrun = mnew;
                asm volatile("s_waitcnt lgkmcnt(0)" ::: "memory");
                const bf16x8 pa0 = *(const LAS bf16x8*)(Pl + r * 72 + 8 * q), pa1 = *(const LAS bf16x8*)(Pl + r * 72 + 32 + 8 * q);
#pragma unroll
                for (int dt = 0; dt < 4; ++dt) { const bf16_t* vp = Vtb + (size_t)(16 * dt + r) * SEQ + k0 + 8 * q; f32x4 a = o[dt] * alpha; a = mma16(a, pa0, ldfrag(vp)); a = mma16(a, pa1, ldfrag(vp + 32)); o[dt] = a; }
                asm volatile("s_waitcnt lgkmcnt(0)" ::: "memory");
            }
            const float rinv = 1.f / fmaxf(lrun, 1e-30f);
            const float gt = sigmoidf_(zf(z + mrow * NZ, ZC_NSA_GT + (g * 4 + hh) * 3 + 1 + br));
#pragma unroll
            for (int dt = 0; dt < 4; ++dt) { if (br == 0) res[dt] = o[dt] * (rinv * gt); else res[dt] += o[dt] * (rinv * gt); }
        }
        const float g0 = sigmoidf_(zf(z + mrow * NZ, ZC_NSA_GT + (g * 4 + hh) * 3));
#pragma unroll
        for (int dt = 0; dt < 4; ++dt) { const u32x2 cw = *(const u32x2*)(ocmp + mrow * 512 + hd + 16 * dt + 4 * q);
            const float c0 = __uint_as_float(cw.x << 16), c1 = __uint_as_float(cw.x & 0xffff0000u), c2 = __uint_as_float(cw.y << 16), c3 = __uint_as_float(cw.y & 0xffff0000u);
            u32x2 w; w.x = cvt_pk_bf16(res[dt][0] + g0 * c0, res[dt][1] + g0 * c1); w.y = cvt_pk_bf16(res[dt][2] + g0 * c2, res[dt][3] + g0 * c3);
            *(u32x2*)(oall + mrow * NBR + 2048 + hd + 16 * dt + 4 * q) = w; }
    }
}

__device__ __forceinline__ void ph_xsoftmax(const Params& p, int bi, int nb) {
    PROLOG;
    const float* sc = WSP(float, WS_SC); bf16_t* pb = WSP(bf16_t, WS_PB);
    const int tid_ = otid(), lane = tid_ & 63, gw = bi * 8 + (tid_ >> 6), NGW = nb * 8;
    for (int it = gw; it < M * 4; it += NGW) { const f32x4 v = *(const f32x4*)(sc + (size_t)it * 256 + lane * 4);
        float mx = fmaxf(fmaxf(v[0], v[1]), fmaxf(v[2], v[3]));
#pragma unroll
        for (int o = 1; o < 64; o <<= 1) mx = fmaxf(mx, __shfl_xor(mx, o));
        const float e0 = __expf(v[0] - mx), e1 = __expf(v[1] - mx), e2 = __expf(v[2] - mx), e3 = __expf(v[3] - mx);
        const float rinv = 1.f / wave_sum((e0 + e1) + (e2 + e3));
        u32x2 w; w.x = cvt_pk_bf16(e0 * rinv, e1 * rinv); w.y = cvt_pk_bf16(e2 * rinv, e3 * rinv); *(u32x2*)(pb + (size_t)it * 256 + lane * 4) = w; }
}
__device__ __forceinline__ void ph_convact(const Params& p, int l, int bi, int nb) {
    PROLOG;
    const bf16_t* u = WSP(bf16_t, WS_U); bf16_t* ga = WSP(bf16_t, WS_GACT); const float* cw = INL(32, 3 * FFN2); const float* cb = INL(33, FFN2);
    const int gt = bi * 512 + otid(), NT = nb * 512;
    for (int i = gt; i < M * (FFN / 4); i += NT) { const int m = i / (FFN / 4), c4 = (i % (FFN / 4)) * 4, t = m & 4095; const int ua = 256 * (c4 >> 7) + (c4 & 127), ub = ua + 128;
        float va[4], vb[4];
#pragma unroll
        for (int j = 0; j < 4; ++j) { va[j] = cb[c4 + j]; vb[j] = cb[FFN + c4 + j]; }
#pragma unroll
        for (int k = 0; k < 3; ++k) { if (t - 2 + k < 0) continue; const bf16_t* ur = u + (size_t)(m - 2 + k) * FFN2; const u32x2 wa = *(const u32x2*)(ur + ua), wb = *(const u32x2*)(ur + ub);
            const float xa[4] = {__uint_as_float(wa.x << 16), __uint_as_float(wa.x & 0xffff0000u), __uint_as_float(wa.y << 16), __uint_as_float(wa.y & 0xffff0000u)};
            const float xb[4] = {__uint_as_float(wb.x << 16), __uint_as_float(wb.x & 0xffff0000u), __uint_as_float(wb.y << 16), __uint_as_float(wb.y & 0xffff0000u)};
#pragma unroll
            for (int j = 0; j < 4; ++j) { va[j] += cw[k * FFN2 + c4 + j] * xa[j]; vb[j] += cw[k * FFN2 + FFN + c4 + j] * xb[j]; } }
        u32x2 w; w.x = cvt_pk_bf16(gelu_tanh(va[0]) * vb[0], gelu_tanh(va[1]) * vb[1]); w.y = cvt_pk_bf16(gelu_tanh(va[2]) * vb[2], gelu_tanh(va[3]) * vb[3]);
        *(u32x2*)(ga + (size_t)m * FFN + c4) = w; }
}


#define XB_TMO      128
#define XB_XCNT(j)  (256  + 64 * (j))
#define XB_XSUB(j)  (1280 + 64 * (j))
#define XB_XGEN(j)  (2304 + 64 * (j))
#define XB_TOP      3328
#define XB_TOPGEN   3392
#define XCD_BAR_WORDS 3456
#define XB_SPIN_CAP (1u << 18)
__device__ __forceinline__ unsigned xb_ld(unsigned* p)              { return __hip_atomic_load(p, __ATOMIC_RELAXED, __HIP_MEMORY_SCOPE_AGENT); }
__device__ __forceinline__ unsigned xb_add(unsigned* p, unsigned v) { return __hip_atomic_fetch_add(p, v, __ATOMIC_RELAXED, __HIP_MEMORY_SCOPE_AGENT); }
__device__ __forceinline__ unsigned xb_xcc_id() { return (unsigned)__builtin_amdgcn_s_getreg((3 << 11) | 20) & 0xFu; }
#define XB_SPIN(cond, bar) do { unsigned _sp = 0; while (cond) { __builtin_amdgcn_s_sleep(1); \
    if ((++_sp & 255u) == 0u) { if (xb_ld(&(bar)[XB_TMO])) break; if (_sp > XB_SPIN_CAP) { atomicAdd(&(bar)[XB_TMO], 1u); break; } } } } while (0)
struct XcdBarrier { unsigned* bar; unsigned x; volatile LAS unsigned* st; };
__device__ __forceinline__ XcdBarrier xcd_barrier_post(unsigned* bar, volatile LAS unsigned* st) {
    XcdBarrier b; b.bar = bar; b.x = xb_xcc_id(); b.st = st;
    if (threadIdx.x == 0) (void)xb_add(&bar[XB_XCNT(b.x)], 1u);
    return b;
}
__device__ __forceinline__ void xcd_barrier_complete(unsigned* bar, unsigned x, unsigned& nloc, unsigned& nx) {
    const unsigned G = gridDim.x * gridDim.y * gridDim.z;
    unsigned sum, cnt, mine, sp = 0u;
    for (;;) {
        sum = 0u; cnt = 0u; mine = 0u;
#pragma unroll
        for (unsigned j = 0; j < 16; ++j) { const unsigned c = xb_ld(&bar[XB_XCNT(j)]); sum += c; cnt += (c > 0u) ? 1u : 0u; mine = (j == x) ? c : mine; }
        if (sum == G) break;
        __builtin_amdgcn_s_sleep(1);
        if ((++sp & 255u) == 0u) { if (xb_ld(&bar[XB_TMO])) break; if (sp > XB_SPIN_CAP) { atomicAdd(&bar[XB_TMO], 1u); break; } }
    }
    nloc = mine > 0u ? mine : 1u; nx = cnt > 0u ? cnt : 1u;
}
__device__ __forceinline__ void xcd_barrier(const XcdBarrier& b) {
    asm volatile("s_waitcnt vmcnt(0)" ::: "memory");
    __syncthreads();
    if (threadIdx.x == 0) {
        unsigned* bar = (unsigned*)(ws_lds() + WS_CTL) + 1024;
        __builtin_amdgcn_s_waitcnt(0);
        unsigned nloc = b.st[0], nx = b.st[1];
        if (nloc == 0u) { xcd_barrier_complete(bar, b.x, nloc, nx); b.st[0] = nloc; b.st[1] = nx; }
        const unsigned old = xb_add(&bar[XB_XSUB(b.x)], 1u);
        const unsigned gen = old / nloc;
        if (old + 1u == (gen + 1u) * nloc) {
            __builtin_amdgcn_fence(__ATOMIC_RELEASE, "agent");
            asm volatile("s_waitcnt vmcnt(0)" ::: "memory");
            const unsigned og = xb_add(&bar[XB_TOP], 1u);
            const unsigned tg = og / nx;
            if (og + 1u == (tg + 1u) * nx) xb_add(&bar[XB_TOPGEN], 1u);
            else XB_SPIN(xb_ld(&bar[XB_TOPGEN]) == tg, bar);
            __builtin_amdgcn_fence(__ATOMIC_ACQUIRE, "agent");
            xb_add(&bar[XB_XGEN(b.x)], 1u);
            asm volatile("s_waitcnt vmcnt(0)" ::: "memory");
        } else {
            XB_SPIN(xb_ld(&bar[XB_XGEN(b.x)]) == gen, bar);
            __builtin_amdgcn_fence(__ATOMIC_ACQUIRE, "agent");
            asm volatile("s_waitcnt vmcnt(0)" ::: "memory");
        }
    }
    __syncthreads();
}

enum { PH_CONVERT = 0, PH_MEMKV, PH_NORM1, PH_INPROJ, PH_MIXPREP, PH_LORA_CMP1, PH_RWPREP2_CMP2_RETU, PH_RWCHUNK, PH_RWSERIAL, PH_RETSCAN, PH_NSACMP, PH_RWPOST_RETOUT, PH_NSAATTN,
       PH_BRANCH, PH_OUTPROJ, PH_FINISH1, PH_QPROJ, PH_XSCORE, PH_XSOFTMAX, PH_XPV, PH_XO, PH_FINISH2, PH_UP, PH_CONVACT, PH_DOWN, PH_FINISH3, PH_COUNT };

template <int PH> __device__ __forceinline__ void run_phase(const Params& p, int l, LAS unsigned char* lds, int bi, int nb) {
    using namespace pg8;
    PROLOG;
    if constexpr (PH == PH_CONVERT) ph_convert(p, l, lds, bi, nb);
    else if constexpr (PH == PH_MEMKV) {
        { GSched s = make_sched(WSP(bf16_t, WS_MEMN), D, WSP(bf16_t, WS_W_KV), D, 2, 8, D, bi, nb); EpiBf16<0> e{WSP(bf16_t, WS_KMEM), D, nullptr}; gemm_phase(lds, D, D, D, s, e); }
        { GSched s = make_sched(WSP(bf16_t, WS_W_KV) + (size_t)D * D, D, WSP(bf16_t, WS_MEMN), D, 8, 2, 512, bi, nb); EpiBf16<0> e{WSP(bf16_t, WS_VTM), 512, nullptr}; gemm_phase(lds, D, D, D, s, e); }
    }
    else if constexpr (PH == PH_NORM1) ph_norm_rows(l == 0 ? inp(p, 0) : (const float*)OUTP, INL(3, D), WSP(bf16_t, WS_H), M, bi, nb);
    else if constexpr (PH == PH_INPROJ) { GSched s = make_sched(WSP(bf16_t, WS_H), D, WSP(bf16_t, WS_W_IN), D, 32, 64, NZ, bi, nb); EpiBf16<0> e{WSP(bf16_t, WS_Z), NZ, nullptr}; gemm_phase(lds, D, D, D, s, e); }
    else if constexpr (PH == PH_MIXPREP) ph_mix_prep(p, l, bi, nb);
    else if constexpr (PH == PH_LORA_CMP1) {
        { GSched s = make_sched(WSP(bf16_t, WS_ALORA), 512, WSP(bf16_t, WS_W_LORA), 512, 32, 6, 1536, bi, nb); EpiF32 e{WSP(float, WS_LO), 1536, 1.f}; gemm_phase(lds, 512, 512, 512, s, e); }
        { GSched s = make_sched(WSP(bf16_t, WS_KVG), 1024, WSP(bf16_t, WS_W_C1), 2048, 1, 1, 256, bi, nb); s.nZ1 = 2; s.nZ2 = 4; s.a_z1 = (long)KVG_SLAB * 2; s.a_z2 = (long)SEQ * 64 * 2; s.b_z1 = (long)256 * 2048 * 2; s.b_z2 = 0;
          s.o_z1 = 4 * 256 * 256; s.o_z2 = 256 * 256;
          EpiC1 e{WSP(bf16_t, WS_HID), WSP(float, WS_CBIAS)}; gemm_phase(lds, 1024, 2048, 2048, s, e); }
    }
    else if constexpr (PH == PH_RWPREP2_CMP2_RETU) { ph_rw_prep2(p, l, bi, nb); ph_cmp2(p, l, bi, nb); ph_ret_u(p, lds, bi, nb); }
    else if constexpr (PH == PH_RWCHUNK) ph_rw_chunk(p, lds, bi, nb);
    else if constexpr (PH == PH_RWSERIAL) ph_rw_serial(p, lds, bi, nb);
    else if constexpr (PH == PH_RETSCAN) ph_ret_scan(p, bi, nb);
    else if constexpr (PH == PH_NSACMP) ph_nsa_cmp(p, lds, bi, nb);
    else if constexpr (PH == PH_RWPOST_RETOUT) { ph_rw_post(p, l, bi, nb); ph_ret_out(p, lds, bi, nb); }
    else if constexpr (PH == PH_NSAATTN) ph_nsa_attn(p, lds, bi, nb);
    else if constexpr (PH == PH_BRANCH) {
        const int koff[4] = {0, 512, 1024, 2048}, kk[4] = {512, 512, 1024, 512};
#pragma unroll
        for (int br = 0; br < 4; ++br) { GSched s = make_sched(WSP(bf16_t, WS_OALL) + koff[br], NBR, WSP(bf16_t, WS_W_BR) + koff[br], NBR, 32, 8, D, bi, nb);
            EpiBranch e{WSP(float, WS_MERGED), WSP(bf16_t, WS_MERGEDB), WSP(bf16_t, WS_Z) + ZC_GATE + br * D, br == 0, br == 3}; gemm_phase(lds, NBR, NBR, kk[br], s, e); }
    }
    else if constexpr (PH == PH_OUTPROJ) { GSched s = make_sched(WSP(bf16_t, WS_MERGEDB), D, WSP(bf16_t, WS_W_OUT), D, 32, 8, D, bi, nb); EpiF32 e{WSP(float, WS_Y), D, 1.f}; gemm_phase(lds, D, D, D, s, e); }
    else if constexpr (PH == PH_FINISH1) ph_finish(l == 0 ? inp(p, 0) : (const float*)OUTP, WSP(float, WS_Y), INL(4, D), INL(5, D), OUTP, WSP(bf16_t, WS_H), bi, nb);
    else if constexpr (PH == PH_QPROJ) { GSched s = make_sched(WSP(bf16_t, WS_H), D, WSP(bf16_t, WS_W_Q), D, 32, 8, D, bi, nb); EpiBf16<0> e{WSP(bf16_t, WS_QX), D, nullptr}; gemm_phase(lds, D, D, D, s, e); }
    else if constexpr (PH == PH_XSCORE) {
        GSched s = make_sched(WSP(bf16_t, WS_QX), D, WSP(bf16_t, WS_KMEM), D, 16, 1, 1024, bi, nb); s.nZ1 = 2; s.nZ2 = 4; s.a_z1 = (long)SEQ * D * 2; s.a_z2 = 512 * 2; s.b_z1 = (long)MEM * D * 2; s.b_z2 = 512 * 2; s.o_z1 = (long)SEQ * 1024; s.o_z2 = 256;
        EpiF32 e{WSP(float, WS_SC), 1024, 0.04419417382415922f}; gemm_phase(lds, D, D, 512, s, e); }
    else if constexpr (PH == PH_XSOFTMAX) ph_xsoftmax(p, bi, nb);
    else if constexpr (PH == PH_XPV) {
        GSched s = make_sched(WSP(bf16_t, WS_PB), 1024, WSP(bf16_t, WS_VTM), 512, 16, 2, D, bi, nb); s.nZ1 = 2; s.nZ2 = 4; s.a_z1 = (long)SEQ * 1024 * 2; s.a_z2 = 256 * 2; s.b_z1 = 256 * 2; s.b_z2 = (long)512 * 512 * 2; s.o_z1 = (long)SEQ * D; s.o_z2 = 512;
        EpiBf16<0> e{WSP(bf16_t, WS_OX), D, nullptr}; gemm_phase(lds, 1024, 512, 256, s, e); }
    else if constexpr (PH == PH_XO) { GSched s = make_sched(WSP(bf16_t, WS_OX), D, WSP(bf16_t, WS_W_O), D, 32, 8, D, bi, nb); EpiF32 e{WSP(float, WS_Y), D, 1.f}; gemm_phase(lds, D, D, D, s, e); }
    else if constexpr (PH == PH_FINISH2) ph_finish(OUTP, WSP(float, WS_Y), INL(7, D), INL(8, D), OUTP, WSP(bf16_t, WS_H), bi, nb);
    else if constexpr (PH == PH_UP) { GSched s = make_sched(WSP(bf16_t, WS_H), D, WSP(bf16_t, WS_W_UP), D, 32, 44, FFN2, bi, nb); EpiBf16<0> e{WSP(bf16_t, WS_U), FFN2, nullptr}; gemm_phase(lds, D, D, D, s, e); }
    else if constexpr (PH == PH_CONVACT) ph_convact(p, l, bi, nb);
    else if constexpr (PH == PH_DOWN) { GSched s = make_sched(WSP(bf16_t, WS_GACT), FFN, WSP(bf16_t, WS_W_DN), FFN, 32, 8, D, bi, nb); EpiF32 e{WSP(float, WS_Y), D, 1.f}; gemm_phase(lds, FFN, FFN, FFN, s, e); }
    else if constexpr (PH == PH_FINISH3) ph_finish(OUTP, WSP(float, WS_Y), INL(9, D), (l + 1 < DEPTH) ? (inp(p, 3) + (size_t)(l + 1) * D) : nullptr, OUTP, WSP(bf16_t, WS_H), bi, nb);
}

__global__ void __launch_bounds__(512, 2) mega_fwd(Params p) {
    extern __shared__ __attribute__((aligned(16))) unsigned char lds_raw[];
    LAS unsigned char* lds = (LAS unsigned char*)lds_raw;
    volatile LAS unsigned* st = (volatile LAS unsigned*)(lds + LDS_BYTES - 16);
    if (threadIdx.x == 0) { st[0] = 0u; st[1] = 0u; st[2] = (unsigned)(u64)p.ws; st[3] = (unsigned)((u64)p.ws >> 32); }
    __syncthreads();
    if (threadIdx.x == 0) { const float** tab = (const float**)(p.ws + WS_PTRTAB);
#pragma unroll
        for (int i = 0; i < 35; ++i) tab[i] = p.in[i];
        tab[35] = p.out; }
    __syncthreads();
    XcdBarrier bar = xcd_barrier_post((unsigned*)(p.ws + WS_CTL) + 1024, st);
    const int bi = (int)blockIdx.x, nb = (int)gridDim.x;
#define PHASE(PH) do { int l_ = l, bi_ = bi; asm volatile("" : "+s"(l_), "+s"(bi_)); run_phase<PH>(p, l_, lds, bi_, nb); xcd_barrier(bar); } while (0)
    for (int l = 0; l < DEPTH; ++l) {
        PHASE(PH_CONVERT);
#if DUP == 5
        PHASE(PH_CONVERT);
#endif
        PHASE(PH_MEMKV);
        if (l == 0) PHASE(PH_NORM1);
        PHASE(PH_INPROJ);
        PHASE(PH_MIXPREP);
#if DUP == 3
        PHASE(PH_MIXPREP);
#endif
        PHASE(PH_LORA_CMP1);
        PHASE(PH_RWPREP2_CMP2_RETU);
        PHASE(PH_RWCHUNK);
        PHASE(PH_RWSERIAL);
        PHASE(PH_RETSCAN);
        PHASE(PH_NSACMP);
        PHASE(PH_RWPOST_RETOUT);
        PHASE(PH_NSAATTN);
#if DUP == 2
        PHASE(PH_NSAATTN);
#endif
        PHASE(PH_BRANCH);
        PHASE(PH_OUTPROJ);
        PHASE(PH_FINISH1);
        PHASE(PH_QPROJ);
        PHASE(PH_XSCORE);
        PHASE(PH_XSOFTMAX);
        PHASE(PH_XPV);
        PHASE(PH_XO);
        PHASE(PH_FINISH2);
        PHASE(PH_UP);
        PHASE(PH_CONVACT);
#if DUP == 4
        PHASE(PH_CONVACT);
#endif
        PHASE(PH_DOWN);
        PHASE(PH_FINISH3);
    }
#undef PHASE
}

extern "C" void kernel_launch(void* const* d_in, const int* in_sizes, int n_in, void* d_out, int out_size, void* d_ws, size_t ws_size, hipStream_t stream) {
    if (n_in != 35 || ws_size < WS_END) { fprintf(stderr, "kernel_launch: unexpected n_in %d / ws_size %zu (need %zu)\n", n_in, ws_size, (size_t)WS_END); return; }
    static int grid = 0;
    if (grid == 0) {
        int dev = 0, cus = 0, per_cu = 0;
        (void)hipGetDevice(&dev); (void)hipDeviceGetAttribute(&cus, hipDeviceAttributeMultiprocessorCount, dev);
        (void)hipFuncSetAttribute((const void*)mega_fwd, hipFuncAttributeMaxDynamicSharedMemorySize, LDS_BYTES);
        if (hipOccupancyMaxActiveBlocksPerMultiprocessor(&per_cu, (const void*)mega_fwd, 512, LDS_BYTES) != hipSuccess || per_cu < 1) fprintf(stderr, "kernel_launch: occupancy query says %d blocks per CU\n", per_cu);
        (void)hipGetLastError();
        grid = cus > 0 ? cus : 256;
    }
    (void)hipMemsetAsync((char*)d_ws + WS_CTL, 0, 1 * MiB, stream);
    Params p; memset(&p, 0, sizeof(p));
    for (int i = 0; i < 35; ++i) p.in[i] = (const float*)d_in[i];
    p.out = (float*)d_out; p.ws = (unsigned char*)d_ws;
    hipLaunchKernelGGL(mega_fwd, dim3(grid), dim3(512), LDS_BYTES, stream, p);
}
```

```cpp
#include <hip/hip_runtime.h>
#ifndef DUP
#define DUP 0
#endif
#include <cstdio>
#include <cstdint>
#include <cstring>

#define LAS __attribute__((address_space(3)))
typedef unsigned short bf16_t;
typedef short bf16x8 __attribute__((ext_vector_type(8)));
typedef float f32x4 __attribute__((ext_vector_type(4)));
typedef float f32x2 __attribute__((ext_vector_type(2)));
typedef unsigned u32x4 __attribute__((ext_vector_type(4)));
typedef unsigned u32x2 __attribute__((ext_vector_type(2)));
typedef unsigned long long u64;

constexpr int D = 2048, BATCH = 2, SEQ = 4096, M = BATCH * SEQ, DEPTH = 2;
constexpr int NZ = 16384;
constexpr int N_IN = 16088;
constexpr int ZC_SC_B = 0, ZC_SC_C = 512, ZC_SC_X = 1024;
constexpr int ZC_RW = 1536;
constexpr int ZC_RW_R = 1536, ZC_RW_K = 2048, ZC_RW_V = 2560, ZC_RW_ZW = 3072, ZC_RW_ZA = 3168, ZC_RW_ZG = 3264;
constexpr int ZC_RET_Q = 3584, ZC_RET_K = 4096, ZC_RET_V = 4608, ZC_RET_G = 5632;
constexpr int ZC_NSA_Q = 6656, ZC_NSA_KC = 7168, ZC_NSA_VC = 7296, ZC_NSA_KS = 7424, ZC_NSA_VS = 7552, ZC_NSA_KW = 7680, ZC_NSA_VW = 7808, ZC_NSA_GT = 7936;
constexpr int ZC_GATE = 8192;
constexpr int NBR = 2560;
constexpr int FFN = 5632, FFN2 = 11264;
constexpr int MEM = 256;

constexpr size_t MiB = 1u << 20;
constexpr size_t WS_CTL = 0;
constexpr size_t WS_W_IN = 1 * MiB, WS_W_BR = 65 * MiB, WS_W_OUT = 75 * MiB, WS_W_Q = 83 * MiB, WS_W_KV = 91 * MiB, WS_W_O = 107 * MiB;
constexpr size_t WS_W_UP = 115 * MiB, WS_W_DN = 159 * MiB, WS_W_LORA = 181 * MiB, WS_W_C1 = 183 * MiB;
constexpr size_t WS_CBIAS = 185 * MiB, WS_MEMN = 186 * MiB, WS_KMEM = 188 * MiB, WS_VTM = 190 * MiB;
constexpr size_t WS_H = 192 * MiB, WS_Z = 224 * MiB, WS_OALL = 480 * MiB, WS_MERGED = 520 * MiB, WS_MERGEDB = 584 * MiB, WS_Y = 616 * MiB;
constexpr size_t WS_T = 680 * MiB;
constexpr size_t WS_ALORA = WS_T, WS_LO = WS_T + 8 * MiB, WS_RWOPS = WS_T + 56 * MiB, WS_YSCAN = WS_T + 152 * MiB;
constexpr size_t WS_QR = WS_T + 168 * MiB, WS_KR = WS_T + 176 * MiB, WS_UBUF = WS_T + 184 * MiB, WS_RPREV = WS_T + 216 * MiB;
constexpr size_t WS_QN = WS_T + 232 * MiB, WS_KVG = WS_T + 240 * MiB, WS_HID = WS_T + 253 * MiB, WS_KCMP = WS_T + 254 * MiB, WS_VCMPT = WS_T + 254 * MiB + 512 * 1024;
constexpr size_t WS_OCMP = WS_T + 255 * MiB, WS_SELM = WS_T + 263 * MiB;
constexpr size_t WS_END = WS_T + 264 * MiB;
constexpr size_t WS_QX = WS_Z, WS_SC = WS_Z + 32 * MiB, WS_PB = WS_Z + 64 * MiB, WS_OX = WS_Z + 80 * MiB;
constexpr size_t WS_U = WS_Z, WS_GACT = WS_T;
constexpr size_t WS_RW_PF = WS_MERGED, WS_RW_QF = WS_MERGED + 32 * MiB, WS_RW_RF = WS_MERGED + 96 * MiB, WS_RW_Y0F = WS_MERGED + 104 * MiB;
constexpr size_t KVG_SLAB = (size_t)BATCH * 2 * SEQ * 64;

constexpr int LDS_BYTES = 147456;

struct Params {
    const float* in[35];
    float* out;
    unsigned char* ws;
};

__device__ __forceinline__ int otid() { int t = (int)threadIdx.x; asm volatile("" : "+v"(t)); return t; }
__device__ __forceinline__ float bf2f(bf16_t v) { return __uint_as_float((unsigned)v << 16); }
typedef __bf16 bf16x2_t __attribute__((ext_vector_type(2)));
__device__ __forceinline__ unsigned cvt_pk_bf16(float lo, float hi) { const f32x2 v = {lo, hi}; const bf16x2_t b = __builtin_convertvector(v, bf16x2_t); return __builtin_bit_cast(unsigned, b); }
__device__ __forceinline__ bf16_t f2bf(float f) { return (bf16_t)(cvt_pk_bf16(f, 0.f) & 0xffffu); }
__device__ __forceinline__ float wave_sum(float v) {
#pragma unroll
    for (int o = 1; o < 64; o <<= 1) v += __shfl_xor(v, o);
    return v;
}
__device__ __forceinline__ float sigmoidf_(float x) { return 1.f / (1.f + __expf(-x)); }
__device__ __forceinline__ float gelu_tanh(float x) { const float u = 1.5957691216057308f * (x + 0.044715f * x * x * x); return x / (1.f + __expf(-u)); }
__device__ __forceinline__ f32x4 mma16(f32x4 acc, bf16x8 a_rowfrag, bf16x8 b_colfrag) {
    return __builtin_amdgcn_mfma_f32_16x16x32_bf16(b_colfrag, a_rowfrag, acc, 0, 0, 0);
}
__device__ __forceinline__ bf16x8 ldfrag(const bf16_t* p) { return *(const bf16x8*)p; }

namespace pg8 {
constexpr int BM = 256, BK = 64, HALF = 128, HTB = HALF * BK * 2, STAGE_BYTES = 8 * HTB, NXCD = 8, WGM = 8;
__host__ __device__ __forceinline__ int lds_byte(int r, int c) { const int st = (r >> 4) * 2 + (c >> 5), rr = r & 15, cc = c & 31, ob = rr * 64 + cc * 2; return st * 1024 + (ob ^ (((ob >> 9) & 1) << 5)); }
__host__ __device__ __forceinline__ void stage_rc(int b, int& R, int& C) { const int st = b / 1024, sb = b % 1024, swz = sb ^ (((sb >> 9) & 1) << 5); R = (st >> 1) * 16 + swz / 64; C = (st & 1) * 32 + (swz % 64) / 2; }
__host__ __device__ __forceinline__ int perm32(int rho) { const int n = rho >> 4, i = rho & 15; return 8 * (i >> 2) + 4 * n + (i & 3); }

struct Unit { const char* A; const char* B; size_t ooff; int pm, pn, z; };

struct GSched {
    const char* A; const char* B;
    long a_pm, b_pn;
    long a_z1, a_z2, b_z1, b_z2;
    long o_pm, o_pn, o_z1, o_z2;
    int nM, nN, nZ1, nZ2, G, c;
    __device__ __forceinline__ bool next(int i, Unit& u) const {
        const int per = nM * nN; const long L = (long)i * G + c; if (L >= (long)per * nZ1 * nZ2) return false;
        const int zz = (int)(L / per); int wgid = (int)(L % per);
        { const int q = per / NXCD, r = per % NXCD, xcd = wgid % NXCD, off = wgid / NXCD; wgid = (xcd < r ? xcd * (q + 1) : r * (q + 1) + (xcd - r) * q) + off; }
        const int nig = WGM * nN, gid = wgid / nig, fm = gid * WGM, gsz = (nM - fm) < WGM ? (nM - fm) : WGM;
        const int pm = fm + ((wgid % nig) % gsz), pn = (wgid % nig) / gsz;
        const int z1 = zz / nZ2, z2 = zz % nZ2;
        u.pm = pm; u.pn = pn; u.z = zz;
        u.A = A + z1 * a_z1 + z2 * a_z2 + pm * a_pm; u.B = B + z1 * b_z1 + z2 * b_z2 + pn * b_pn;
        u.ooff = (size_t)(z1 * o_z1 + z2 * o_z2 + pm * o_pm + pn * o_pn);
        return true;
    }
};
__device__ __forceinline__ GSched make_sched(const void* A, int lda, const void* B, int ldb, int nM, int nN, long ldc, int bi, int nb) {
    GSched s; s.A = (const char*)A; s.B = (const char*)B; s.a_pm = (long)BM * lda * 2; s.b_pn = (long)BM * ldb * 2; s.a_z1 = s.a_z2 = s.b_z1 = s.b_z2 = 0;
    s.o_pm = (long)BM * ldc; s.o_pn = BM; s.o_z1 = s.o_z2 = 0; s.nM = nM; s.nN = nN; s.nZ1 = 1; s.nZ2 = 1; s.G = nb; s.c = bi; return s;
}

template <class Epi, class Sched>
__device__ __forceinline__ void gemm_phase(LAS unsigned char* lds, const int lda, const int ldb, const int K, const Sched& S, const Epi& E) {
    const int tid = otid(), wid = __builtin_amdgcn_readfirstlane(tid >> 6), lane = tid & 63, wr = wid >> 2, wc = wid & 3, fr = lane & 15, fq = lane >> 4;
    const int nt = K / BK;
    unsigned voffA[2], voffB[2];
#pragma unroll
    for (int i = 0; i < 2; ++i) { int R, C; stage_rc(tid * 16 + i * 8192, R, C); const int Rb = Epi::PERM ? ((R & ~31) + perm32(R & 31)) : R;
        voffA[i] = (unsigned)(R * lda + C) * 2u; voffB[i] = (unsigned)(Rb * ldb + C) * 2u; }
    const size_t kstep = (size_t)(BK * 2);
    const size_t hstepA = (size_t)HALF * lda * 2, hstepB = (size_t)HALF * ldb * 2;
    const unsigned ldsw = (unsigned)wid * 1024u;
    const int aoff = lds_byte(wr * 64 + fr, fq * 8), boff = lds_byte(wc * 32 + fr, fq * 8);
#define PG8_SA(b, h) (((b) * 2 + (h)) * HTB)
#define PG8_SB(b, h) ((4 + (b) * 2 + (h)) * HTB)
#define PG8_STAGE(bufoff, gbase, voff) do { _Pragma("unroll") for (int _i = 0; _i < 2; ++_i) \
        __builtin_amdgcn_global_load_lds((const unsigned*)((const char*)(gbase) + (voff)[_i]), (LAS unsigned*)(lds + (bufoff) + ldsw + _i * 8192), 16, 0, 0); } while (0)
#define PG8_LDA(dst, b, h) do { _Pragma("unroll") for (int m = 0; m < 4; ++m) _Pragma("unroll") for (int k = 0; k < 2; ++k) dst[m][k] = *(const LAS bf16x8*)(lds + PG8_SA(b, h) + aoff + m * 2048 + k * 1024); } while (0)
#define PG8_LDB(dst, b, h) do { _Pragma("unroll") for (int n = 0; n < 2; ++n) _Pragma("unroll") for (int k = 0; k < 2; ++k) dst[n][k] = *(const LAS bf16x8*)(lds + PG8_SB(b, h) + boff + n * 2048 + k * 1024); } while (0)
#define PG8_MMA(ai, bj, At, Bt) do { __builtin_amdgcn_s_setprio(1); _Pragma("unroll") for (int m = 0; m < 4; ++m) _Pragma("unroll") for (int n = 0; n < 2; ++n) _Pragma("unroll") for (int k = 0; k < 2; ++k) \
        acc[ai][bj][m][n] = __builtin_amdgcn_mfma_f32_16x16x32_bf16(Bt[n][k], At[m][k], acc[ai][bj][m][n], 0, 0, 0); __builtin_amdgcn_s_setprio(0); } while (0)
#define PG8_WAIT_V(n) asm volatile("s_waitcnt vmcnt(" #n ")" ::: "memory")
#define PG8_WAIT_L(n) asm volatile("s_waitcnt lgkmcnt(" #n ")" ::: "memory")
#define PG8_BAR __builtin_amdgcn_s_barrier()
#define PG8_SCHED __builtin_amdgcn_sched_barrier(0)
    Unit cur, nxt; int ui = 0;
    if (!S.next(0, cur)) return;
    f32x4 acc[2][2][4][2];
#pragma unroll
    for (int a = 0; a < 2; ++a)
#pragma unroll
        for (int b = 0; b < 2; ++b)
#pragma unroll
            for (int m = 0; m < 4; ++m)
#pragma unroll
                for (int n = 0; n < 2; ++n) acc[a][b][m][n] = (f32x4){0.f, 0.f, 0.f, 0.f};
    bf16x8 At[4][2], B0[2][2], B1[2][2];
    const char* cA = cur.A; const char* cB = cur.B;
    PG8_STAGE(PG8_SB(0, 0), cB, voffB); PG8_STAGE(PG8_SB(0, 1), cB + hstepB, voffB); PG8_STAGE(PG8_SA(0, 0), cA, voffA); PG8_STAGE(PG8_SA(0, 1), cA + hstepA, voffA);
    if (wr == 1) PG8_BAR;
    PG8_WAIT_V(2); PG8_BAR;
    PG8_STAGE(PG8_SB(1, 0), cB + kstep, voffB); PG8_STAGE(PG8_SA(1, 0), cA + kstep, voffA); PG8_STAGE(PG8_SB(1, 1), cB + hstepB + kstep, voffB);
    PG8_WAIT_V(6); PG8_BAR;
    for (;;) {
        const bool has_next = S.next(ui + 1, nxt);
        const char* nA = has_next ? nxt.A : cA; const char* nB = has_next ? nxt.B : cB;
        for (int t = 0; t < nt; t += 2) {
            const bool last = (t == nt - 2);
            const char* a1 = cA + (size_t)(t + 1) * kstep;
            const char* a2 = last ? nA : cA + (size_t)(t + 2) * kstep; const char* b2 = last ? nB : cB + (size_t)(t + 2) * kstep;
            const char* a3 = a2 + kstep; const char* b3 = b2 + kstep;
            PG8_LDB(B0, 0, 0); PG8_LDB(B1, 0, 1); PG8_SCHED; PG8_LDA(At, 0, 0); PG8_STAGE(PG8_SA(1, 1), a1 + hstepA, voffA);
            PG8_WAIT_V(8); PG8_WAIT_L(0); PG8_BAR; PG8_MMA(0, 0, At, B0); PG8_MMA(0, 1, At, B1); PG8_BAR; PG8_SCHED;
            PG8_LDA(At, 0, 1); PG8_STAGE(PG8_SB(0, 0), b2, voffB); PG8_STAGE(PG8_SB(0, 1), b2 + hstepB, voffB); PG8_STAGE(PG8_SA(0, 0), a2, voffA);
            PG8_WAIT_V(8); PG8_WAIT_L(0); PG8_BAR; PG8_MMA(1, 0, At, B0); PG8_MMA(1, 1, At, B1); PG8_BAR; PG8_SCHED;
            PG8_LDB(B0, 1, 0); PG8_LDB(B1, 1, 1); PG8_SCHED; PG8_LDA(At, 1, 0); PG8_STAGE(PG8_SA(0, 1), a2 + hstepA, voffA);
            PG8_WAIT_V(8); PG8_WAIT_L(0); PG8_BAR; PG8_MMA(0, 0, At, B0); PG8_MMA(0, 1, At, B1); PG8_BAR; PG8_SCHED;
            PG8_LDA(At, 1, 1); PG8_STAGE(PG8_SB(1, 0), b3, voffB); PG8_STAGE(PG8_SB(1, 1), b3 + hstepB, voffB); PG8_STAGE(PG8_SA(1, 0), a3, voffA);
            PG8_WAIT_V(8); PG8_WAIT_L(0); PG8_BAR; PG8_MMA(1, 0, At, B0); PG8_MMA(1, 1, At, B1); PG8_BAR; PG8_SCHED;
        }
        if (wr == 0) PG8_BAR;
        E(acc, cur, wr, wc, fr, fq);
        if (!has_next) break;
#pragma unroll
        for (int a = 0; a < 2; ++a)
#pragma unroll
            for (int b = 0; b < 2; ++b)
#pragma unroll
                for (int m = 0; m < 4; ++m)
#pragma unroll
                    for (int n = 0; n < 2; ++n) acc[a][b][m][n] = (f32x4){0.f, 0.f, 0.f, 0.f};
        cur = nxt; cA = nA; cB = nB; ++ui;
        if (wr == 1) PG8_BAR;
    }
    PG8_WAIT_V(0);
    PG8_BAR;
#undef PG8_SA
#undef PG8_SB
#undef PG8_STAGE
#undef PG8_LDA
#undef PG8_LDB
#undef PG8_MMA
#undef PG8_WAIT_V
#undef PG8_WAIT_L
#undef PG8_BAR
#undef PG8_SCHED
}

template <int ACT> struct EpiBf16 {
    static constexpr bool PERM = true;
    bf16_t* O; int ldc; const float* bias;
    __device__ __forceinline__ void operator()(const f32x4 (&acc)[2][2][4][2], const Unit& u, int wr, int wc, int fr, int fq) const {
        bf16_t* base = O + u.ooff; const int col0 = wc * 32 + 8 * fq;
#pragma unroll
        for (int ai = 0; ai < 2; ++ai)
#pragma unroll
            for (int m = 0; m < 4; ++m) { bf16_t* rowp = base + (size_t)(ai * HALF + wr * 64 + m * 16 + fr) * ldc + col0;
#pragma unroll
                for (int bj = 0; bj < 2; ++bj) { f32x4 v0 = acc[ai][bj][m][0], v1 = acc[ai][bj][m][1];
                    if (ACT == 1) { const float* bp = bias + u.pn * BM + col0 + bj * HALF; const f32x4 b0 = *(const f32x4*)bp, b1 = *(const f32x4*)(bp + 4);
                        v0 += b0; v1 += b1;
#pragma unroll
                        for (int j = 0; j < 4; ++j) { v0[j] = gelu_tanh(v0[j]); v1[j] = gelu_tanh(v1[j]); } }
                    u32x4 w; w.x = cvt_pk_bf16(v0[0], v0[1]); w.y = cvt_pk_bf16(v0[2], v0[3]); w.z = cvt_pk_bf16(v1[0], v1[1]); w.w = cvt_pk_bf16(v1[2], v1[3]);
                    *(u32x4*)(rowp + bj * HALF) = w; } }
    }
};
struct EpiF32 {
    static constexpr bool PERM = false;
    float* C; int ldc; float scale;
    __device__ __forceinline__ void operator()(const f32x4 (&acc)[2][2][4][2], const Unit& u, int wr, int wc, int fr, int fq) const {
        float* base = C + u.ooff; const int col0 = wc * 32 + 4 * fq;
#pragma unroll
        for (int ai = 0; ai < 2; ++ai)
#pragma unroll
            for (int m = 0; m < 4; ++m) { float* rowp = base + (size_t)(ai * HALF + wr * 64 + m * 16 + fr) * ldc + col0;
#pragma unroll
                for (int bj = 0; bj < 2; ++bj)
#pragma unroll
                    for (int n = 0; n < 2; ++n) *(f32x4*)(rowp + bj * HALF + n * 16) = acc[ai][bj][m][n] * scale; }
    }
};
struct EpiBranch {
    static constexpr bool PERM = false;
    float* merged; bf16_t* mergedb; const bf16_t* gate; int first, last;
    __device__ __forceinline__ void operator()(const f32x4 (&acc)[2][2][4][2], const Unit& u, int wr, int wc, int fr, int fq) const {
        const int col0 = u.pn * BM + wc * 32 + 4 * fq;
#pragma unroll
        for (int ai = 0; ai < 2; ++ai)
#pragma unroll
            for (int m = 0; m < 4; ++m) { const size_t row = (size_t)(u.pm * BM + ai * HALF + wr * 64 + m * 16 + fr);
#pragma unroll
                for (int bj = 0; bj < 2; ++bj)
#pragma unroll
                    for (int n = 0; n < 2; ++n) { const int col = col0 + bj * HALF + n * 16;
                        const u32x2 gw = *(const u32x2*)(gate + row * NZ + col);
                        f32x4 g; g[0] = sigmoidf_(__uint_as_float(gw.x << 16)); g[1] = sigmoidf_(__uint_as_float(gw.x & 0xffff0000u)); g[2] = sigmoidf_(__uint_as_float(gw.y << 16)); g[3] = sigmoidf_(__uint_as_float(gw.y & 0xffff0000u));
                        f32x4 v = acc[ai][bj][m][n] * g;
                        if (!first) v += *(const f32x4*)(merged + row * D + col);
                        if (last) { u32x2 w; w.x = cvt_pk_bf16(v[0], v[1]); w.y = cvt_pk_bf16(v[2], v[3]); *(u32x2*)(mergedb + row * D + col) = w; }
                        else *(f32x4*)(merged + row * D + col) = v; } }
    }
};
struct EpiC1 { static constexpr bool PERM = true; bf16_t* O; const float* bias;
    __device__ __forceinline__ void operator()(const f32x4 (&acc)[2][2][4][2], const Unit& u, int wr, int wc, int fr, int fq) const { EpiBf16<1> e{O, 256, bias + (u.z >> 2) * 256}; e(acc, u, wr, wc, fr, fq); } };
}

__device__ __forceinline__ void ph_norm_rows(const float* x, const float* g, bf16_t* out, int rows, int bi, int nb) {
    const int tid_ = otid(), lane = tid_ & 63, gw = bi * 8 + (tid_ >> 6), NGW = nb * 8;
    for (int m = gw; m < rows; m += NGW) {
        const f32x4* xr = (const f32x4*)(x + (size_t)m * D) + lane; f32x4 v[8]; float s = 0.f;
#pragma unroll
        for (int j = 0; j < 8; ++j) { v[j] = xr[64 * j]; s += v[j][0] * v[j][0] + v[j][1] * v[j][1] + v[j][2] * v[j][2] + v[j][3] * v[j][3]; }
        const float rstd = rsqrtf(wave_sum(s) * (1.f / D) + 1e-6f);
        u32x2* o = (u32x2*)(out + (size_t)m * D) + lane;
#pragma unroll
        for (int j = 0; j < 8; ++j) { const f32x4 gg = ((const f32x4*)g)[lane + 64 * j]; u32x2 w; w.x = cvt_pk_bf16(v[j][0] * rstd * gg[0], v[j][1] * rstd * gg[1]); w.y = cvt_pk_bf16(v[j][2] * rstd * gg[2], v[j][3] * rstd * gg[3]); o[64 * j] = w; }
    }
}
__device__ __forceinline__ void ph_finish(const float* xin, const float* y, const float* g1, const float* g2, float* xout, bf16_t* h, int bi, int nb) {
    const int tid_ = otid(), lane = tid_ & 63, gw = bi * 8 + (tid_ >> 6), NGW = nb * 8;
    for (int m = gw; m < M; m += NGW) {
        const f32x4* yr = (const f32x4*)(y + (size_t)m * D) + lane; const f32x4* xr = (const f32x4*)(xin + (size_t)m * D) + lane; f32x4 v[8]; float s = 0.f;
#pragma unroll
        for (int j = 0; j < 8; ++j) { v[j] = yr[64 * j]; s += v[j][0] * v[j][0] + v[j][1] * v[j][1] + v[j][2] * v[j][2] + v[j][3] * v[j][3]; }
        const float rstd = rsqrtf(wave_sum(s) * (1.f / D) + 1e-6f); float s2 = 0.f;
        f32x4* xo = (f32x4*)(xout + (size_t)m * D) + lane;
#pragma unroll
        for (int j = 0; j < 8; ++j) { const f32x4 gg = ((const f32x4*)g1)[lane + 64 * j]; const f32x4 xv = xr[64 * j];
            v[j] = xv + v[j] * rstd * gg; xo[64 * j] = v[j]; s2 += v[j][0] * v[j][0] + v[j][1] * v[j][1] + v[j][2] * v[j][2] + v[j][3] * v[j][3]; }
        if (g2) { const float r2 = rsqrtf(wave_sum(s2) * (1.f / D) + 1e-6f); u32x2* o = (u32x2*)(h + (size_t)m * D) + lane;
#pragma unroll
            for (int j = 0; j < 8; ++j) { const f32x4 gg = ((const f32x4*)g2)[lane + 64 * j]; u32x2 w; w.x = cvt_pk_bf16(v[j][0] * r2 * gg[0], v[j][1] * r2 * gg[1]); w.y = cvt_pk_bf16(v[j][2] * r2 * gg[2], v[j][3] * r2 * gg[3]); o[64 * j] = w; } }
    }
}

enum { MAP_ID = 0, MAP_WIN = 1, MAP_UP = 2 };
__device__ __forceinline__ int cmap(int kind, int n) {
    if (kind == MAP_ID) return n;
    if (kind == MAP_WIN) { if (n < 3520) return n; if (n < 3584) return -1; if (n < 6656) return n - 64; if (n < 7960) return n - 64; if (n < 8192) return -1; return n - 296; }
    const int j = n >> 8, s = n & 255; return s < 128 ? 128 * j + s : FFN + 128 * j + (s - 128);
}
__device__ __forceinline__ void transpose_item(const float* W, int K, int Nsrc, bf16_t* WT, int kind, LAS unsigned* T, int item, int nblk, int tid) {
    const int kb = item / nblk, nb_ = item % nblk, k0 = 128 * kb, n0 = 128 * nb_;
    { const int cg = tid & 31, r0 = tid >> 5; const int src = cmap(kind, n0 + 4 * cg);
      f32x4 v[8];
#pragma unroll
      for (int i = 0; i < 8; ++i) v[i] = src >= 0 ? *(const f32x4*)(W + (size_t)(k0 + r0 + 16 * i) * Nsrc + src) : (f32x4){0.f, 0.f, 0.f, 0.f};
#pragma unroll
      for (int i = 0; i < 8; ++i) { LAS unsigned* d = T + (r0 + 16 * i) * 65 + 2 * cg; d[0] = cvt_pk_bf16(v[i][0], v[i][1]); d[1] = cvt_pk_bf16(v[i][2], v[i][3]); } }
    __syncthreads();
#pragma unroll
    for (int j = 0; j < 2; ++j) { const int c = tid + 512 * j, np = (c & 7) + 8 * ((c >> 6) & 7), kg = ((c >> 3) & 7) + 8 * (c >> 9);
        unsigned w[8];
#pragma unroll
        for (int e = 0; e < 8; ++e) w[e] = T[(8 * kg + e) * 65 + np];
        u32x4 lo, hi;
        lo.x = (w[0] & 0xffffu) | (w[1] << 16); lo.y = (w[2] & 0xffffu) | (w[3] << 16); lo.z = (w[4] & 0xffffu) | (w[5] << 16); lo.w = (w[6] & 0xffffu) | (w[7] << 16);
        hi.x = (w[0] >> 16) | (w[1] & 0xffff0000u); hi.y = (w[2] >> 16) | (w[3] & 0xffff0000u); hi.z = (w[4] >> 16) | (w[5] & 0xffff0000u); hi.w = (w[6] >> 16) | (w[7] & 0xffff0000u);
        bf16_t* o = WT + (size_t)(n0 + 2 * np) * K + k0 + 8 * kg;
        *(u32x4*)o = lo; *(u32x4*)(o + K) = hi; }
    __syncthreads();
}
__device__ __forceinline__ unsigned char* ws_lds() {
    volatile LAS unsigned* q = (volatile LAS unsigned*)(LDS_BYTES - 8); unsigned lo = q[0], hi = q[1];
    lo = (unsigned)__builtin_amdgcn_readfirstlane((int)lo); hi = (unsigned)__builtin_amdgcn_readfirstlane((int)hi); return (unsigned char*)(__attribute__((address_space(1))) unsigned char*)(((u64)hi << 32) | (u64)lo); }
#define PROLOG unsigned char* const wsl = ws_lds()
#define WS_PTRTAB 256
#define inp(p_, i) ((const float*)(__attribute__((address_space(1))) const float*)(((const u64*)(wsl + WS_PTRTAB))[i]))
#define OUTP ((float*)(__attribute__((address_space(1))) float*)(((const u64*)(wsl + WS_PTRTAB))[35]))
#define WSP(T, off) ((T*)(wsl + (off)))
#define INL(i, per) (inp(p, i) + (size_t)l * (per))

__device__ __forceinline__ void ph_convert(const Params& p, int l, LAS unsigned char* lds, int bi, int nb) {
    PROLOG;
    const int tid = otid();
    LAS unsigned* T = (LAS unsigned*)lds;
    const int I0 = 16 * 128, I1 = 20 * 16, I2 = 16 * 16, I3 = 16 * 32, I4 = 16 * 88, I5 = 44 * 16, I6 = 16 * 2;
    const int NIT = I0 + I1 + 3 * I2 + I3 + I4 + I5 + 2 * I6;
    for (int it = bi; it < NIT; it += nb) {
        int r = it;
        if (r < I0) { transpose_item(INL(10, (size_t)D * N_IN), D, N_IN, WSP(bf16_t, WS_W_IN), MAP_WIN, T, r, 128, tid); continue; } r -= I0;
        if (r < I1) { transpose_item(INL(26, (size_t)NBR * D), NBR, D, WSP(bf16_t, WS_W_BR), MAP_ID, T, r, 16, tid); continue; } r -= I1;
        if (r < I2) { transpose_item(INL(27, (size_t)D * D), D, D, WSP(bf16_t, WS_W_OUT), MAP_ID, T, r, 16, tid); continue; } r -= I2;
        if (r < I2) { transpose_item(INL(28, (size_t)D * D), D, D, WSP(bf16_t, WS_W_Q), MAP_ID, T, r, 16, tid); continue; } r -= I2;
        if (r < I2) { transpose_item(INL(30, (size_t)D * D), D, D, WSP(bf16_t, WS_W_O), MAP_ID, T, r, 16, tid); continue; } r -= I2;
        if (r < I3) { transpose_item(INL(29, (size_t)D * 2 * D), D, 2 * D, WSP(bf16_t, WS_W_KV), MAP_ID, T, r, 32, tid); continue; } r -= I3;
        if (r < I4) { transpose_item(INL(31, (size_t)D * FFN2), D, FFN2, WSP(bf16_t, WS_W_UP), MAP_UP, T, r, 88, tid); continue; } r -= I4;
        if (r < I5) { transpose_item(INL(34, (size_t)FFN * D), FFN, D, WSP(bf16_t, WS_W_DN), MAP_ID, T, r, 16, tid); continue; } r -= I5;
        if (r < I6) { transpose_item(INL(24, (size_t)2 * 2048 * 256), 2048, 256, WSP(bf16_t, WS_W_C1), MAP_ID, T, r, 2, tid); continue; } r -= I6;
        transpose_item(INL(24, (size_t)2 * 2048 * 256) + (size_t)2048 * 256, 2048, 256, WSP(bf16_t, WS_W_C1) + (size_t)256 * 2048, MAP_ID, T, r, 2, tid);
    }
    const int gt = bi * 512 + otid(), NT = nb * 512;
    bf16_t* wl = WSP(bf16_t, WS_W_LORA);
    const float* w2 = INL(14, 96 * 512); const float* a2 = INL(16, 96 * 512); const float* g2 = INL(17, 256 * 512);
    for (int i = gt; i < 1536 * 512; i += NT) { const int n = i >> 9, k = i & 511; float v = 0.f;
        if (n < 512) { if (k < 96) v = w2[k * 512 + n]; } else if (n < 1024) { if (k >= 128 && k < 224) v = a2[(k - 128) * 512 + (n - 512)]; } else { if (k >= 256) v = g2[(k - 256) * 512 + (n - 1024)]; }
        wl[i] = f2bf(v); }
    { float* cbp = WSP(float, WS_CBIAS) + 512; const int lane_ = tid & 63, gwv = bi * 8 + (tid >> 6), NGWV = nb * 8;
      for (int wt = gwv; wt < 128; wt += NGWV) { const int ks = wt & 15, ii = wt >> 6, n = ((wt >> 4) & 3) * 64 + lane_; const float* pos = INL(23, 2 * 32 * 64) + ii * 2048 + ks * 128; const float* w1 = INL(24, (size_t)2 * 2048 * 256) + (size_t)ii * 2048 * 256 + (size_t)ks * 128 * 256; float s0 = 0.f, s1 = 0.f, s2 = 0.f, s3 = 0.f;
          for (int k = 0; k < 128; k += 4) { s0 += pos[k] * w1[(size_t)k * 256 + n]; s1 += pos[k + 1] * w1[(size_t)(k + 1) * 256 + n]; s2 += pos[k + 2] * w1[(size_t)(k + 2) * 256 + n]; s3 += pos[k + 3] * w1[(size_t)(k + 3) * 256 + n]; }
          cbp[ks * 512 + ii * 256 + n] = (s0 + s1) + (s2 + s3); } }
    ph_norm_rows(inp(p, 1), INL(6, D), WSP(bf16_t, WS_MEMN), BATCH * MEM, bi, nb);
}

__device__ __forceinline__ float zf(const bf16_t* zr, int c) { return bf2f(zr[c]); }
__device__ __forceinline__ void ph_mix_prep(const Params& p, int l, int bi, int nb) {
    PROLOG;
    const int tid_ = otid(), lane = tid_ & 63, gw = bi * 8 + (tid_ >> 6), NGW = nb * 8;
    const bf16_t* z = WSP(bf16_t, WS_Z); bf16_t* oall = WSP(bf16_t, WS_OALL); bf16_t* alora = WSP(bf16_t, WS_ALORA);
    bf16_t* qr = WSP(bf16_t, WS_QR); bf16_t* kr = WSP(bf16_t, WS_KR); bf16_t* qn = WSP(bf16_t, WS_QN); bf16_t* kvg = WSP(bf16_t, WS_KVG);
    const float* scw = INL(11, 3 * 512); const float* mu = INL(12, 1984); const int* posi = (const int*)inp(p, 2);
    if (bi == 0) { float* cb = WSP(float, WS_CBIAS); float sacc = 0.f;
        for (int ks = 0; ks < 16; ++ks) sacc += cb[512 + ks * 512 + tid_]; cb[tid_] = sacc; }
    for (int m = gw; m < M; m += NGW) {
        const int b = m >> 12, t = m & 4095; const bf16_t* zr = z + (size_t)m * NZ; const bf16_t* z1 = zr - NZ; const bf16_t* z2 = zr - 2 * NZ;
        const float pos = (float)posi[m];
        for (int c = lane; c < 512; c += 64) {
            float s = scw[2 * 512 + c] * zf(zr, ZC_SC_C + c) * zf(zr, ZC_SC_X + c);
            if (t >= 1) s += scw[1 * 512 + c] * zf(z1, ZC_SC_C + c) * zf(z1, ZC_SC_X + c);
            if (t >= 2) s += scw[0 * 512 + c] * zf(z2, ZC_SC_C + c) * zf(z2, ZC_SC_X + c);
            oall[(size_t)m * NBR + c] = f2bf(zf(zr, ZC_SC_B + c) * s);
        }
        for (int c = lane; c < 512; c += 64) {
            int src = -1, kind = 0;
            if (c < 96) { src = ZC_RW_ZW + c; kind = 1; } else if (c >= 128 && c < 224) { src = ZC_RW_ZA + (c - 128); kind = 0; } else if (c >= 256) { src = ZC_RW_ZG + (c - 256); kind = 2; }
            float v = 0.f;
            if (src >= 0) { const float a = zf(zr, src), pv = t >= 1 ? zf(z1, src) : 0.f; v = a + (pv - a) * mu[src - ZC_RW]; v = kind == 1 ? tanhf(v) : (kind == 2 ? sigmoidf_(v) : v); }
            alora[(size_t)m * 512 + c] = f2bf(v);
        }
        for (int i = lane; i < 256; i += 64) { const int hh = i >> 6, ii = i & 63; const float inv = __expf(-(float)ii * (9.210340371976184f / 63.f)); float sn, cs; sincosf(pos * inv, &sn, &cs);
            const float q1 = zf(zr, ZC_RET_Q + hh * 128 + ii), q2 = zf(zr, ZC_RET_Q + hh * 128 + 64 + ii), k1 = zf(zr, ZC_RET_K + hh * 128 + ii), k2 = zf(zr, ZC_RET_K + hh * 128 + 64 + ii);
            const float ksc = 0.08838834764831845f;
            qr[(size_t)m * 512 + hh * 128 + ii] = f2bf(q1 * cs - q2 * sn); qr[(size_t)m * 512 + hh * 128 + 64 + ii] = f2bf(q2 * cs + q1 * sn);
            kr[(size_t)m * 512 + hh * 128 + ii] = f2bf((k1 * cs - k2 * sn) * ksc); kr[(size_t)m * 512 + hh * 128 + 64 + ii] = f2bf((k2 * cs + k1 * sn) * ksc); }
        for (int i = lane; i < 256; i += 64) { const int hh = i >> 5, ii = i & 31; const float inv = __expf(-(float)ii * (9.210340371976184f / 32.f)); float sn, cs; sincosf(pos * inv, &sn, &cs);
            const float q1 = zf(zr, ZC_NSA_Q + hh * 64 + ii), q2 = zf(zr, ZC_NSA_Q + hh * 64 + 32 + ii);
            qn[(size_t)m * 512 + hh * 64 + ii] = f2bf(q1 * cs - q2 * sn); qn[(size_t)m * 512 + hh * 64 + 32 + ii] = f2bf(q2 * cs + q1 * sn); }
        { const int g = lane >> 5, ii = lane & 31; const float inv = __expf(-(float)ii * (9.210340371976184f / 32.f)); float sn, cs; sincosf(pos * inv, &sn, &cs);
            const size_t rowo = ((size_t)(b * 2 + g) * SEQ + t) * 64;
            { const float k1 = zf(zr, ZC_NSA_KS + g * 64 + ii), k2 = zf(zr, ZC_NSA_KS + g * 64 + 32 + ii); kvg[2 * KVG_SLAB + rowo + ii] = f2bf(k1 * cs - k2 * sn); kvg[2 * KVG_SLAB + rowo + 32 + ii] = f2bf(k2 * cs + k1 * sn); }
            { const float k1 = zf(zr, ZC_NSA_KW + g * 64 + ii), k2 = zf(zr, ZC_NSA_KW + g * 64 + 32 + ii); kvg[4 * KVG_SLAB + rowo + ii] = f2bf(k1 * cs - k2 * sn); kvg[4 * KVG_SLAB + rowo + 32 + ii] = f2bf(k2 * cs + k1 * sn); } }
        for (int i = lane; i < 128; i += 64) { const int g = i >> 6, d = i & 63; const size_t rowo = ((size_t)(b * 2 + g) * SEQ + t) * 64; const size_t tro = ((size_t)(b * 2 + g) * 64 + d) * SEQ + t;
            kvg[0 * KVG_SLAB + rowo + d] = zr[ZC_NSA_KC + i]; kvg[1 * KVG_SLAB + rowo + d] = zr[ZC_NSA_VC + i];
            kvg[3 * KVG_SLAB + tro] = zr[ZC_NSA_VS + i]; kvg[5 * KVG_SLAB + tro] = zr[ZC_NSA_VW + i]; }
    }
}

__device__ __forceinline__ void bf8_to_f(const u32x4 w, float (&f)[8]) {
    f[0] = __uint_as_float(w.x << 16); f[1] = __uint_as_float(w.x & 0xffff0000u); f[2] = __uint_as_float(w.y << 16); f[3] = __uint_as_float(w.y & 0xffff0000u);
    f[4] = __uint_as_float(w.z << 16); f[5] = __uint_as_float(w.z & 0xffff0000u); f[6] = __uint_as_float(w.w << 16); f[7] = __uint_as_float(w.w & 0xffff0000u); }
__device__ __forceinline__ void ld8(const float* p, float (&f)[8]) { const f32x4 a = *(const f32x4*)p, b = *(const f32x4*)(p + 4); f[0] = a[0]; f[1] = a[1]; f[2] = a[2]; f[3] = a[3]; f[4] = b[0]; f[5] = b[1]; f[6] = b[2]; f[7] = b[3]; }
__device__ __forceinline__ void st8(float* p, const float (&f)[8]) { *(f32x4*)p = (f32x4){f[0], f[1], f[2], f[3]}; *(f32x4*)(p + 4) = (f32x4){f[4], f[5], f[6], f[7]}; }
__device__ __forceinline__ void ph_rw_prep2(const Params& p, int l, int bi, int nb) {
    PROLOG;
    const int tid_ = otid(), lane = tid_ & 63, gw = bi * 8 + (tid_ >> 6), NGW = nb * 8;
    const bf16_t* z = WSP(bf16_t, WS_Z); const float* lo = WSP(float, WS_LO); float* ops = WSP(float, WS_RWOPS);
    const float* mu = INL(12, 1984); constexpr size_t AS = (size_t)M * 512; const int c0 = 8 * lane;
    float mur[8], muk[8], muv[8], w0[8], a0[8], kkw[8], kaw[8];
    ld8(mu + c0, mur); ld8(mu + 512 + c0, muk); ld8(mu + 1024 + c0, muv); ld8(INL(13, 512) + c0, w0); ld8(INL(15, 512) + c0, a0); ld8(INL(18, 512) + c0, kkw); ld8(INL(19, 512) + c0, kaw);
    for (int m0 = gw; m0 < M; m0 += 2 * NGW) {
        u32x4 zc[2][3], zp[2][3]; float ld_[2][8], la_[2][8];
#pragma unroll
        for (int u = 0; u < 2; ++u) { const int m = m0 + u * NGW; if (m < M) { const bf16_t* zr = z + (size_t)m * NZ + ZC_RW_R + c0; const bool hp = (m & 4095) >= 1;
#pragma unroll
            for (int a = 0; a < 3; ++a) { zc[u][a] = *(const u32x4*)(zr + 512 * a); zp[u][a] = hp ? *(const u32x4*)(zr + 512 * a - NZ) : (u32x4){0u, 0u, 0u, 0u}; }
            ld8(lo + (size_t)m * 1536 + c0, ld_[u]); ld8(lo + (size_t)m * 1536 + 512 + c0, la_[u]); } }
#pragma unroll
        for (int u = 0; u < 2; ++u) { const int m = m0 + u * NGW; if (m < M) {
            float r[8], k[8], v[8], pr[8], pk[8], pv[8], w[8], kk[8], k2[8], bb[8];
            bf8_to_f(zc[u][0], r); bf8_to_f(zc[u][1], k); bf8_to_f(zc[u][2], v); bf8_to_f(zp[u][0], pr); bf8_to_f(zp[u][1], pk); bf8_to_f(zp[u][2], pv);
            float ss = 0.f;
#pragma unroll
            for (int j = 0; j < 8; ++j) { r[j] += (pr[j] - r[j]) * mur[j]; k[j] += (pk[j] - k[j]) * muk[j]; v[j] += (pv[j] - v[j]) * muv[j];
                w[j] = __expf(-0.6065306597126334f * sigmoidf_(w0[j] + ld_[u][j])); kk[j] = k[j] * kkw[j]; ss += kk[j] * kk[j]; }
            ss += __shfl_xor(ss, 1); ss += __shfl_xor(ss, 2); ss += __shfl_xor(ss, 4);
            const float rn = 1.f / fmaxf(sqrtf(ss), 1e-12f);
#pragma unroll
            for (int j = 0; j < 8; ++j) { const float a = sigmoidf_(a0[j] + la_[u][j]); kk[j] *= rn; k2[j] = k[j] * (1.f + (a - 1.f) * kaw[j]); bb[j] = kk[j] * a; }
            float* o = ops + (size_t)m * 512 + c0;
            st8(o, r); st8(o + AS, w); st8(o + 2 * AS, k2); st8(o + 3 * AS, v); st8(o + 4 * AS, kk); st8(o + 5 * AS, bb); } }
    }
}
#define DPP_ROR_ADD(x, n) (x) += __int_as_float(__builtin_amdgcn_update_dpp(0, __float_as_int(x), 0x120 + (n), 0xf, 0xf, false))
__device__ __forceinline__ float row_allreduce16(float x) { DPP_ROR_ADD(x, 8); DPP_ROR_ADD(x, 4); DPP_ROR_ADD(x, 2); DPP_ROR_ADD(x, 1); return x; }
__device__ __forceinline__ void ph_rw_scan(const Params& p, LAS unsigned char* lds, int bi, int nb) {
    PROLOG;
    const float* ops = WSP(float, WS_RWOPS); float* ys = WSP(float, WS_YSCAN); constexpr size_t AS = (size_t)M * 512; constexpr int TC = 32;
    LAS float* lop = (LAS float*)lds;
    LAS float* ybuf = (LAS float*)(lds + 6 * TC * 64 * 4);
    const int tid = otid(), wave = tid >> 6, lane = tid & 63, Rg = wave * 4 + (lane >> 4), Pc = lane & 15;
    for (int task = bi; task < 16; task += nb) {
        const int b = task >> 3, hh = task & 7;
        float s[4][4];
#pragma unroll
        for (int i = 0; i < 4; ++i)
#pragma unroll
            for (int j = 0; j < 4; ++j) s[i][j] = 0.f;
        for (int t0 = 0; t0 < SEQ; t0 += TC) {
            for (int idx = tid; idx < 6 * TC * 16; idx += 512) { const int arr = idx / (TC * 16), rem = idx % (TC * 16), tt = rem >> 4, c4 = rem & 15;
                *(LAS f32x4*)(lop + (arr * TC + tt) * 64 + c4 * 4) = *(const f32x4*)(ops + arr * AS + (size_t)(b * SEQ + t0 + tt) * 512 + hh * 64 + c4 * 4); }
            __syncthreads();
            if (wave < 4) {
                for (int tt = 0; tt < TC; ++tt) {
                    const f32x4 r4 = *(const LAS f32x4*)(lop + (0 * TC + tt) * 64 + Pc * 4), w4 = *(const LAS f32x4*)(lop + (1 * TC + tt) * 64 + Pc * 4), k4 = *(const LAS f32x4*)(lop + (2 * TC + tt) * 64 + Pc * 4);
                    const f32x4 v4 = *(const LAS f32x4*)(lop + (3 * TC + tt) * 64 + Rg * 4), kk4 = *(const LAS f32x4*)(lop + (4 * TC + tt) * 64 + Pc * 4), b4 = *(const LAS f32x4*)(lop + (5 * TC + tt) * 64 + Pc * 4);
                    float sa[4];
#pragma unroll
                    for (int i = 0; i < 4; ++i) { float x = -(s[i][0] * kk4[0] + s[i][1] * kk4[1] + s[i][2] * kk4[2] + s[i][3] * kk4[3]); sa[i] = row_allreduce16(x); }
                    float y[4];
#pragma unroll
                    for (int i = 0; i < 4; ++i) { float acc = 0.f;
#pragma unroll
                        for (int j = 0; j < 4; ++j) { s[i][j] = s[i][j] * w4[j] + sa[i] * b4[j] + v4[i] * k4[j]; acc += s[i][j] * r4[j]; }
                        y[i] = row_allreduce16(acc); }
                    if (Pc == 0) *(LAS f32x4*)(ybuf + tt * 64 + Rg * 4) = (f32x4){y[0], y[1], y[2], y[3]};
                }
            }
            __syncthreads();
            { const int tt = tid >> 4, c4 = tid & 15; *(f32x4*)(ys + (size_t)(b * SEQ + t0 + tt) * 512 + hh * 64 + c4 * 4) = *(const LAS f32x4*)(ybuf + tt * 64 + c4 * 4); }
        }
        __syncthreads();
    }
}

typedef short bf16x8s __attribute__((ext_vector_type(8)));
__device__ __forceinline__ bf16x8 zfrag() { return (bf16x8){0, 0, 0, 0, 0, 0, 0, 0}; }
__device__ __forceinline__ bf16x8 pack8(f32x4 a, f32x4 b) { u32x4 w; w.x = cvt_pk_bf16(a[0], a[1]); w.y = cvt_pk_bf16(a[2], a[3]); w.z = cvt_pk_bf16(b[0], b[1]); w.w = cvt_pk_bf16(b[2], b[3]); return __builtin_bit_cast(bf16x8, w); }
__device__ __forceinline__ void ph_rw_chunk(const Params& p, LAS unsigned char* lds, int bi, int nb) {
    PROLOG;
    const float* ops = WSP(float, WS_RWOPS); constexpr size_t AS = (size_t)M * 512;
    unsigned char* PFg = WSP(unsigned char, WS_RW_PF); unsigned char* QFg = WSP(unsigned char, WS_RW_QF); unsigned char* RFg = WSP(unsigned char, WS_RW_RF); unsigned char* Y0g = WSP(unsigned char, WS_RW_Y0F);
    const int tid = otid(), wave = tid >> 6, lane = tid & 63, r = lane & 15, q = lane >> 4;
    if (wave >= 4) return;
    LAS unsigned char* L = lds + wave * 30720;
    LAS bf16_t* BE = (LAS bf16_t*)(L);
    LAS bf16_t* KA = (LAS bf16_t*)(L + 2048);
    LAS bf16_t* AL = (LAS bf16_t*)(L + 4096);
    LAS bf16_t* RHO = (LAS bf16_t*)(L + 6144);
    LAS bf16_t* ALT = (LAS bf16_t*)(L + 8192);
    LAS bf16_t* BEPT = (LAS bf16_t*)(L + 10240);
    LAS bf16_t* KAPT = (LAS bf16_t*)(L + 12288);
    LAS bf16_t* VT = (LAS bf16_t*)(L + 14336);
    LAS bf16_t* RHOT = (LAS bf16_t*)(L + 16384);
    LAS bf16_t* OM = (LAS bf16_t*)(L + 18432);
    LAS bf16_t* VBm = (LAS bf16_t*)(L + 20480);
    LAS bf16_t* MU = (LAS bf16_t*)(L + 22528);
    LAS float* Af = (LAS float*)(L + 24576);
    LAS bf16_t* NT = (LAS bf16_t*)(L + 25600);
    LAS bf16_t* BmT = (LAS bf16_t*)(L + 26112);
    LAS bf16_t* CbT = (LAS bf16_t*)(L + 26624);
    LAS bf16_t* CkT = (LAS bf16_t*)(L + 27136);
    LAS float* GT = (LAS float*)(L + 27648);
    const int gw = bi * 4 + wave, NGW = nb * 4;
    for (int task = gw; task < 4096; task += NGW) {
        const int bh = task >> 8, n = task & 255, b = bh >> 3, hh = bh & 7; const size_t i0 = ((size_t)b * SEQ + 16 * n) * 512 + hh * 64 + lane;
        { float g = 1.f; float be[16], ka[16];
#pragma unroll
          for (int t = 0; t < 16; ++t) { const size_t ix = i0 + (size_t)t * 512;
              const float rr = ops[ix], ww = ops[AS + ix], k2 = ops[2 * AS + ix], vv = ops[3 * AS + ix], kk = ops[4 * AS + ix], bb = ops[5 * AS + ix];
              const float gprev = g; g *= ww; const float al = gprev * kk, rg = 1.f / g; be[t] = bb * rg; ka[t] = k2 * rg; const float rho = g * rr;
              BE[t * 64 + lane] = f2bf(be[t]); KA[t * 64 + lane] = f2bf(ka[t]); AL[t * 64 + lane] = f2bf(al); RHO[t * 64 + lane] = f2bf(rho);
              ALT[lane * 16 + t] = f2bf(al); VT[lane * 16 + t] = f2bf(vv); RHOT[lane * 16 + t] = f2bf(rho); }
          GT[lane] = g;
#pragma unroll
          for (int t = 0; t < 16; ++t) { BEPT[lane * 16 + t] = f2bf(be[t] * g); KAPT[lane * 16 + t] = f2bf(ka[t] * g); } }
        asm volatile("s_waitcnt lgkmcnt(0)" ::: "memory");
        { bf16x8 xb[2], xk[2], ya[2], yr[2];
#pragma unroll
          for (int ks = 0; ks < 2; ++ks) { xb[ks] = *(const LAS bf16x8*)(BE + r * 64 + 32 * ks + 8 * q); xk[ks] = *(const LAS bf16x8*)(KA + r * 64 + 32 * ks + 8 * q);
              ya[ks] = *(const LAS bf16x8*)(AL + r * 64 + 32 * ks + 8 * q); yr[ks] = *(const LAS bf16x8*)(RHO + r * 64 + 32 * ks + 8 * q); }
          f32x4 A = {0.f, 0.f, 0.f, 0.f}, Bm = A, Cb = A, Ck = A;
#pragma unroll
          for (int ks = 0; ks < 2; ++ks) { A = mma16(A, xb[ks], ya[ks]); Bm = mma16(Bm, xk[ks], ya[ks]); Cb = mma16(Cb, xb[ks], yr[ks]); Ck = mma16(Ck, xk[ks], yr[ks]); }
#pragma unroll
          for (int jj = 0; jj < 4; ++jj) { const int c = 4 * q + jj; const bool lt = r < c, le = r <= c;
              A[jj] = lt ? A[jj] : 0.f; BmT[c * 16 + r] = f2bf(lt ? Bm[jj] : 0.f); CbT[c * 16 + r] = f2bf(le ? Cb[jj] : 0.f); CkT[c * 16 + r] = f2bf(le ? Ck[jj] : 0.f); }
          *(LAS f32x4*)(Af + r * 16 + 4 * q) = A; }
        asm volatile("s_waitcnt lgkmcnt(0)" ::: "memory");
        { float nrow[16];
#pragma unroll
          for (int i = 0; i < 16; ++i) { float sacc = (i == r) ? 1.f : 0.f;
#pragma unroll
              for (int j = 0; j < i; ++j) sacc -= nrow[j] * Af[j * 16 + i];
              nrow[i] = sacc; }
          if (q == 0) {
#pragma unroll
              for (int i = 0; i < 16; ++i) NT[i * 16 + r] = f2bf(nrow[i]); } }
        asm volatile("s_waitcnt lgkmcnt(0)" ::: "memory");
        const bool lo = q < 2; const int q2 = q & 1;
        { const bf16x8 bN = lo ? *(const LAS bf16x8*)(NT + r * 16 + 8 * q2) : zfrag(); const bf16x8 bB = lo ? *(const LAS bf16x8*)(BmT + r * 16 + 8 * q2) : zfrag();
#pragma unroll
          for (int mt = 0; mt < 4; ++mt) { const int row = 16 * mt + r;
              const bf16x8 aA = lo ? *(const LAS bf16x8*)(ALT + row * 16 + 8 * q2) : zfrag(); const bf16x8 aV = lo ? *(const LAS bf16x8*)(VT + row * 16 + 8 * q2) : zfrag();
              f32x4 om = mma16((f32x4){0.f, 0.f, 0.f, 0.f}, aA, bN), vb = mma16((f32x4){0.f, 0.f, 0.f, 0.f}, aV, bB);
              u32x2 w; w.x = cvt_pk_bf16(-om[0], -om[1]); w.y = cvt_pk_bf16(-om[2], -om[3]); *(LAS u32x2*)(OM + row * 16 + 4 * q) = w;
              w.x = cvt_pk_bf16(vb[0], vb[1]); w.y = cvt_pk_bf16(vb[2], vb[3]); *(LAS u32x2*)(VBm + row * 16 + 4 * q) = w; }
          asm volatile("s_waitcnt lgkmcnt(0)" ::: "memory");
#pragma unroll
          for (int mt = 0; mt < 4; ++mt) { const int row = 16 * mt + r; const bf16x8 aB = lo ? *(const LAS bf16x8*)(VBm + row * 16 + 8 * q2) : zfrag();
              f32x4 mu = mma16((f32x4){0.f, 0.f, 0.f, 0.f}, aB, bN);
              u32x2 w; w.x = cvt_pk_bf16(-mu[0], -mu[1]); w.y = cvt_pk_bf16(-mu[2], -mu[3]); *(LAS u32x2*)(MU + row * 16 + 4 * q) = w; } }
        asm volatile("s_waitcnt lgkmcnt(0)" ::: "memory");
        const size_t rec = (size_t)bh * 256 + n;
        { bf16x8 bO[4];
#pragma unroll
          for (int nt = 0; nt < 4; ++nt) bO[nt] = lo ? *(const LAS bf16x8*)(OM + (16 * nt + r) * 16 + 8 * q2) : zfrag();
#pragma unroll
          for (int mt = 0; mt < 4; ++mt) { const bf16x8 a = lo ? *(const LAS bf16x8*)(BEPT + (16 * mt + r) * 16 + 8 * q2) : zfrag(); f32x4 acc[4];
#pragma unroll
              for (int nt = 0; nt < 4; ++nt) acc[nt] = mma16((f32x4){0.f, 0.f, 0.f, 0.f}, a, bO[nt]);
              { const float gd = GT[16 * mt + r];
#pragma unroll
                for (int jj = 0; jj < 4; ++jj) if (4 * q + jj == r) acc[mt][jj] += gd; }
#pragma unroll
              for (int ks = 0; ks < 2; ++ks) *(bf16x8*)(PFg + rec * 8192 + (size_t)((mt * 2 + ks) * 64 + lane) * 16) = pack8(acc[2 * ks], acc[2 * ks + 1]); }
          { bf16x8 a; if (lo) a = *(const LAS bf16x8*)(CbT + r * 16 + 8 * q2); else { a = zfrag();
#pragma unroll
                for (int e = 0; e < 8; ++e) if (8 * q2 + e == r) a[e] = (short)0x3f80; }
            f32x4 acc[4];
#pragma unroll
            for (int nt = 0; nt < 4; ++nt) { const bf16x8 bb = lo ? bO[nt] : *(const LAS bf16x8*)(RHOT + (16 * nt + r) * 16 + 8 * q2); acc[nt] = mma16((f32x4){0.f, 0.f, 0.f, 0.f}, a, bb); }
#pragma unroll
            for (int ks = 0; ks < 2; ++ks) *(bf16x8*)(RFg + rec * 2048 + (size_t)(ks * 64 + lane) * 16) = pack8(acc[2 * ks], acc[2 * ks + 1]); } }
        { bf16x8 bQ[4];
#pragma unroll
          for (int nt = 0; nt < 4; ++nt) bQ[nt] = *(const LAS bf16x8*)((lo ? BEPT : KAPT) + (16 * nt + r) * 16 + 8 * q2);
          const bf16x8 bY = *(const LAS bf16x8*)((lo ? CbT : CkT) + r * 16 + 8 * q2);
#pragma unroll
          for (int mt = 0; mt < 4; ++mt) { const bf16x8 a = *(const LAS bf16x8*)((lo ? MU : VT) + (16 * mt + r) * 16 + 8 * q2);
#pragma unroll
              for (int nt = 0; nt < 4; ++nt) { const f32x4 acc = mma16((f32x4){0.f, 0.f, 0.f, 0.f}, a, bQ[nt]); *(f32x4*)(QFg + rec * 16384 + (size_t)((mt * 4 + nt) * 64 + lane) * 16) = acc; }
              const f32x4 y0 = mma16((f32x4){0.f, 0.f, 0.f, 0.f}, a, bY); *(f32x4*)(Y0g + rec * 4096 + (size_t)(mt * 64 + lane) * 16) = y0; } }
        asm volatile("s_waitcnt lgkmcnt(0)" ::: "memory");
    }
}
__device__ __forceinline__ void ph_rw_serial(const Params& p, LAS unsigned char* lds, int bi, int nb) {
    PROLOG;
    constexpr int NS = 8, DD = 6, SLOT = 16384;
    const unsigned char* PFg = WSP(unsigned char, WS_RW_PF); const unsigned char* QFg = WSP(unsigned char, WS_RW_QF); const unsigned char* RFg = WSP(unsigned char, WS_RW_RF); const unsigned char* Y0g = WSP(unsigned char, WS_RW_Y0F);
    float* ys = WSP(float, WS_YSCAN);
    const int tid = otid(), wave = __builtin_amdgcn_readfirstlane(tid >> 6), lane = tid & 63, l15 = lane & 15, q = lane >> 4;
    for (int task = bi; task < 64; task += nb) {
        const int bh = task >> 2, w = task & 3, b = bh >> 3, hh = bh & 7;
        const unsigned char* gp[3]; size_t gs[3];
#pragma unroll
        for (int k = 0; k < 3; ++k) { const int pc = 3 * (wave - 1) + k;
            if (pc < 8) { gp[k] = PFg + (size_t)bh * 256 * 8192 + pc * 1024; gs[k] = 8192; }
            else if (pc < 12) { gp[k] = QFg + (size_t)bh * 256 * 16384 + w * 4096 + (pc - 8) * 1024; gs[k] = 16384; }
            else if (pc < 14) { gp[k] = RFg + (size_t)bh * 256 * 2048 + (pc - 12) * 1024; gs[k] = 2048; }
            else { gp[k] = Y0g + (size_t)bh * 256 * 4096 + w * 1024; gs[k] = 4096; } }
        const bool loader = wave >= 1 && wave <= 5; const int pofs = 3 * (wave - 1) * 1024;
#define RW_ISSUE(step) do { const int c_ = (step) < 256 ? (step) : 255; LAS unsigned char* sl_ = lds + ((step) % NS) * SLOT + pofs; \
        __builtin_amdgcn_global_load_lds((const unsigned*)(gp[0] + (size_t)c_ * gs[0] + lane * 16), (LAS unsigned*)(sl_), 16, 0, 0); \
        __builtin_amdgcn_global_load_lds((const unsigned*)(gp[1] + (size_t)c_ * gs[1] + lane * 16), (LAS unsigned*)(sl_ + 1024), 16, 0, 0); \
        __builtin_amdgcn_global_load_lds((const unsigned*)(gp[2] + (size_t)c_ * gs[2] + lane * 16), (LAS unsigned*)(sl_ + 2048), 16, 0, 0); \
        asm volatile("" ::: "memory"); } while (0)
        do { asm volatile("" ::: "memory"); __builtin_amdgcn_s_barrier(); asm volatile("" ::: "memory"); } while (0);
        if (loader) { for (int s0 = 0; s0 < DD; ++s0) RW_ISSUE(s0);
            asm volatile("s_waitcnt vmcnt(15)" ::: "memory"); }
        do { asm volatile("" ::: "memory"); __builtin_amdgcn_s_barrier(); asm volatile("" ::: "memory"); } while (0);
        f32x4 S[4];
#pragma unroll
        for (int mt = 0; mt < 4; ++mt) S[mt] = (f32x4){0.f, 0.f, 0.f, 0.f};
        for (int n = 0; n < 256; ++n) {
            if (loader) { RW_ISSUE(n + DD); asm volatile("s_waitcnt vmcnt(15)" ::: "memory"); }
            else if (wave == 0) {
                const LAS unsigned char* sl = lds + (n % NS) * SLOT;
                bf16x8 sf[2]; sf[0] = pack8(S[0], S[1]); sf[1] = pack8(S[2], S[3]);
                f32x4 y = *(const LAS f32x4*)(sl + 14336 + lane * 16);
#pragma unroll
                for (int ks = 0; ks < 2; ++ks) y = __builtin_amdgcn_mfma_f32_16x16x32_bf16(*(const LAS bf16x8*)(sl + 12288 + (ks * 64 + lane) * 16), sf[ks], y, 0, 0, 0);
#pragma unroll
                for (int mt = 0; mt < 4; ++mt) { f32x4 a = *(const LAS f32x4*)(sl + 8192 + (mt * 64 + lane) * 16);
#pragma unroll
                    for (int ks = 0; ks < 2; ++ks) a = __builtin_amdgcn_mfma_f32_16x16x32_bf16(*(const LAS bf16x8*)(sl + ((mt * 2 + ks) * 64 + lane) * 16), sf[ks], a, 0, 0, 0);
                    S[mt] = a; }
                float* yo = ys + ((size_t)b * SEQ + 16 * n + 4 * q) * 512 + hh * 64 + 16 * w + l15;
#pragma unroll
                for (int jj = 0; jj < 4; ++jj) yo[(size_t)jj * 512] = y[jj];
                asm volatile("s_waitcnt lgkmcnt(0)" ::: "memory");
            }
            do { asm volatile("" ::: "memory"); __builtin_amdgcn_s_barrier(); asm volatile("" ::: "memory"); } while (0);
        }
        asm volatile("s_waitcnt vmcnt(0)" ::: "memory");
        do { asm volatile("" ::: "memory"); __builtin_amdgcn_s_barrier(); asm volatile("" ::: "memory"); } while (0);
#undef RW_ISSUE
    }
}

__device__ __forceinline__ void ph_rw_post(const Params& p, int l, int bi, int nb) {
    PROLOG;
    const int tid_ = otid(), lane = tid_ & 63, gw = bi * 8 + (tid_ >> 6), NGW = nb * 8;
    const float* ops = WSP(float, WS_RWOPS); const float* ys = WSP(float, WS_YSCAN); const float* lo = WSP(float, WS_LO); bf16_t* oall = WSP(bf16_t, WS_OALL);
    constexpr size_t AS = (size_t)M * 512; const int c0 = 8 * lane;
    float rk[8], lg[8], lb[8]; ld8(INL(20, 512) + c0, rk); ld8(INL(21, 512) + c0, lg); ld8(INL(22, 512) + c0, lb);
    for (int m0 = gw; m0 < M; m0 += 2 * NGW) {
        float y[2][8], r[2][8], k2[2][8], v[2][8], g[2][8];
#pragma unroll
        for (int u = 0; u < 2; ++u) { const int m = m0 + u * NGW; if (m < M) { const size_t o = (size_t)m * 512 + c0;
            ld8(ys + o, y[u]); ld8(ops + o, r[u]); ld8(ops + 2 * AS + o, k2[u]); ld8(ops + 3 * AS + o, v[u]); ld8(lo + (size_t)m * 1536 + 1024 + c0, g[u]); } }
#pragma unroll
        for (int u = 0; u < 2; ++u) { const int m = m0 + u * NGW; if (m < M) {
            float s1 = 0.f, sb = 0.f;
#pragma unroll
            for (int j = 0; j < 8; ++j) { s1 += y[u][j]; sb += r[u][j] * k2[u][j] * rk[j]; }
            s1 += __shfl_xor(s1, 1); s1 += __shfl_xor(s1, 2); s1 += __shfl_xor(s1, 4); sb += __shfl_xor(sb, 1); sb += __shfl_xor(sb, 2); sb += __shfl_xor(sb, 4);
            const float mean = s1 * (1.f / 64.f); float s2 = 0.f;
#pragma unroll
            for (int j = 0; j < 8; ++j) { y[u][j] -= mean; s2 += y[u][j] * y[u][j]; }
            s2 += __shfl_xor(s2, 1); s2 += __shfl_xor(s2, 2); s2 += __shfl_xor(s2, 4);
            const float rstd = rsqrtf(s2 * (1.f / 64.f) + 64e-5f); float o8[8];
#pragma unroll
            for (int j = 0; j < 8; ++j) o8[j] = (y[u][j] * rstd * lg[j] + lb[j] + sb * v[u][j]) * g[u][j];
            u32x4 w; w.x = cvt_pk_bf16(o8[0], o8[1]); w.y = cvt_pk_bf16(o8[2], o8[3]); w.z = cvt_pk_bf16(o8[4], o8[5]); w.w = cvt_pk_bf16(o8[6], o8[7]);
            *(u32x4*)(oall + (size_t)m * NBR + 512 + c0) = w; } }
    }
}

__device__ __forceinline__ float ret_lg(int hh) { return logf(1.f - exp2f(-5.f - (float)hh)); }
__device__ __forceinline__ void ph_ret_u(const Params& p, LAS unsigned char* lds, int bi, int nb) {
    PROLOG;
    const bf16_t* z = WSP(bf16_t, WS_Z); const bf16_t* kr = WSP(bf16_t, WS_KR); float* ub = WSP(float, WS_UBUF);
    LAS bf16_t* Vt = (LAS bf16_t*)lds;
    LAS bf16_t* Kt = (LAS bf16_t*)(lds + 256 * 136 * 2);
    const int tid = otid(), wave = tid >> 6, lane = tid & 63, r = lane & 15, q = lane >> 4;
    for (int task = bi; task < 256; task += nb) {
        const int b = task >> 7, hh = (task >> 5) & 3, n = task & 31; const float lgh = ret_lg(hh); const size_t m0 = (size_t)b * SEQ + n * 128;
        __syncthreads();
        for (int idx = tid; idx < 128 * 32; idx += 512) { const int mm = idx & 127, ch = idx >> 7; const u32x4 w = *(const u32x4*)(z + (m0 + mm) * NZ + ZC_RET_V + hh * 256 + ch * 8);
            const unsigned ww[4] = {w.x, w.y, w.z, w.w};
#pragma unroll
            for (int i = 0; i < 4; ++i) { Vt[(ch * 8 + 2 * i) * 136 + mm] = (bf16_t)(ww[i] & 0xffffu); Vt[(ch * 8 + 2 * i + 1) * 136 + mm] = (bf16_t)(ww[i] >> 16); } }
        for (int idx = tid; idx < 128 * 16; idx += 512) { const int mm = idx & 127, ch = idx >> 7; const float zeta = __expf((float)(127 - mm) * lgh);
            const u32x4 w = *(const u32x4*)(kr + (m0 + mm) * 512 + hh * 128 + ch * 8); const unsigned ww[4] = {w.x, w.y, w.z, w.w};
#pragma unroll
            for (int i = 0; i < 4; ++i) { Kt[(ch * 8 + 2 * i) * 136 + mm] = f2bf(__uint_as_float(ww[i] << 16) * zeta); Kt[(ch * 8 + 2 * i + 1) * 136 + mm] = f2bf(__uint_as_float(ww[i] & 0xffff0000u) * zeta); } }
        __syncthreads();
        float* uo = ub + (size_t)task * 256 * 128;
#pragma unroll
        for (int et = 0; et < 2; ++et) { const int e0 = 16 * (2 * wave + et); bf16x8 a[4];
#pragma unroll
            for (int ks = 0; ks < 4; ++ks) a[ks] = *(const LAS bf16x8*)(Vt + (e0 + r) * 136 + 32 * ks + 8 * q);
#pragma unroll
            for (int dt = 0; dt < 8; ++dt) { f32x4 acc = {0.f, 0.f, 0.f, 0.f};
#pragma unroll
                for (int ks = 0; ks < 4; ++ks) { const bf16x8 bb = *(const LAS bf16x8*)(Kt + (16 * dt + r) * 136 + 32 * ks + 8 * q); acc = mma16(acc, a[ks], bb); }
                *(f32x4*)(uo + (size_t)(e0 + r) * 128 + 16 * dt + 4 * q) = acc; } }
    }
}
__device__ __forceinline__ void ph_ret_scan(const Params& p, int bi, int nb) {
    PROLOG;
    const float* ub = WSP(float, WS_UBUF); bf16_t* rp = WSP(bf16_t, WS_RPREV);
    const int gt = bi * 512 + otid(), NT = nb * 512;
    for (int i = gt; i < 8 * 8192; i += NT) { const int bh = i >> 13, e4 = i & 8191, hh = bh & 3; const float cd = __expf(128.f * ret_lg(hh)); f32x4 st = {0.f, 0.f, 0.f, 0.f};
        for (int n0 = 0; n0 < 32; n0 += 8) { f32x4 uu[8];
#pragma unroll
            for (int k = 0; k < 8; ++k) uu[k] = *(const f32x4*)(ub + ((size_t)(bh * 32 + n0 + k) * 8192 + e4) * 4);
#pragma unroll
            for (int k = 0; k < 8; ++k) { u32x2 w; w.x = cvt_pk_bf16(st[0], st[1]); w.y = cvt_pk_bf16(st[2], st[3]); *(u32x2*)(rp + ((size_t)(bh * 32 + n0 + k) * 8192 + e4) * 4) = w; st = st * cd + uu[k]; } } }
}
__device__ __forceinline__ void ph_ret_out(const Params& p, LAS unsigned char* lds, int bi, int nb) {
    PROLOG;
    const bf16_t* z = WSP(bf16_t, WS_Z); const bf16_t* qr = WSP(bf16_t, WS_QR); const bf16_t* kr = WSP(bf16_t, WS_KR); const bf16_t* rp = WSP(bf16_t, WS_RPREV); bf16_t* oall = WSP(bf16_t, WS_OALL);
    LAS bf16_t* Vt = (LAS bf16_t*)lds;
    const int tid = otid(), wave = tid >> 6, lane = tid & 63, r = lane & 15, q = lane >> 4;
    LAS bf16_t* Sc = (LAS bf16_t*)(lds + 256 * 136 * 2) + wave * 16 * 136;
    for (int task = bi; task < 256; task += nb) {
        const int b = task >> 7, hh = (task >> 5) & 3, n = task & 31; const float lgh = ret_lg(hh); const size_t m0 = (size_t)b * SEQ + n * 128;
        __syncthreads();
        for (int idx = tid; idx < 128 * 32; idx += 512) { const int mm = idx & 127, ch = idx >> 7; const u32x4 w = *(const u32x4*)(z + (m0 + mm) * NZ + ZC_RET_V + hh * 256 + ch * 8);
            const unsigned ww[4] = {w.x, w.y, w.z, w.w};
#pragma unroll
            for (int i = 0; i < 4; ++i) { Vt[(ch * 8 + 2 * i) * 136 + mm] = (bf16_t)(ww[i] & 0xffffu); Vt[(ch * 8 + 2 * i + 1) * 136 + mm] = (bf16_t)(ww[i] >> 16); } }
        __syncthreads();
        const int c = 16 * wave + r; const size_t mrow = m0 + c;
        bf16x8 qa[4];
#pragma unroll
        for (int ks = 0; ks < 4; ++ks) qa[ks] = ldfrag(qr + mrow * 512 + hh * 128 + 32 * ks + 8 * q);
#pragma unroll
        for (int mt = 0; mt < 8; ++mt) { f32x4 s = {0.f, 0.f, 0.f, 0.f};
#pragma unroll
            for (int ks = 0; ks < 4; ++ks) s = mma16(s, qa[ks], ldfrag(kr + (m0 + 16 * mt + r) * 512 + hh * 128 + 32 * ks + 8 * q));
            float v[4];
#pragma unroll
            for (int j = 0; j < 4; ++j) { const int mm = 16 * mt + 4 * q + j; v[j] = (c >= mm) ? s[j] * __expf((float)(c - mm) * lgh) : 0.f; }
            u32x2 w; w.x = cvt_pk_bf16(v[0], v[1]); w.y = cvt_pk_bf16(v[2], v[3]); *(LAS u32x2*)(Sc + r * 136 + 16 * mt + 4 * q) = w; }
        asm volatile("s_waitcnt lgkmcnt(0)" ::: "memory");
        const float xi = __expf((float)(c + 1) * lgh);
        const bf16_t* rpc = rp + (size_t)task * 256 * 128;
        f32x4 acc[16]; bf16x8 sa[4];
#pragma unroll
        for (int ks = 0; ks < 4; ++ks) sa[ks] = *(const LAS bf16x8*)(Sc + r * 136 + 32 * ks + 8 * q);
#pragma unroll
        for (int et = 0; et < 16; ++et) { f32x4 a = {0.f, 0.f, 0.f, 0.f};
#pragma unroll
            for (int ks = 0; ks < 4; ++ks) a = mma16(a, qa[ks], ldfrag(rpc + (size_t)(16 * et + r) * 128 + 32 * ks + 8 * q));
            a = a * xi;
#pragma unroll
            for (int ks = 0; ks < 4; ++ks) a = mma16(a, sa[ks], *(const LAS bf16x8*)(Vt + (16 * et + r) * 136 + 32 * ks + 8 * q));
            acc[et] = a; }
        float s1 = 0.f;
#pragma unroll
        for (int et = 0; et < 16; ++et) s1 += acc[et][0] + acc[et][1] + acc[et][2] + acc[et][3];
        s1 += __shfl_xor(s1, 16); s1 += __shfl_xor(s1, 32); const float mean = s1 * (1.f / 256.f); float s2 = 0.f;
#pragma unroll
        for (int et = 0; et < 16; ++et) { acc[et] = acc[et] - mean; s2 += acc[et][0] * acc[et][0] + acc[et][1] * acc[et][1] + acc[et][2] * acc[et][2] + acc[et][3] * acc[et][3]; }
        s2 += __shfl_xor(s2, 16); s2 += __shfl_xor(s2, 32); const float rstd = rsqrtf(s2 * (1.f / 256.f) + 1e-5f);
#pragma unroll
        for (int et = 0; et < 16; ++et) { const int e = 16 * et + 4 * q; const u32x2 gw = *(const u32x2*)(z + mrow * NZ + ZC_RET_G + hh * 256 + e);
            const float g0 = __uint_as_float(gw.x << 16), g1 = __uint_as_float(gw.x & 0xffff0000u), g2 = __uint_as_float(gw.y << 16), g3 = __uint_as_float(gw.y & 0xffff0000u);
            u32x2 w; w.x = cvt_pk_bf16(acc[et][0] * rstd * g0 * sigmoidf_(g0), acc[et][1] * rstd * g1 * sigmoidf_(g1)); w.y = cvt_pk_bf16(acc[et][2] * rstd * g2 * sigmoidf_(g2), acc[et][3] * rstd * g3 * sigmoidf_(g3));
            *(u32x2*)(oall + mrow * NBR + 1024 + hh * 256 + e) = w; }
    }
}

__device__ __forceinline__ void ph_cmp2(const Params& p, int l, LAS unsigned char* lds, int bi, int nb) {
    PROLOG;
    const bf16_t* hid = WSP(bf16_t, WS_HID); bf16_t* kc = WSP(bf16_t, WS_KCMP); bf16_t* vt = WSP(bf16_t, WS_VCMPT); const int* posi = (const int*)inp(p, 2);
    const float* w2 = INL(25, 2 * 256 * 64);
    const int tid = otid(), wave = tid >> 6, lane = tid & 63, r = lane & 15, q = lane >> 4;
    LAS bf16_t* W2T = (LAS bf16_t*)lds;
    if (bi * 8 < 128) {
        for (int i = tid; i < 2 * 256 * 64; i += 512) { const int ii = i >> 14, k = (i >> 6) & 255, d = i & 63; W2T[(ii * 64 + d) * 264 + k] = f2bf(w2[i]); }
        __syncthreads();
        for (int task = bi * 8 + wave; task < 128; task += nb * 8) {
            const int ii = task >> 6, R0 = (task & 63) * 16, row = R0 + r, bg = row >> 8, c = row & 255;
            const bf16_t* hr = hid + ((size_t)ii * 1024 + row) * 256 + 8 * q;
            f32x4 acc[4];
#pragma unroll
            for (int dt = 0; dt < 4; ++dt) acc[dt] = (f32x4){0.f, 0.f, 0.f, 0.f};
#pragma unroll
            for (int ks = 0; ks < 8; ++ks) { const bf16x8 a = ldfrag(hr + 32 * ks);
#pragma unroll
                for (int dt = 0; dt < 4; ++dt) acc[dt] = mma16(acc[dt], a, *(const LAS bf16x8*)(W2T + (ii * 64 + 16 * dt + r) * 264 + 32 * ks + 8 * q)); }
            if (ii == 0) {
                const float pos = (float)posi[(bg >> 1) * SEQ + 16 * (c < 255 ? c : 254) + 31];
#pragma unroll
                for (int dt = 0; dt < 2; ++dt) { float o1[4], o2[4];
#pragma unroll
                    for (int jj = 0; jj < 4; ++jj) { const int d = 16 * dt + 4 * q + jj; const float inv = __expf(-(float)d * (9.210340371976184f / 32.f)); float sn, cs; sincosf(pos * inv, &sn, &cs);
                        const float x1 = acc[dt][jj], x2 = acc[dt + 2][jj]; o1[jj] = (c < 255) ? x1 * cs - x2 * sn : 0.f; o2[jj] = (c < 255) ? x2 * cs + x1 * sn : 0.f; }
                    u32x2 w; w.x = cvt_pk_bf16(o1[0], o1[1]); w.y = cvt_pk_bf16(o1[2], o1[3]); *(u32x2*)(kc + (size_t)row * 64 + 16 * dt + 4 * q) = w;
                    w.x = cvt_pk_bf16(o2[0], o2[1]); w.y = cvt_pk_bf16(o2[2], o2[3]); *(u32x2*)(kc + (size_t)row * 64 + 32 + 16 * dt + 4 * q) = w; }
            } else {
#pragma unroll
                for (int dt = 0; dt < 4; ++dt)
#pragma unroll
                    for (int jj = 0; jj < 4; ++jj) vt[((size_t)bg * 64 + 16 * dt + 4 * q + jj) * 256 + c] = f2bf(c < 255 ? acc[dt][jj] : 0.f);
            }
        }
    }
}
__device__ __forceinline__ void ph_nsa_cmp(const Params& p, LAS unsigned char* lds, int bi, int nb) {
    PROLOG;
    const bf16_t* qn = WSP(bf16_t, WS_QN); const bf16_t* kc = WSP(bf16_t, WS_KCMP); const bf16_t* vt = WSP(bf16_t, WS_VCMPT); bf16_t* ocmp = WSP(bf16_t, WS_OCMP); u64* selm = WSP(u64, WS_SELM);
    const int tid = otid(), wave = tid >> 6, lane = tid & 63, r = lane & 15, q = lane >> 4, gw = bi * 8 + wave, NGW = nb * 8;
    LAS bf16_t* Pl = (LAS bf16_t*)(lds + wave * 16384);
    LAS float* Il = (LAS float*)(lds + wave * 16384 + 16 * 264 * 2);
    for (int task = gw; task < 1024; task += NGW) {
        const int bg = task >> 8, b = bg >> 1, g = bg & 1, tt = task & 255, t0 = 16 * tt, t = t0 + r; const size_t mrow = (size_t)b * SEQ + t;
        const int cmax = t >= 31 ? (t - 31) >> 4 : -1;
#pragma unroll
        for (int ct = 0; ct < 16; ++ct) Il[r * 64 + 4 * ct + q] = 0.f;
        for (int hh = 0; hh < 4; ++hh) {
            const int hd = (g * 4 + hh) * 64;
            bf16x8 qa[2]; qa[0] = ldfrag(qn + mrow * 512 + hd + 8 * q); qa[1] = ldfrag(qn + mrow * 512 + hd + 32 + 8 * q);
            f32x4 s[16]; float mx = -1e30f;
#pragma unroll
            for (int ct = 0; ct < 16; ++ct) { f32x4 a = {0.f, 0.f, 0.f, 0.f}; const bf16_t* kp = kc + ((size_t)bg * 256 + 16 * ct + r) * 64 + 8 * q;
                a = mma16(a, qa[0], ldfrag(kp)); a = mma16(a, qa[1], ldfrag(kp + 32));
#pragma unroll
                for (int j = 0; j < 4; ++j) { const int c = 16 * ct + 4 * q + j; a[j] = (c <= cmax) ? a[j] * 0.125f : -1e30f; mx = fmaxf(mx, a[j]); }
                s[ct] = a; }
            mx = fmaxf(mx, __shfl_xor(mx, 16)); mx = fmaxf(mx, __shfl_xor(mx, 32));
            float sum = 0.f;
#pragma unroll
            for (int ct = 0; ct < 16; ++ct)
#pragma unroll
                for (int j = 0; j < 4; ++j) { const int c = 16 * ct + 4 * q + j; const float e = (c <= cmax) ? __expf(s[ct][j] - mx) : 0.f; s[ct][j] = e; sum += e; }
            sum += __shfl_xor(sum, 16); sum += __shfl_xor(sum, 32);
            const float rinv = 1.f / fmaxf(sum, 1e-30f);
            float yprev = 0.f;
#pragma unroll
            for (int ct = 0; ct < 16; ++ct) { s[ct] = s[ct] * rinv;
                const float y = __shfl(s[ct][3], (lane + 48) & 63);
                const float prev = q > 0 ? y : yprev; yprev = y;
                Il[r * 64 + 4 * ct + q] += (s[ct][0] + s[ct][1]) + (s[ct][2] + s[ct][3]) + prev;
                u32x2 w; w.x = cvt_pk_bf16(s[ct][0], s[ct][1]); w.y = cvt_pk_bf16(s[ct][2], s[ct][3]); *(LAS u32x2*)(Pl + r * 264 + 16 * ct + 4 * q) = w; }
            asm volatile("s_waitcnt lgkmcnt(0)" ::: "memory");
            f32x4 o[4];
#pragma unroll
            for (int dt = 0; dt < 4; ++dt) o[dt] = (f32x4){0.f, 0.f, 0.f, 0.f};
#pragma unroll
            for (int ks = 0; ks < 8; ++ks) { const bf16x8 pa = *(const LAS bf16x8*)(Pl + r * 264 + 32 * ks + 8 * q);
#pragma unroll
                for (int dt = 0; dt < 4; ++dt) o[dt] = mma16(o[dt], pa, ldfrag(vt + ((size_t)bg * 64 + 16 * dt + r) * 256 + 32 * ks + 8 * q)); }
#pragma unroll
            for (int dt = 0; dt < 4; ++dt) { u32x2 w; w.x = cvt_pk_bf16(o[dt][0], o[dt][1]); w.y = cvt_pk_bf16(o[dt][2], o[dt][3]); *(u32x2*)(ocmp + mrow * 512 + hd + 16 * dt + 4 * q) = w; }
        }
        asm volatile("s_waitcnt lgkmcnt(0)" ::: "memory");
        for (int rr = 0; rr < 16; ++rr) {
            const int tq = t0 + rr, cur = tq >> 6; const float v = Il[rr * 64 + lane];
            const bool valid = lane <= cur; const bool forced = (lane == 0) || (lane == cur) || (lane == cur - 1);
            const float key = forced ? __builtin_inff() : v; int rank = 0;
            for (int i = 0; i <= cur; ++i) { const float ki = __int_as_float(__builtin_amdgcn_readlane(__float_as_int(key), i)); rank += (ki > key || (ki == key && i < lane)) ? 1 : 0; }
            const u64 msk = __ballot(valid && rank < 16);
            if (lane == 0) selm[(size_t)bg * SEQ + tq] = msk;
        }
        asm volatile("s_waitcnt lgkmcnt(0)" ::: "memory");
    }
}
__device__ __forceinline__ void ph_nsa_attn(const Params& p, LAS unsigned char* lds, int bi, int nb) {
    PROLOG;
    const bf16_t* z = WSP(bf16_t, WS_Z); const bf16_t* qn = WSP(bf16_t, WS_QN); const bf16_t* kvg = WSP(bf16_t, WS_KVG); const bf16_t* ocmp = WSP(bf16_t, WS_OCMP); const u64* selm = WSP(u64, WS_SELM); bf16_t* oall = WSP(bf16_t, WS_OALL);
    const int tid = otid(), wave = tid >> 6, lane = tid & 63, r = lane & 15, q = lane >> 4, gw = bi * 8 + wave, NGW = nb * 8;
    LAS bf16_t* Pl = (LAS bf16_t*)(lds + wave * 4096);
    for (int task = gw; task < 4096; task += NGW) {
        int tt, sub; if (task < 2048) { tt = 255 - (task >> 4); sub = task & 15; } else { tt = (task - 2048) >> 4; sub = task & 15; }
        const int bg = sub >> 2, hh = sub & 3, b = bg >> 1, g = bg & 1, t0 = 16 * tt, t = t0 + r, cur = t0 >> 6; const size_t mrow = (size_t)b * SEQ + t;
        const int hd = (g * 4 + hh) * 64;
        bf16x8 qa[2]; qa[0] = ldfrag(qn + mrow * 512 + hd + 8 * q); qa[1] = ldfrag(qn + mrow * 512 + hd + 32 + 8 * q);
        const u64 mymask = selm[(size_t)bg * SEQ + t];
        unsigned mlo = (unsigned)mymask, mhi = (unsigned)(mymask >> 32);
#pragma unroll
        for (int o = 1; o < 16; o <<= 1) { mlo |= __shfl_xor(mlo, o); mhi |= __shfl_xor(mhi, o); }
        const u64 umask = ((u64)__builtin_amdgcn_readfirstlane(mhi) << 32) | (u64)__builtin_amdgcn_readfirstlane(mlo);
        f32x4 res[4];
#pragma unroll
        for (int br = 0; br < 2; ++br) {
            const bf16_t* Kb = kvg + (br == 0 ? 2 : 4) * KVG_SLAB + (size_t)bg * SEQ * 64;
            const bf16_t* Vtb = kvg + (br == 0 ? 3 : 5) * KVG_SLAB + (size_t)bg * 64 * SEQ;
            const int j0 = br == 0 ? 0 : ((t0 >= 511) ? ((t0 - 511) >> 6) : 0);
            float mrun = -1e30f, lrun = 0.f; f32x4 o[4];
#pragma unroll
            for (int dt = 0; dt < 4; ++dt) o[dt] = (f32x4){0.f, 0.f, 0.f, 0.f};
            for (int j = j0; j <= cur; ++j) {
                if (br == 0 && !((umask >> j) & 1ull)) continue;
                const int k0 = 64 * j; const bool rowsel = br == 0 ? (((mymask >> j) & 1ull) != 0) : true;
                f32x4 s[4]; float mx = -1e30f;
#pragma unroll
                for (int ct = 0; ct < 4; ++ct) { f32x4 a = {0.f, 0.f, 0.f, 0.f}; const bf16_t* kp = Kb + (size_t)(k0 + 16 * ct + r) * 64 + 8 * q;
                    a = mma16(a, qa[0], ldfrag(kp)); a = mma16(a, qa[1], ldfrag(kp + 32));
#pragma unroll
                    for (int jj = 0; jj < 4; ++jj) { const int key = k0 + 16 * ct + 4 * q + jj; const bool ok = rowsel && key <= t && (br == 0 || t - key < 512); a[jj] = ok ? a[jj] * 0.125f : -1e30f; mx = fmaxf(mx, a[jj]); }
                    s[ct] = a; }
                mx = fmaxf(mx, __shfl_xor(mx, 16)); mx = fmaxf(mx, __shfl_xor(mx, 32));
                const float mnew = fmaxf(mrun, mx), alpha = __expf(mrun - mnew); float sum = 0.f;
#pragma unroll
                for (int ct = 0; ct < 4; ++ct) {
#pragma unroll
                    for (int jj = 0; jj < 4; ++jj) { const float e = (s[ct][jj] > -1e29f) ? __expf(s[ct][jj] - mnew) : 0.f; s[ct][jj] = e; sum += e; }
                    u32x2 w; w.x = cvt_pk_bf16(s[ct][0], s[ct][1]); w.y = cvt_pk_bf16(s[ct][2], s[ct][3]); *(LAS u32x2*)(Pl + r * 72 + 16 * ct + 4 * q) = w; }
                sum += __shfl_xor(sum, 16); sum += __shfl_xor(sum, 32);
                lrun = lrun * alpha + sum; mrun = mnew;
                asm volatile("s_waitcnt lgkmcnt(0)" ::: "memory");
                const bf16x8 pa0 = *(const LAS bf16x8*)(Pl + r * 72 + 8 * q), pa1 = *(const LAS bf16x8*)(Pl + r * 72 + 32 + 8 * q);
#pragma unroll
                for (int dt = 0; dt < 4; ++dt) { const bf16_t* vp = Vtb + (size_t)(16 * dt + r) * SEQ + k0 + 8 * q; f32x4 a = o[dt] * alpha; a = mma16(a, pa0, ldfrag(vp)); a = mma16(a, pa1, ldfrag(vp + 32)); o[dt] = a; }
                asm volatile("s_waitcnt lgkmcnt(0)" ::: "memory");
            }
            const float rinv = 1.f / fmaxf(lrun, 1e-30f);
            const float gt = sigmoidf_(zf(z + mrow * NZ, ZC_NSA_GT + (g * 4 + hh) * 3 + 1 + br));
#pragma unroll
            for (int dt = 0; dt < 4; ++dt) { if (br == 0) res[dt] = o[dt] * (rinv * gt); else res[dt] += o[dt] * (rinv * gt); }
        }
        const float g0 = sigmoidf_(zf(z + mrow * NZ, ZC_NSA_GT + (g * 4 + hh) * 3));
#pragma unroll
        for (int dt = 0; dt < 4; ++dt) { const u32x2 cw = *(const u32x2*)(ocmp + mrow * 512 + hd + 16 * dt + 4 * q);
            const float c0 = __uint_as_float(cw.x << 16), c1 = __uint_as_float(cw.x & 0xffff0000u), c2 = __uint_as_float(cw.y << 16), c3 = __uint_as_float(cw.y & 0xffff0000u);
            u32x2 w; w.x = cvt_pk_bf16(res[dt][0] + g0 * c0, res[dt][1] + g0 * c1); w.y = cvt_pk_bf16(res[dt][2] + g0 * c2, res[dt][3] + g0 * c3);
            *(u32x2*)(oall + mrow * NBR + 2048 + hd + 16 * dt + 4 * q) = w; }
    }
}

__device__ __forceinline__ void ph_xsoftmax(const Params& p, int bi, int nb) {
    PROLOG;
    const float* sc = WSP(float, WS_SC); bf16_t* pb = WSP(bf16_t, WS_PB);
    const int tid_ = otid(), lane = tid_ & 63, gw = bi * 8 + (tid_ >> 6), NGW = nb * 8;
    for (int it = gw; it < M * 4; it += NGW) { const f32x4 v = *(const f32x4*)(sc + (size_t)it * 256 + lane * 4);
        float mx = fmaxf(fmaxf(v[0], v[1]), fmaxf(v[2], v[3]));
#pragma unroll
        for (int o = 1; o < 64; o <<= 1) mx = fmaxf(mx, __shfl_xor(mx, o));
        const float e0 = __expf(v[0] - mx), e1 = __expf(v[1] - mx), e2 = __expf(v[2] - mx), e3 = __expf(v[3] - mx);
        const float rinv = 1.f / wave_sum((e0 + e1) + (e2 + e3));
        u32x2 w; w.x = cvt_pk_bf16(e0 * rinv, e1 * rinv); w.y = cvt_pk_bf16(e2 * rinv, e3 * rinv); *(u32x2*)(pb + (size_t)it * 256 + lane * 4) = w; }
}
__device__ __forceinline__ void ph_convact(const Params& p, int l, int bi, int nb) {
    PROLOG;
    const bf16_t* u = WSP(bf16_t, WS_U); bf16_t* ga = WSP(bf16_t, WS_GACT); const float* cw = INL(32, 3 * FFN2); const float* cb = INL(33, FFN2);
    const int gt = bi * 512 + otid(), NT = nb * 512;
    for (int i = gt; i < (M / 16) * (FFN / 8); i += NT) { const int rb = i / (FFN / 8), c8 = (i % (FFN / 8)) * 8, m0 = rb * 16, t0 = m0 & 4095; const int ua = 256 * (c8 >> 7) + (c8 & 127);
        float wa[3][8], wb[3][8], ba[8], bb[8];
#pragma unroll
        for (int k = 0; k < 3; ++k) { ld8(cw + k * FFN2 + c8, wa[k]); ld8(cw + k * FFN2 + FFN + c8, wb[k]); }
        ld8(cb + c8, ba); ld8(cb + FFN + c8, bb);
        float a1[8], a2[8], b1[8], b2[8];
        if (t0 >= 2) { bf8_to_f(*(const u32x4*)(u + (size_t)(m0 - 1) * FFN2 + ua), a1); bf8_to_f(*(const u32x4*)(u + (size_t)(m0 - 2) * FFN2 + ua), a2);
            bf8_to_f(*(const u32x4*)(u + (size_t)(m0 - 1) * FFN2 + ua + 128), b1); bf8_to_f(*(const u32x4*)(u + (size_t)(m0 - 2) * FFN2 + ua + 128), b2); }
        else {
#pragma unroll
            for (int j = 0; j < 8; ++j) { a1[j] = 0.f; a2[j] = 0.f; b1[j] = 0.f; b2[j] = 0.f; } }
#pragma unroll 4
        for (int rr = 0; rr < 16; ++rr) { float a0[8], b0[8]; const bf16_t* ur = u + (size_t)(m0 + rr) * FFN2 + ua; bf8_to_f(*(const u32x4*)ur, a0); bf8_to_f(*(const u32x4*)(ur + 128), b0);
            float o8[8];
#pragma unroll
            for (int j = 0; j < 8; ++j) { const float va = ba[j] + wa[0][j] * a2[j] + wa[1][j] * a1[j] + wa[2][j] * a0[j], vb = bb[j] + wb[0][j] * b2[j] + wb[1][j] * b1[j] + wb[2][j] * b0[j];
                o8[j] = gelu_tanh(va) * vb; a2[j] = a1[j]; a1[j] = a0[j]; b2[j] = b1[j]; b1[j] = b0[j]; }
            u32x4 w; w.x = cvt_pk_bf16(o8[0], o8[1]); w.y = cvt_pk_bf16(o8[2], o8[3]); w.z = cvt_pk_bf16(o8[4], o8[5]); w.w = cvt_pk_bf16(o8[6], o8[7]);
            *(u32x4*)(ga + (size_t)(m0 + rr) * FFN + c8) = w; }
    }
}


#define XB_TMO      128
#define XB_XCNT(j)  (256  + 64 * (j))
#define XB_XSUB(j)  (1280 + 64 * (j))
#define XB_XGEN(j)  (2304 + 64 * (j))
#define XB_TOP      3328
#define XB_TOPGEN   3392
#define XCD_BAR_WORDS 3456
#define XB_SPIN_CAP (1u << 18)
__device__ __forceinline__ unsigned xb_ld(unsigned* p)              { return __hip_atomic_load(p, __ATOMIC_RELAXED, __HIP_MEMORY_SCOPE_AGENT); }
__device__ __forceinline__ unsigned xb_add(unsigned* p, unsigned v) { return __hip_atomic_fetch_add(p, v, __ATOMIC_RELAXED, __HIP_MEMORY_SCOPE_AGENT); }
__device__ __forceinline__ unsigned xb_xcc_id() { return (unsigned)__builtin_amdgcn_s_getreg((3 << 11) | 20) & 0xFu; }
#define XB_SPIN(cond, bar) do { unsigned _sp = 0; while (cond) { __builtin_amdgcn_s_sleep(1); \
    if ((++_sp & 255u) == 0u) { if (xb_ld(&(bar)[XB_TMO])) break; if (_sp > XB_SPIN_CAP) { atomicAdd(&(bar)[XB_TMO], 1u); break; } } } } while (0)
struct XcdBarrier { unsigned* bar; unsigned x; volatile LAS unsigned* st; };
__device__ __forceinline__ XcdBarrier xcd_barrier_post(unsigned* bar, volatile LAS unsigned* st) {
    XcdBarrier b; b.bar = bar; b.x = xb_xcc_id(); b.st = st;
    if (threadIdx.x == 0) (void)xb_add(&bar[XB_XCNT(b.x)], 1u);
    return b;
}
__device__ __forceinline__ void xcd_barrier_complete(unsigned* bar, unsigned x, unsigned& nloc, unsigned& nx) {
    const unsigned G = gridDim.x * gridDim.y * gridDim.z;
    unsigned sum, cnt, mine, sp = 0u;
    for (;;) {
        sum = 0u; cnt = 0u; mine = 0u;
#pragma unroll
        for (unsigned j = 0; j < 16; ++j) { const unsigned c = xb_ld(&bar[XB_XCNT(j)]); sum += c; cnt += (c > 0u) ? 1u : 0u; mine = (j == x) ? c : mine; }
        if (sum == G) break;
        __builtin_amdgcn_s_sleep(1);
        if ((++sp & 255u) == 0u) { if (xb_ld(&bar[XB_TMO])) break; if (sp > XB_SPIN_CAP) { atomicAdd(&bar[XB_TMO], 1u); break; } }
    }
    nloc = mine > 0u ? mine : 1u; nx = cnt > 0u ? cnt : 1u;
}
__device__ __forceinline__ void xcd_barrier(const XcdBarrier& b) {
    asm volatile("s_waitcnt vmcnt(0)" ::: "memory");
    __syncthreads();
    if (threadIdx.x == 0) {
        unsigned* bar = (unsigned*)(ws_lds() + WS_CTL) + 1024;
        __builtin_amdgcn_s_waitcnt(0);
        unsigned nloc = b.st[0], nx = b.st[1];
        if (nloc == 0u) { xcd_barrier_complete(bar, b.x, nloc, nx); b.st[0] = nloc; b.st[1] = nx; }
        const unsigned old = xb_add(&bar[XB_XSUB(b.x)], 1u);
        const unsigned gen = old / nloc;
        if (old + 1u == (gen + 1u) * nloc) {
            __builtin_amdgcn_fence(__ATOMIC_RELEASE, "agent");
            asm volatile("s_waitcnt vmcnt(0)" ::: "memory");
            const unsigned og = xb_add(&bar[XB_TOP], 1u);
            const unsigned tg = og / nx;
            if (og + 1u == (tg + 1u) * nx) xb_add(&bar[XB_TOPGEN], 1u);
            else XB_SPIN(xb_ld(&bar[XB_TOPGEN]) == tg, bar);
            __builtin_amdgcn_fence(__ATOMIC_ACQUIRE, "agent");
            xb_add(&bar[XB_XGEN(b.x)], 1u);
            asm volatile("s_waitcnt vmcnt(0)" ::: "memory");
        } else {
            XB_SPIN(xb_ld(&bar[XB_XGEN(b.x)]) == gen, bar);
            __builtin_amdgcn_fence(__ATOMIC_ACQUIRE, "agent");
            asm volatile("s_waitcnt vmcnt(0)" ::: "memory");
        }
    }
    __syncthreads();
}

enum { PH_CONVERT = 0, PH_MEMKV, PH_NORM1, PH_INPROJ, PH_MIXPREP, PH_LORA_CMP1, PH_RWPREP2_CMP2_RETU, PH_RWCHUNK, PH_RWSERIAL, PH_RETSCAN, PH_NSACMP, PH_RWPOST_RETOUT, PH_NSAATTN,
       PH_BRANCH, PH_OUTPROJ, PH_FINISH1, PH_QPROJ, PH_XSCORE, PH_XSOFTMAX, PH_XPV, PH_XO, PH_FINISH2, PH_UP, PH_CONVACT, PH_DOWN, PH_FINISH3, PH_COUNT };

template <int PH> __device__ __forceinline__ void run_phase(const Params& p, int l, LAS unsigned char* lds, int bi, int nb) {
    using namespace pg8;
    PROLOG;
    if constexpr (PH == PH_CONVERT) ph_convert(p, l, lds, bi, nb);
    else if constexpr (PH == PH_MEMKV) {
        { GSched s = make_sched(WSP(bf16_t, WS_MEMN), D, WSP(bf16_t, WS_W_KV), D, 2, 8, D, bi, nb); EpiBf16<0> e{WSP(bf16_t, WS_KMEM), D, nullptr}; gemm_phase(lds, D, D, D, s, e); }
        { GSched s = make_sched(WSP(bf16_t, WS_W_KV) + (size_t)D * D, D, WSP(bf16_t, WS_MEMN), D, 8, 2, 512, bi, nb); EpiBf16<0> e{WSP(bf16_t, WS_VTM), 512, nullptr}; gemm_phase(lds, D, D, D, s, e); }
    }
    else if constexpr (PH == PH_NORM1) ph_norm_rows(l == 0 ? inp(p, 0) : (const float*)OUTP, INL(3, D), WSP(bf16_t, WS_H), M, bi, nb);
    else if constexpr (PH == PH_INPROJ) { GSched s = make_sched(WSP(bf16_t, WS_H), D, WSP(bf16_t, WS_W_IN), D, 32, 64, NZ, bi, nb); EpiBf16<0> e{WSP(bf16_t, WS_Z), NZ, nullptr}; gemm_phase(lds, D, D, D, s, e); }
    else if constexpr (PH == PH_MIXPREP) ph_mix_prep(p, l, bi, nb);
    else if constexpr (PH == PH_LORA_CMP1) {
        { GSched s = make_sched(WSP(bf16_t, WS_ALORA), 512, WSP(bf16_t, WS_W_LORA), 512, 32, 6, 1536, bi, nb); EpiF32 e{WSP(float, WS_LO), 1536, 1.f}; gemm_phase(lds, 512, 512, 512, s, e); }
        { GSched s = make_sched(WSP(bf16_t, WS_KVG), 1024, WSP(bf16_t, WS_W_C1), 2048, 1, 1, 256, bi, nb); s.nZ1 = 2; s.nZ2 = 4; s.a_z1 = (long)KVG_SLAB * 2; s.a_z2 = (long)SEQ * 64 * 2; s.b_z1 = (long)256 * 2048 * 2; s.b_z2 = 0;
          s.o_z1 = 4 * 256 * 256; s.o_z2 = 256 * 256;
          EpiC1 e{WSP(bf16_t, WS_HID), WSP(float, WS_CBIAS)}; gemm_phase(lds, 1024, 2048, 2048, s, e); }
    }
    else if constexpr (PH == PH_RWPREP2_CMP2_RETU) { ph_rw_prep2(p, l, bi, nb); ph_cmp2(p, l, lds, bi, nb); ph_ret_u(p, lds, bi, nb); }
    else if constexpr (PH == PH_RWCHUNK) ph_rw_chunk(p, lds, bi, nb);
    else if constexpr (PH == PH_RWSERIAL) ph_rw_serial(p, lds, bi, nb);
    else if constexpr (PH == PH_RETSCAN) ph_ret_scan(p, bi, nb);
    else if constexpr (PH == PH_NSACMP) ph_nsa_cmp(p, lds, bi, nb);
    else if constexpr (PH == PH_RWPOST_RETOUT) { ph_rw_post(p, l, bi, nb); ph_ret_out(p, lds, bi, nb); }
    else if constexpr (PH == PH_NSAATTN) ph_nsa_attn(p, lds, bi, nb);
    else if constexpr (PH == PH_BRANCH) {
        const int koff[4] = {0, 512, 1024, 2048}, kk[4] = {512, 512, 1024, 512};
#pragma unroll
        for (int br = 0; br < 4; ++br) { GSched s = make_sched(WSP(bf16_t, WS_OALL) + koff[br], NBR, WSP(bf16_t, WS_W_BR) + koff[br], NBR, 32, 8, D, bi, nb);
            EpiBranch e{WSP(float, WS_MERGED), WSP(bf16_t, WS_MERGEDB), WSP(bf16_t, WS_Z) + ZC_GATE + br * D, br == 0, br == 3}; gemm_phase(lds, NBR, NBR, kk[br], s, e); }
    }
    else if constexpr (PH == PH_OUTPROJ) { GSched s = make_sched(WSP(bf16_t, WS_MERGEDB), D, WSP(bf16_t, WS_W_OUT), D, 32, 8, D, bi, nb); EpiF32 e{WSP(float, WS_Y), D, 1.f}; gemm_phase(lds, D, D, D, s, e); }
    else if constexpr (PH == PH_FINISH1) ph_finish(l == 0 ? inp(p, 0) : (const float*)OUTP, WSP(float, WS_Y), INL(4, D), INL(5, D), OUTP, WSP(bf16_t, WS_H), bi, nb);
    else if constexpr (PH == PH_QPROJ) { GSched s = make_sched(WSP(bf16_t, WS_H), D, WSP(bf16_t, WS_W_Q), D, 32, 8, D, bi, nb); EpiBf16<0> e{WSP(bf16_t, WS_QX), D, nullptr}; gemm_phase(lds, D, D, D, s, e); }
    else if constexpr (PH == PH_XSCORE) {
        GSched s = make_sched(WSP(bf16_t, WS_QX), D, WSP(bf16_t, WS_KMEM), D, 16, 1, 1024, bi, nb); s.nZ1 = 2; s.nZ2 = 4; s.a_z1 = (long)SEQ * D * 2; s.a_z2 = 512 * 2; s.b_z1 = (long)MEM * D * 2; s.b_z2 = 512 * 2; s.o_z1 = (long)SEQ * 1024; s.o_z2 = 256;
        EpiF32 e{WSP(float, WS_SC), 1024, 0.04419417382415922f}; gemm_phase(lds, D, D, 512, s, e); }
    else if constexpr (PH == PH_XSOFTMAX) ph_xsoftmax(p, bi, nb);
    else if constexpr (PH == PH_XPV) {
        GSched s = make_sched(WSP(bf16_t, WS_PB), 1024, WSP(bf16_t, WS_VTM), 512, 16, 2, D, bi, nb); s.nZ1 = 2; s.nZ2 = 4; s.a_z1 = (long)SEQ * 1024 * 2; s.a_z2 = 256 * 2; s.b_z1 = 256 * 2; s.b_z2 = (long)512 * 512 * 2; s.o_z1 = (long)SEQ * D; s.o_z2 = 512;
        EpiBf16<0> e{WSP(bf16_t, WS_OX), D, nullptr}; gemm_phase(lds, 1024, 512, 256, s, e); }
    else if constexpr (PH == PH_XO) { GSched s = make_sched(WSP(bf16_t, WS_OX), D, WSP(bf16_t, WS_W_O), D, 32, 8, D, bi, nb); EpiF32 e{WSP(float, WS_Y), D, 1.f}; gemm_phase(lds, D, D, D, s, e); }
    else if constexpr (PH == PH_FINISH2) ph_finish(OUTP, WSP(float, WS_Y), INL(7, D), INL(8, D), OUTP, WSP(bf16_t, WS_H), bi, nb);
    else if constexpr (PH == PH_UP) { GSched s = make_sched(WSP(bf16_t, WS_H), D, WSP(bf16_t, WS_W_UP), D, 32, 44, FFN2, bi, nb); EpiBf16<0> e{WSP(bf16_t, WS_U), FFN2, nullptr}; gemm_phase(lds, D, D, D, s, e); }
    else if constexpr (PH == PH_CONVACT) ph_convact(p, l, bi, nb);
    else if constexpr (PH == PH_DOWN) { GSched s = make_sched(WSP(bf16_t, WS_GACT), FFN, WSP(bf16_t, WS_W_DN), FFN, 32, 8, D, bi, nb); EpiF32 e{WSP(float, WS_Y), D, 1.f}; gemm_phase(lds, FFN, FFN, FFN, s, e); }
    else if constexpr (PH == PH_FINISH3) ph_finish(OUTP, WSP(float, WS_Y), INL(9, D), (l + 1 < DEPTH) ? (inp(p, 3) + (size_t)(l + 1) * D) : nullptr, OUTP, WSP(bf16_t, WS_H), bi, nb);
}

__global__ void __launch_bounds__(512, 2) mega_fwd(Params p) {
    extern __shared__ __attribute__((aligned(16))) unsigned char lds_raw[];
    LAS unsigned char* lds = (LAS unsigned char*)lds_raw;
    volatile LAS unsigned* st = (volatile LAS unsigned*)(lds + LDS_BYTES - 16);
    if (threadIdx.x == 0) { st[0] = 0u; st[1] = 0u; st[2] = (unsigned)(u64)p.ws; st[3] = (unsigned)((u64)p.ws >> 32); }
    __syncthreads();
    if (threadIdx.x == 0) { const float** tab = (const float**)(p.ws + WS_PTRTAB);
#pragma unroll
        for (int i = 0; i < 35; ++i) tab[i] = p.in[i];
        tab[35] = p.out; }
    __syncthreads();
    XcdBarrier bar = xcd_barrier_post((unsigned*)(p.ws + WS_CTL) + 1024, st);
    const int bi = (int)blockIdx.x, nb = (int)gridDim.x;
#define PHASE(PH) do { int l_ = l, bi_ = bi; asm volatile("" : "+s"(l_), "+s"(bi_)); run_phase<PH>(p, l_, lds, bi_, nb); xcd_barrier(bar); } while (0)
    for (int l = 0; l < DEPTH; ++l) {
        PHASE(PH_CONVERT);
#if DUP == 5
        PHASE(PH_CONVERT);
#endif
        PHASE(PH_MEMKV);
        if (l == 0) PHASE(PH_NORM1);
        PHASE(PH_INPROJ);
        PHASE(PH_MIXPREP);
#if DUP == 3
        PHASE(PH_MIXPREP);
#endif
        PHASE(PH_LORA_CMP1);
        PHASE(PH_RWPREP2_CMP2_RETU);
        PHASE(PH_RWCHUNK);
        PHASE(PH_RWSERIAL);
        PHASE(PH_RETSCAN);
        PHASE(PH_NSACMP);
        PHASE(PH_RWPOST_RETOUT);
        PHASE(PH_NSAATTN);
#if DUP == 2
        PHASE(PH_NSAATTN);
#endif
        PHASE(PH_BRANCH);
        PHASE(PH_OUTPROJ);
        PHASE(PH_FINISH1);
        PHASE(PH_QPROJ);
        PHASE(PH_XSCORE);
        PHASE(PH_XSOFTMAX);
        PHASE(PH_XPV);
        PHASE(PH_XO);
        PHASE(PH_FINISH2);
        PHASE(PH_UP);
        PHASE(PH_CONVACT);
#if DUP == 4
        PHASE(PH_CONVACT);
#endif
        PHASE(PH_DOWN);
        PHASE(PH_FINISH3);
    }
#undef PHASE
}

extern "C" void kernel_launch(void* const* d_in, const int* in_sizes, int n_in, void* d_out, int out_size, void* d_ws, size_t ws_size, hipStream_t stream) {
    if (n_in != 35 || ws_size < WS_END) { fprintf(stderr, "kernel_launch: unexpected n_in %d / ws_size %zu (need %zu)\n", n_in, ws_size, (size_t)WS_END); return; }
    static int grid = 0;
    if (grid == 0) {
        int dev = 0, cus = 0, per_cu = 0;
        (void)hipGetDevice(&dev); (void)hipDeviceGetAttribute(&cus, hipDeviceAttributeMultiprocessorCount, dev);
        (void)hipFuncSetAttribute((const void*)mega_fwd, hipFuncAttributeMaxDynamicSharedMemorySize, LDS_BYTES);
        if (hipOccupancyMaxActiveBlocksPerMultiprocessor(&per_cu, (const void*)mega_fwd, 512, LDS_BYTES) != hipSuccess || per_cu < 1) fprintf(stderr, "kernel_launch: occupancy query says %d blocks per CU\n", per_cu);
        (void)hipGetLastError();
        grid = cus > 0 ? cus : 256;
    }
    (void)hipMemsetAsync((char*)d_ws + WS_CTL, 0, 1 * MiB, stream);
    Params p; memset(&p, 0, sizeof(p));
    for (int i = 0; i < 35; ++i) p.in[i] = (const float*)d_in[i];
    p.out = (float*)d_out; p.ws = (unsigned char*)d_ws;
    hipLaunchKernelGGL(mega_fwd, dim3(grid), dim3(512), LDS_BYTES, stream, p);
}
```

```cpp
#include <hip/hip_runtime.h>
#ifndef DUP
#define DUP 0
#endif
#include <cstdio>
#include <cstdint>
#include <cstring>

#define LAS __attribute__((address_space(3)))
typedef unsigned short bf16_t;
typedef short bf16x8 __attribute__((ext_vector_type(8)));
typedef float f32x4 __attribute__((ext_vector_type(4)));
typedef float f32x2 __attribute__((ext_vector_type(2)));
typedef unsigned u32x4 __attribute__((ext_vector_type(4)));
typedef unsigned u32x2 __attribute__((ext_vector_type(2)));
typedef unsigned long long u64;

constexpr int D = 2048, BATCH = 2, SEQ = 4096, M = BATCH * SEQ, DEPTH = 2;
constexpr int NZC = 16384;
constexpr int NZ = 16384 + 128;
constexpr int N_IN = 16088;
constexpr int ZC_SC_B = 0, ZC_SC_C = 512, ZC_SC_X = 1024;
constexpr int ZC_RW = 1536;
constexpr int ZC_RW_R = 1536, ZC_RW_K = 2048, ZC_RW_V = 2560, ZC_RW_ZW = 3072, ZC_RW_ZA = 3168, ZC_RW_ZG = 3264;
constexpr int ZC_RET_Q = 3584, ZC_RET_K = 4096, ZC_RET_V = 4608, ZC_RET_G = 5632;
constexpr int ZC_NSA_Q = 6656, ZC_NSA_KC = 7168, ZC_NSA_VC = 7296, ZC_NSA_KS = 7424, ZC_NSA_VS = 7552, ZC_NSA_KW = 7680, ZC_NSA_VW = 7808, ZC_NSA_GT = 7936;
constexpr int ZC_GATE = 8192;
constexpr int NBR = 2560;
constexpr int FFN = 5632, FFN2 = 11264;
constexpr int MEM = 256;

constexpr size_t MiB = 1u << 20;
constexpr size_t WS_CTL = 0;
constexpr size_t WS_W_IN = 1 * MiB, WS_W_BR = 65 * MiB, WS_W_OUT = 75 * MiB, WS_W_Q = 83 * MiB, WS_W_KV = 91 * MiB, WS_W_O = 107 * MiB;
constexpr size_t WS_W_UP = 115 * MiB, WS_W_DN = 159 * MiB, WS_W_LORA = 181 * MiB, WS_W_C1 = 183 * MiB;
constexpr size_t WS_CBIAS = 185 * MiB, WS_MEMN = 186 * MiB, WS_KMEM = 188 * MiB, WS_VTM = 190 * MiB;
constexpr size_t WS_H = 192 * MiB, WS_Z = 224 * MiB, WS_OALL = 484 * MiB, WS_MERGED = 524 * MiB, WS_MERGEDB = 588 * MiB, WS_Y = 620 * MiB;
constexpr size_t WS_T = 684 * MiB;
constexpr size_t WS_ALORA = WS_T, WS_LO = WS_T + 8 * MiB, WS_RWOPS = WS_T + 56 * MiB, WS_YSCAN = WS_T + 152 * MiB;
constexpr size_t WS_QR = WS_T + 168 * MiB, WS_KR = WS_T + 176 * MiB, WS_UBUF = WS_T + 184 * MiB, WS_RPREV = WS_T + 216 * MiB;
constexpr size_t WS_QN = WS_T + 232 * MiB, WS_KVG = WS_T + 240 * MiB, WS_HID = WS_T + 253 * MiB, WS_KCMP = WS_T + 254 * MiB, WS_VCMPT = WS_T + 254 * MiB + 512 * 1024;
constexpr size_t WS_OCMP = WS_T + 255 * MiB, WS_SELM = WS_T + 263 * MiB;
constexpr size_t WS_END = WS_T + 264 * MiB;
constexpr size_t WS_QX = WS_Z, WS_SC = WS_Z + 32 * MiB, WS_PB = WS_Z + 64 * MiB, WS_OX = WS_Z + 80 * MiB;
constexpr size_t WS_U = WS_Z, WS_GACT = WS_T;
constexpr size_t WS_RW_PF = WS_MERGED, WS_RW_QF = WS_MERGED + 32 * MiB, WS_RW_RF = WS_MERGED + 96 * MiB, WS_RW_Y0F = WS_MERGED + 104 * MiB;
constexpr size_t KVG_SLAB = (size_t)BATCH * 2 * SEQ * 64;

constexpr int LDS_BYTES = 147456;

struct Params {
    const float* in[35];
    float* out;
    unsigned char* ws;
};

__device__ __forceinline__ int otid() { int t = (int)threadIdx.x; asm volatile("" : "+v"(t)); return t; }
__device__ __forceinline__ float bf2f(bf16_t v) { return __uint_as_float((unsigned)v << 16); }
typedef __bf16 bf16x2_t __attribute__((ext_vector_type(2)));
__device__ __forceinline__ unsigned cvt_pk_bf16(float lo, float hi) { const f32x2 v = {lo, hi}; const bf16x2_t b = __builtin_convertvector(v, bf16x2_t); return __builtin_bit_cast(unsigned, b); }
__device__ __forceinline__ bf16_t f2bf(float f) { return (bf16_t)(cvt_pk_bf16(f, 0.f) & 0xffffu); }
__device__ __forceinline__ float wave_sum(float v) {
#pragma unroll
    for (int o = 1; o < 64; o <<= 1) v += __shfl_xor(v, o);
    return v;
}
__device__ __forceinline__ float sigmoidf_(float x) { return 1.f / (1.f + __expf(-x)); }
__device__ __forceinline__ float gelu_tanh(float x) { const float u = 1.5957691216057308f * (x + 0.044715f * x * x * x); return x / (1.f + __expf(-u)); }
__device__ __forceinline__ f32x4 mma16(f32x4 acc, bf16x8 a_rowfrag, bf16x8 b_colfrag) {
    return __builtin_amdgcn_mfma_f32_16x16x32_bf16(b_colfrag, a_rowfrag, acc, 0, 0, 0);
}
__device__ __forceinline__ bf16x8 ldfrag(const bf16_t* p) { return *(const bf16x8*)p; }

namespace pg8 {
constexpr int BM = 256, BK = 64, HALF = 128, HTB = HALF * BK * 2, STAGE_BYTES = 8 * HTB, NXCD = 8, WGM = 8;
__host__ __device__ __forceinline__ int lds_byte(int r, int c) { const int st = (r >> 4) * 2 + (c >> 5), rr = r & 15, cc = c & 31, ob = rr * 64 + cc * 2; return st * 1024 + (ob ^ (((ob >> 9) & 1) << 5)); }
__host__ __device__ __forceinline__ void stage_rc(int b, int& R, int& C) { const int st = b / 1024, sb = b % 1024, swz = sb ^ (((sb >> 9) & 1) << 5); R = (st >> 1) * 16 + swz / 64; C = (st & 1) * 32 + (swz % 64) / 2; }
__host__ __device__ __forceinline__ int perm32(int rho) { const int n = rho >> 4, i = rho & 15; return 8 * (i >> 2) + 4 * n + (i & 3); }

struct Unit { const char* A; const char* B; size_t ooff; int pm, pn, z; };

struct GSched {
    const char* A; const char* B;
    long a_pm, b_pn;
    long a_z1, a_z2, b_z1, b_z2;
    long o_pm, o_pn, o_z1, o_z2;
    int nM, nN, nZ1, nZ2, G, c, pst;
    __device__ __forceinline__ bool next(int i, Unit& u) const {
        if (pst) {
            const int k = c >> 3, pm = 4 * (c & 7) + (k & 3), pn = 8 * i + (k >> 2); if (pn >= nN) return false;
            u.pm = pm; u.pn = pn; u.z = 0; u.A = A + pm * a_pm; u.B = B + pn * b_pn; u.ooff = (size_t)(pm * o_pm + pn * o_pn); return true; }
        const int per = nM * nN; const long L = (long)i * G + c; if (L >= (long)per * nZ1 * nZ2) return false;
        const int zz = (int)(L / per); int wgid = (int)(L % per);
        { const int q = per / NXCD, r = per % NXCD, xcd = wgid % NXCD, off = wgid / NXCD; wgid = (xcd < r ? xcd * (q + 1) : r * (q + 1) + (xcd - r) * q) + off; }
        const int nig = WGM * nN, gid = wgid / nig, fm = gid * WGM, gsz = (nM - fm) < WGM ? (nM - fm) : WGM;
        const int pm = fm + ((wgid % nig) % gsz), pn = (wgid % nig) / gsz;
        const int z1 = zz / nZ2, z2 = zz % nZ2;
        u.pm = pm; u.pn = pn; u.z = zz;
        u.A = A + z1 * a_z1 + z2 * a_z2 + pm * a_pm; u.B = B + z1 * b_z1 + z2 * b_z2 + pn * b_pn;
        u.ooff = (size_t)(z1 * o_z1 + z2 * o_z2 + pm * o_pm + pn * o_pn);
        return true;
    }
};
__device__ __forceinline__ GSched make_sched(const void* A, int lda, const void* B, int ldb, int nM, int nN, long ldc, int bi, int nb) {
    GSched s; s.A = (const char*)A; s.B = (const char*)B; s.a_pm = (long)BM * lda * 2; s.b_pn = (long)BM * ldb * 2; s.a_z1 = s.a_z2 = s.b_z1 = s.b_z2 = 0;
    s.o_pm = (long)BM * ldc; s.o_pn = BM; s.o_z1 = s.o_z2 = 0; s.nM = nM; s.nN = nN; s.nZ1 = 1; s.nZ2 = 1; s.G = nb; s.c = bi; s.pst = (nM == 32 && nb == 256) ? 1 : 0; return s;
}

template <class Epi, class Sched>
__device__ __forceinline__ void gemm_phase(LAS unsigned char* lds, const int lda, const int ldb, const int K, const Sched& S, const Epi& E) {
    const int tid = otid(), wid = __builtin_amdgcn_readfirstlane(tid >> 6), lane = tid & 63, wr = wid >> 2, wc = wid & 3, fr = lane & 15, fq = lane >> 4;
    const int nt = K / BK;
    unsigned voffA[2], voffB[2];
#pragma unroll
    for (int i = 0; i < 2; ++i) { int R, C; stage_rc(tid * 16 + i * 8192, R, C); const int Rb = Epi::PERM ? ((R & ~31) + perm32(R & 31)) : R;
        voffA[i] = (unsigned)(R * lda + C) * 2u; voffB[i] = (unsigned)(Rb * ldb + C) * 2u; }
    const size_t kstep = (size_t)(BK * 2);
    const size_t hstepA = (size_t)HALF * lda * 2, hstepB = (size_t)HALF * ldb * 2;
    const unsigned ldsw = (unsigned)wid * 1024u;
    const int aoff = lds_byte(wr * 64 + fr, fq * 8), boff = lds_byte(wc * 32 + fr, fq * 8);
#define PG8_SA(b, h) (((b) * 2 + (h)) * HTB)
#define PG8_SB(b, h) ((4 + (b) * 2 + (h)) * HTB)
#define PG8_STAGE(bufoff, gbase, voff) do { _Pragma("unroll") for (int _i = 0; _i < 2; ++_i) \
        __builtin_amdgcn_global_load_lds((const unsigned*)((const char*)(gbase) + (voff)[_i]), (LAS unsigned*)(lds + (bufoff) + ldsw + _i * 8192), 16, 0, 0); } while (0)
#define PG8_LDA(dst, b, h) do { _Pragma("unroll") for (int m = 0; m < 4; ++m) _Pragma("unroll") for (int k = 0; k < 2; ++k) dst[m][k] = *(const LAS bf16x8*)(lds + PG8_SA(b, h) + aoff + m * 2048 + k * 1024); } while (0)
#define PG8_LDB(dst, b, h) do { _Pragma("unroll") for (int n = 0; n < 2; ++n) _Pragma("unroll") for (int k = 0; k < 2; ++k) dst[n][k] = *(const LAS bf16x8*)(lds + PG8_SB(b, h) + boff + n * 2048 + k * 1024); } while (0)
#define PG8_MMA(ai, bj, At, Bt) do { __builtin_amdgcn_s_setprio(1); _Pragma("unroll") for (int m = 0; m < 4; ++m) _Pragma("unroll") for (int n = 0; n < 2; ++n) _Pragma("unroll") for (int k = 0; k < 2; ++k) \
        acc[ai][bj][m][n] = __builtin_amdgcn_mfma_f32_16x16x32_bf16(Bt[n][k], At[m][k], acc[ai][bj][m][n], 0, 0, 0); __builtin_amdgcn_s_setprio(0); } while (0)
#define PG8_WAIT_V(n) asm volatile("s_waitcnt vmcnt(" #n ")" ::: "memory")
#define PG8_WAIT_L(n) asm volatile("s_waitcnt lgkmcnt(" #n ")" ::: "memory")
#define PG8_BAR __builtin_amdgcn_s_barrier()
#define PG8_SCHED __builtin_amdgcn_sched_barrier(0)
    Unit cur, nxt; int ui = 0;
    if (!S.next(0, cur)) return;
    f32x4 acc[2][2][4][2];
#pragma unroll
    for (int a = 0; a < 2; ++a)
#pragma unroll
        for (int b = 0; b < 2; ++b)
#pragma unroll
            for (int m = 0; m < 4; ++m)
#pragma unroll
                for (int n = 0; n < 2; ++n) acc[a][b][m][n] = (f32x4){0.f, 0.f, 0.f, 0.f};
    bf16x8 At[4][2], B0[2][2], B1[2][2];
    const char* cA = cur.A; const char* cB = cur.B;
    PG8_STAGE(PG8_SB(0, 0), cB, voffB); PG8_STAGE(PG8_SB(0, 1), cB + hstepB, voffB); PG8_STAGE(PG8_SA(0, 0), cA, voffA); PG8_STAGE(PG8_SA(0, 1), cA + hstepA, voffA);
    if (wr == 1) PG8_BAR;
    PG8_WAIT_V(2); PG8_BAR;
    PG8_STAGE(PG8_SB(1, 0), cB + kstep, voffB); PG8_STAGE(PG8_SA(1, 0), cA + kstep, voffA); PG8_STAGE(PG8_SB(1, 1), cB + hstepB + kstep, voffB);
    PG8_WAIT_V(6); PG8_BAR;
    for (;;) {
        const bool has_next = S.next(ui + 1, nxt);
        const char* nA = has_next ? nxt.A : cA; const char* nB = has_next ? nxt.B : cB;
        for (int t = 0; t < nt; t += 2) {
            const bool last = (t == nt - 2);
            const char* a1 = cA + (size_t)(t + 1) * kstep;
            const char* a2 = last ? nA : cA + (size_t)(t + 2) * kstep; const char* b2 = last ? nB : cB + (size_t)(t + 2) * kstep;
            const char* a3 = a2 + kstep; const char* b3 = b2 + kstep;
            PG8_LDB(B0, 0, 0); PG8_LDB(B1, 0, 1); PG8_SCHED; PG8_LDA(At, 0, 0); PG8_STAGE(PG8_SA(1, 1), a1 + hstepA, voffA);
            PG8_WAIT_V(8); PG8_WAIT_L(0); PG8_BAR; PG8_MMA(0, 0, At, B0); PG8_MMA(0, 1, At, B1); PG8_BAR; PG8_SCHED;
            PG8_LDA(At, 0, 1); PG8_STAGE(PG8_SB(0, 0), b2, voffB); PG8_STAGE(PG8_SB(0, 1), b2 + hstepB, voffB); PG8_STAGE(PG8_SA(0, 0), a2, voffA);
            PG8_WAIT_V(8); PG8_WAIT_L(0); PG8_BAR; PG8_MMA(1, 0, At, B0); PG8_MMA(1, 1, At, B1); PG8_BAR; PG8_SCHED;
            PG8_LDB(B0, 1, 0); PG8_LDB(B1, 1, 1); PG8_SCHED; PG8_LDA(At, 1, 0); PG8_STAGE(PG8_SA(0, 1), a2 + hstepA, voffA);
            PG8_WAIT_V(8); PG8_WAIT_L(0); PG8_BAR; PG8_MMA(0, 0, At, B0); PG8_MMA(0, 1, At, B1); PG8_BAR; PG8_SCHED;
            PG8_LDA(At, 1, 1); PG8_STAGE(PG8_SB(1, 0), b3, voffB); PG8_STAGE(PG8_SB(1, 1), b3 + hstepB, voffB); PG8_STAGE(PG8_SA(1, 0), a3, voffA);
            PG8_WAIT_V(8); PG8_WAIT_L(0); PG8_BAR; PG8_MMA(1, 0, At, B0); PG8_MMA(1, 1, At, B1); PG8_BAR; PG8_SCHED;
        }
        if (wr == 0) PG8_BAR;
        E(acc, cur, wr, wc, fr, fq);
        if (!has_next) break;
#pragma unroll
        for (int a = 0; a < 2; ++a)
#pragma unroll
            for (int b = 0; b < 2; ++b)
#pragma unroll
                for (int m = 0; m < 4; ++m)
#pragma unroll
                    for (int n = 0; n < 2; ++n) acc[a][b][m][n] = (f32x4){0.f, 0.f, 0.f, 0.f};
        cur = nxt; cA = nA; cB = nB; ++ui;
        if (wr == 1) PG8_BAR;
    }
    PG8_WAIT_V(0);
    PG8_BAR;
#undef PG8_SA
#undef PG8_SB
#undef PG8_STAGE
#undef PG8_LDA
#undef PG8_LDB
#undef PG8_MMA
#undef PG8_WAIT_V
#undef PG8_WAIT_L
#undef PG8_BAR
#undef PG8_SCHED
}

template <int ACT> struct EpiBf16 {
    static constexpr bool PERM = true;
    bf16_t* O; int ldc; const float* bias;
    __device__ __forceinline__ void operator()(const f32x4 (&acc)[2][2][4][2], const Unit& u, int wr, int wc, int fr, int fq) const {
        bf16_t* base = O + u.ooff; const int col0 = wc * 32 + 8 * fq;
#pragma unroll
        for (int ai = 0; ai < 2; ++ai)
#pragma unroll
            for (int m = 0; m < 4; ++m) { bf16_t* rowp = base + (size_t)(ai * HALF + wr * 64 + m * 16 + fr) * ldc + col0;
#pragma unroll
                for (int bj = 0; bj < 2; ++bj) { f32x4 v0 = acc[ai][bj][m][0], v1 = acc[ai][bj][m][1];
                    if (ACT == 1) { const float* bp = bias + u.pn * BM + col0 + bj * HALF; const f32x4 b0 = *(const f32x4*)bp, b1 = *(const f32x4*)(bp + 4);
                        v0 += b0; v1 += b1;
#pragma unroll
                        for (int j = 0; j < 4; ++j) { v0[j] = gelu_tanh(v0[j]); v1[j] = gelu_tanh(v1[j]); } }
                    u32x4 w; w.x = cvt_pk_bf16(v0[0], v0[1]); w.y = cvt_pk_bf16(v0[2], v0[3]); w.z = cvt_pk_bf16(v1[0], v1[1]); w.w = cvt_pk_bf16(v1[2], v1[3]);
                    *(u32x4*)(rowp + bj * HALF) = w; } }
    }
};
struct EpiF32 {
    static constexpr bool PERM = false;
    float* C; int ldc; float scale;
    __device__ __forceinline__ void operator()(const f32x4 (&acc)[2][2][4][2], const Unit& u, int wr, int wc, int fr, int fq) const {
        float* base = C + u.ooff; const int col0 = wc * 32 + 4 * fq;
#pragma unroll
        for (int ai = 0; ai < 2; ++ai)
#pragma unroll
            for (int m = 0; m < 4; ++m) { float* rowp = base + (size_t)(ai * HALF + wr * 64 + m * 16 + fr) * ldc + col0;
#pragma unroll
                for (int bj = 0; bj < 2; ++bj)
#pragma unroll
                    for (int n = 0; n < 2; ++n) *(f32x4*)(rowp + bj * HALF + n * 16) = acc[ai][bj][m][n] * scale; }
    }
};
struct EpiBranch {
    static constexpr bool PERM = false;
    float* merged; bf16_t* mergedb; const bf16_t* gate; int first, last;
    __device__ __forceinline__ void operator()(const f32x4 (&acc)[2][2][4][2], const Unit& u, int wr, int wc, int fr, int fq) const {
        const int col0 = u.pn * BM + wc * 32 + 4 * fq;
#pragma unroll
        for (int ai = 0; ai < 2; ++ai)
#pragma unroll
            for (int m = 0; m < 4; ++m) { const size_t row = (size_t)(u.pm * BM + ai * HALF + wr * 64 + m * 16 + fr);
#pragma unroll
                for (int bj = 0; bj < 2; ++bj)
#pragma unroll
                    for (int n = 0; n < 2; ++n) { const int col = col0 + bj * HALF + n * 16;
                        const u32x2 gw = *(const u32x2*)(gate + row * NZ + col);
                        f32x4 g; g[0] = sigmoidf_(__uint_as_float(gw.x << 16)); g[1] = sigmoidf_(__uint_as_float(gw.x & 0xffff0000u)); g[2] = sigmoidf_(__uint_as_float(gw.y << 16)); g[3] = sigmoidf_(__uint_as_float(gw.y & 0xffff0000u));
                        f32x4 v = acc[ai][bj][m][n] * g;
                        if (!first) v += *(const f32x4*)(merged + row * D + col);
                        if (last) { u32x2 w; w.x = cvt_pk_bf16(v[0], v[1]); w.y = cvt_pk_bf16(v[2], v[3]); *(u32x2*)(mergedb + row * D + col) = w; }
                        else *(f32x4*)(merged + row * D + col) = v; } }
    }
};
struct EpiC1 { static constexpr bool PERM = true; bf16_t* O; const float* bias;
    __device__ __forceinline__ void operator()(const f32x4 (&acc)[2][2][4][2], const Unit& u, int wr, int wc, int fr, int fq) const { EpiBf16<1> e{O, 256, bias + (u.z >> 2) * 256}; e(acc, u, wr, wc, fr, fq); } };
}

__device__ __forceinline__ void ph_norm_rows(const float* x, const float* g, bf16_t* out, int rows, int bi, int nb) {
    const int tid_ = otid(), lane = tid_ & 63, gw = bi * 8 + (tid_ >> 6), NGW = nb * 8;
    for (int m = gw; m < rows; m += NGW) {
        const f32x4* xr = (const f32x4*)(x + (size_t)m * D) + lane; f32x4 v[8]; float s = 0.f;
#pragma unroll
        for (int j = 0; j < 8; ++j) { v[j] = xr[64 * j]; s += v[j][0] * v[j][0] + v[j][1] * v[j][1] + v[j][2] * v[j][2] + v[j][3] * v[j][3]; }
        const float rstd = rsqrtf(wave_sum(s) * (1.f / D) + 1e-6f);
        u32x2* o = (u32x2*)(out + (size_t)m * D) + lane;
#pragma unroll
        for (int j = 0; j < 8; ++j) { const f32x4 gg = ((const f32x4*)g)[lane + 64 * j]; u32x2 w; w.x = cvt_pk_bf16(v[j][0] * rstd * gg[0], v[j][1] * rstd * gg[1]); w.y = cvt_pk_bf16(v[j][2] * rstd * gg[2], v[j][3] * rstd * gg[3]); o[64 * j] = w; }
    }
}
__device__ __forceinline__ void ph_finish(const float* xin, const float* y, const float* g1, const float* g2, float* xout, bf16_t* h, int bi, int nb) {
    const int tid_ = otid(), lane = tid_ & 63, gw = bi * 8 + (tid_ >> 6), NGW = nb * 8;
    for (int m = gw; m < M; m += NGW) {
        const f32x4* yr = (const f32x4*)(y + (size_t)m * D) + lane; const f32x4* xr = (const f32x4*)(xin + (size_t)m * D) + lane; f32x4 v[8]; float s = 0.f;
#pragma unroll
        for (int j = 0; j < 8; ++j) { v[j] = yr[64 * j]; s += v[j][0] * v[j][0] + v[j][1] * v[j][1] + v[j][2] * v[j][2] + v[j][3] * v[j][3]; }
        const float rstd = rsqrtf(wave_sum(s) * (1.f / D) + 1e-6f); float s2 = 0.f;
        f32x4* xo = (f32x4*)(xout + (size_t)m * D) + lane;
#pragma unroll
        for (int j = 0; j < 8; ++j) { const f32x4 gg = ((const f32x4*)g1)[lane + 64 * j]; const f32x4 xv = xr[64 * j];
            v[j] = xv + v[j] * rstd * gg; xo[64 * j] = v[j]; s2 += v[j][0] * v[j][0] + v[j][1] * v[j][1] + v[j][2] * v[j][2] + v[j][3] * v[j][3]; }
        if (g2) { const float r2 = rsqrtf(wave_sum(s2) * (1.f / D) + 1e-6f); u32x2* o = (u32x2*)(h + (size_t)m * D) + lane;
#pragma unroll
            for (int j = 0; j < 8; ++j) { const f32x4 gg = ((const f32x4*)g2)[lane + 64 * j]; u32x2 w; w.x = cvt_pk_bf16(v[j][0] * r2 * gg[0], v[j][1] * r2 * gg[1]); w.y = cvt_pk_bf16(v[j][2] * r2 * gg[2], v[j][3] * r2 * gg[3]); o[64 * j] = w; } }
    }
}

enum { MAP_ID = 0, MAP_WIN = 1, MAP_UP = 2 };
__device__ __forceinline__ int cmap(int kind, int n) {
    if (kind == MAP_ID) return n;
    if (kind == MAP_WIN) { if (n < 3520) return n; if (n < 3584) return -1; if (n < 6656) return n - 64; if (n < 7960) return n - 64; if (n < 8192) return -1; return n - 296; }
    const int j = n >> 8, s = n & 255; return s < 128 ? 128 * j + s : FFN + 128 * j + (s - 128);
}
__device__ __forceinline__ void transpose_item(const float* W, int K, int Nsrc, bf16_t* WT, int kind, LAS unsigned* T, int item, int nblk, int tid) {
    const int kb = item / nblk, nb_ = item % nblk, k0 = 128 * kb, n0 = 128 * nb_;
    { const int cg = tid & 31, r0 = tid >> 5; const int src = cmap(kind, n0 + 4 * cg);
      f32x4 v[8];
#pragma unroll
      for (int i = 0; i < 8; ++i) v[i] = src >= 0 ? *(const f32x4*)(W + (size_t)(k0 + r0 + 16 * i) * Nsrc + src) : (f32x4){0.f, 0.f, 0.f, 0.f};
#pragma unroll
      for (int i = 0; i < 8; ++i) { LAS unsigned* d = T + (r0 + 16 * i) * 65 + 2 * cg; d[0] = cvt_pk_bf16(v[i][0], v[i][1]); d[1] = cvt_pk_bf16(v[i][2], v[i][3]); } }
    __syncthreads();
#pragma unroll
    for (int j = 0; j < 2; ++j) { const int c = tid + 512 * j, np = (c & 7) + 8 * ((c >> 6) & 7), kg = ((c >> 3) & 7) + 8 * (c >> 9);
        unsigned w[8];
#pragma unroll
        for (int e = 0; e < 8; ++e) w[e] = T[(8 * kg + e) * 65 + np];
        u32x4 lo, hi;
        lo.x = (w[0] & 0xffffu) | (w[1] << 16); lo.y = (w[2] & 0xffffu) | (w[3] << 16); lo.z = (w[4] & 0xffffu) | (w[5] << 16); lo.w = (w[6] & 0xffffu) | (w[7] << 16);
        hi.x = (w[0] >> 16) | (w[1] & 0xffff0000u); hi.y = (w[2] >> 16) | (w[3] & 0xffff0000u); hi.z = (w[4] >> 16) | (w[5] & 0xffff0000u); hi.w = (w[6] >> 16) | (w[7] & 0xffff0000u);
        bf16_t* o = WT + (size_t)(n0 + 2 * np) * K + k0 + 8 * kg;
        *(u32x4*)o = lo; *(u32x4*)(o + K) = hi; }
    __syncthreads();
}
__device__ __forceinline__ unsigned char* ws_lds() {
    volatile LAS unsigned* q = (volatile LAS unsigned*)(LDS_BYTES - 8); unsigned lo = q[0], hi = q[1];
    lo = (unsigned)__builtin_amdgcn_readfirstlane((int)lo); hi = (unsigned)__builtin_amdgcn_readfirstlane((int)hi); return (unsigned char*)(__attribute__((address_space(1))) unsigned char*)(((u64)hi << 32) | (u64)lo); }
#define PROLOG unsigned char* const wsl = ws_lds()
#define WS_PTRTAB 256
#define inp(p_, i) ((const float*)(__attribute__((address_space(1))) const float*)(((const u64*)(wsl + WS_PTRTAB))[i]))
#define OUTP ((float*)(__attribute__((address_space(1))) float*)(((const u64*)(wsl + WS_PTRTAB))[35]))
#define WSP(T, off) ((T*)(wsl + (off)))
#define INL(i, per) (inp(p, i) + (size_t)l * (per))

__device__ __forceinline__ void ph_convert(const Params& p, int l, LAS unsigned char* lds, int bi, int nb) {
    PROLOG;
    const int tid = otid();
    LAS unsigned* T = (LAS unsigned*)lds;
    const int I0 = 16 * 128, I1 = 20 * 16, I2 = 16 * 16, I3 = 16 * 32, I4 = 16 * 88, I5 = 44 * 16, I6 = 16 * 2;
    const int NIT = I0 + I1 + 3 * I2 + I3 + I4 + I5 + 2 * I6;
    for (int it = bi; it < NIT; it += nb) {
        int r = it;
        if (r < I0) { transpose_item(INL(10, (size_t)D * N_IN), D, N_IN, WSP(bf16_t, WS_W_IN), MAP_WIN, T, r, 128, tid); continue; } r -= I0;
        if (r < I1) { transpose_item(INL(26, (size_t)NBR * D), NBR, D, WSP(bf16_t, WS_W_BR), MAP_ID, T, r, 16, tid); continue; } r -= I1;
        if (r < I2) { transpose_item(INL(27, (size_t)D * D), D, D, WSP(bf16_t, WS_W_OUT), MAP_ID, T, r, 16, tid); continue; } r -= I2;
        if (r < I2) { transpose_item(INL(28, (size_t)D * D), D, D, WSP(bf16_t, WS_W_Q), MAP_ID, T, r, 16, tid); continue; } r -= I2;
        if (r < I2) { transpose_item(INL(30, (size_t)D * D), D, D, WSP(bf16_t, WS_W_O), MAP_ID, T, r, 16, tid); continue; } r -= I2;
        if (r < I3) { transpose_item(INL(29, (size_t)D * 2 * D), D, 2 * D, WSP(bf16_t, WS_W_KV), MAP_ID, T, r, 32, tid); continue; } r -= I3;
        if (r < I4) { transpose_item(INL(31, (size_t)D * FFN2), D, FFN2, WSP(bf16_t, WS_W_UP), MAP_UP, T, r, 88, tid); continue; } r -= I4;
        if (r < I5) { transpose_item(INL(34, (size_t)FFN * D), FFN, D, WSP(bf16_t, WS_W_DN), MAP_ID, T, r, 16, tid); continue; } r -= I5;
        if (r < I6) { transpose_item(INL(24, (size_t)2 * 2048 * 256), 2048, 256, WSP(bf16_t, WS_W_C1), MAP_ID, T, r, 2, tid); continue; } r -= I6;
        transpose_item(INL(24, (size_t)2 * 2048 * 256) + (size_t)2048 * 256, 2048, 256, WSP(bf16_t, WS_W_C1) + (size_t)256 * 2048, MAP_ID, T, r, 2, tid);
    }
    const int gt = bi * 512 + otid(), NT = nb * 512;
    bf16_t* wl = WSP(bf16_t, WS_W_LORA);
    const float* w2 = INL(14, 96 * 512); const float* a2 = INL(16, 96 * 512); const float* g2 = INL(17, 256 * 512);
    for (int i = gt; i < 1536 * 512; i += NT) { const int n = i >> 9, k = i & 511; float v = 0.f;
        if (n < 512) { if (k < 96) v = w2[k * 512 + n]; } else if (n < 1024) { if (k >= 128 && k < 224) v = a2[(k - 128) * 512 + (n - 512)]; } else { if (k >= 256) v = g2[(k - 256) * 512 + (n - 1024)]; }
        wl[i] = f2bf(v); }
    { float* cbp = WSP(float, WS_CBIAS) + 512; const int lane_ = tid & 63, gwv = bi * 8 + (tid >> 6), NGWV = nb * 8;
      for (int wt = gwv; wt < 128; wt += NGWV) { const int ks = wt & 15, ii = wt >> 6, n = ((wt >> 4) & 3) * 64 + lane_; const float* pos = INL(23, 2 * 32 * 64) + ii * 2048 + ks * 128; const float* w1 = INL(24, (size_t)2 * 2048 * 256) + (size_t)ii * 2048 * 256 + (size_t)ks * 128 * 256; float s0 = 0.f, s1 = 0.f, s2 = 0.f, s3 = 0.f;
          for (int k = 0; k < 128; k += 4) { s0 += pos[k] * w1[(size_t)k * 256 + n]; s1 += pos[k + 1] * w1[(size_t)(k + 1) * 256 + n]; s2 += pos[k + 2] * w1[(size_t)(k + 2) * 256 + n]; s3 += pos[k + 3] * w1[(size_t)(k + 3) * 256 + n]; }
          cbp[ks * 512 + ii * 256 + n] = (s0 + s1) + (s2 + s3); } }
    ph_norm_rows(inp(p, 1), INL(6, D), WSP(bf16_t, WS_MEMN), BATCH * MEM, bi, nb);
}

__device__ __forceinline__ float zf(const bf16_t* zr, int c) { return bf2f(zr[c]); }
__device__ __forceinline__ void bf8_to_f(const u32x4 w, float (&f)[8]) {
    f[0] = __uint_as_float(w.x << 16); f[1] = __uint_as_float(w.x & 0xffff0000u); f[2] = __uint_as_float(w.y << 16); f[3] = __uint_as_float(w.y & 0xffff0000u);
    f[4] = __uint_as_float(w.z << 16); f[5] = __uint_as_float(w.z & 0xffff0000u); f[6] = __uint_as_float(w.w << 16); f[7] = __uint_as_float(w.w & 0xffff0000u); }
__device__ __forceinline__ void ld8(const float* p, float (&f)[8]) { const f32x4 a = *(const f32x4*)p, b = *(const f32x4*)(p + 4); f[0] = a[0]; f[1] = a[1]; f[2] = a[2]; f[3] = a[3]; f[4] = b[0]; f[5] = b[1]; f[6] = b[2]; f[7] = b[3]; }
__device__ __forceinline__ void st8(float* p, const float (&f)[8]) { *(f32x4*)p = (f32x4){f[0], f[1], f[2], f[3]}; *(f32x4*)(p + 4) = (f32x4){f[4], f[5], f[6], f[7]}; }
__device__ __forceinline__ u32x4 pk8(const float (&f)[8]) { u32x4 w; w.x = cvt_pk_bf16(f[0], f[1]); w.y = cvt_pk_bf16(f[2], f[3]); w.z = cvt_pk_bf16(f[4], f[5]); w.w = cvt_pk_bf16(f[6], f[7]); return w; }
__device__ __forceinline__ void ph_mix_prep(const Params& p, int l, LAS unsigned char* lds, int bi, int nb) {
    PROLOG;
    const int tid_ = otid(), lane = tid_ & 63, wave = tid_ >> 6, gw = bi * 8 + wave, NGW = nb * 8;
    const bf16_t* z = WSP(bf16_t, WS_Z); bf16_t* oall = WSP(bf16_t, WS_OALL); bf16_t* alora = WSP(bf16_t, WS_ALORA);
    bf16_t* qr = WSP(bf16_t, WS_QR); bf16_t* kr = WSP(bf16_t, WS_KR); bf16_t* qn = WSP(bf16_t, WS_QN); bf16_t* kvg = WSP(bf16_t, WS_KVG);
    const float* scw = INL(11, 3 * 512); const float* mu = INL(12, 1984); const int* posi = (const int*)inp(p, 2);
    LAS float* tab = (LAS float*)(lds + wave * 1024);
    if (bi == 0) { float* cb = WSP(float, WS_CBIAS); float sacc = 0.f;
        for (int ks = 0; ks < 16; ++ks) sacc += cb[512 + ks * 512 + tid_]; cb[tid_] = sacc; }
    for (int task = gw; task < 2048; task += NGW) {
        const int m0 = (task >> 1) * 8, b = m0 >> 12, t0 = m0 & 4095;
        if ((task & 1) == 0) {
            float w0[8], w1[8], w2[8]; ld8(scw + 8 * lane, w0); ld8(scw + 512 + 8 * lane, w1); ld8(scw + 1024 + 8 * lane, w2);
            float cx1[8], cx2[8];
            if (t0 >= 2) { float c_[8], x_[8]; bf8_to_f(*(const u32x4*)(z + (size_t)(m0 - 1) * NZ + ZC_SC_C + 8 * lane), c_); bf8_to_f(*(const u32x4*)(z + (size_t)(m0 - 1) * NZ + ZC_SC_X + 8 * lane), x_);
#pragma unroll
                for (int j = 0; j < 8; ++j) cx1[j] = c_[j] * x_[j];
                bf8_to_f(*(const u32x4*)(z + (size_t)(m0 - 2) * NZ + ZC_SC_C + 8 * lane), c_); bf8_to_f(*(const u32x4*)(z + (size_t)(m0 - 2) * NZ + ZC_SC_X + 8 * lane), x_);
#pragma unroll
                for (int j = 0; j < 8; ++j) cx2[j] = c_[j] * x_[j]; }
            else {
#pragma unroll
                for (int j = 0; j < 8; ++j) { cx1[j] = 0.f; cx2[j] = 0.f; } }
            int src = -1, kind = 0;
            if (lane < 12) { src = ZC_RW_ZW + 8 * lane; kind = 1; } else if (lane >= 16 && lane < 28) { src = ZC_RW_ZA + 8 * (lane - 16); } else if (lane >= 32) { src = ZC_RW_ZG + 8 * (lane - 32); kind = 2; }
            float mus[8], pv[8];
#pragma unroll
            for (int j = 0; j < 8; ++j) { mus[j] = 0.f; pv[j] = 0.f; }
            if (src >= 0) { ld8(mu + (src - ZC_RW), mus); if (t0 >= 1) bf8_to_f(*(const u32x4*)(z + (size_t)(m0 - 1) * NZ + src), pv); }
#pragma unroll 2
            for (int rr = 0; rr < 8; ++rr) { const size_t m = (size_t)(m0 + rr); const bf16_t* zr = z + m * NZ;
                float b_[8], c_[8], x_[8], o8[8]; bf8_to_f(*(const u32x4*)(zr + ZC_SC_B + 8 * lane), b_); bf8_to_f(*(const u32x4*)(zr + ZC_SC_C + 8 * lane), c_); bf8_to_f(*(const u32x4*)(zr + ZC_SC_X + 8 * lane), x_);
#pragma unroll
                for (int j = 0; j < 8; ++j) { const float cx0 = c_[j] * x_[j]; o8[j] = b_[j] * (w2[j] * cx0 + w1[j] * cx1[j] + w0[j] * cx2[j]); cx2[j] = cx1[j]; cx1[j] = cx0; }
                *(u32x4*)(oall + m * NBR + 8 * lane) = pk8(o8);
                float a8[8];
                if (src >= 0) { float cur[8]; bf8_to_f(*(const u32x4*)(zr + src), cur);
#pragma unroll
                    for (int j = 0; j < 8; ++j) { const float v = cur[j] + (pv[j] - cur[j]) * mus[j]; a8[j] = kind == 1 ? tanhf(v) : (kind == 2 ? sigmoidf_(v) : v); pv[j] = cur[j]; } }
                else {
#pragma unroll
                    for (int j = 0; j < 8; ++j) a8[j] = 0.f; }
                *(u32x4*)(alora + m * 512 + 8 * lane) = pk8(a8);
                if (lane < 32) { const int arr = lane >> 4, L2 = lane & 15, g = L2 >> 3, d0 = (L2 & 7) * 8;
                    *(u32x4*)(kvg + (size_t)arr * KVG_SLAB + ((size_t)(b * 2 + g) * SEQ + (t0 + rr)) * 64 + d0) = *(const u32x4*)(zr + (arr ? ZC_NSA_VC : ZC_NSA_KC) + 8 * L2); }
            }
        } else {
            const float invr = __expf(-(float)lane * (9.210340371976184f / 63.f)), invn = __expf(-(float)(lane & 31) * (9.210340371976184f / 32.f));
            for (int rr = 0; rr < 8; ++rr) { const size_t m = (size_t)(m0 + rr); const bf16_t* zr = z + m * NZ; const float pos = (float)posi[m];
                { float sn, cs; sincosf(pos * invr, &sn, &cs); tab[lane] = cs; tab[64 + lane] = sn; sincosf(pos * invn, &sn, &cs); if (lane < 32) { tab[128 + lane] = cs; tab[160 + lane] = sn; } }
                asm volatile("s_waitcnt lgkmcnt(0)" ::: "memory");
                {
                    const int isk = lane >> 5, L2 = lane & 31, hh = L2 >> 3, j8 = (L2 & 7) * 8; const bf16_t* src = zr + (isk ? ZC_RET_K : ZC_RET_Q) + hh * 128 + j8;
                    float x1[8], x2[8], cs[8], sn[8], o1[8], o2[8]; bf8_to_f(*(const u32x4*)src, x1); bf8_to_f(*(const u32x4*)(src + 64), x2);
                    { const f32x4 a = *(const LAS f32x4*)(tab + j8), c2 = *(const LAS f32x4*)(tab + j8 + 4), d = *(const LAS f32x4*)(tab + 64 + j8), e = *(const LAS f32x4*)(tab + 64 + j8 + 4);
                      cs[0] = a[0]; cs[1] = a[1]; cs[2] = a[2]; cs[3] = a[3]; cs[4] = c2[0]; cs[5] = c2[1]; cs[6] = c2[2]; cs[7] = c2[3]; sn[0] = d[0]; sn[1] = d[1]; sn[2] = d[2]; sn[3] = d[3]; sn[4] = e[0]; sn[5] = e[1]; sn[6] = e[2]; sn[7] = e[3]; }
                    const float sc = isk ? 0.08838834764831845f : 1.f;
#pragma unroll
                    for (int j = 0; j < 8; ++j) { o1[j] = (x1[j] * cs[j] - x2[j] * sn[j]) * sc; o2[j] = (x2[j] * cs[j] + x1[j] * sn[j]) * sc; }
                    bf16_t* dst = (isk ? kr : qr) + m * 512 + hh * 128 + j8; *(u32x4*)dst = pk8(o1); *(u32x4*)(dst + 64) = pk8(o2); }
                if (lane < 48) {
                    const int j8 = (lane & 3) * 8; const bf16_t* src; bf16_t* dst;
                    if (lane < 32) { const int hh = lane >> 2; src = zr + ZC_NSA_Q + hh * 64 + j8; dst = qn + m * 512 + hh * 64 + j8; }
                    else { const int L2 = lane & 7, g = L2 >> 2, isw = (lane >= 40); src = zr + (isw ? ZC_NSA_KW : ZC_NSA_KS) + g * 64 + j8; dst = kvg + (size_t)(isw ? 4 : 2) * KVG_SLAB + ((size_t)(b * 2 + g) * SEQ + (t0 + rr)) * 64 + j8; }
                    float x1[8], x2[8], cs[8], sn[8], o1[8], o2[8]; bf8_to_f(*(const u32x4*)src, x1); bf8_to_f(*(const u32x4*)(src + 32), x2);
                    { const f32x4 a = *(const LAS f32x4*)(tab + 128 + j8), c2 = *(const LAS f32x4*)(tab + 128 + j8 + 4), d = *(const LAS f32x4*)(tab + 160 + j8), e = *(const LAS f32x4*)(tab + 160 + j8 + 4);
                      cs[0] = a[0]; cs[1] = a[1]; cs[2] = a[2]; cs[3] = a[3]; cs[4] = c2[0]; cs[5] = c2[1]; cs[6] = c2[2]; cs[7] = c2[3]; sn[0] = d[0]; sn[1] = d[1]; sn[2] = d[2]; sn[3] = d[3]; sn[4] = e[0]; sn[5] = e[1]; sn[6] = e[2]; sn[7] = e[3]; }
#pragma unroll
                    for (int j = 0; j < 8; ++j) { o1[j] = x1[j] * cs[j] - x2[j] * sn[j]; o2[j] = x2[j] * cs[j] + x1[j] * sn[j]; }
                    *(u32x4*)dst = pk8(o1); *(u32x4*)(dst + 32) = pk8(o2); }
                asm volatile("s_waitcnt lgkmcnt(0)" ::: "memory");
            }
#pragma unroll
            for (int k = 0; k < 4; ++k) { const int c = lane + 64 * k, arr = c >> 7, gd = c & 127, g = gd >> 6, d = gd & 63; const bf16_t* src = z + (size_t)m0 * NZ + (arr ? ZC_NSA_VW : ZC_NSA_VS) + gd;
                unsigned short e[8];
#pragma unroll
                for (int rr = 0; rr < 8; ++rr) e[rr] = src[(size_t)rr * NZ];
                u32x4 w; w.x = (unsigned)e[0] | ((unsigned)e[1] << 16); w.y = (unsigned)e[2] | ((unsigned)e[3] << 16); w.z = (unsigned)e[4] | ((unsigned)e[5] << 16); w.w = (unsigned)e[6] | ((unsigned)e[7] << 16);
                *(u32x4*)(kvg + (size_t)(arr ? 5 : 3) * KVG_SLAB + ((size_t)(b * 2 + g) * 64 + d) * SEQ + t0) = w; }
        }
    }
}

__device__ __forceinline__ void ph_rw_prep2(const Params& p, int l, int bi, int nb) {
    PROLOG;
    const int tid_ = otid(), lane = tid_ & 63, gw = bi * 8 + (tid_ >> 6), NGW = nb * 8;
    const bf16_t* z = WSP(bf16_t, WS_Z); const float* lo = WSP(float, WS_LO); float* ops = WSP(float, WS_RWOPS);
    const float* mu = INL(12, 1984); constexpr size_t AS = (size_t)M * 512; const int c0 = 8 * lane;
    float mur[8], muk[8], muv[8], w0[8], a0[8], kkw[8], kaw[8];
    ld8(mu + c0, mur); ld8(mu + 512 + c0, muk); ld8(mu + 1024 + c0, muv); ld8(INL(13, 512) + c0, w0); ld8(INL(15, 512) + c0, a0); ld8(INL(18, 512) + c0, kkw); ld8(INL(19, 512) + c0, kaw);
    for (int m0 = gw; m0 < M; m0 += 2 * NGW) {
        u32x4 zc[2][3], zp[2][3]; float ld_[2][8], la_[2][8];
#pragma unroll
        for (int u = 0; u < 2; ++u) { const int m = m0 + u * NGW; if (m < M) { const bf16_t* zr = z + (size_t)m * NZ + ZC_RW_R + c0; const bool hp = (m & 4095) >= 1;
#pragma unroll
            for (int a = 0; a < 3; ++a) { zc[u][a] = *(const u32x4*)(zr + 512 * a); zp[u][a] = hp ? *(const u32x4*)(zr + 512 * a - NZ) : (u32x4){0u, 0u, 0u, 0u}; }
            ld8(lo + (size_t)m * 1536 + c0, ld_[u]); ld8(lo + (size_t)m * 1536 + 512 + c0, la_[u]); } }
#pragma unroll
        for (int u = 0; u < 2; ++u) { const int m = m0 + u * NGW; if (m < M) {
            float r[8], k[8], v[8], pr[8], pk[8], pv[8], w[8], kk[8], k2[8], bb[8];
            bf8_to_f(zc[u][0], r); bf8_to_f(zc[u][1], k); bf8_to_f(zc[u][2], v); bf8_to_f(zp[u][0], pr); bf8_to_f(zp[u][1], pk); bf8_to_f(zp[u][2], pv);
            float ss = 0.f;
#pragma unroll
            for (int j = 0; j < 8; ++j) { r[j] += (pr[j] - r[j]) * mur[j]; k[j] += (pk[j] - k[j]) * muk[j]; v[j] += (pv[j] - v[j]) * muv[j];
                w[j] = __expf(-0.6065306597126334f * sigmoidf_(w0[j] + ld_[u][j])); kk[j] = k[j] * kkw[j]; ss += kk[j] * kk[j]; }
            ss += __shfl_xor(ss, 1); ss += __shfl_xor(ss, 2); ss += __shfl_xor(ss, 4);
            const float rn = 1.f / fmaxf(sqrtf(ss), 1e-12f);
#pragma unroll
            for (int j = 0; j < 8; ++j) { const float a = sigmoidf_(a0[j] + la_[u][j]); kk[j] *= rn; k2[j] = k[j] * (1.f + (a - 1.f) * kaw[j]); bb[j] = kk[j] * a; }
            float* o = ops + (size_t)m * 512 + c0;
            st8(o, r); st8(o + AS, w); st8(o + 2 * AS, k2); st8(o + 3 * AS, v); st8(o + 4 * AS, kk); st8(o + 5 * AS, bb); } }
    }
}
#define DPP_ROR_ADD(x, n) (x) += __int_as_float(__builtin_amdgcn_update_dpp(0, __float_as_int(x), 0x120 + (n), 0xf, 0xf, false))
__device__ __forceinline__ float row_allreduce16(float x) { DPP_ROR_ADD(x, 8); DPP_ROR_ADD(x, 4); DPP_ROR_ADD(x, 2); DPP_ROR_ADD(x, 1); return x; }
__device__ __forceinline__ void ph_rw_scan(const Params& p, LAS unsigned char* lds, int bi, int nb) {
    PROLOG;
    const float* ops = WSP(float, WS_RWOPS); float* ys = WSP(float, WS_YSCAN); constexpr size_t AS = (size_t)M * 512; constexpr int TC = 32;
    LAS float* lop = (LAS float*)lds;
    LAS float* ybuf = (LAS float*)(lds + 6 * TC * 64 * 4);
    const int tid = otid(), wave = tid >> 6, lane = tid & 63, Rg = wave * 4 + (lane >> 4), Pc = lane & 15;
    for (int task = bi; task < 16; task += nb) {
        const int b = task >> 3, hh = task & 7;
        float s[4][4];
#pragma unroll
        for (int i = 0; i < 4; ++i)
#pragma unroll
            for (int j = 0; j < 4; ++j) s[i][j] = 0.f;
        for (int t0 = 0; t0 < SEQ; t0 += TC) {
            for (int idx = tid; idx < 6 * TC * 16; idx += 512) { const int arr = idx / (TC * 16), rem = idx % (TC * 16), tt = rem >> 4, c4 = rem & 15;
                *(LAS f32x4*)(lop + (arr * TC + tt) * 64 + c4 * 4) = *(const f32x4*)(ops + arr * AS + (size_t)(b * SEQ + t0 + tt) * 512 + hh * 64 + c4 * 4); }
            __syncthreads();
            if (wave < 4) {
                for (int tt = 0; tt < TC; ++tt) {
                    const f32x4 r4 = *(const LAS f32x4*)(lop + (0 * TC + tt) * 64 + Pc * 4), w4 = *(const LAS f32x4*)(lop + (1 * TC + tt) * 64 + Pc * 4), k4 = *(const LAS f32x4*)(lop + (2 * TC + tt) * 64 + Pc * 4);
                    const f32x4 v4 = *(const LAS f32x4*)(lop + (3 * TC + tt) * 64 + Rg * 4), kk4 = *(const LAS f32x4*)(lop + (4 * TC + tt) * 64 + Pc * 4), b4 = *(const LAS f32x4*)(lop + (5 * TC + tt) * 64 + Pc * 4);
                    float sa[4];
#pragma unroll
                    for (int i = 0; i < 4; ++i) { float x = -(s[i][0] * kk4[0] + s[i][1] * kk4[1] + s[i][2] * kk4[2] + s[i][3] * kk4[3]); sa[i] = row_allreduce16(x); }
                    float y[4];
#pragma unroll
                    for (int i = 0; i < 4; ++i) { float acc = 0.f;
#pragma unroll
                        for (int j = 0; j < 4; ++j) { s[i][j] = s[i][j] * w4[j] + sa[i] * b4[j] + v4[i] * k4[j]; acc += s[i][j] * r4[j]; }
                        y[i] = row_allreduce16(acc); }
                    if (Pc == 0) *(LAS f32x4*)(ybuf + tt * 64 + Rg * 4) = (f32x4){y[0], y[1], y[2], y[3]};
                }
            }
            __syncthreads();
            { const int tt = tid >> 4, c4 = tid & 15; *(f32x4*)(ys + (size_t)(b * SEQ + t0 + tt) * 512 + hh * 64 + c4 * 4) = *(const LAS f32x4*)(ybuf + tt * 64 + c4 * 4); }
        }
        __syncthreads();
    }
}

typedef short bf16x8s __attribute__((ext_vector_type(8)));
__device__ __forceinline__ bf16x8 zfrag() { return (bf16x8){0, 0, 0, 0, 0, 0, 0, 0}; }
__device__ __forceinline__ bf16x8 pack8(f32x4 a, f32x4 b) { u32x4 w; w.x = cvt_pk_bf16(a[0], a[1]); w.y = cvt_pk_bf16(a[2], a[3]); w.z = cvt_pk_bf16(b[0], b[1]); w.w = cvt_pk_bf16(b[2], b[3]); return __builtin_bit_cast(bf16x8, w); }
__device__ __forceinline__ void ph_rw_chunk(const Params& p, LAS unsigned char* lds, int bi, int nb) {
    PROLOG;
    const float* ops = WSP(float, WS_RWOPS); constexpr size_t AS = (size_t)M * 512;
    unsigned char* PFg = WSP(unsigned char, WS_RW_PF); unsigned char* QFg = WSP(unsigned char, WS_RW_QF); unsigned char* RFg = WSP(unsigned char, WS_RW_RF); unsigned char* Y0g = WSP(unsigned char, WS_RW_Y0F);
    const int tid = otid(), wave = tid >> 6, lane = tid & 63, r = lane & 15, q = lane >> 4;
    if (wave >= 4) return;
    LAS unsigned char* L = lds + wave * 30720;
    LAS bf16_t* BE = (LAS bf16_t*)(L);
    LAS bf16_t* KA = (LAS bf16_t*)(L + 2048);
    LAS bf16_t* AL = (LAS bf16_t*)(L + 4096);
    LAS bf16_t* RHO = (LAS bf16_t*)(L + 6144);
    LAS bf16_t* ALT = (LAS bf16_t*)(L + 8192);
    LAS bf16_t* BEPT = (LAS bf16_t*)(L + 10240);
    LAS bf16_t* KAPT = (LAS bf16_t*)(L + 12288);
    LAS bf16_t* VT = (LAS bf16_t*)(L + 14336);
    LAS bf16_t* RHOT = (LAS bf16_t*)(L + 16384);
    LAS bf16_t* OM = (LAS bf16_t*)(L + 18432);
    LAS bf16_t* VBm = (LAS bf16_t*)(L + 20480);
    LAS bf16_t* MU = (LAS bf16_t*)(L + 22528);
    LAS float* Af = (LAS float*)(L + 24576);
    LAS bf16_t* NT = (LAS bf16_t*)(L + 25600);
    LAS bf16_t* BmT = (LAS bf16_t*)(L + 26112);
    LAS bf16_t* CbT = (LAS bf16_t*)(L + 26624);
    LAS bf16_t* CkT = (LAS bf16_t*)(L + 27136);
    LAS float* GT = (LAS float*)(L + 27648);
    const int gw = bi * 4 + wave, NGW = nb * 4;
    for (int task = gw; task < 4096; task += NGW) {
        const int bh = task >> 8, n = task & 255, b = bh >> 3, hh = bh & 7; const size_t i0 = ((size_t)b * SEQ + 16 * n) * 512 + hh * 64 + lane;
        { float g = 1.f; float be[16], ka[16];
#pragma unroll
          for (int t = 0; t < 16; ++t) { const size_t ix = i0 + (size_t)t * 512;
              const float rr = ops[ix], ww = ops[AS + ix], k2 = ops[2 * AS + ix], vv = ops[3 * AS + ix], kk = ops[4 * AS + ix], bb = ops[5 * AS + ix];
              const float gprev = g; g *= ww; const float al = gprev * kk, rg = 1.f / g; be[t] = bb * rg; ka[t] = k2 * rg; const float rho = g * rr;
              BE[t * 64 + lane] = f2bf(be[t]); KA[t * 64 + lane] = f2bf(ka[t]); AL[t * 64 + lane] = f2bf(al); RHO[t * 64 + lane] = f2bf(rho);
              ALT[lane * 16 + t] = f2bf(al); VT[lane * 16 + t] = f2bf(vv); RHOT[lane * 16 + t] = f2bf(rho); }
          GT[lane] = g;
#pragma unroll
          for (int t = 0; t < 16; ++t) { BEPT[lane * 16 + t] = f2bf(be[t] * g); KAPT[lane * 16 + t] = f2bf(ka[t] * g); } }
        asm volatile("s_waitcnt lgkmcnt(0)" ::: "memory");
        { bf16x8 xb[2], xk[2], ya[2], yr[2];
#pragma unroll
          for (int ks = 0; ks < 2; ++ks) { xb[ks] = *(const LAS bf16x8*)(BE + r * 64 + 32 * ks + 8 * q); xk[ks] = *(const LAS bf16x8*)(KA + r * 64 + 32 * ks + 8 * q);
              ya[ks] = *(const LAS bf16x8*)(AL + r * 64 + 32 * ks + 8 * q); yr[ks] = *(const LAS bf16x8*)(RHO + r * 64 + 32 * ks + 8 * q); }
          f32x4 A = {0.f, 0.f, 0.f, 0.f}, Bm = A, Cb = A, Ck = A;
#pragma unroll
          for (int ks = 0; ks < 2; ++ks) { A = mma16(A, xb[ks], ya[ks]); Bm = mma16(Bm, xk[ks], ya[ks]); Cb = mma16(Cb, xb[ks], yr[ks]); Ck = mma16(Ck, xk[ks], yr[ks]); }
#pragma unroll
          for (int jj = 0; jj < 4; ++jj) { const int c = 4 * q + jj; const bool lt = r < c, le = r <= c;
              A[jj] = lt ? A[jj] : 0.f; BmT[c * 16 + r] = f2bf(lt ? Bm[jj] : 0.f); CbT[c * 16 + r] = f2bf(le ? Cb[jj] : 0.f); CkT[c * 16 + r] = f2bf(le ? Ck[jj] : 0.f); }
          *(LAS f32x4*)(Af + r * 16 + 4 * q) = A; }
        asm volatile("s_waitcnt lgkmcnt(0)" ::: "memory");
        { float nrow[16];
#pragma unroll
          for (int i = 0; i < 16; ++i) { float sacc = (i == r) ? 1.f : 0.f;
#pragma unroll
              for (int j = 0; j < i; ++j) sacc -= nrow[j] * Af[j * 16 + i];
              nrow[i] = sacc; }
          if (q == 0) {
#pragma unroll
              for (int i = 0; i < 16; ++i) NT[i * 16 + r] = f2bf(nrow[i]); } }
        asm volatile("s_waitcnt lgkmcnt(0)" ::: "memory");
        const bool lo = q < 2; const int q2 = q & 1;
        { const bf16x8 bN = lo ? *(const LAS bf16x8*)(NT + r * 16 + 8 * q2) : zfrag(); const bf16x8 bB = lo ? *(const LAS bf16x8*)(BmT + r * 16 + 8 * q2) : zfrag();
#pragma unroll
          for (int mt = 0; mt < 4; ++mt) { const int row = 16 * mt + r;
              const bf16x8 aA = lo ? *(const LAS bf16x8*)(ALT + row * 16 + 8 * q2) : zfrag(); const bf16x8 aV = lo ? *(const LAS bf16x8*)(VT + row * 16 + 8 * q2) : zfrag();
              f32x4 om = mma16((f32x4){0.f, 0.f, 0.f, 0.f}, aA, bN), vb = mma16((f32x4){0.f, 0.f, 0.f, 0.f}, aV, bB);
              u32x2 w; w.x = cvt_pk_bf16(-om[0], -om[1]); w.y = cvt_pk_bf16(-om[2], -om[3]); *(LAS u32x2*)(OM + row * 16 + 4 * q) = w;
              w.x = cvt_pk_bf16(vb[0], vb[1]); w.y = cvt_pk_bf16(vb[2], vb[3]); *(LAS u32x2*)(VBm + row * 16 + 4 * q) = w; }
          asm volatile("s_waitcnt lgkmcnt(0)" ::: "memory");
#pragma unroll
          for (int mt = 0; mt < 4; ++mt) { const int row = 16 * mt + r; const bf16x8 aB = lo ? *(const LAS bf16x8*)(VBm + row * 16 + 8 * q2) : zfrag();
              f32x4 mu = mma16((f32x4){0.f, 0.f, 0.f, 0.f}, aB, bN);
              u32x2 w; w.x = cvt_pk_bf16(-mu[0], -mu[1]); w.y = cvt_pk_bf16(-mu[2], -mu[3]); *(LAS u32x2*)(MU + row * 16 + 4 * q) = w; } }
        asm volatile("s_waitcnt lgkmcnt(0)" ::: "memory");
        const size_t rec = (size_t)bh * 256 + n;
        { bf16x8 bO[4];
#pragma unroll
          for (int nt = 0; nt < 4; ++nt) bO[nt] = lo ? *(const LAS bf16x8*)(OM + (16 * nt + r) * 16 + 8 * q2) : zfrag();
#pragma unroll
          for (int mt = 0; mt < 4; ++mt) { const bf16x8 a = lo ? *(const LAS bf16x8*)(BEPT + (16 * mt + r) * 16 + 8 * q2) : zfrag(); f32x4 acc[4];
#pragma unroll
              for (int nt = 0; nt < 4; ++nt) acc[nt] = mma16((f32x4){0.f, 0.f, 0.f, 0.f}, a, bO[nt]);
              { const float gd = GT[16 * mt + r];
#pragma unroll
                for (int jj = 0; jj < 4; ++jj) if (4 * q + jj == r) acc[mt][jj] += gd; }
#pragma unroll
              for (int ks = 0; ks < 2; ++ks) *(bf16x8*)(PFg + rec * 8192 + (size_t)((mt * 2 + ks) * 64 + lane) * 16) = pack8(acc[2 * ks], acc[2 * ks + 1]); }
          { bf16x8 a; if (lo) a = *(const LAS bf16x8*)(CbT + r * 16 + 8 * q2); else { a = zfrag();
#pragma unroll
                for (int e = 0; e < 8; ++e) if (8 * q2 + e == r) a[e] = (short)0x3f80; }
            f32x4 acc[4];
#pragma unroll
            for (int nt = 0; nt < 4; ++nt) { const bf16x8 bb = lo ? bO[nt] : *(const LAS bf16x8*)(RHOT + (16 * nt + r) * 16 + 8 * q2); acc[nt] = mma16((f32x4){0.f, 0.f, 0.f, 0.f}, a, bb); }
#pragma unroll
            for (int ks = 0; ks < 2; ++ks) *(bf16x8*)(RFg + rec * 2048 + (size_t)(ks * 64 + lane) * 16) = pack8(acc[2 * ks], acc[2 * ks + 1]); } }
        { bf16x8 bQ[4];
#pragma unroll
          for (int nt = 0; nt < 4; ++nt) bQ[nt] = *(const LAS bf16x8*)((lo ? BEPT : KAPT) + (16 * nt + r) * 16 + 8 * q2);
          const bf16x8 bY = *(const LAS bf16x8*)((lo ? CbT : CkT) + r * 16 + 8 * q2);
#pragma unroll
          for (int mt = 0; mt < 4; ++mt) { const bf16x8 a = *(const LAS bf16x8*)((lo ? MU : VT) + (16 * mt + r) * 16 + 8 * q2);
#pragma unroll
              for (int nt = 0; nt < 4; ++nt) { const f32x4 acc = mma16((f32x4){0.f, 0.f, 0.f, 0.f}, a, bQ[nt]); *(f32x4*)(QFg + rec * 16384 + (size_t)((mt * 4 + nt) * 64 + lane) * 16) = acc; }
              const f32x4 y0 = mma16((f32x4){0.f, 0.f, 0.f, 0.f}, a, bY); *(f32x4*)(Y0g + rec * 4096 + (size_t)(mt * 64 + lane) * 16) = y0; } }
        asm volatile("s_waitcnt lgkmcnt(0)" ::: "memory");
    }
}
__device__ __forceinline__ void ph_rw_serial(const Params& p, LAS unsigned char* lds, int bi, int nb) {
    PROLOG;
    constexpr int NS = 8, DD = 6, SLOT = 16384;
    const unsigned char* PFg = WSP(unsigned char, WS_RW_PF); const unsigned char* QFg = WSP(unsigned char, WS_RW_QF); const unsigned char* RFg = WSP(unsigned char, WS_RW_RF); const unsigned char* Y0g = WSP(unsigned char, WS_RW_Y0F);
    float* ys = WSP(float, WS_YSCAN);
    const int tid = otid(), wave = __builtin_amdgcn_readfirstlane(tid >> 6), lane = tid & 63, l15 = lane & 15, q = lane >> 4;
    for (int task = bi; task < 64; task += nb) {
        const int bh = task >> 2, w = task & 3, b = bh >> 3, hh = bh & 7;
        const unsigned char* gp[3]; size_t gs[3];
#pragma unroll
        for (int k = 0; k < 3; ++k) { const int pc = 3 * (wave - 1) + k;
            if (pc < 8) { gp[k] = PFg + (size_t)bh * 256 * 8192 + pc * 1024; gs[k] = 8192; }
            else if (pc < 12) { gp[k] = QFg + (size_t)bh * 256 * 16384 + w * 4096 + (pc - 8) * 1024; gs[k] = 16384; }
            else if (pc < 14) { gp[k] = RFg + (size_t)bh * 256 * 2048 + (pc - 12) * 1024; gs[k] = 2048; }
            else { gp[k] = Y0g + (size_t)bh * 256 * 4096 + w * 1024; gs[k] = 4096; } }
        const bool loader = wave >= 1 && wave <= 5; const int pofs = 3 * (wave - 1) * 1024;
#define RW_ISSUE(step) do { const int c_ = (step) < 256 ? (step) : 255; LAS unsigned char* sl_ = lds + ((step) % NS) * SLOT + pofs; \
        __builtin_amdgcn_global_load_lds((const unsigned*)(gp[0] + (size_t)c_ * gs[0] + lane * 16), (LAS unsigned*)(sl_), 16, 0, 0); \
        __builtin_amdgcn_global_load_lds((const unsigned*)(gp[1] + (size_t)c_ * gs[1] + lane * 16), (LAS unsigned*)(sl_ + 1024), 16, 0, 0); \
        __builtin_amdgcn_global_load_lds((const unsigned*)(gp[2] + (size_t)c_ * gs[2] + lane * 16), (LAS unsigned*)(sl_ + 2048), 16, 0, 0); \
        asm volatile("" ::: "memory"); } while (0)
        do { asm volatile("" ::: "memory"); __builtin_amdgcn_s_barrier(); asm volatile("" ::: "memory"); } while (0);
        if (loader) { for (int s0 = 0; s0 < DD; ++s0) RW_ISSUE(s0);
            asm volatile("s_waitcnt vmcnt(15)" ::: "memory"); }
        do { asm volatile("" ::: "memory"); __builtin_amdgcn_s_barrier(); asm volatile("" ::: "memory"); } while (0);
        f32x4 S[4];
#pragma unroll
        for (int mt = 0; mt < 4; ++mt) S[mt] = (f32x4){0.f, 0.f, 0.f, 0.f};
        for (int n = 0; n < 256; ++n) {
            if (loader) { RW_ISSUE(n + DD); asm volatile("s_waitcnt vmcnt(15)" ::: "memory"); }
            else if (wave == 0) {
                const LAS unsigned char* sl = lds + (n % NS) * SLOT;
                bf16x8 sf[2]; sf[0] = pack8(S[0], S[1]); sf[1] = pack8(S[2], S[3]);
                f32x4 y = *(const LAS f32x4*)(sl + 14336 + lane * 16);
#pragma unroll
                for (int ks = 0; ks < 2; ++ks) y = __builtin_amdgcn_mfma_f32_16x16x32_bf16(*(const LAS bf16x8*)(sl + 12288 + (ks * 64 + lane) * 16), sf[ks], y, 0, 0, 0);
#pragma unroll
                for (int mt = 0; mt < 4; ++mt) { f32x4 a = *(const LAS f32x4*)(sl + 8192 + (mt * 64 + lane) * 16);
#pragma unroll
                    for (int ks = 0; ks < 2; ++ks) a = __builtin_amdgcn_mfma_f32_16x16x32_bf16(*(const LAS bf16x8*)(sl + ((mt * 2 + ks) * 64 + lane) * 16), sf[ks], a, 0, 0, 0);
                    S[mt] = a; }
                float* yo = ys + ((size_t)b * SEQ + 16 * n + 4 * q) * 512 + hh * 64 + 16 * w + l15;
#pragma unroll
                for (int jj = 0; jj < 4; ++jj) yo[(size_t)jj * 512] = y[jj];
                asm volatile("s_waitcnt lgkmcnt(0)" ::: "memory");
            }
            do { asm volatile("" ::: "memory"); __builtin_amdgcn_s_barrier(); asm volatile("" ::: "memory"); } while (0);
        }
        asm volatile("s_waitcnt vmcnt(0)" ::: "memory");
        do { asm volatile("" ::: "memory"); __builtin_amdgcn_s_barrier(); asm volatile("" ::: "memory"); } while (0);
#undef RW_ISSUE
    }
}

__device__ __forceinline__ void ph_rw_post(const Params& p, int l, int bi, int nb) {
    PROLOG;
    const int tid_ = otid(), lane = tid_ & 63, gw = bi * 8 + (tid_ >> 6), NGW = nb * 8;
    const float* ops = WSP(float, WS_RWOPS); const float* ys = WSP(float, WS_YSCAN); const float* lo = WSP(float, WS_LO); bf16_t* oall = WSP(bf16_t, WS_OALL);
    constexpr size_t AS = (size_t)M * 512; const int c0 = 8 * lane;
    float rk[8], lg[8], lb[8]; ld8(INL(20, 512) + c0, rk); ld8(INL(21, 512) + c0, lg); ld8(INL(22, 512) + c0, lb);
    for (int m0 = gw; m0 < M; m0 += 2 * NGW) {
        float y[2][8], r[2][8], k2[2][8], v[2][8], g[2][8];
#pragma unroll
        for (int u = 0; u < 2; ++u) { const int m = m0 + u * NGW; if (m < M) { const size_t o = (size_t)m * 512 + c0;
            ld8(ys + o, y[u]); ld8(ops + o, r[u]); ld8(ops + 2 * AS + o, k2[u]); ld8(ops + 3 * AS + o, v[u]); ld8(lo + (size_t)m * 1536 + 1024 + c0, g[u]); } }
#pragma unroll
        for (int u = 0; u < 2; ++u) { const int m = m0 + u * NGW; if (m < M) {
            float s1 = 0.f, sb = 0.f;
#pragma unroll
            for (int j = 0; j < 8; ++j) { s1 += y[u][j]; sb += r[u][j] * k2[u][j] * rk[j]; }
            s1 += __shfl_xor(s1, 1); s1 += __shfl_xor(s1, 2); s1 += __shfl_xor(s1, 4); sb += __shfl_xor(sb, 1); sb += __shfl_xor(sb, 2); sb += __shfl_xor(sb, 4);
            const float mean = s1 * (1.f / 64.f); float s2 = 0.f;
#pragma unroll
            for (int j = 0; j < 8; ++j) { y[u][j] -= mean; s2 += y[u][j] * y[u][j]; }
            s2 += __shfl_xor(s2, 1); s2 += __shfl_xor(s2, 2); s2 += __shfl_xor(s2, 4);
            const float rstd = rsqrtf(s2 * (1.f / 64.f) + 64e-5f); float o8[8];
#pragma unroll
            for (int j = 0; j < 8; ++j) o8[j] = (y[u][j] * rstd * lg[j] + lb[j] + sb * v[u][j]) * g[u][j];
            u32x4 w; w.x = cvt_pk_bf16(o8[0], o8[1]); w.y = cvt_pk_bf16(o8[2], o8[3]); w.z = cvt_pk_bf16(o8[4], o8[5]); w.w = cvt_pk_bf16(o8[6], o8[7]);
            *(u32x4*)(oall + (size_t)m * NBR + 512 + c0) = w; } }
    }
}

__device__ __forceinline__ float ret_lg(int hh) { return logf(1.f - exp2f(-5.f - (float)hh)); }
__device__ __forceinline__ void ph_ret_u(const Params& p, LAS unsigned char* lds, int bi, int nb) {
    PROLOG;
    const bf16_t* z = WSP(bf16_t, WS_Z); const bf16_t* kr = WSP(bf16_t, WS_KR); float* ub = WSP(float, WS_UBUF);
    LAS bf16_t* Vt = (LAS bf16_t*)lds;
    LAS bf16_t* Kt = (LAS bf16_t*)(lds + 256 * 136 * 2);
    const int tid = otid(), wave = tid >> 6, lane = tid & 63, r = lane & 15, q = lane >> 4;
    for (int task = bi; task < 256; task += nb) {
        const int b = task >> 7, hh = (task >> 5) & 3, n = task & 31; const float lgh = ret_lg(hh); const size_t m0 = (size_t)b * SEQ + n * 128;
        __syncthreads();
        for (int idx = tid; idx < 128 * 32; idx += 512) { const int mm = idx & 127, ch = idx >> 7; const u32x4 w = *(const u32x4*)(z + (m0 + mm) * NZ + ZC_RET_V + hh * 256 + ch * 8);
            const unsigned ww[4] = {w.x, w.y, w.z, w.w};
#pragma unroll
            for (int i = 0; i < 4; ++i) { Vt[(ch * 8 + 2 * i) * 136 + mm] = (bf16_t)(ww[i] & 0xffffu); Vt[(ch * 8 + 2 * i + 1) * 136 + mm] = (bf16_t)(ww[i] >> 16); } }
        for (int idx = tid; idx < 128 * 16; idx += 512) { const int mm = idx & 127, ch = idx >> 7; const float zeta = __expf((float)(127 - mm) * lgh);
            const u32x4 w = *(const u32x4*)(kr + (m0 + mm) * 512 + hh * 128 + ch * 8); const unsigned ww[4] = {w.x, w.y, w.z, w.w};
#pragma unroll
            for (int i = 0; i < 4; ++i) { Kt[(ch * 8 + 2 * i) * 136 + mm] = f2bf(__uint_as_float(ww[i] << 16) * zeta); Kt[(ch * 8 + 2 * i + 1) * 136 + mm] = f2bf(__uint_as_float(ww[i] & 0xffff0000u) * zeta); } }
        __syncthreads();
        float* uo = ub + (size_t)task * 256 * 128;
#pragma unroll
        for (int et = 0; et < 2; ++et) { const int e0 = 16 * (2 * wave + et); bf16x8 a[4];
#pragma unroll
            for (int ks = 0; ks < 4; ++ks) a[ks] = *(const LAS bf16x8*)(Vt + (e0 + r) * 136 + 32 * ks + 8 * q);
#pragma unroll
            for (int dt = 0; dt < 8; ++dt) { f32x4 acc = {0.f, 0.f, 0.f, 0.f};
#pragma unroll
                for (int ks = 0; ks < 4; ++ks) { const bf16x8 bb = *(const LAS bf16x8*)(Kt + (16 * dt + r) * 136 + 32 * ks + 8 * q); acc = mma16(acc, a[ks], bb); }
                *(f32x4*)(uo + (size_t)(e0 + r) * 128 + 16 * dt + 4 * q) = acc; } }
    }
}
__device__ __forceinline__ void ph_ret_scan(const Params& p, int bi, int nb) {
    PROLOG;
    const float* ub = WSP(float, WS_UBUF); bf16_t* rp = WSP(bf16_t, WS_RPREV);
    const int gt = bi * 512 + otid(), NT = nb * 512;
    for (int i = gt; i < 8 * 8192; i += NT) { const int bh = i >> 13, e4 = i & 8191, hh = bh & 3; const float cd = __expf(128.f * ret_lg(hh)); f32x4 st = {0.f, 0.f, 0.f, 0.f};
        for (int n0 = 0; n0 < 32; n0 += 8) { f32x4 uu[8];
#pragma unroll
            for (int k = 0; k < 8; ++k) uu[k] = *(const f32x4*)(ub + ((size_t)(bh * 32 + n0 + k) * 8192 + e4) * 4);
#pragma unroll
            for (int k = 0; k < 8; ++k) { u32x2 w; w.x = cvt_pk_bf16(st[0], st[1]); w.y = cvt_pk_bf16(st[2], st[3]); *(u32x2*)(rp + ((size_t)(bh * 32 + n0 + k) * 8192 + e4) * 4) = w; st = st * cd + uu[k]; } } }
}
__device__ __forceinline__ void ph_ret_out(const Params& p, LAS unsigned char* lds, int bi, int nb) {
    PROLOG;
    const bf16_t* z = WSP(bf16_t, WS_Z); const bf16_t* qr = WSP(bf16_t, WS_QR); const bf16_t* kr = WSP(bf16_t, WS_KR); const bf16_t* rp = WSP(bf16_t, WS_RPREV); bf16_t* oall = WSP(bf16_t, WS_OALL);
    LAS bf16_t* Vt = (LAS bf16_t*)lds;
    const int tid = otid(), wave = tid >> 6, lane = tid & 63, r = lane & 15, q = lane >> 4;
    LAS bf16_t* Sc = (LAS bf16_t*)(lds + 256 * 136 * 2) + wave * 16 * 136;
    for (int task = bi; task < 256; task += nb) {
        const int b = task >> 7, hh = (task >> 5) & 3, n = task & 31; const float lgh = ret_lg(hh); const size_t m0 = (size_t)b * SEQ + n * 128;
        __syncthreads();
        for (int idx = tid; idx < 128 * 32; idx += 512) { const int mm = idx & 127, ch = idx >> 7; const u32x4 w = *(const u32x4*)(z + (m0 + mm) * NZ + ZC_RET_V + hh * 256 + ch * 8);
            const unsigned ww[4] = {w.x, w.y, w.z, w.w};
#pragma unroll
            for (int i = 0; i < 4; ++i) { Vt[(ch * 8 + 2 * i) * 136 + mm] = (bf16_t)(ww[i] & 0xffffu); Vt[(ch * 8 + 2 * i + 1) * 136 + mm] = (bf16_t)(ww[i] >> 16); } }
        __syncthreads();
        const int c = 16 * wave + r; const size_t mrow = m0 + c;
        bf16x8 qa[4];
#pragma unroll
        for (int ks = 0; ks < 4; ++ks) qa[ks] = ldfrag(qr + mrow * 512 + hh * 128 + 32 * ks + 8 * q);
#pragma unroll
        for (int mt = 0; mt < 8; ++mt) { f32x4 s = {0.f, 0.f, 0.f, 0.f};
#pragma unroll
            for (int ks = 0; ks < 4; ++ks) s = mma16(s, qa[ks], ldfrag(kr + (m0 + 16 * mt + r) * 512 + hh * 128 + 32 * ks + 8 * q));
            float v[4];
#pragma unroll
            for (int j = 0; j < 4; ++j) { const int mm = 16 * mt + 4 * q + j; v[j] = (c >= mm) ? s[j] * __expf((float)(c - mm) * lgh) : 0.f; }
            u32x2 w; w.x = cvt_pk_bf16(v[0], v[1]); w.y = cvt_pk_bf16(v[2], v[3]); *(LAS u32x2*)(Sc + r * 136 + 16 * mt + 4 * q) = w; }
        asm volatile("s_waitcnt lgkmcnt(0)" ::: "memory");
        const float xi = __expf((float)(c + 1) * lgh);
        const bf16_t* rpc = rp + (size_t)task * 256 * 128;
        f32x4 acc[16]; bf16x8 sa[4];
#pragma unroll
        for (int ks = 0; ks < 4; ++ks) sa[ks] = *(const LAS bf16x8*)(Sc + r * 136 + 32 * ks + 8 * q);
#pragma unroll
        for (int et = 0; et < 16; ++et) { f32x4 a = {0.f, 0.f, 0.f, 0.f};
#pragma unroll
            for (int ks = 0; ks < 4; ++ks) a = mma16(a, qa[ks], ldfrag(rpc + (size_t)(16 * et + r) * 128 + 32 * ks + 8 * q));
            a = a * xi;
#pragma unroll
            for (int ks = 0; ks < 4; ++ks) a = mma16(a, sa[ks], *(const LAS bf16x8*)(Vt + (16 * et + r) * 136 + 32 * ks + 8 * q));
            acc[et] = a; }
        float s1 = 0.f;
#pragma unroll
        for (int et = 0; et < 16; ++et) s1 += acc[et][0] + acc[et][1] + acc[et][2] + acc[et][3];
        s1 += __shfl_xor(s1, 16); s1 += __shfl_xor(s1, 32); const float mean = s1 * (1.f / 256.f); float s2 = 0.f;
#pragma unroll
        for (int et = 0; et < 16; ++et) { acc[et] = acc[et] - mean; s2 += acc[et][0] * acc[et][0] + acc[et][1] * acc[et][1] + acc[et][2] * acc[et][2] + acc[et][3] * acc[et][3]; }
        s2 += __shfl_xor(s2, 16); s2 += __shfl_xor(s2, 32); const float rstd = rsqrtf(s2 * (1.f / 256.f) + 1e-5f);
#pragma unroll
        for (int et = 0; et < 16; ++et) { const int e = 16 * et + 4 * q; const u32x2 gw = *(const u32x2*)(z + mrow * NZ + ZC_RET_G + hh * 256 + e);
            const float g0 = __uint_as_float(gw.x << 16), g1 = __uint_as_float(gw.x & 0xffff0000u), g2 = __uint_as_float(gw.y << 16), g3 = __uint_as_float(gw.y & 0xffff0000u);
            u32x2 w; w.x = cvt_pk_bf16(acc[et][0] * rstd * g0 * sigmoidf_(g0), acc[et][1] * rstd * g1 * sigmoidf_(g1)); w.y = cvt_pk_bf16(acc[et][2] * rstd * g2 * sigmoidf_(g2), acc[et][3] * rstd * g3 * sigmoidf_(g3));
            *(u32x2*)(oall + mrow * NBR + 1024 + hh * 256 + e) = w; }
    }
}

__device__ __forceinline__ void ph_cmp2(const Params& p, int l, LAS unsigned char* lds, int bi, int nb) {
    PROLOG;
    const bf16_t* hid = WSP(bf16_t, WS_HID); bf16_t* kc = WSP(bf16_t, WS_KCMP); bf16_t* vt = WSP(bf16_t, WS_VCMPT); const int* posi = (const int*)inp(p, 2);
    const float* w2 = INL(25, 2 * 256 * 64);
    const int tid = otid(), wave = tid >> 6, lane = tid & 63, r = lane & 15, q = lane >> 4;
    LAS bf16_t* W2T = (LAS bf16_t*)lds;
    if (bi * 8 < 128) {
        for (int i = tid; i < 2 * 256 * 64; i += 512) { const int ii = i >> 14, k = (i >> 6) & 255, d = i & 63; W2T[(ii * 64 + d) * 264 + k] = f2bf(w2[i]); }
        __syncthreads();
        for (int task = bi * 8 + wave; task < 128; task += nb * 8) {
            const int ii = task >> 6, R0 = (task & 63) * 16, row = R0 + r, bg = row >> 8, c = row & 255;
            const bf16_t* hr = hid + ((size_t)ii * 1024 + row) * 256 + 8 * q;
            f32x4 acc[4];
#pragma unroll
            for (int dt = 0; dt < 4; ++dt) acc[dt] = (f32x4){0.f, 0.f, 0.f, 0.f};
#pragma unroll
            for (int ks = 0; ks < 8; ++ks) { const bf16x8 a = ldfrag(hr + 32 * ks);
#pragma unroll
                for (int dt = 0; dt < 4; ++dt) acc[dt] = mma16(acc[dt], a, *(const LAS bf16x8*)(W2T + (ii * 64 + 16 * dt + r) * 264 + 32 * ks + 8 * q)); }
            if (ii == 0) {
                const float pos = (float)posi[(bg >> 1) * SEQ + 16 * (c < 255 ? c : 254) + 31];
#pragma unroll
                for (int dt = 0; dt < 2; ++dt) { float o1[4], o2[4];
#pragma unroll
                    for (int jj = 0; jj < 4; ++jj) { const int d = 16 * dt + 4 * q + jj; const float inv = __expf(-(float)d * (9.210340371976184f / 32.f)); float sn, cs; sincosf(pos * inv, &sn, &cs);
                        const float x1 = acc[dt][jj], x2 = acc[dt + 2][jj]; o1[jj] = (c < 255) ? x1 * cs - x2 * sn : 0.f; o2[jj] = (c < 255) ? x2 * cs + x1 * sn : 0.f; }
                    u32x2 w; w.x = cvt_pk_bf16(o1[0], o1[1]); w.y = cvt_pk_bf16(o1[2], o1[3]); *(u32x2*)(kc + (size_t)row * 64 + 16 * dt + 4 * q) = w;
                    w.x = cvt_pk_bf16(o2[0], o2[1]); w.y = cvt_pk_bf16(o2[2], o2[3]); *(u32x2*)(kc + (size_t)row * 64 + 32 + 16 * dt + 4 * q) = w; }
            } else {
#pragma unroll
                for (int dt = 0; dt < 4; ++dt)
#pragma unroll
                    for (int jj = 0; jj < 4; ++jj) vt[((size_t)bg * 64 + 16 * dt + 4 * q + jj) * 256 + c] = f2bf(c < 255 ? acc[dt][jj] : 0.f);
            }
        }
    }
}
__device__ __forceinline__ void ph_nsa_cmp(const Params& p, LAS unsigned char* lds, int bi, int nb) {
    PROLOG;
    const bf16_t* qn = WSP(bf16_t, WS_QN); const bf16_t* kc = WSP(bf16_t, WS_KCMP); const bf16_t* vt = WSP(bf16_t, WS_VCMPT); bf16_t* ocmp = WSP(bf16_t, WS_OCMP); u64* selm = WSP(u64, WS_SELM);
    const int tid = otid(), wave = tid >> 6, lane = tid & 63, r = lane & 15, q = lane >> 4, gw = bi * 8 + wave, NGW = nb * 8;
    LAS bf16_t* Pl = (LAS bf16_t*)(lds + wave * 16384);
    LAS float* Il = (LAS float*)(lds + wave * 16384 + 16 * 264 * 2);
    for (int task = gw; task < 1024; task += NGW) {
        const int bg = task >> 8, b = bg >> 1, g = bg & 1, tt = task & 255, t0 = 16 * tt, t = t0 + r; const size_t mrow = (size_t)b * SEQ + t;
        const int cmax = t >= 31 ? (t - 31) >> 4 : -1;
#pragma unroll
        for (int ct = 0; ct < 16; ++ct) Il[r * 64 + 4 * ct + q] = 0.f;
        for (int hh = 0; hh < 4; ++hh) {
            const int hd = (g * 4 + hh) * 64;
            bf16x8 qa[2]; qa[0] = ldfrag(qn + mrow * 512 + hd + 8 * q); qa[1] = ldfrag(qn + mrow * 512 + hd + 32 + 8 * q);
            f32x4 s[16]; float mx = -1e30f;
#pragma unroll
            for (int ct = 0; ct < 16; ++ct) { f32x4 a = {0.f, 0.f, 0.f, 0.f}; const bf16_t* kp = kc + ((size_t)bg * 256 + 16 * ct + r) * 64 + 8 * q;
                a = mma16(a, qa[0], ldfrag(kp)); a = mma16(a, qa[1], ldfrag(kp + 32));
#pragma unroll
                for (int j = 0; j < 4; ++j) { const int c = 16 * ct + 4 * q + j; a[j] = (c <= cmax) ? a[j] * 0.125f : -1e30f; mx = fmaxf(mx, a[j]); }
                s[ct] = a; }
            mx = fmaxf(mx, __shfl_xor(mx, 16)); mx = fmaxf(mx, __shfl_xor(mx, 32));
            float sum = 0.f;
#pragma unroll
            for (int ct = 0; ct < 16; ++ct)
#pragma unroll
                for (int j = 0; j < 4; ++j) { const int c = 16 * ct + 4 * q + j; const float e = (c <= cmax) ? __expf(s[ct][j] - mx) : 0.f; s[ct][j] = e; sum += e; }
            sum += __shfl_xor(sum, 16); sum += __shfl_xor(sum, 32);
            const float rinv = 1.f / fmaxf(sum, 1e-30f);
            float yprev = 0.f;
#pragma unroll
            for (int ct = 0; ct < 16; ++ct) { s[ct] = s[ct] * rinv;
                const float y = __shfl(s[ct][3], (lane + 48) & 63);
                const float prev = q > 0 ? y : yprev; yprev = y;
                Il[r * 64 + 4 * ct + q] += (s[ct][0] + s[ct][1]) + (s[ct][2] + s[ct][3]) + prev;
                u32x2 w; w.x = cvt_pk_bf16(s[ct][0], s[ct][1]); w.y = cvt_pk_bf16(s[ct][2], s[ct][3]); *(LAS u32x2*)(Pl + r * 264 + 16 * ct + 4 * q) = w; }
            asm volatile("s_waitcnt lgkmcnt(0)" ::: "memory");
            f32x4 o[4];
#pragma unroll
            for (int dt = 0; dt < 4; ++dt) o[dt] = (f32x4){0.f, 0.f, 0.f, 0.f};
#pragma unroll
            for (int ks = 0; ks < 8; ++ks) { const bf16x8 pa = *(const LAS bf16x8*)(Pl + r * 264 + 32 * ks + 8 * q);
#pragma unroll
                for (int dt = 0; dt < 4; ++dt) o[dt] = mma16(o[dt], pa, ldfrag(vt + ((size_t)bg * 64 + 16 * dt + r) * 256 + 32 * ks + 8 * q)); }
#pragma unroll
            for (int dt = 0; dt < 4; ++dt) { u32x2 w; w.x = cvt_pk_bf16(o[dt][0], o[dt][1]); w.y = cvt_pk_bf16(o[dt][2], o[dt][3]); *(u32x2*)(ocmp + mrow * 512 + hd + 16 * dt + 4 * q) = w; }
        }
        asm volatile("s_waitcnt lgkmcnt(0)" ::: "memory");
        for (int rr = 0; rr < 16; ++rr) {
            const int tq = t0 + rr, cur = tq >> 6; const float v = Il[rr * 64 + lane];
            const bool valid = lane <= cur; const bool forced = (lane == 0) || (lane == cur) || (lane == cur - 1);
            const float key = forced ? __builtin_inff() : v; int rank = 0;
            for (int i = 0; i <= cur; ++i) { const float ki = __int_as_float(__builtin_amdgcn_readlane(__float_as_int(key), i)); rank += (ki > key || (ki == key && i < lane)) ? 1 : 0; }
            const u64 msk = __ballot(valid && rank < 16);
            if (lane == 0) selm[(size_t)bg * SEQ + tq] = msk;
        }
        asm volatile("s_waitcnt lgkmcnt(0)" ::: "memory");
    }
}
__device__ __forceinline__ void ph_nsa_attn(const Params& p, int l, LAS unsigned char* lds, int bi, int nb) {
    PROLOG;
    const bf16_t* z = WSP(bf16_t, WS_Z); const bf16_t* qn = WSP(bf16_t, WS_QN); const bf16_t* kvg = WSP(bf16_t, WS_KVG); const bf16_t* ocmp = WSP(bf16_t, WS_OCMP); const u64* selm = WSP(u64, WS_SELM); bf16_t* oall = WSP(bf16_t, WS_OALL);
    const int tid = otid(), wave = tid >> 6, lane = tid & 63, r = lane & 15, q = lane >> 4;
    LAS bf16_t* Pl = (LAS bf16_t*)(lds + wave * 4096);
    unsigned* qhead = WSP(unsigned, 1024 + 256 * l);
    for (;;) {
        unsigned tk = 0u; if (lane == 0) tk = __hip_atomic_fetch_add(qhead, 1u, __ATOMIC_RELAXED, __HIP_MEMORY_SCOPE_AGENT);
        const int task = __builtin_amdgcn_readfirstlane((int)tk); if (task >= 4096) break;
        const int tt = 255 - (task >> 4), sub = task & 15;
        const int bg = sub >> 2, hh = sub & 3, b = bg >> 1, g = bg & 1, t0 = 16 * tt, t = t0 + r, cur = t0 >> 6; const size_t mrow = (size_t)b * SEQ + t;
        const int hd = (g * 4 + hh) * 64;
        bf16x8 qa[2]; qa[0] = ldfrag(qn + mrow * 512 + hd + 8 * q); qa[1] = ldfrag(qn + mrow * 512 + hd + 32 + 8 * q);
        const u64 mymask = selm[(size_t)bg * SEQ + t];
        unsigned mlo = (unsigned)mymask, mhi = (unsigned)(mymask >> 32);
#pragma unroll
        for (int o = 1; o < 16; o <<= 1) { mlo |= __shfl_xor(mlo, o); mhi |= __shfl_xor(mhi, o); }
        const u64 umask = ((u64)(unsigned)__builtin_amdgcn_readfirstlane((int)mhi) << 32) | (u64)(unsigned)__builtin_amdgcn_readfirstlane((int)mlo);
        const u64 upto = (cur >= 63) ? ~0ull : ((2ull << cur) - 1ull);
        f32x4 res[4];
#pragma unroll
        for (int br = 0; br < 2; ++br) {
            const bf16_t* Kb = kvg + (br == 0 ? 2 : 4) * KVG_SLAB + (size_t)bg * SEQ * 64 + (size_t)r * 64 + 8 * q;
            const bf16_t* Vtb = kvg + (br == 0 ? 3 : 5) * KVG_SLAB + (size_t)bg * 64 * SEQ + (size_t)r * SEQ + 8 * q;
            const int j0 = (t0 >= 511) ? ((t0 - 511) >> 6) : 0;
            u64 rem = (br == 0) ? (umask & upto) : (upto & ~((1ull << j0) - 1ull));
            float mrun = -1e30f, lrun = 0.f; f32x4 o[4];
#pragma unroll
            for (int dt = 0; dt < 4; ++dt) o[dt] = (f32x4){0.f, 0.f, 0.f, 0.f};
            bf16x8 kf[8], vf[8], kn[8], vn[8];
            int j = rem ? __builtin_ctzll(rem) : -1; if (rem) rem &= rem - 1ull;
            if (j >= 0) {
#pragma unroll
                for (int ct = 0; ct < 4; ++ct) { kf[2 * ct] = ldfrag(Kb + (size_t)(64 * j + 16 * ct) * 64); kf[2 * ct + 1] = ldfrag(Kb + (size_t)(64 * j + 16 * ct) * 64 + 32);
                    vf[2 * ct] = ldfrag(Vtb + (size_t)(16 * ct) * SEQ + 64 * j); vf[2 * ct + 1] = ldfrag(Vtb + (size_t)(16 * ct) * SEQ + 64 * j + 32); } }
            while (j >= 0) {
                const int jn = rem ? __builtin_ctzll(rem) : -1; if (rem) rem &= rem - 1ull;
                if (jn >= 0) {
#pragma unroll
                    for (int ct = 0; ct < 4; ++ct) { kn[2 * ct] = ldfrag(Kb + (size_t)(64 * jn + 16 * ct) * 64); kn[2 * ct + 1] = ldfrag(Kb + (size_t)(64 * jn + 16 * ct) * 64 + 32);
                        vn[2 * ct] = ldfrag(Vtb + (size_t)(16 * ct) * SEQ + 64 * jn); vn[2 * ct + 1] = ldfrag(Vtb + (size_t)(16 * ct) * SEQ + 64 * jn + 32); } }
                const int k0 = 64 * j; const bool rowsel = br == 0 ? (((mymask >> j) & 1ull) != 0) : true;
                f32x4 s[4]; float mx = -1e30f;
#pragma unroll
                for (int ct = 0; ct < 4; ++ct) { f32x4 a = {0.f, 0.f, 0.f, 0.f}; a = mma16(a, qa[0], kf[2 * ct]); a = mma16(a, qa[1], kf[2 * ct + 1]);
#pragma unroll
                    for (int jj = 0; jj < 4; ++jj) { const int key = k0 + 16 * ct + 4 * q + jj; const bool ok = rowsel && key <= t && (br == 0 || t - key < 512); a[jj] = ok ? a[jj] * 0.125f : -1e30f; mx = fmaxf(mx, a[jj]); }
                    s[ct] = a; }
                mx = fmaxf(mx, __shfl_xor(mx, 16)); mx = fmaxf(mx, __shfl_xor(mx, 32));
                const float mnew = fmaxf(mrun, mx), alpha = __expf(mrun - mnew); float sum = 0.f;
#pragma unroll
                for (int ct = 0; ct < 4; ++ct) {
#pragma unroll
                    for (int jj = 0; jj < 4; ++jj) { const float e = (s[ct][jj] > -1e29f) ? __expf(s[ct][jj] - mnew) : 0.f; s[ct][jj] = e; sum += e; }
                    u32x2 w; w.x = cvt_pk_bf16(s[ct][0], s[ct][1]); w.y = cvt_pk_bf16(s[ct][2], s[ct][3]); *(LAS u32x2*)(Pl + r * 72 + 16 * ct + 4 * q) = w; }
                sum += __shfl_xor(sum, 16); sum += __shfl_xor(sum, 32);
                lrun = lrun * alpha + sum; mrun = mnew;
                asm volatile("s_waitcnt lgkmcnt(0)" ::: "memory");
                const bf16x8 pa0 = *(const LAS bf16x8*)(Pl + r * 72 + 8 * q), pa1 = *(const LAS bf16x8*)(Pl + r * 72 + 32 + 8 * q);
#pragma unroll
                for (int dt = 0; dt < 4; ++dt) { f32x4 a = o[dt] * alpha; a = mma16(a, pa0, vf[2 * dt]); a = mma16(a, pa1, vf[2 * dt + 1]); o[dt] = a; }
                asm volatile("s_waitcnt lgkmcnt(0)" ::: "memory");
#pragma unroll
                for (int e = 0; e < 8; ++e) { kf[e] = kn[e]; vf[e] = vn[e]; }
                j = jn;
            }
            const float rinv = 1.f / fmaxf(lrun, 1e-30f);
            const float gt = sigmoidf_(zf(z + mrow * NZ, ZC_NSA_GT + (g * 4 + hh) * 3 + 1 + br));
#pragma unroll
            for (int dt = 0; dt < 4; ++dt) { if (br == 0) res[dt] = o[dt] * (rinv * gt); else res[dt] += o[dt] * (rinv * gt); }
        }
        const float g0 = sigmoidf_(zf(z + mrow * NZ, ZC_NSA_GT + (g * 4 + hh) * 3));
#pragma unroll
        for (int dt = 0; dt < 4; ++dt) { const u32x2 cw = *(const u32x2*)(ocmp + mrow * 512 + hd + 16 * dt + 4 * q);
            const float c0 = __uint_as_float(cw.x << 16), c1 = __uint_as_float(cw.x & 0xffff0000u), c2 = __uint_as_float(cw.y << 16), c3 = __uint_as_float(cw.y & 0xffff0000u);
            u32x2 w; w.x = cvt_pk_bf16(res[dt][0] + g0 * c0, res[dt][1] + g0 * c1); w.y = cvt_pk_bf16(res[dt][2] + g0 * c2, res[dt][3] + g0 * c3);
            *(u32x2*)(oall + mrow * NBR + 2048 + hd + 16 * dt + 4 * q) = w; }
    }
}

__device__ __forceinline__ void ph_xsoftmax(const Params& p, int bi, int nb) {
    PROLOG;
    const float* sc = WSP(float, WS_SC); bf16_t* pb = WSP(bf16_t, WS_PB);
    const int tid_ = otid(), lane = tid_ & 63, gw = bi * 8 + (tid_ >> 6), NGW = nb * 8;
    for (int it = gw; it < M * 4; it += NGW) { const f32x4 v = *(const f32x4*)(sc + (size_t)it * 256 + lane * 4);
        float mx = fmaxf(fmaxf(v[0], v[1]), fmaxf(v[2], v[3]));
#pragma unroll
        for (int o = 1; o < 64; o <<= 1) mx = fmaxf(mx, __shfl_xor(mx, o));
        const float e0 = __expf(v[0] - mx), e1 = __expf(v[1] - mx), e2 = __expf(v[2] - mx), e3 = __expf(v[3] - mx);
        const float rinv = 1.f / wave_sum((e0 + e1) + (e2 + e3));
        u32x2 w; w.x = cvt_pk_bf16(e0 * rinv, e1 * rinv); w.y = cvt_pk_bf16(e2 * rinv, e3 * rinv); *(u32x2*)(pb + (size_t)it * 256 + lane * 4) = w; }
}
__device__ __forceinline__ void ph_convact(const Params& p, int l, int bi, int nb) {
    PROLOG;
    const bf16_t* u = WSP(bf16_t, WS_U); bf16_t* ga = WSP(bf16_t, WS_GACT); const float* cw = INL(32, 3 * FFN2); const float* cb = INL(33, FFN2);
    const int gt = bi * 512 + otid(), NT = nb * 512;
    for (int i = gt; i < (M / 16) * (FFN / 8); i += NT) { const int rb = i / (FFN / 8), c8 = (i % (FFN / 8)) * 8, m0 = rb * 16, t0 = m0 & 4095; const int ua = 256 * (c8 >> 7) + (c8 & 127);
        float wa[3][8], wb[3][8], ba[8], bb[8];
#pragma unroll
        for (int k = 0; k < 3; ++k) { ld8(cw + k * FFN2 + c8, wa[k]); ld8(cw + k * FFN2 + FFN + c8, wb[k]); }
        ld8(cb + c8, ba); ld8(cb + FFN + c8, bb);
        float a1[8], a2[8], b1[8], b2[8];
        if (t0 >= 2) { bf8_to_f(*(const u32x4*)(u + (size_t)(m0 - 1) * FFN2 + ua), a1); bf8_to_f(*(const u32x4*)(u + (size_t)(m0 - 2) * FFN2 + ua), a2);
            bf8_to_f(*(const u32x4*)(u + (size_t)(m0 - 1) * FFN2 + ua + 128), b1); bf8_to_f(*(const u32x4*)(u + (size_t)(m0 - 2) * FFN2 + ua + 128), b2); }
        else {
#pragma unroll
            for (int j = 0; j < 8; ++j) { a1[j] = 0.f; a2[j] = 0.f; b1[j] = 0.f; b2[j] = 0.f; } }
#pragma unroll 4
        for (int rr = 0; rr < 16; ++rr) { float a0[8], b0[8]; const bf16_t* ur = u + (size_t)(m0 + rr) * FFN2 + ua; bf8_to_f(*(const u32x4*)ur, a0); bf8_to_f(*(const u32x4*)(ur + 128), b0);
            float o8[8];
#pragma unroll
            for (int j = 0; j < 8; ++j) { const float va = ba[j] + wa[0][j] * a2[j] + wa[1][j] * a1[j] + wa[2][j] * a0[j], vb = bb[j] + wb[0][j] * b2[j] + wb[1][j] * b1[j] + wb[2][j] * b0[j];
                o8[j] = gelu_tanh(va) * vb; a2[j] = a1[j]; a1[j] = a0[j]; b2[j] = b1[j]; b1[j] = b0[j]; }
            u32x4 w; w.x = cvt_pk_bf16(o8[0], o8[1]); w.y = cvt_pk_bf16(o8[2], o8[3]); w.z = cvt_pk_bf16(o8[4], o8[5]); w.w = cvt_pk_bf16(o8[6], o8[7]);
            *(u32x4*)(ga + (size_t)(m0 + rr) * FFN + c8) = w; }
    }
}


#define XB_TMO      128
#define XB_XCNT(j)  (256  + 64 * (j))
#define XB_XSUB(j)  (1280 + 64 * (j))
#define XB_XGEN(j)  (2304 + 64 * (j))
#define XB_TOP      3328
#define XB_TOPGEN   3392
#define XCD_BAR_WORDS 3456
#define XB_SPIN_CAP (1u << 18)
__device__ __forceinline__ unsigned xb_ld(unsigned* p)              { return __hip_atomic_load(p, __ATOMIC_RELAXED, __HIP_MEMORY_SCOPE_AGENT); }
__device__ __forceinline__ unsigned xb_add(unsigned* p, unsigned v) { return __hip_atomic_fetch_add(p, v, __ATOMIC_RELAXED, __HIP_MEMORY_SCOPE_AGENT); }
__device__ __forceinline__ unsigned xb_xcc_id() { return (unsigned)__builtin_amdgcn_s_getreg((3 << 11) | 20) & 0xFu; }
#define XB_SPIN(cond, bar) do { unsigned _sp = 0; while (cond) { __builtin_amdgcn_s_sleep(1); \
    if ((++_sp & 255u) == 0u) { if (xb_ld(&(bar)[XB_TMO])) break; if (_sp > XB_SPIN_CAP) { atomicAdd(&(bar)[XB_TMO], 1u); break; } } } } while (0)
struct XcdBarrier { unsigned* bar; unsigned x; volatile LAS unsigned* st; };
__device__ __forceinline__ XcdBarrier xcd_barrier_post(unsigned* bar, volatile LAS unsigned* st) {
    XcdBarrier b; b.bar = bar; b.x = xb_xcc_id(); b.st = st;
    if (threadIdx.x == 0) (void)xb_add(&bar[XB_XCNT(b.x)], 1u);
    return b;
}
__device__ __forceinline__ void xcd_barrier_complete(unsigned* bar, unsigned x, unsigned& nloc, unsigned& nx) {
    const unsigned G = gridDim.x * gridDim.y * gridDim.z;
    unsigned sum, cnt, mine, sp = 0u;
    for (;;) {
        sum = 0u; cnt = 0u; mine = 0u;
#pragma unroll
        for (unsigned j = 0; j < 16; ++j) { const unsigned c = xb_ld(&bar[XB_XCNT(j)]); sum += c; cnt += (c > 0u) ? 1u : 0u; mine = (j == x) ? c : mine; }
        if (sum == G) break;
        __builtin_amdgcn_s_sleep(1);
        if ((++sp & 255u) == 0u) { if (xb_ld(&bar[XB_TMO])) break; if (sp > XB_SPIN_CAP) { atomicAdd(&bar[XB_TMO], 1u); break; } }
    }
    nloc = mine > 0u ? mine : 1u; nx = cnt > 0u ? cnt : 1u;
}
__device__ __forceinline__ void xcd_barrier(const XcdBarrier& b) {
    asm volatile("s_waitcnt vmcnt(0)" ::: "memory");
    __syncthreads();
    if (threadIdx.x == 0) {
        unsigned* bar = (unsigned*)(ws_lds() + WS_CTL) + 1024;
        __builtin_amdgcn_s_waitcnt(0);
        unsigned nloc = b.st[0], nx = b.st[1];
        if (nloc == 0u) { xcd_barrier_complete(bar, b.x, nloc, nx); b.st[0] = nloc; b.st[1] = nx; }
        const unsigned old = xb_add(&bar[XB_XSUB(b.x)], 1u);
        const unsigned gen = old / nloc;
        if (old + 1u == (gen + 1u) * nloc) {
            __builtin_amdgcn_fence(__ATOMIC_RELEASE, "agent");
            asm volatile("s_waitcnt vmcnt(0)" ::: "memory");
            const unsigned og = xb_add(&bar[XB_TOP], 1u);
            const unsigned tg = og / nx;
            if (og + 1u == (tg + 1u) * nx) xb_add(&bar[XB_TOPGEN], 1u);
            else XB_SPIN(xb_ld(&bar[XB_TOPGEN]) == tg, bar);
            __builtin_amdgcn_fence(__ATOMIC_ACQUIRE, "agent");
            xb_add(&bar[XB_XGEN(b.x)], 1u);
            asm volatile("s_waitcnt vmcnt(0)" ::: "memory");
        } else {
            XB_SPIN(xb_ld(&bar[XB_XGEN(b.x)]) == gen, bar);
            __builtin_amdgcn_fence(__ATOMIC_ACQUIRE, "agent");
            asm volatile("s_waitcnt vmcnt(0)" ::: "memory");
        }
    }
    __syncthreads();
}

enum { PH_CONVERT = 0, PH_MEMKV, PH_NORM1, PH_INPROJ, PH_MIXPREP, PH_LORA_CMP1, PH_RWPREP2_CMP2_RETU, PH_RWCHUNK, PH_RWSERIAL, PH_RETSCAN, PH_NSACMP, PH_RWPOST_RETOUT, PH_NSAATTN,
       PH_P1, PH_P4, PH_P5, PH_P6, PH_P7, PH_P8,
       PH_BRANCH, PH_OUTPROJ, PH_FINISH1, PH_QPROJ, PH_XSCORE, PH_XSOFTMAX, PH_XPV, PH_XO, PH_FINISH2, PH_UP, PH_CONVACT, PH_DOWN, PH_FINISH3, PH_COUNT };

template <int PH> __device__ __forceinline__ void run_phase(const Params& p, int l, LAS unsigned char* lds, int bi, int nb) {
    using namespace pg8;
    PROLOG;
    if constexpr (PH == PH_CONVERT) ph_convert(p, l, lds, bi, nb);
    else if constexpr (PH == PH_MEMKV) {
        { GSched s = make_sched(WSP(bf16_t, WS_MEMN), D, WSP(bf16_t, WS_W_KV), D, 2, 8, D, bi, nb); EpiBf16<0> e{WSP(bf16_t, WS_KMEM), D, nullptr}; gemm_phase(lds, D, D, D, s, e); }
        { GSched s = make_sched(WSP(bf16_t, WS_W_KV) + (size_t)D * D, D, WSP(bf16_t, WS_MEMN), D, 8, 2, 512, bi, nb); EpiBf16<0> e{WSP(bf16_t, WS_VTM), 512, nullptr}; gemm_phase(lds, D, D, D, s, e); }
    }
    else if constexpr (PH == PH_NORM1) ph_norm_rows(l == 0 ? inp(p, 0) : (const float*)OUTP, INL(3, D), WSP(bf16_t, WS_H), M, bi, nb);
    else if constexpr (PH == PH_INPROJ) { GSched s = make_sched(WSP(bf16_t, WS_H), D, WSP(bf16_t, WS_W_IN), D, 32, 64, NZ, bi, nb); EpiBf16<0> e{WSP(bf16_t, WS_Z), NZ, nullptr}; gemm_phase(lds, D, D, D, s, e); }
    else if constexpr (PH == PH_MIXPREP) ph_mix_prep(p, l, lds, bi, nb);
    else if constexpr (PH == PH_LORA_CMP1) {
        { GSched s = make_sched(WSP(bf16_t, WS_ALORA), 512, WSP(bf16_t, WS_W_LORA), 512, 32, 6, 1536, bi, nb); EpiF32 e{WSP(float, WS_LO), 1536, 1.f}; gemm_phase(lds, 512, 512, 512, s, e); }
        { GSched s = make_sched(WSP(bf16_t, WS_KVG), 1024, WSP(bf16_t, WS_W_C1), 2048, 1, 1, 256, bi, nb); s.nZ1 = 2; s.nZ2 = 4; s.a_z1 = (long)KVG_SLAB * 2; s.a_z2 = (long)SEQ * 64 * 2; s.b_z1 = (long)256 * 2048 * 2; s.b_z2 = 0;
          s.o_z1 = 4 * 256 * 256; s.o_z2 = 256 * 256;
          EpiC1 e{WSP(bf16_t, WS_HID), WSP(float, WS_CBIAS)}; gemm_phase(lds, 1024, 2048, 2048, s, e); }
    }
    else if constexpr (PH == PH_RWPREP2_CMP2_RETU) { ph_rw_prep2(p, l, bi, nb); ph_cmp2(p, l, lds, bi, nb); ph_ret_u(p, lds, bi, nb); }
    else if constexpr (PH == PH_RWCHUNK) ph_rw_chunk(p, lds, bi, nb);
    else if constexpr (PH == PH_RWSERIAL) ph_rw_serial(p, lds, bi, nb);
    else if constexpr (PH == PH_RETSCAN) ph_ret_scan(p, bi, nb);
    else if constexpr (PH == PH_NSACMP) ph_nsa_cmp(p, lds, bi, nb);
    else if constexpr (PH == PH_RWPOST_RETOUT) { ph_rw_post(p, l, bi, nb); ph_ret_out(p, lds, bi, nb); }
    else if constexpr (PH == PH_NSAATTN) ph_nsa_attn(p, l, lds, bi, nb);
    else if constexpr (PH == PH_P1) { ph_convert(p, l, lds, bi, nb); if (l == 0) ph_norm_rows(inp(p, 0), INL(3, D), WSP(bf16_t, WS_H), M, bi, nb); }
    else if constexpr (PH == PH_P4) {
        if (bi < 192) { GSched s = make_sched(WSP(bf16_t, WS_ALORA), 512, WSP(bf16_t, WS_W_LORA), 512, 32, 6, 1536, bi, 192); EpiF32 e{WSP(float, WS_LO), 1536, 1.f}; gemm_phase(lds, 512, 512, 512, s, e); }
        else if (bi < 200) { GSched s = make_sched(WSP(bf16_t, WS_KVG), 1024, WSP(bf16_t, WS_W_C1), 2048, 1, 1, 256, bi - 192, 8); s.nZ1 = 2; s.nZ2 = 4; s.a_z1 = (long)KVG_SLAB * 2; s.a_z2 = (long)SEQ * 64 * 2; s.b_z1 = (long)256 * 2048 * 2; s.b_z2 = 0;
            s.o_z1 = 4 * 256 * 256; s.o_z2 = 256 * 256; EpiC1 e{WSP(bf16_t, WS_HID), WSP(float, WS_CBIAS)}; gemm_phase(lds, 1024, 2048, 2048, s, e); }
        else if (bi < 216) { GSched s = make_sched(WSP(bf16_t, WS_MEMN), D, WSP(bf16_t, WS_W_KV), D, 2, 8, D, bi - 200, 16); EpiBf16<0> e{WSP(bf16_t, WS_KMEM), D, nullptr}; gemm_phase(lds, D, D, D, s, e); }
        else if (bi < 232) { GSched s = make_sched(WSP(bf16_t, WS_W_KV) + (size_t)D * D, D, WSP(bf16_t, WS_MEMN), D, 8, 2, 512, bi - 216, 16); EpiBf16<0> e{WSP(bf16_t, WS_VTM), 512, nullptr}; gemm_phase(lds, D, D, D, s, e); }
        if (bi < 192) ph_ret_u(p, lds, bi, 216); else if (bi >= 232) ph_ret_u(p, lds, 192 + (bi - 232), 216);
    }
    else if constexpr (PH == PH_P5) { ph_rw_prep2(p, l, bi, nb); ph_cmp2(p, l, lds, bi, nb); ph_ret_scan(p, bi, nb); }
    else if constexpr (PH == PH_P6) { ph_rw_chunk(p, lds, bi, nb); __syncthreads(); ph_nsa_cmp(p, lds, bi, nb); __syncthreads(); ph_ret_out(p, lds, bi, nb); }
    else if constexpr (PH == PH_P7) { ph_rw_serial(p, lds, bi, nb); __syncthreads(); ph_nsa_attn(p, l, lds, bi, nb); }
    else if constexpr (PH == PH_P8) ph_rw_post(p, l, bi, nb);
    else if constexpr (PH == PH_BRANCH) {
        const int koff[4] = {0, 512, 1024, 2048}, kk[4] = {512, 512, 1024, 512};
#pragma unroll
        for (int br = 0; br < 4; ++br) { GSched s = make_sched(WSP(bf16_t, WS_OALL) + koff[br], NBR, WSP(bf16_t, WS_W_BR) + koff[br], NBR, 32, 8, D, bi, nb);
            EpiBranch e{WSP(float, WS_MERGED), WSP(bf16_t, WS_MERGEDB), WSP(bf16_t, WS_Z) + ZC_GATE + br * D, br == 0, br == 3}; gemm_phase(lds, NBR, NBR, kk[br], s, e); }
    }
    else if constexpr (PH == PH_OUTPROJ) { GSched s = make_sched(WSP(bf16_t, WS_MERGEDB), D, WSP(bf16_t, WS_W_OUT), D, 32, 8, D, bi, nb); EpiF32 e{WSP(float, WS_Y), D, 1.f}; gemm_phase(lds, D, D, D, s, e); }
    else if constexpr (PH == PH_FINISH1) ph_finish(l == 0 ? inp(p, 0) : (const float*)OUTP, WSP(float, WS_Y), INL(4, D), INL(5, D), OUTP, WSP(bf16_t, WS_H), bi, nb);
    else if constexpr (PH == PH_QPROJ) { GSched s = make_sched(WSP(bf16_t, WS_H), D, WSP(bf16_t, WS_W_Q), D, 32, 8, D, bi, nb); EpiBf16<0> e{WSP(bf16_t, WS_QX), D, nullptr}; gemm_phase(lds, D, D, D, s, e); }
    else if constexpr (PH == PH_XSCORE) {
        GSched s = make_sched(WSP(bf16_t, WS_QX), D, WSP(bf16_t, WS_KMEM), D, 16, 1, 1024, bi, nb); s.nZ1 = 2; s.nZ2 = 4; s.a_z1 = (long)SEQ * D * 2; s.a_z2 = 512 * 2; s.b_z1 = (long)MEM * D * 2; s.b_z2 = 512 * 2; s.o_z1 = (long)SEQ * 1024; s.o_z2 = 256;
        EpiF32 e{WSP(float, WS_SC), 1024, 0.04419417382415922f}; gemm_phase(lds, D, D, 512, s, e); }
    else if constexpr (PH == PH_XSOFTMAX) ph_xsoftmax(p, bi, nb);
    else if constexpr (PH == PH_XPV) {
        GSched s = make_sched(WSP(bf16_t, WS_PB), 1024, WSP(bf16_t, WS_VTM), 512, 16, 2, D, bi, nb); s.nZ1 = 2; s.nZ2 = 4; s.a_z1 = (long)SEQ * 1024 * 2; s.a_z2 = 256 * 2; s.b_z1 = 256 * 2; s.b_z2 = (long)512 * 512 * 2; s.o_z1 = (long)SEQ * D; s.o_z2 = 512;
        EpiBf16<0> e{WSP(bf16_t, WS_OX), D, nullptr}; gemm_phase(lds, 1024, 512, 256, s, e); }
    else if constexpr (PH == PH_XO) { GSched s = make_sched(WSP(bf16_t, WS_OX), D, WSP(bf16_t, WS_W_O), D, 32, 8, D, bi, nb); EpiF32 e{WSP(float, WS_Y), D, 1.f}; gemm_phase(lds, D, D, D, s, e); }
    else if constexpr (PH == PH_FINISH2) ph_finish(OUTP, WSP(float, WS_Y), INL(7, D), INL(8, D), OUTP, WSP(bf16_t, WS_H), bi, nb);
    else if constexpr (PH == PH_UP) { GSched s = make_sched(WSP(bf16_t, WS_H), D, WSP(bf16_t, WS_W_UP), D, 32, 44, FFN2, bi, nb); EpiBf16<0> e{WSP(bf16_t, WS_U), FFN2, nullptr}; gemm_phase(lds, D, D, D, s, e); }
    else if constexpr (PH == PH_CONVACT) ph_convact(p, l, bi, nb);
    else if constexpr (PH == PH_DOWN) { GSched s = make_sched(WSP(bf16_t, WS_GACT), FFN, WSP(bf16_t, WS_W_DN), FFN, 32, 8, D, bi, nb); EpiF32 e{WSP(float, WS_Y), D, 1.f}; gemm_phase(lds, FFN, FFN, FFN, s, e); }
    else if constexpr (PH == PH_FINISH3) ph_finish(OUTP, WSP(float, WS_Y), INL(9, D), (l + 1 < DEPTH) ? (inp(p, 3) + (size_t)(l + 1) * D) : nullptr, OUTP, WSP(bf16_t, WS_H), bi, nb);
}

__global__ void __launch_bounds__(512, 2) mega_fwd(Params p) {
    extern __shared__ __attribute__((aligned(16))) unsigned char lds_raw[];
    LAS unsigned char* lds = (LAS unsigned char*)lds_raw;
    volatile LAS unsigned* st = (volatile LAS unsigned*)(lds + LDS_BYTES - 16);
    if (threadIdx.x == 0) { st[0] = 0u; st[1] = 0u; st[2] = (unsigned)(u64)p.ws; st[3] = (unsigned)((u64)p.ws >> 32); }
    __syncthreads();
    if (threadIdx.x == 0) { const float** tab = (const float**)(p.ws + WS_PTRTAB);
#pragma unroll
        for (int i = 0; i < 35; ++i) tab[i] = p.in[i];
        tab[35] = p.out; }
    __syncthreads();
    XcdBarrier bar = xcd_barrier_post((unsigned*)(p.ws + WS_CTL) + 1024, st);
    const int bi = (int)blockIdx.x, nb = (int)gridDim.x;
#define PHASE(PH) do { int l_ = l, bi_ = bi; asm volatile("" : "+s"(l_), "+s"(bi_)); run_phase<PH>(p, l_, lds, bi_, nb); xcd_barrier(bar); } while (0)
    for (int l = 0; l < DEPTH; ++l) {
        PHASE(PH_P1);
        PHASE(PH_INPROJ);
        PHASE(PH_MIXPREP);
        PHASE(PH_P4);
        PHASE(PH_P5);
        PHASE(PH_P6);
        PHASE(PH_P7);
        PHASE(PH_P8);
        PHASE(PH_BRANCH);
        PHASE(PH_OUTPROJ);
        PHASE(PH_FINISH1);
        PHASE(PH_QPROJ);
        PHASE(PH_XSCORE);
        PHASE(PH_XSOFTMAX);
        PHASE(PH_XPV);
        PHASE(PH_XO);
        PHASE(PH_FINISH2);
        PHASE(PH_UP);
        PHASE(PH_CONVACT);
#if DUP == 4
        PHASE(PH_CONVACT);
#endif
        PHASE(PH_DOWN);
        PHASE(PH_FINISH3);
    }
#undef PHASE
}

extern "C" void kernel_launch(void* const* d_in, const int* in_sizes, int n_in, void* d_out, int out_size, void* d_ws, size_t ws_size, hipStream_t stream) {
    if (n_in != 35 || ws_size < WS_END) { fprintf(stderr, "kernel_launch: unexpected n_in %d / ws_size %zu (need %zu)\n", n_in, ws_size, (size_t)WS_END); return; }
    static int grid = 0;
    if (grid == 0) {
        int dev = 0, cus = 0, per_cu = 0;
        (void)hipGetDevice(&dev); (void)hipDeviceGetAttribute(&cus, hipDeviceAttributeMultiprocessorCount, dev);
        (void)hipFuncSetAttribute((const void*)mega_fwd, hipFuncAttributeMaxDynamicSharedMemorySize, LDS_BYTES);
        if (hipOccupancyMaxActiveBlocksPerMultiprocessor(&per_cu, (const void*)mega_fwd, 512, LDS_BYTES) != hipSuccess || per_cu < 1) fprintf(stderr, "kernel_launch: occupancy query says %d blocks per CU\n", per_cu);
        (void)hipGetLastError();
        grid = cus > 0 ? cus : 256;
    }
    (void)hipMemsetAsync((char*)d_ws + WS_CTL, 0, 1 * MiB, stream);
    Params p; memset(&p, 0, sizeof(p));
    for (int i = 0; i < 35; ++i) p.in[i] = (const float*)d_in[i];
    p.out = (float*)d_out; p.ws = (unsigned char*)d_ws;
    hipLaunchKernelGGL(mega_fwd, dim3(grid), dim3(512), LDS_BYTES, stream, p);
}
```

```cpp
#include <hip/hip_runtime.h>
#ifndef DUP
#define DUP 0
#endif
#include <cstdio>
#include <cstdint>
#include <cstring>

#define LAS __attribute__((address_space(3)))
typedef unsigned short bf16_t;
typedef short bf16x8 __attribute__((ext_vector_type(8)));
typedef float f32x4 __attribute__((ext_vector_type(4)));
typedef float f32x2 __attribute__((ext_vector_type(2)));
typedef unsigned u32x4 __attribute__((ext_vector_type(4)));
typedef unsigned u32x2 __attribute__((ext_vector_type(2)));
typedef unsigned long long u64;

constexpr int D = 2048, BATCH = 2, SEQ = 4096, M = BATCH * SEQ, DEPTH = 2;
constexpr int NZC = 16384;
constexpr int NZ = 16384 + 128;
constexpr int N_IN = 16088;
constexpr int ZC_SC_B = 0, ZC_SC_C = 512, ZC_SC_X = 1024;
constexpr int ZC_RW = 1536;
constexpr int ZC_RW_R = 1536, ZC_RW_K = 2048, ZC_RW_V = 2560, ZC_RW_ZW = 3072, ZC_RW_ZA = 3168, ZC_RW_ZG = 3264;
constexpr int ZC_RET_Q = 3584, ZC_RET_K = 4096, ZC_RET_V = 4608, ZC_RET_G = 5632;
constexpr int ZC_NSA_Q = 6656, ZC_NSA_KC = 7168, ZC_NSA_VC = 7296, ZC_NSA_KS = 7424, ZC_NSA_VS = 7552, ZC_NSA_KW = 7680, ZC_NSA_VW = 7808, ZC_NSA_GT = 7936;
constexpr int ZC_GATE = 8192;
constexpr int NBR = 2560;
constexpr int FFN = 5632, FFN2 = 11264;
constexpr int MEM = 256;

constexpr size_t MiB = 1u << 20;
constexpr size_t WS_CTL = 0;
constexpr size_t WS_W_IN = 1 * MiB, WS_W_BR = 65 * MiB, WS_W_OUT = 75 * MiB, WS_W_Q = 83 * MiB, WS_W_KV = 91 * MiB, WS_W_O = 107 * MiB;
constexpr size_t WS_W_UP = 115 * MiB, WS_W_DN = 159 * MiB, WS_W_LORA = 181 * MiB, WS_W_C1 = 183 * MiB;
constexpr size_t WS_CBIAS = 185 * MiB, WS_MEMN = 186 * MiB, WS_KMEM = 188 * MiB, WS_VTM = 190 * MiB;
constexpr size_t WS_H = 192 * MiB, WS_Z = 224 * MiB, WS_OALL = 484 * MiB, WS_MERGED = 524 * MiB, WS_MERGEDB = 588 * MiB, WS_Y = 620 * MiB;
constexpr size_t WS_T = 684 * MiB;
constexpr size_t WS_ALORA = WS_T, WS_LO = WS_T + 8 * MiB, WS_RWOPS = WS_T + 56 * MiB, WS_YSCAN = WS_T + 152 * MiB;
constexpr size_t WS_QR = WS_T + 168 * MiB, WS_KR = WS_T + 176 * MiB, WS_UBUF = WS_T + 184 * MiB, WS_RPREV = WS_T + 216 * MiB;
constexpr size_t WS_QN = WS_T + 232 * MiB, WS_KVG = WS_T + 240 * MiB, WS_HID = WS_T + 253 * MiB, WS_KCMP = WS_T + 254 * MiB, WS_VCMPT = WS_T + 254 * MiB + 512 * 1024;
constexpr size_t WS_OCMP = WS_T + 255 * MiB, WS_SELM = WS_T + 263 * MiB;
constexpr size_t WS_END = WS_T + 264 * MiB;
constexpr size_t WS_QX = WS_Z, WS_SC = WS_Z + 32 * MiB, WS_PB = WS_Z + 64 * MiB, WS_OX = WS_Z + 80 * MiB;
constexpr size_t WS_U = WS_Z, WS_GACT = WS_T;
constexpr size_t WS_RW_PF = WS_MERGED, WS_RW_QF = WS_MERGED + 32 * MiB, WS_RW_RF = WS_MERGED + 96 * MiB, WS_RW_Y0F = WS_MERGED + 104 * MiB;
constexpr size_t KVG_SLAB = (size_t)BATCH * 2 * SEQ * 64;

constexpr int LDS_BYTES = 147456;

struct Params {
    const float* in[35];
    float* out;
    unsigned char* ws;
};

__device__ __forceinline__ int otid() { int t = (int)threadIdx.x; asm volatile("" : "+v"(t)); return t; }
__device__ __forceinline__ float bf2f(bf16_t v) { return __uint_as_float((unsigned)v << 16); }
typedef __bf16 bf16x2_t __attribute__((ext_vector_type(2)));
__device__ __forceinline__ unsigned cvt_pk_bf16(float lo, float hi) { const f32x2 v = {lo, hi}; const bf16x2_t b = __builtin_convertvector(v, bf16x2_t); return __builtin_bit_cast(unsigned, b); }
__device__ __forceinline__ bf16_t f2bf(float f) { return (bf16_t)(cvt_pk_bf16(f, 0.f) & 0xffffu); }
__device__ __forceinline__ float wave_sum(float v) {
#pragma unroll
    for (int o = 1; o < 64; o <<= 1) v += __shfl_xor(v, o);
    return v;
}
__device__ __forceinline__ float sigmoidf_(float x) { return 1.f / (1.f + __expf(-x)); }
__device__ __forceinline__ float gelu_tanh(float x) { const float u = 1.5957691216057308f * (x + 0.044715f * x * x * x); return x / (1.f + __expf(-u)); }
__device__ __forceinline__ f32x4 mma16(f32x4 acc, bf16x8 a_rowfrag, bf16x8 b_colfrag) {
    return __builtin_amdgcn_mfma_f32_16x16x32_bf16(b_colfrag, a_rowfrag, acc, 0, 0, 0);
}
__device__ __forceinline__ bf16x8 ldfrag(const bf16_t* p) { return *(const bf16x8*)p; }

namespace pg8 {
constexpr int BM = 256, BK = 64, HALF = 128, HTB = HALF * BK * 2, STAGE_BYTES = 8 * HTB, NXCD = 8, WGM = 8;
__host__ __device__ __forceinline__ int lds_byte(int r, int c) { const int st = (r >> 4) * 2 + (c >> 5), rr = r & 15, cc = c & 31, ob = rr * 64 + cc * 2; return st * 1024 + (ob ^ (((ob >> 9) & 1) << 5)); }
__host__ __device__ __forceinline__ void stage_rc(int b, int& R, int& C) { const int st = b / 1024, sb = b % 1024, swz = sb ^ (((sb >> 9) & 1) << 5); R = (st >> 1) * 16 + swz / 64; C = (st & 1) * 32 + (swz % 64) / 2; }
__host__ __device__ __forceinline__ int perm32(int rho) { const int n = rho >> 4, i = rho & 15; return 8 * (i >> 2) + 4 * n + (i & 3); }

struct Unit { const char* A; const char* B; size_t ooff; int pm, pn, z, nt; };

struct GSched {
    const char* A; const char* B;
    long a_pm, b_pn;
    long a_z1, a_z2, b_z1, b_z2;
    long o_pm, o_pn, o_z1, o_z2;
    int nM, nN, nZ1, nZ2, G, c, pst;
    __device__ __forceinline__ bool next(int i, Unit& u) const {
        if (pst) {
            const int k = c >> 3, pm = 4 * (c & 7) + (k & 3), pn = 8 * i + (k >> 2); if (pn >= nN) return false;
            u.pm = pm; u.pn = pn; u.z = 0; u.nt = 0; u.A = A + pm * a_pm; u.B = B + pn * b_pn; u.ooff = (size_t)(pm * o_pm + pn * o_pn); return true; }
        const int per = nM * nN; const long L = (long)i * G + c; if (L >= (long)per * nZ1 * nZ2) return false;
        const int zz = (int)(L / per); int wgid = (int)(L % per);
        { const int q = per / NXCD, r = per % NXCD, xcd = wgid % NXCD, off = wgid / NXCD; wgid = (xcd < r ? xcd * (q + 1) : r * (q + 1) + (xcd - r) * q) + off; }
        const int nig = WGM * nN, gid = wgid / nig, fm = gid * WGM, gsz = (nM - fm) < WGM ? (nM - fm) : WGM;
        const int pm = fm + ((wgid % nig) % gsz), pn = (wgid % nig) / gsz;
        const int z1 = zz / nZ2, z2 = zz % nZ2;
        u.pm = pm; u.pn = pn; u.z = zz; u.nt = 0;
        u.A = A + z1 * a_z1 + z2 * a_z2 + pm * a_pm; u.B = B + z1 * b_z1 + z2 * b_z2 + pn * b_pn;
        u.ooff = (size_t)(z1 * o_z1 + z2 * o_z2 + pm * o_pm + pn * o_pn);
        return true;
    }
};
__device__ __forceinline__ GSched make_sched(const void* A, int lda, const void* B, int ldb, int nM, int nN, long ldc, int bi, int nb) {
    GSched s; s.A = (const char*)A; s.B = (const char*)B; s.a_pm = (long)BM * lda * 2; s.b_pn = (long)BM * ldb * 2; s.a_z1 = s.a_z2 = s.b_z1 = s.b_z2 = 0;
    s.o_pm = (long)BM * ldc; s.o_pn = BM; s.o_z1 = s.o_z2 = 0; s.nM = nM; s.nN = nN; s.nZ1 = 1; s.nZ2 = 1; s.G = nb; s.c = bi; s.pst = (nM == 32 && nb == 256) ? 1 : 0; return s;
}

template <class Epi, class Sched>
__device__ __forceinline__ void gemm_phase(LAS unsigned char* lds, const int lda, const int ldb, const int K, const Sched& S, const Epi& E) {
    const int tid = otid(), wid = __builtin_amdgcn_readfirstlane(tid >> 6), lane = tid & 63, wr = wid >> 2, wc = wid & 3, fr = lane & 15, fq = lane >> 4;
    const int ntK = K / BK;
    unsigned voffA[2], voffB[2];
#pragma unroll
    for (int i = 0; i < 2; ++i) { int R, C; stage_rc(tid * 16 + i * 8192, R, C); const int Rb = Epi::PERM ? ((R & ~31) + perm32(R & 31)) : R;
        voffA[i] = (unsigned)(R * lda + C) * 2u; voffB[i] = (unsigned)(Rb * ldb + C) * 2u; }
    const size_t kstep = (size_t)(BK * 2);
    const size_t hstepA = (size_t)HALF * lda * 2, hstepB = (size_t)HALF * ldb * 2;
    const unsigned ldsw = (unsigned)wid * 1024u;
    const int aoff = lds_byte(wr * 64 + fr, fq * 8), boff = lds_byte(wc * 32 + fr, fq * 8);
#define PG8_SA(b, h) (((b) * 2 + (h)) * HTB)
#define PG8_SB(b, h) ((4 + (b) * 2 + (h)) * HTB)
#define PG8_STAGE(bufoff, gbase, voff) do { _Pragma("unroll") for (int _i = 0; _i < 2; ++_i) \
        __builtin_amdgcn_global_load_lds((const unsigned*)((const char*)(gbase) + (voff)[_i]), (LAS unsigned*)(lds + (bufoff) + ldsw + _i * 8192), 16, 0, 0); } while (0)
#define PG8_LDA(dst, b, h) do { _Pragma("unroll") for (int m = 0; m < 4; ++m) _Pragma("unroll") for (int k = 0; k < 2; ++k) dst[m][k] = *(const LAS bf16x8*)(lds + PG8_SA(b, h) + aoff + m * 2048 + k * 1024); } while (0)
#define PG8_LDB(dst, b, h) do { _Pragma("unroll") for (int n = 0; n < 2; ++n) _Pragma("unroll") for (int k = 0; k < 2; ++k) dst[n][k] = *(const LAS bf16x8*)(lds + PG8_SB(b, h) + boff + n * 2048 + k * 1024); } while (0)
#define PG8_MMA(ai, bj, At, Bt) do { __builtin_amdgcn_s_setprio(1); _Pragma("unroll") for (int m = 0; m < 4; ++m) _Pragma("unroll") for (int n = 0; n < 2; ++n) _Pragma("unroll") for (int k = 0; k < 2; ++k) \
        acc[ai][bj][m][n] = __builtin_amdgcn_mfma_f32_16x16x32_bf16(Bt[n][k], At[m][k], acc[ai][bj][m][n], 0, 0, 0); __builtin_amdgcn_s_setprio(0); } while (0)
#define PG8_WAIT_V(n) asm volatile("s_waitcnt vmcnt(" #n ")" ::: "memory")
#define PG8_WAIT_L(n) asm volatile("s_waitcnt lgkmcnt(" #n ")" ::: "memory")
#define PG8_BAR __builtin_amdgcn_s_barrier()
#define PG8_SCHED __builtin_amdgcn_sched_barrier(0)
    Unit cur, nxt; int ui = 0;
    if (!S.next(0, cur)) return;
    f32x4 acc[2][2][4][2];
#pragma unroll
    for (int a = 0; a < 2; ++a)
#pragma unroll
        for (int b = 0; b < 2; ++b)
#pragma unroll
            for (int m = 0; m < 4; ++m)
#pragma unroll
                for (int n = 0; n < 2; ++n) acc[a][b][m][n] = (f32x4){0.f, 0.f, 0.f, 0.f};
    bf16x8 At[4][2], B0[2][2], B1[2][2];
    const char* cA = cur.A; const char* cB = cur.B;
    PG8_STAGE(PG8_SB(0, 0), cB, voffB); PG8_STAGE(PG8_SB(0, 1), cB + hstepB, voffB); PG8_STAGE(PG8_SA(0, 0), cA, voffA); PG8_STAGE(PG8_SA(0, 1), cA + hstepA, voffA);
    if (wr == 1) PG8_BAR;
    PG8_WAIT_V(2); PG8_BAR;
    PG8_STAGE(PG8_SB(1, 0), cB + kstep, voffB); PG8_STAGE(PG8_SA(1, 0), cA + kstep, voffA); PG8_STAGE(PG8_SB(1, 1), cB + hstepB + kstep, voffB);
    PG8_WAIT_V(6); PG8_BAR;
    for (;;) {
        const bool has_next = S.next(ui + 1, nxt);
        const char* nA = has_next ? nxt.A : cA; const char* nB = has_next ? nxt.B : cB;
        const int nt = cur.nt ? cur.nt : ntK;
        for (int t = 0; t < nt; t += 2) {
            const bool last = (t == nt - 2);
            const char* a1 = cA + (size_t)(t + 1) * kstep;
            const char* a2 = last ? nA : cA + (size_t)(t + 2) * kstep; const char* b2 = last ? nB : cB + (size_t)(t + 2) * kstep;
            const char* a3 = a2 + kstep; const char* b3 = b2 + kstep;
            PG8_LDB(B0, 0, 0); PG8_LDB(B1, 0, 1); PG8_SCHED; PG8_LDA(At, 0, 0); PG8_STAGE(PG8_SA(1, 1), a1 + hstepA, voffA);
            PG8_WAIT_V(8); PG8_WAIT_L(0); PG8_BAR; PG8_MMA(0, 0, At, B0); PG8_MMA(0, 1, At, B1); PG8_BAR; PG8_SCHED;
            PG8_LDA(At, 0, 1); PG8_STAGE(PG8_SB(0, 0), b2, voffB); PG8_STAGE(PG8_SB(0, 1), b2 + hstepB, voffB); PG8_STAGE(PG8_SA(0, 0), a2, voffA);
            PG8_WAIT_V(8); PG8_WAIT_L(0); PG8_BAR; PG8_MMA(1, 0, At, B0); PG8_MMA(1, 1, At, B1); PG8_BAR; PG8_SCHED;
            PG8_LDB(B0, 1, 0); PG8_LDB(B1, 1, 1); PG8_SCHED; PG8_LDA(At, 1, 0); PG8_STAGE(PG8_SA(0, 1), a2 + hstepA, voffA);
            PG8_WAIT_V(8); PG8_WAIT_L(0); PG8_BAR; PG8_MMA(0, 0, At, B0); PG8_MMA(0, 1, At, B1); PG8_BAR; PG8_SCHED;
            PG8_LDA(At, 1, 1); PG8_STAGE(PG8_SB(1, 0), b3, voffB); PG8_STAGE(PG8_SB(1, 1), b3 + hstepB, voffB); PG8_STAGE(PG8_SA(1, 0), a3, voffA);
            PG8_WAIT_V(8); PG8_WAIT_L(0); PG8_BAR; PG8_MMA(1, 0, At, B0); PG8_MMA(1, 1, At, B1); PG8_BAR; PG8_SCHED;
        }
        if (wr == 0) PG8_BAR;
        const bool reset = E(acc, cur, wr, wc, fr, fq);
        if (!has_next) break;
        if (reset) {
#pragma unroll
        for (int a = 0; a < 2; ++a)
#pragma unroll
            for (int b = 0; b < 2; ++b)
#pragma unroll
                for (int m = 0; m < 4; ++m)
#pragma unroll
                    for (int n = 0; n < 2; ++n) acc[a][b][m][n] = (f32x4){0.f, 0.f, 0.f, 0.f};
        }
        cur = nxt; cA = nA; cB = nB; ++ui;
        if (wr == 1) PG8_BAR;
    }
    PG8_WAIT_V(0);
    PG8_BAR;
#undef PG8_SA
#undef PG8_SB
#undef PG8_STAGE
#undef PG8_LDA
#undef PG8_LDB
#undef PG8_MMA
#undef PG8_WAIT_V
#undef PG8_WAIT_L
#undef PG8_BAR
#undef PG8_SCHED
}

template <int ACT> struct EpiBf16 {
    static constexpr bool PERM = true;
    bf16_t* O; int ldc; const float* bias;
    __device__ __forceinline__ bool operator()(f32x4 (&acc)[2][2][4][2], const Unit& u, int wr, int wc, int fr, int fq) const {
        bf16_t* base = O + u.ooff; const int col0 = wc * 32 + 8 * fq;
#pragma unroll
        for (int ai = 0; ai < 2; ++ai)
#pragma unroll
            for (int m = 0; m < 4; ++m) { bf16_t* rowp = base + (size_t)(ai * HALF + wr * 64 + m * 16 + fr) * ldc + col0;
#pragma unroll
                for (int bj = 0; bj < 2; ++bj) { f32x4 v0 = acc[ai][bj][m][0], v1 = acc[ai][bj][m][1];
                    if (ACT == 1) { const float* bp = bias + u.pn * BM + col0 + bj * HALF; const f32x4 b0 = *(const f32x4*)bp, b1 = *(const f32x4*)(bp + 4);
                        v0 += b0; v1 += b1;
#pragma unroll
                        for (int j = 0; j < 4; ++j) { v0[j] = gelu_tanh(v0[j]); v1[j] = gelu_tanh(v1[j]); } }
                    u32x4 w; w.x = cvt_pk_bf16(v0[0], v0[1]); w.y = cvt_pk_bf16(v0[2], v0[3]); w.z = cvt_pk_bf16(v1[0], v1[1]); w.w = cvt_pk_bf16(v1[2], v1[3]);
                    *(u32x4*)(rowp + bj * HALF) = w; } }
     return true; }
};
struct EpiF32 {
    static constexpr bool PERM = false;
    float* C; int ldc; float scale;
    __device__ __forceinline__ bool operator()(f32x4 (&acc)[2][2][4][2], const Unit& u, int wr, int wc, int fr, int fq) const {
        float* base = C + u.ooff; const int col0 = wc * 32 + 4 * fq;
#pragma unroll
        for (int ai = 0; ai < 2; ++ai)
#pragma unroll
            for (int m = 0; m < 4; ++m) { float* rowp = base + (size_t)(ai * HALF + wr * 64 + m * 16 + fr) * ldc + col0;
#pragma unroll
                for (int bj = 0; bj < 2; ++bj)
#pragma unroll
                    for (int n = 0; n < 2; ++n) *(f32x4*)(rowp + bj * HALF + n * 16) = acc[ai][bj][m][n] * scale; }
     return true; }
};
struct EpiBranch {
    static constexpr bool PERM = false;
    float* merged; bf16_t* mergedb; const bf16_t* gate; int first, last;
    __device__ __forceinline__ bool operator()(f32x4 (&acc)[2][2][4][2], const Unit& u, int wr, int wc, int fr, int fq) const {
        const int col0 = u.pn * BM + wc * 32 + 4 * fq;
#pragma unroll
        for (int ai = 0; ai < 2; ++ai)
#pragma unroll
            for (int m = 0; m < 4; ++m) { const size_t row = (size_t)(u.pm * BM + ai * HALF + wr * 64 + m * 16 + fr);
#pragma unroll
                for (int bj = 0; bj < 2; ++bj)
#pragma unroll
                    for (int n = 0; n < 2; ++n) { const int col = col0 + bj * HALF + n * 16;
                        const u32x2 gw = *(const u32x2*)(gate + row * NZ + col);
                        f32x4 g; g[0] = sigmoidf_(__uint_as_float(gw.x << 16)); g[1] = sigmoidf_(__uint_as_float(gw.x & 0xffff0000u)); g[2] = sigmoidf_(__uint_as_float(gw.y << 16)); g[3] = sigmoidf_(__uint_as_float(gw.y & 0xffff0000u));
                        f32x4 v = acc[ai][bj][m][n] * g;
                        if (!first) v += *(const f32x4*)(merged + row * D + col);
                        if (last) { u32x2 w; w.x = cvt_pk_bf16(v[0], v[1]); w.y = cvt_pk_bf16(v[2], v[3]); *(u32x2*)(mergedb + row * D + col) = w; }
                        else *(f32x4*)(merged + row * D + col) = v; } }
     return true; }
};

struct EpiZ {
    static constexpr bool PERM = true;
    bf16_t* O; int ldc;
    __device__ __forceinline__ bool operator()(f32x4 (&acc)[2][2][4][2], const Unit& u, int wr, int wc, int fr, int fq) const {
        bf16_t* base = O + u.ooff; const int col0 = wc * 32 + 8 * fq; const bool gate = u.pn >= 32;
#pragma unroll
        for (int ai = 0; ai < 2; ++ai)
#pragma unroll
            for (int m = 0; m < 4; ++m) { bf16_t* rowp = base + (size_t)(ai * HALF + wr * 64 + m * 16 + fr) * ldc + col0;
                f32x4 v00 = acc[ai][0][m][0], v01 = acc[ai][0][m][1], v10 = acc[ai][1][m][0], v11 = acc[ai][1][m][1];
                if (gate) {
#pragma unroll
                    for (int e = 0; e < 4; ++e) { const float ea = __expf(-v00[e]), eb = __expf(-v01[e]), ec = __expf(-v10[e]), ed = __expf(-v11[e]);
                        const float ia = __builtin_amdgcn_rcpf(1.f + ea), ib = __builtin_amdgcn_rcpf(1.f + eb), ic = __builtin_amdgcn_rcpf(1.f + ec), id = __builtin_amdgcn_rcpf(1.f + ed);
                        v00[e] = (1.f + eb) * ia; v01[e] = (1.f + ec) * ib; v10[e] = (1.f + ed) * ic; v11[e] = id; } }
                u32x4 w; w.x = cvt_pk_bf16(v00[0], v00[1]); w.y = cvt_pk_bf16(v00[2], v00[3]); w.z = cvt_pk_bf16(v01[0], v01[1]); w.w = cvt_pk_bf16(v01[2], v01[3]); *(u32x4*)rowp = w;
                w.x = cvt_pk_bf16(v10[0], v10[1]); w.y = cvt_pk_bf16(v10[2], v10[3]); w.z = cvt_pk_bf16(v11[0], v11[1]); w.w = cvt_pk_bf16(v11[2], v11[3]); *(u32x4*)(rowp + HALF) = w; }
        return true;
    }
};
struct BranchSched {
    const char* A; const char* B; int c;
    __device__ __forceinline__ bool next(int i, Unit& u) const {
        if (i >= 4) return false;
        const int k = c >> 3, pm = 4 * (c & 7) + (k & 3), pn = k >> 2, br = i;
        const int koff = br == 0 ? 0 : (br == 1 ? 512 : (br == 2 ? 1024 : 2048));
        u.pm = pm; u.pn = pn; u.z = br; u.nt = (br == 2) ? 16 : 8;
        u.A = A + (size_t)koff * 2 + (size_t)pm * BM * NBR * 2; u.B = B + (size_t)koff * 2 + (size_t)pn * BM * NBR * 2; u.ooff = (size_t)pm * BM * D + (size_t)pn * BM; return true;
    }
};
struct EpiBranch2 {
    static constexpr bool PERM = false;
    bf16_t* mergedb; const bf16_t* zg;
    __device__ __forceinline__ bool operator()(f32x4 (&acc)[2][2][4][2], const Unit& u, int wr, int wc, int fr, int fq) const {
        const int br = u.z; const int gcol = (br >> 1) * 128 + (br & 1) * 4;
#pragma unroll
        for (int ai = 0; ai < 2; ++ai)
#pragma unroll
            for (int m = 0; m < 4; ++m) { const size_t row = (size_t)(u.pm * BM + ai * HALF + wr * 64 + m * 16 + fr);
#pragma unroll
                for (int bj = 0; bj < 2; ++bj)
#pragma unroll
                    for (int n = 0; n < 2; ++n) { const int ch = u.pn * BM + bj * HALF + wc * 32 + n * 16 + 4 * fq;
                        const u32x2 gw = *(const u32x2*)(zg + row * NZ + (ch >> 6) * 256 + ((ch & 63) >> 2) * 8 + gcol);
                        f32x4 g; g[0] = __uint_as_float(gw.x << 16); g[1] = __uint_as_float(gw.x & 0xffff0000u); g[2] = __uint_as_float(gw.y << 16); g[3] = __uint_as_float(gw.y & 0xffff0000u);
                        const f32x4 v = acc[ai][bj][m][n] * g; acc[ai][bj][m][n] = v;
                        if (br == 3) { u32x2 w; w.x = cvt_pk_bf16(v[0], v[1]); w.y = cvt_pk_bf16(v[2], v[3]); *(u32x2*)(mergedb + row * D + ch) = w; } } }
        return br == 3;
    }
};
struct EpiC1 { static constexpr bool PERM = true; bf16_t* O; const float* bias;
    __device__ __forceinline__ bool operator()(f32x4 (&acc)[2][2][4][2], const Unit& u, int wr, int wc, int fr, int fq) const { EpiBf16<1> e{O, 256, bias + (u.z >> 2) * 256}; e(acc, u, wr, wc, fr, fq);  return true; } };
}

__device__ __forceinline__ void ph_norm_rows(const float* x, const float* g, bf16_t* out, int rows, int bi, int nb) {
    const int tid_ = otid(), lane = tid_ & 63, gw = bi * 8 + (tid_ >> 6), NGW = nb * 8;
    for (int m = gw; m < rows; m += NGW) {
        const f32x4* xr = (const f32x4*)(x + (size_t)m * D) + lane; f32x4 v[8]; float s = 0.f;
#pragma unroll
        for (int j = 0; j < 8; ++j) { v[j] = xr[64 * j]; s += v[j][0] * v[j][0] + v[j][1] * v[j][1] + v[j][2] * v[j][2] + v[j][3] * v[j][3]; }
        const float rstd = rsqrtf(wave_sum(s) * (1.f / D) + 1e-6f);
        u32x2* o = (u32x2*)(out + (size_t)m * D) + lane;
#pragma unroll
        for (int j = 0; j < 8; ++j) { const f32x4 gg = ((const f32x4*)g)[lane + 64 * j]; u32x2 w; w.x = cvt_pk_bf16(v[j][0] * rstd * gg[0], v[j][1] * rstd * gg[1]); w.y = cvt_pk_bf16(v[j][2] * rstd * gg[2], v[j][3] * rstd * gg[3]); o[64 * j] = w; }
    }
}
__device__ __forceinline__ void ph_finish(const float* xin, const float* y, const float* g1, const float* g2, float* xout, bf16_t* h, int bi, int nb) {
    const int tid_ = otid(), lane = tid_ & 63, gw = bi * 8 + (tid_ >> 6), NGW = nb * 8;
    for (int m = gw; m < M; m += NGW) {
        const f32x4* yr = (const f32x4*)(y + (size_t)m * D) + lane; const f32x4* xr = (const f32x4*)(xin + (size_t)m * D) + lane; f32x4 v[8]; float s = 0.f;
#pragma unroll
        for (int j = 0; j < 8; ++j) { v[j] = yr[64 * j]; s += v[j][0] * v[j][0] + v[j][1] * v[j][1] + v[j][2] * v[j][2] + v[j][3] * v[j][3]; }
        const float rstd = rsqrtf(wave_sum(s) * (1.f / D) + 1e-6f); float s2 = 0.f;
        f32x4* xo = (f32x4*)(xout + (size_t)m * D) + lane;
#pragma unroll
        for (int j = 0; j < 8; ++j) { const f32x4 gg = ((const f32x4*)g1)[lane + 64 * j]; const f32x4 xv = xr[64 * j];
            v[j] = xv + v[j] * rstd * gg; xo[64 * j] = v[j]; s2 += v[j][0] * v[j][0] + v[j][1] * v[j][1] + v[j][2] * v[j][2] + v[j][3] * v[j][3]; }
        if (g2) { const float r2 = rsqrtf(wave_sum(s2) * (1.f / D) + 1e-6f); u32x2* o = (u32x2*)(h + (size_t)m * D) + lane;
#pragma unroll
            for (int j = 0; j < 8; ++j) { const f32x4 gg = ((const f32x4*)g2)[lane + 64 * j]; u32x2 w; w.x = cvt_pk_bf16(v[j][0] * r2 * gg[0], v[j][1] * r2 * gg[1]); w.y = cvt_pk_bf16(v[j][2] * r2 * gg[2], v[j][3] * r2 * gg[3]); o[64 * j] = w; } }
    }
}

enum { MAP_ID = 0, MAP_WIN = 1, MAP_UP = 2 };
__device__ __forceinline__ int cmap(int kind, int n) {
    if (kind == MAP_ID) return n;
    if (kind == MAP_WIN) { if (n < 3520) return n; if (n < 3584) return -1; if (n < 6656) return n - 64; if (n < 7960) return n - 64; if (n < 8192) return -1;
        { const int g = n - 8192, tile = g >> 8, col = g & 255, bj = col >> 7, q4 = (col & 127) >> 3, nn = (col >> 2) & 1, e = col & 3; return 7896 + (2 * bj + nn) * 2048 + tile * 64 + 4 * q4 + e; } }
    const int j = n >> 8, s = n & 255; return s < 128 ? 128 * j + s : FFN + 128 * j + (s - 128);
}
__device__ __forceinline__ void transpose_item(const float* W, int K, int Nsrc, bf16_t* WT, int kind, LAS unsigned* T, int item, int nblk, int tid) {
    const int kb = item / nblk, nb_ = item % nblk, k0 = 128 * kb, n0 = 128 * nb_;
    { const int cg = tid & 31, r0 = tid >> 5; const int src = cmap(kind, n0 + 4 * cg);
      f32x4 v[8];
#pragma unroll
      for (int i = 0; i < 8; ++i) v[i] = src >= 0 ? *(const f32x4*)(W + (size_t)(k0 + r0 + 16 * i) * Nsrc + src) : (f32x4){0.f, 0.f, 0.f, 0.f};
#pragma unroll
      for (int i = 0; i < 8; ++i) { LAS unsigned* d = T + (r0 + 16 * i) * 65 + 2 * cg; d[0] = cvt_pk_bf16(v[i][0], v[i][1]); d[1] = cvt_pk_bf16(v[i][2], v[i][3]); } }
    __syncthreads();
#pragma unroll
    for (int j = 0; j < 2; ++j) { const int c = tid + 512 * j, np = (c & 7) + 8 * ((c >> 6) & 7), kg = ((c >> 3) & 7) + 8 * (c >> 9);
        unsigned w[8];
#pragma unroll
        for (int e = 0; e < 8; ++e) w[e] = T[(8 * kg + e) * 65 + np];
        u32x4 lo, hi;
        lo.x = (w[0] & 0xffffu) | (w[1] << 16); lo.y = (w[2] & 0xffffu) | (w[3] << 16); lo.z = (w[4] & 0xffffu) | (w[5] << 16); lo.w = (w[6] & 0xffffu) | (w[7] << 16);
        hi.x = (w[0] >> 16) | (w[1] & 0xffff0000u); hi.y = (w[2] >> 16) | (w[3] & 0xffff0000u); hi.z = (w[4] >> 16) | (w[5] & 0xffff0000u); hi.w = (w[6] >> 16) | (w[7] & 0xffff0000u);
        bf16_t* o = WT + (size_t)(n0 + 2 * np) * K + k0 + 8 * kg;
        *(u32x4*)o = lo; *(u32x4*)(o + K) = hi; }
    __syncthreads();
}
__device__ __forceinline__ unsigned char* ws_lds() {
    volatile LAS unsigned* q = (volatile LAS unsigned*)(LDS_BYTES - 8); unsigned lo = q[0], hi = q[1];
    lo = (unsigned)__builtin_amdgcn_readfirstlane((int)lo); hi = (unsigned)__builtin_amdgcn_readfirstlane((int)hi); return (unsigned char*)(__attribute__((address_space(1))) unsigned char*)(((u64)hi << 32) | (u64)lo); }
#define PROLOG unsigned char* const wsl = ws_lds()
#define WS_PTRTAB 256
#define inp(p_, i) ((const float*)(__attribute__((address_space(1))) const float*)(((const u64*)(wsl + WS_PTRTAB))[i]))
#define OUTP ((float*)(__attribute__((address_space(1))) float*)(((const u64*)(wsl + WS_PTRTAB))[35]))
#define WSP(T, off) ((T*)(wsl + (off)))
#define INL(i, per) (inp(p, i) + (size_t)l * (per))

__device__ __forceinline__ void ph_convert(const Params& p, int l, LAS unsigned char* lds, int bi, int nb) {
    PROLOG;
    const int tid = otid();
    LAS unsigned* T = (LAS unsigned*)lds;
    const int I0 = 16 * 128, I1 = 20 * 16, I2 = 16 * 16, I3 = 16 * 32, I4 = 16 * 88, I5 = 44 * 16, I6 = 16 * 2;
    const int NIT = I0 + I1 + 3 * I2 + I3 + I4 + I5 + 2 * I6;
    for (int it = bi; it < NIT; it += nb) {
        int r = it;
        if (r < I0) { transpose_item(INL(10, (size_t)D * N_IN), D, N_IN, WSP(bf16_t, WS_W_IN), MAP_WIN, T, r, 128, tid); continue; } r -= I0;
        if (r < I1) { transpose_item(INL(26, (size_t)NBR * D), NBR, D, WSP(bf16_t, WS_W_BR), MAP_ID, T, r, 16, tid); continue; } r -= I1;
        if (r < I2) { transpose_item(INL(27, (size_t)D * D), D, D, WSP(bf16_t, WS_W_OUT), MAP_ID, T, r, 16, tid); continue; } r -= I2;
        if (r < I2) { transpose_item(INL(28, (size_t)D * D), D, D, WSP(bf16_t, WS_W_Q), MAP_ID, T, r, 16, tid); continue; } r -= I2;
        if (r < I2) { transpose_item(INL(30, (size_t)D * D), D, D, WSP(bf16_t, WS_W_O), MAP_ID, T, r, 16, tid); continue; } r -= I2;
        if (r < I3) { transpose_item(INL(29, (size_t)D * 2 * D), D, 2 * D, WSP(bf16_t, WS_W_KV), MAP_ID, T, r, 32, tid); continue; } r -= I3;
        if (r < I4) { transpose_item(INL(31, (size_t)D * FFN2), D, FFN2, WSP(bf16_t, WS_W_UP), MAP_UP, T, r, 88, tid); continue; } r -= I4;
        if (r < I5) { transpose_item(INL(34, (size_t)FFN * D), FFN, D, WSP(bf16_t, WS_W_DN), MAP_ID, T, r, 16, tid); continue; } r -= I5;
        if (r < I6) { transpose_item(INL(24, (size_t)2 * 2048 * 256), 2048, 256, WSP(bf16_t, WS_W_C1), MAP_ID, T, r, 2, tid); continue; } r -= I6;
        transpose_item(INL(24, (size_t)2 * 2048 * 256) + (size_t)2048 * 256, 2048, 256, WSP(bf16_t, WS_W_C1) + (size_t)256 * 2048, MAP_ID, T, r, 2, tid);
    }
    const int gt = bi * 512 + otid(), NT = nb * 512;
    bf16_t* wl = WSP(bf16_t, WS_W_LORA);
    const float* w2 = INL(14, 96 * 512); const float* a2 = INL(16, 96 * 512); const float* g2 = INL(17, 256 * 512);
    for (int i = gt; i < 1536 * 512; i += NT) { const int n = i >> 9, k = i & 511; float v = 0.f;
        if (n < 512) { if (k < 96) v = w2[k * 512 + n]; } else if (n < 1024) { if (k >= 128 && k < 224) v = a2[(k - 128) * 512 + (n - 512)]; } else { if (k >= 256) v = g2[(k - 256) * 512 + (n - 1024)]; }
        wl[i] = f2bf(v); }
    { float* cbp = WSP(float, WS_CBIAS) + 512; const int lane_ = tid & 63, gwv = bi * 8 + (tid >> 6), NGWV = nb * 8;
      for (int wt = gwv; wt < 128; wt += NGWV) { const int ks = wt & 15, ii = wt >> 6, n = ((wt >> 4) & 3) * 64 + lane_; const float* pos = INL(23, 2 * 32 * 64) + ii * 2048 + ks * 128; const float* w1 = INL(24, (size_t)2 * 2048 * 256) + (size_t)ii * 2048 * 256 + (size_t)ks * 128 * 256; float s0 = 0.f, s1 = 0.f, s2 = 0.f, s3 = 0.f;
          for (int k = 0; k < 128; k += 4) { s0 += pos[k] * w1[(size_t)k * 256 + n]; s1 += pos[k + 1] * w1[(size_t)(k + 1) * 256 + n]; s2 += pos[k + 2] * w1[(size_t)(k + 2) * 256 + n]; s3 += pos[k + 3] * w1[(size_t)(k + 3) * 256 + n]; }
          cbp[ks * 512 + ii * 256 + n] = (s0 + s1) + (s2 + s3); } }
    ph_norm_rows(inp(p, 1), INL(6, D), WSP(bf16_t, WS_MEMN), BATCH * MEM, bi, nb);
}

__device__ __forceinline__ float zf(const bf16_t* zr, int c) { return bf2f(zr[c]); }
__device__ __forceinline__ void bf8_to_f(const u32x4 w, float (&f)[8]) {
    f[0] = __uint_as_float(w.x << 16); f[1] = __uint_as_float(w.x & 0xffff0000u); f[2] = __uint_as_float(w.y << 16); f[3] = __uint_as_float(w.y & 0xffff0000u);
    f[4] = __uint_as_float(w.z << 16); f[5] = __uint_as_float(w.z & 0xffff0000u); f[6] = __uint_as_float(w.w << 16); f[7] = __uint_as_float(w.w & 0xffff0000u); }
__device__ __forceinline__ void ld8(const float* p, float (&f)[8]) { const f32x4 a = *(const f32x4*)p, b = *(const f32x4*)(p + 4); f[0] = a[0]; f[1] = a[1]; f[2] = a[2]; f[3] = a[3]; f[4] = b[0]; f[5] = b[1]; f[6] = b[2]; f[7] = b[3]; }
__device__ __forceinline__ void st8(float* p, const float (&f)[8]) { *(f32x4*)p = (f32x4){f[0], f[1], f[2], f[3]}; *(f32x4*)(p + 4) = (f32x4){f[4], f[5], f[6], f[7]}; }
__device__ __forceinline__ u32x4 pk8(const float (&f)[8]) { u32x4 w; w.x = cvt_pk_bf16(f[0], f[1]); w.y = cvt_pk_bf16(f[2], f[3]); w.z = cvt_pk_bf16(f[4], f[5]); w.w = cvt_pk_bf16(f[6], f[7]); return w; }
__device__ __forceinline__ void ph_mix_prep(const Params& p, int l, LAS unsigned char* lds, int bi, int nb) {
    PROLOG;
    const int tid_ = otid(), lane = tid_ & 63, wave = tid_ >> 6, gw = bi * 8 + wave, NGW = nb * 8;
    const bf16_t* z = WSP(bf16_t, WS_Z); bf16_t* oall = WSP(bf16_t, WS_OALL); bf16_t* alora = WSP(bf16_t, WS_ALORA);
    bf16_t* qr = WSP(bf16_t, WS_QR); bf16_t* kr = WSP(bf16_t, WS_KR); bf16_t* qn = WSP(bf16_t, WS_QN); bf16_t* kvg = WSP(bf16_t, WS_KVG);
    const float* scw = INL(11, 3 * 512); const float* mu = INL(12, 1984); const int* posi = (const int*)inp(p, 2);
    LAS float* tab = (LAS float*)(lds + wave * 1024);
    if (bi == 0) { float* cb = WSP(float, WS_CBIAS); float sacc = 0.f;
        for (int ks = 0; ks < 16; ++ks) sacc += cb[512 + ks * 512 + tid_]; cb[tid_] = sacc; }
    for (int task = gw; task < 2048; task += NGW) {
        const int m0 = (task >> 1) * 8, b = m0 >> 12, t0 = m0 & 4095;
        if ((task & 1) == 0) {
            float w0[8], w1[8], w2[8]; ld8(scw + 8 * lane, w0); ld8(scw + 512 + 8 * lane, w1); ld8(scw + 1024 + 8 * lane, w2);
            float cx1[8], cx2[8];
            if (t0 >= 2) { float c_[8], x_[8]; bf8_to_f(*(const u32x4*)(z + (size_t)(m0 - 1) * NZ + ZC_SC_C + 8 * lane), c_); bf8_to_f(*(const u32x4*)(z + (size_t)(m0 - 1) * NZ + ZC_SC_X + 8 * lane), x_);
#pragma unroll
                for (int j = 0; j < 8; ++j) cx1[j] = c_[j] * x_[j];
                bf8_to_f(*(const u32x4*)(z + (size_t)(m0 - 2) * NZ + ZC_SC_C + 8 * lane), c_); bf8_to_f(*(const u32x4*)(z + (size_t)(m0 - 2) * NZ + ZC_SC_X + 8 * lane), x_);
#pragma unroll
                for (int j = 0; j < 8; ++j) cx2[j] = c_[j] * x_[j]; }
            else {
#pragma unroll
                for (int j = 0; j < 8; ++j) { cx1[j] = 0.f; cx2[j] = 0.f; } }
            int src = -1, kind = 0;
            if (lane < 12) { src = ZC_RW_ZW + 8 * lane; kind = 1; } else if (lane >= 16 && lane < 28) { src = ZC_RW_ZA + 8 * (lane - 16); } else if (lane >= 32) { src = ZC_RW_ZG + 8 * (lane - 32); kind = 2; }
            float mus[8], pv[8];
#pragma unroll
            for (int j = 0; j < 8; ++j) { mus[j] = 0.f; pv[j] = 0.f; }
            if (src >= 0) { ld8(mu + (src - ZC_RW), mus); if (t0 >= 1) bf8_to_f(*(const u32x4*)(z + (size_t)(m0 - 1) * NZ + src), pv); }
#pragma unroll 2
            for (int rr = 0; rr < 8; ++rr) { const size_t m = (size_t)(m0 + rr); const bf16_t* zr = z + m * NZ;
                float b_[8], c_[8], x_[8], o8[8]; bf8_to_f(*(const u32x4*)(zr + ZC_SC_B + 8 * lane), b_); bf8_to_f(*(const u32x4*)(zr + ZC_SC_C + 8 * lane), c_); bf8_to_f(*(const u32x4*)(zr + ZC_SC_X + 8 * lane), x_);
#pragma unroll
                for (int j = 0; j < 8; ++j) { const float cx0 = c_[j] * x_[j]; o8[j] = b_[j] * (w2[j] * cx0 + w1[j] * cx1[j] + w0[j] * cx2[j]); cx2[j] = cx1[j]; cx1[j] = cx0; }
                *(u32x4*)(oall + m * NBR + 8 * lane) = pk8(o8);
                float a8[8];
                if (src >= 0) { float cur[8]; bf8_to_f(*(const u32x4*)(zr + src), cur);
#pragma unroll
                    for (int j = 0; j < 8; ++j) { const float v = cur[j] + (pv[j] - cur[j]) * mus[j]; a8[j] = kind == 1 ? tanhf(v) : (kind == 2 ? sigmoidf_(v) : v); pv[j] = cur[j]; } }
                else {
#pragma unroll
                    for (int j = 0; j < 8; ++j) a8[j] = 0.f; }
                *(u32x4*)(alora + m * 512 + 8 * lane) = pk8(a8);
                if (lane < 32) { const int arr = lane >> 4, L2 = lane & 15, g = L2 >> 3, d0 = (L2 & 7) * 8;
                    *(u32x4*)(kvg + (size_t)arr * KVG_SLAB + ((size_t)(b * 2 + g) * SEQ + (t0 + rr)) * 64 + d0) = *(const u32x4*)(zr + (arr ? ZC_NSA_VC : ZC_NSA_KC) + 8 * L2); }
            }
        } else {
            const float invr = __expf(-(float)lane * (9.210340371976184f / 63.f)), invn = __expf(-(float)(lane & 31) * (9.210340371976184f / 32.f));
            for (int rr = 0; rr < 8; ++rr) { const size_t m = (size_t)(m0 + rr); const bf16_t* zr = z + m * NZ; const float pos = (float)posi[m];
                { float sn, cs; sincosf(pos * invr, &sn, &cs); tab[lane] = cs; tab[64 + lane] = sn; sincosf(pos * invn, &sn, &cs); if (lane < 32) { tab[128 + lane] = cs; tab[160 + lane] = sn; } }
                asm volatile("s_waitcnt lgkmcnt(0)" ::: "memory");
                {
                    const int isk = lane >> 5, L2 = lane & 31, hh = L2 >> 3, j8 = (L2 & 7) * 8; const bf16_t* src = zr + (isk ? ZC_RET_K : ZC_RET_Q) + hh * 128 + j8;
                    float x1[8], x2[8], cs[8], sn[8], o1[8], o2[8]; bf8_to_f(*(const u32x4*)src, x1); bf8_to_f(*(const u32x4*)(src + 64), x2);
                    { const f32x4 a = *(const LAS f32x4*)(tab + j8), c2 = *(const LAS f32x4*)(tab + j8 + 4), d = *(const LAS f32x4*)(tab + 64 + j8), e = *(const LAS f32x4*)(tab + 64 + j8 + 4);
                      cs[0] = a[0]; cs[1] = a[1]; cs[2] = a[2]; cs[3] = a[3]; cs[4] = c2[0]; cs[5] = c2[1]; cs[6] = c2[2]; cs[7] = c2[3]; sn[0] = d[0]; sn[1] = d[1]; sn[2] = d[2]; sn[3] = d[3]; sn[4] = e[0]; sn[5] = e[1]; sn[6] = e[2]; sn[7] = e[3]; }
                    const float sc = isk ? 0.08838834764831845f : 1.f;
#pragma unroll
                    for (int j = 0; j < 8; ++j) { o1[j] = (x1[j] * cs[j] - x2[j] * sn[j]) * sc; o2[j] = (x2[j] * cs[j] + x1[j] * sn[j]) * sc; }
                    bf16_t* dst = (isk ? kr : qr) + m * 512 + hh * 128 + j8; *(u32x4*)dst = pk8(o1); *(u32x4*)(dst + 64) = pk8(o2); }
                if (lane < 48) {
                    const int j8 = (lane & 3) * 8; const bf16_t* src; bf16_t* dst;
                    if (lane < 32) { const int hh = lane >> 2; src = zr + ZC_NSA_Q + hh * 64 + j8; dst = qn + m * 512 + hh * 64 + j8; }
                    else { const int L2 = lane & 7, g = L2 >> 2, isw = (lane >= 40); src = zr + (isw ? ZC_NSA_KW : ZC_NSA_KS) + g * 64 + j8; dst = kvg + (size_t)(isw ? 4 : 2) * KVG_SLAB + ((size_t)(b * 2 + g) * SEQ + (t0 + rr)) * 64 + j8; }
                    float x1[8], x2[8], cs[8], sn[8], o1[8], o2[8]; bf8_to_f(*(const u32x4*)src, x1); bf8_to_f(*(const u32x4*)(src + 32), x2);
                    { const f32x4 a = *(const LAS f32x4*)(tab + 128 + j8), c2 = *(const LAS f32x4*)(tab + 128 + j8 + 4), d = *(const LAS f32x4*)(tab + 160 + j8), e = *(const LAS f32x4*)(tab + 160 + j8 + 4);
                      cs[0] = a[0]; cs[1] = a[1]; cs[2] = a[2]; cs[3] = a[3]; cs[4] = c2[0]; cs[5] = c2[1]; cs[6] = c2[2]; cs[7] = c2[3]; sn[0] = d[0]; sn[1] = d[1]; sn[2] = d[2]; sn[3] = d[3]; sn[4] = e[0]; sn[5] = e[1]; sn[6] = e[2]; sn[7] = e[3]; }
#pragma unroll
                    for (int j = 0; j < 8; ++j) { o1[j] = x1[j] * cs[j] - x2[j] * sn[j]; o2[j] = x2[j] * cs[j] + x1[j] * sn[j]; }
                    *(u32x4*)dst = pk8(o1); *(u32x4*)(dst + 32) = pk8(o2); }
                asm volatile("s_waitcnt lgkmcnt(0)" ::: "memory");
            }
#pragma unroll
            for (int k = 0; k < 4; ++k) { const int c = lane + 64 * k, arr = c >> 7, gd = c & 127, g = gd >> 6, d = gd & 63; const bf16_t* src = z + (size_t)m0 * NZ + (arr ? ZC_NSA_VW : ZC_NSA_VS) + gd;
                unsigned short e[8];
#pragma unroll
                for (int rr = 0; rr < 8; ++rr) e[rr] = src[(size_t)rr * NZ];
                u32x4 w; w.x = (unsigned)e[0] | ((unsigned)e[1] << 16); w.y = (unsigned)e[2] | ((unsigned)e[3] << 16); w.z = (unsigned)e[4] | ((unsigned)e[5] << 16); w.w = (unsigned)e[6] | ((unsigned)e[7] << 16);
                *(u32x4*)(kvg + (size_t)(arr ? 5 : 3) * KVG_SLAB + ((size_t)(b * 2 + g) * 64 + d) * SEQ + t0) = w; }
        }
    }
}

__device__ __forceinline__ void ph_rw_prep2(const Params& p, int l, int bi, int nb) {
    PROLOG;
    const int tid_ = otid(), lane = tid_ & 63, gw = bi * 8 + (tid_ >> 6), NGW = nb * 8;
    const bf16_t* z = WSP(bf16_t, WS_Z); const float* lo = WSP(float, WS_LO); float* ops = WSP(float, WS_RWOPS);
    const float* mu = INL(12, 1984); constexpr size_t AS = (size_t)M * 512; const int c0 = 8 * lane;
    float mur[8], muk[8], muv[8], w0[8], a0[8], kkw[8], kaw[8];
    ld8(mu + c0, mur); ld8(mu + 512 + c0, muk); ld8(mu + 1024 + c0, muv); ld8(INL(13, 512) + c0, w0); ld8(INL(15, 512) + c0, a0); ld8(INL(18, 512) + c0, kkw); ld8(INL(19, 512) + c0, kaw);
    for (int m0 = gw; m0 < M; m0 += 2 * NGW) {
        u32x4 zc[2][3], zp[2][3]; float ld_[2][8], la_[2][8];
#pragma unroll
        for (int u = 0; u < 2; ++u) { const int m = m0 + u * NGW; if (m < M) { const bf16_t* zr = z + (size_t)m * NZ + ZC_RW_R + c0; const bool hp = (m & 4095) >= 1;
#pragma unroll
            for (int a = 0; a < 3; ++a) { zc[u][a] = *(const u32x4*)(zr + 512 * a); zp[u][a] = hp ? *(const u32x4*)(zr + 512 * a - NZ) : (u32x4){0u, 0u, 0u, 0u}; }
            ld8(lo + (size_t)m * 1536 + c0, ld_[u]); ld8(lo + (size_t)m * 1536 + 512 + c0, la_[u]); } }
#pragma unroll
        for (int u = 0; u < 2; ++u) { const int m = m0 + u * NGW; if (m < M) {
            float r[8], k[8], v[8], pr[8], pk[8], pv[8], w[8], kk[8], k2[8], bb[8];
            bf8_to_f(zc[u][0], r); bf8_to_f(zc[u][1], k); bf8_to_f(zc[u][2], v); bf8_to_f(zp[u][0], pr); bf8_to_f(zp[u][1], pk); bf8_to_f(zp[u][2], pv);
            float ss = 0.f;
#pragma unroll
            for (int j = 0; j < 8; ++j) { r[j] += (pr[j] - r[j]) * mur[j]; k[j] += (pk[j] - k[j]) * muk[j]; v[j] += (pv[j] - v[j]) * muv[j];
                w[j] = __expf(-0.6065306597126334f * sigmoidf_(w0[j] + ld_[u][j])); kk[j] = k[j] * kkw[j]; ss += kk[j] * kk[j]; }
            ss += __shfl_xor(ss, 1); ss += __shfl_xor(ss, 2); ss += __shfl_xor(ss, 4);
            const float rn = 1.f / fmaxf(sqrtf(ss), 1e-12f);
#pragma unroll
            for (int j = 0; j < 8; ++j) { const float a = sigmoidf_(a0[j] + la_[u][j]); kk[j] *= rn; k2[j] = k[j] * (1.f + (a - 1.f) * kaw[j]); bb[j] = kk[j] * a; }
            float* o = ops + (size_t)m * 512 + c0;
            st8(o, r); st8(o + AS, w); st8(o + 2 * AS, k2); st8(o + 3 * AS, v); st8(o + 4 * AS, kk); st8(o + 5 * AS, bb); } }
    }
}
#define DPP_ROR_ADD(x, n) (x) += __int_as_float(__builtin_amdgcn_update_dpp(0, __float_as_int(x), 0x120 + (n), 0xf, 0xf, false))
__device__ __forceinline__ float row_allreduce16(float x) { DPP_ROR_ADD(x, 8); DPP_ROR_ADD(x, 4); DPP_ROR_ADD(x, 2); DPP_ROR_ADD(x, 1); return x; }
__device__ __forceinline__ void ph_rw_scan(const Params& p, LAS unsigned char* lds, int bi, int nb) {
    PROLOG;
    const float* ops = WSP(float, WS_RWOPS); float* ys = WSP(float, WS_YSCAN); constexpr size_t AS = (size_t)M * 512; constexpr int TC = 32;
    LAS float* lop = (LAS float*)lds;
    LAS float* ybuf = (LAS float*)(lds + 6 * TC * 64 * 4);
    const int tid = otid(), wave = tid >> 6, lane = tid & 63, Rg = wave * 4 + (lane >> 4), Pc = lane & 15;
    for (int task = bi; task < 16; task += nb) {
        const int b = task >> 3, hh = task & 7;
        float s[4][4];
#pragma unroll
        for (int i = 0; i < 4; ++i)
#pragma unroll
            for (int j = 0; j < 4; ++j) s[i][j] = 0.f;
        for (int t0 = 0; t0 < SEQ; t0 += TC) {
            for (int idx = tid; idx < 6 * TC * 16; idx += 512) { const int arr = idx / (TC * 16), rem = idx % (TC * 16), tt = rem >> 4, c4 = rem & 15;
                *(LAS f32x4*)(lop + (arr * TC + tt) * 64 + c4 * 4) = *(const f32x4*)(ops + arr * AS + (size_t)(b * SEQ + t0 + tt) * 512 + hh * 64 + c4 * 4); }
            __syncthreads();
            if (wave < 4) {
                for (int tt = 0; tt < TC; ++tt) {
                    const f32x4 r4 = *(const LAS f32x4*)(lop + (0 * TC + tt) * 64 + Pc * 4), w4 = *(const LAS f32x4*)(lop + (1 * TC + tt) * 64 + Pc * 4), k4 = *(const LAS f32x4*)(lop + (2 * TC + tt) * 64 + Pc * 4);
                    const f32x4 v4 = *(const LAS f32x4*)(lop + (3 * TC + tt) * 64 + Rg * 4), kk4 = *(const LAS f32x4*)(lop + (4 * TC + tt) * 64 + Pc * 4), b4 = *(const LAS f32x4*)(lop + (5 * TC + tt) * 64 + Pc * 4);
                    float sa[4];
#pragma unroll
                    for (int i = 0; i < 4; ++i) { float x = -(s[i][0] * kk4[0] + s[i][1] * kk4[1] + s[i][2] * kk4[2] + s[i][3] * kk4[3]); sa[i] = row_allreduce16(x); }
                    float y[4];
#pragma unroll
                    for (int i = 0; i < 4; ++i) { float acc = 0.f;
#pragma unroll
                        for (int j = 0; j < 4; ++j) { s[i][j] = s[i][j] * w4[j] + sa[i] * b4[j] + v4[i] * k4[j]; acc += s[i][j] * r4[j]; }
                        y[i] = row_allreduce16(acc); }
                    if (Pc == 0) *(LAS f32x4*)(ybuf + tt * 64 + Rg * 4) = (f32x4){y[0], y[1], y[2], y[3]};
                }
            }
            __syncthreads();
            { const int tt = tid >> 4, c4 = tid & 15; *(f32x4*)(ys + (size_t)(b * SEQ + t0 + tt) * 512 + hh * 64 + c4 * 4) = *(const LAS f32x4*)(ybuf + tt * 64 + c4 * 4); }
        }
        __syncthreads();
    }
}

typedef short bf16x8s __attribute__((ext_vector_type(8)));
__device__ __forceinline__ bf16x8 zfrag() { return (bf16x8){0, 0, 0, 0, 0, 0, 0, 0}; }
__device__ __forceinline__ bf16x8 pack8(f32x4 a, f32x4 b) { u32x4 w; w.x = cvt_pk_bf16(a[0], a[1]); w.y = cvt_pk_bf16(a[2], a[3]); w.z = cvt_pk_bf16(b[0], b[1]); w.w = cvt_pk_bf16(b[2], b[3]); return __builtin_bit_cast(bf16x8, w); }
__device__ __forceinline__ void ph_rw_chunk(const Params& p, LAS unsigned char* lds, int bi, int nb) {
    PROLOG;
    const float* ops = WSP(float, WS_RWOPS); constexpr size_t AS = (size_t)M * 512;
    unsigned char* PFg = WSP(unsigned char, WS_RW_PF); unsigned char* QFg = WSP(unsigned char, WS_RW_QF); unsigned char* RFg = WSP(unsigned char, WS_RW_RF); unsigned char* Y0g = WSP(unsigned char, WS_RW_Y0F);
    const int tid = otid(), wave = tid >> 6, lane = tid & 63, r = lane & 15, q = lane >> 4;
    if (wave >= 4) return;
    LAS unsigned char* L = lds + wave * 30720;
    LAS bf16_t* BE = (LAS bf16_t*)(L);
    LAS bf16_t* KA = (LAS bf16_t*)(L + 2048);
    LAS bf16_t* AL = (LAS bf16_t*)(L + 4096);
    LAS bf16_t* RHO = (LAS bf16_t*)(L + 6144);
    LAS bf16_t* ALT = (LAS bf16_t*)(L + 8192);
    LAS bf16_t* BEPT = (LAS bf16_t*)(L + 10240);
    LAS bf16_t* KAPT = (LAS bf16_t*)(L + 12288);
    LAS bf16_t* VT = (LAS bf16_t*)(L + 14336);
    LAS bf16_t* RHOT = (LAS bf16_t*)(L + 16384);
    LAS bf16_t* OM = (LAS bf16_t*)(L + 18432);
    LAS bf16_t* VBm = (LAS bf16_t*)(L + 20480);
    LAS bf16_t* MU = (LAS bf16_t*)(L + 22528);
    LAS float* Af = (LAS float*)(L + 24576);
    LAS bf16_t* NT = (LAS bf16_t*)(L + 25600);
    LAS bf16_t* BmT = (LAS bf16_t*)(L + 26112);
    LAS bf16_t* CbT = (LAS bf16_t*)(L + 26624);
    LAS bf16_t* CkT = (LAS bf16_t*)(L + 27136);
    LAS float* GT = (LAS float*)(L + 27648);
    const int gw = bi * 4 + wave, NGW = nb * 4;
    for (int task = gw; task < 4096; task += NGW) {
        const int bh = task >> 8, n = task & 255, b = bh >> 3, hh = bh & 7; const size_t i0 = ((size_t)b * SEQ + 16 * n) * 512 + hh * 64 + lane;
        { float g = 1.f; float be[16], ka[16];
#pragma unroll
          for (int t = 0; t < 16; ++t) { const size_t ix = i0 + (size_t)t * 512;
              const float rr = ops[ix], ww = ops[AS + ix], k2 = ops[2 * AS + ix], vv = ops[3 * AS + ix], kk = ops[4 * AS + ix], bb = ops[5 * AS + ix];
              const float gprev = g; g *= ww; const float al = gprev * kk, rg = 1.f / g; be[t] = bb * rg; ka[t] = k2 * rg; const float rho = g * rr;
              BE[t * 64 + lane] = f2bf(be[t]); KA[t * 64 + lane] = f2bf(ka[t]); AL[t * 64 + lane] = f2bf(al); RHO[t * 64 + lane] = f2bf(rho);
              ALT[lane * 16 + t] = f2bf(al); VT[lane * 16 + t] = f2bf(vv); RHOT[lane * 16 + t] = f2bf(rho); }
          GT[lane] = g;
#pragma unroll
          for (int t = 0; t < 16; ++t) { BEPT[lane * 16 + t] = f2bf(be[t] * g); KAPT[lane * 16 + t] = f2bf(ka[t] * g); } }
        asm volatile("s_waitcnt lgkmcnt(0)" ::: "memory");
        { bf16x8 xb[2], xk[2], ya[2], yr[2];
#pragma unroll
          for (int ks = 0; ks < 2; ++ks) { xb[ks] = *(const LAS bf16x8*)(BE + r * 64 + 32 * ks + 8 * q); xk[ks] = *(const LAS bf16x8*)(KA + r * 64 + 32 * ks + 8 * q);
              ya[ks] = *(const LAS bf16x8*)(AL + r * 64 + 32 * ks + 8 * q); yr[ks] = *(const LAS bf16x8*)(RHO + r * 64 + 32 * ks + 8 * q); }
          f32x4 A = {0.f, 0.f, 0.f, 0.f}, Bm = A, Cb = A, Ck = A;
#pragma unroll
          for (int ks = 0; ks < 2; ++ks) { A = mma16(A, xb[ks], ya[ks]); Bm = mma16(Bm, xk[ks], ya[ks]); Cb = mma16(Cb, xb[ks], yr[ks]); Ck = mma16(Ck, xk[ks], yr[ks]); }
#pragma unroll
          for (int jj = 0; jj < 4; ++jj) { const int c = 4 * q + jj; const bool lt = r < c, le = r <= c;
              A[jj] = lt ? A[jj] : 0.f; BmT[c * 16 + r] = f2bf(lt ? Bm[jj] : 0.f); CbT[c * 16 + r] = f2bf(le ? Cb[jj] : 0.f); CkT[c * 16 + r] = f2bf(le ? Ck[jj] : 0.f); }
          *(LAS f32x4*)(Af + r * 16 + 4 * q) = A; }
        asm volatile("s_waitcnt lgkmcnt(0)" ::: "memory");
        { float nrow[16];
#pragma unroll
          for (int i = 0; i < 16; ++i) { float sacc = (i == r) ? 1.f : 0.f;
#pragma unroll
              for (int j = 0; j < i; ++j) sacc -= nrow[j] * Af[j * 16 + i];
              nrow[i] = sacc; }
          if (q == 0) {
#pragma unroll
              for (int i = 0; i < 16; ++i) NT[i * 16 + r] = f2bf(nrow[i]); } }
        asm volatile("s_waitcnt lgkmcnt(0)" ::: "memory");
        const bool lo = q < 2; const int q2 = q & 1;
        { const bf16x8 bN = lo ? *(const LAS bf16x8*)(NT + r * 16 + 8 * q2) : zfrag(); const bf16x8 bB = lo ? *(const LAS bf16x8*)(BmT + r * 16 + 8 * q2) : zfrag();
#pragma unroll
          for (int mt = 0; mt < 4; ++mt) { const int row = 16 * mt + r;
              const bf16x8 aA = lo ? *(const LAS bf16x8*)(ALT + row * 16 + 8 * q2) : zfrag(); const bf16x8 aV = lo ? *(const LAS bf16x8*)(VT + row * 16 + 8 * q2) : zfrag();
              f32x4 om = mma16((f32x4){0.f, 0.f, 0.f, 0.f}, aA, bN), vb = mma16((f32x4){0.f, 0.f, 0.f, 0.f}, aV, bB);
              u32x2 w; w.x = cvt_pk_bf16(-om[0], -om[1]); w.y = cvt_pk_bf16(-om[2], -om[3]); *(LAS u32x2*)(OM + row * 16 + 4 * q) = w;
              w.x = cvt_pk_bf16(vb[0], vb[1]); w.y = cvt_pk_bf16(vb[2], vb[3]); *(LAS u32x2*)(VBm + row * 16 + 4 * q) = w; }
          asm volatile("s_waitcnt lgkmcnt(0)" ::: "memory");
#pragma unroll
          for (int mt = 0; mt < 4; ++mt) { const int row = 16 * mt + r; const bf16x8 aB = lo ? *(const LAS bf16x8*)(VBm + row * 16 + 8 * q2) : zfrag();
              f32x4 mu = mma16((f32x4){0.f, 0.f, 0.f, 0.f}, aB, bN);
              u32x2 w; w.x = cvt_pk_bf16(-mu[0], -mu[1]); w.y = cvt_pk_bf16(-mu[2], -mu[3]); *(LAS u32x2*)(MU + row * 16 + 4 * q) = w; } }
        asm volatile("s_waitcnt lgkmcnt(0)" ::: "memory");
        const size_t rec = (size_t)bh * 256 + n;
        { bf16x8 bO[4];
#pragma unroll
          for (int nt = 0; nt < 4; ++nt) bO[nt] = lo ? *(const LAS bf16x8*)(OM + (16 * nt + r) * 16 + 8 * q2) : zfrag();
#pragma unroll
          for (int mt = 0; mt < 4; ++mt) { const bf16x8 a = lo ? *(const LAS bf16x8*)(BEPT + (16 * mt + r) * 16 + 8 * q2) : zfrag(); f32x4 acc[4];
#pragma unroll
              for (int nt = 0; nt < 4; ++nt) acc[nt] = mma16((f32x4){0.f, 0.f, 0.f, 0.f}, a, bO[nt]);
              { const float gd = GT[16 * mt + r];
#pragma unroll
                for (int jj = 0; jj < 4; ++jj) if (4 * q + jj == r) acc[mt][jj] += gd; }
#pragma unroll
              for (int ks = 0; ks < 2; ++ks) *(bf16x8*)(PFg + rec * 8192 + (size_t)((mt * 2 + ks) * 64 + lane) * 16) = pack8(acc[2 * ks], acc[2 * ks + 1]); }
          { bf16x8 a; if (lo) a = *(const LAS bf16x8*)(CbT + r * 16 + 8 * q2); else { a = zfrag();
#pragma unroll
                for (int e = 0; e < 8; ++e) if (8 * q2 + e == r) a[e] = (short)0x3f80; }
            f32x4 acc[4];
#pragma unroll
            for (int nt = 0; nt < 4; ++nt) { const bf16x8 bb = lo ? bO[nt] : *(const LAS bf16x8*)(RHOT + (16 * nt + r) * 16 + 8 * q2); acc[nt] = mma16((f32x4){0.f, 0.f, 0.f, 0.f}, a, bb); }
#pragma unroll
            for (int ks = 0; ks < 2; ++ks) *(bf16x8*)(RFg + rec * 2048 + (size_t)(ks * 64 + lane) * 16) = pack8(acc[2 * ks], acc[2 * ks + 1]); } }
        { bf16x8 bQ[4];
#pragma unroll
          for (int nt = 0; nt < 4; ++nt) bQ[nt] = *(const LAS bf16x8*)((lo ? BEPT : KAPT) + (16 * nt + r) * 16 + 8 * q2);
          const bf16x8 bY = *(const LAS bf16x8*)((lo ? CbT : CkT) + r * 16 + 8 * q2);
#pragma unroll
          for (int mt = 0; mt < 4; ++mt) { const bf16x8 a = *(const LAS bf16x8*)((lo ? MU : VT) + (16 * mt + r) * 16 + 8 * q2);
#pragma unroll
              for (int nt = 0; nt < 4; ++nt) { const f32x4 acc = mma16((f32x4){0.f, 0.f, 0.f, 0.f}, a, bQ[nt]); *(f32x4*)(QFg + rec * 16384 + (size_t)((mt * 4 + nt) * 64 + lane) * 16) = acc; }
              const f32x4 y0 = mma16((f32x4){0.f, 0.f, 0.f, 0.f}, a, bY); *(f32x4*)(Y0g + rec * 4096 + (size_t)(mt * 64 + lane) * 16) = y0; } }
        asm volatile("s_waitcnt lgkmcnt(0)" ::: "memory");
    }
}
__device__ __forceinline__ void ph_rw_serial(const Params& p, LAS unsigned char* lds, int bi, int nb) {
    PROLOG;
    constexpr int NS = 8, DD = 6, SLOT = 16384;
    const unsigned char* PFg = WSP(unsigned char, WS_RW_PF); const unsigned char* QFg = WSP(unsigned char, WS_RW_QF); const unsigned char* RFg = WSP(unsigned char, WS_RW_RF); const unsigned char* Y0g = WSP(unsigned char, WS_RW_Y0F);
    float* ys = WSP(float, WS_YSCAN);
    const int tid = otid(), wave = __builtin_amdgcn_readfirstlane(tid >> 6), lane = tid & 63, l15 = lane & 15, q = lane >> 4;
    for (int task = bi; task < 64; task += nb) {
        const int bh = task >> 2, w = task & 3, b = bh >> 3, hh = bh & 7;
        const unsigned char* gp[3]; size_t gs[3];
#pragma unroll
        for (int k = 0; k < 3; ++k) { const int pc = 3 * (wave - 1) + k;
            if (pc < 8) { gp[k] = PFg + (size_t)bh * 256 * 8192 + pc * 1024; gs[k] = 8192; }
            else if (pc < 12) { gp[k] = QFg + (size_t)bh * 256 * 16384 + w * 4096 + (pc - 8) * 1024; gs[k] = 16384; }
            else if (pc < 14) { gp[k] = RFg + (size_t)bh * 256 * 2048 + (pc - 12) * 1024; gs[k] = 2048; }
            else { gp[k] = Y0g + (size_t)bh * 256 * 4096 + w * 1024; gs[k] = 4096; } }
        const bool loader = wave >= 1 && wave <= 5; const int pofs = 3 * (wave - 1) * 1024;
#define RW_ISSUE(step) do { const int c_ = (step) < 256 ? (step) : 255; LAS unsigned char* sl_ = lds + ((step) % NS) * SLOT + pofs; \
        __builtin_amdgcn_global_load_lds((const unsigned*)(gp[0] + (size_t)c_ * gs[0] + lane * 16), (LAS unsigned*)(sl_), 16, 0, 0); \
        __builtin_amdgcn_global_load_lds((const unsigned*)(gp[1] + (size_t)c_ * gs[1] + lane * 16), (LAS unsigned*)(sl_ + 1024), 16, 0, 0); \
        __builtin_amdgcn_global_load_lds((const unsigned*)(gp[2] + (size_t)c_ * gs[2] + lane * 16), (LAS unsigned*)(sl_ + 2048), 16, 0, 0); \
        asm volatile("" ::: "memory"); } while (0)
        do { asm volatile("" ::: "memory"); __builtin_amdgcn_s_barrier(); asm volatile("" ::: "memory"); } while (0);
        if (loader) { for (int s0 = 0; s0 < DD; ++s0) RW_ISSUE(s0);
            asm volatile("s_waitcnt vmcnt(15)" ::: "memory"); }
        do { asm volatile("" ::: "memory"); __builtin_amdgcn_s_barrier(); asm volatile("" ::: "memory"); } while (0);
        f32x4 S[4];
#pragma unroll
        for (int mt = 0; mt < 4; ++mt) S[mt] = (f32x4){0.f, 0.f, 0.f, 0.f};
        for (int n = 0; n < 256; ++n) {
            if (loader) { RW_ISSUE(n + DD); asm volatile("s_waitcnt vmcnt(15)" ::: "memory"); }
            else if (wave == 0) {
                const LAS unsigned char* sl = lds + (n % NS) * SLOT;
                bf16x8 sf[2]; sf[0] = pack8(S[0], S[1]); sf[1] = pack8(S[2], S[3]);
                f32x4 y = *(const LAS f32x4*)(sl + 14336 + lane * 16);
#pragma unroll
                for (int ks = 0; ks < 2; ++ks) y = __builtin_amdgcn_mfma_f32_16x16x32_bf16(*(const LAS bf16x8*)(sl + 12288 + (ks * 64 + lane) * 16), sf[ks], y, 0, 0, 0);
#pragma unroll
                for (int mt = 0; mt < 4; ++mt) { f32x4 a = *(const LAS f32x4*)(sl + 8192 + (mt * 64 + lane) * 16);
#pragma unroll
                    for (int ks = 0; ks < 2; ++ks) a = __builtin_amdgcn_mfma_f32_16x16x32_bf16(*(const LAS bf16x8*)(sl + ((mt * 2 + ks) * 64 + lane) * 16), sf[ks], a, 0, 0, 0);
                    S[mt] = a; }
                float* yo = ys + ((size_t)b * SEQ + 16 * n + 4 * q) * 512 + hh * 64 + 16 * w + l15;
#pragma unroll
                for (int jj = 0; jj < 4; ++jj) yo[(size_t)jj * 512] = y[jj];
                asm volatile("s_waitcnt lgkmcnt(0)" ::: "memory");
            }
            do { asm volatile("" ::: "memory"); __builtin_amdgcn_s_barrier(); asm volatile("" ::: "memory"); } while (0);
        }
        asm volatile("s_waitcnt vmcnt(0)" ::: "memory");
        do { asm volatile("" ::: "memory"); __builtin_amdgcn_s_barrier(); asm volatile("" ::: "memory"); } while (0);
#undef RW_ISSUE
    }
}

__device__ __forceinline__ void ph_rw_post(const Params& p, int l, int bi, int nb) {
    PROLOG;
    const int tid_ = otid(), lane = tid_ & 63, gw = bi * 8 + (tid_ >> 6), NGW = nb * 8;
    const float* ops = WSP(float, WS_RWOPS); const float* ys = WSP(float, WS_YSCAN); const float* lo = WSP(float, WS_LO); bf16_t* oall = WSP(bf16_t, WS_OALL);
    constexpr size_t AS = (size_t)M * 512; const int c0 = 8 * lane;
    float rk[8], lg[8], lb[8]; ld8(INL(20, 512) + c0, rk); ld8(INL(21, 512) + c0, lg); ld8(INL(22, 512) + c0, lb);
    for (int m0 = gw; m0 < M; m0 += 2 * NGW) {
        float y[2][8], r[2][8], k2[2][8], v[2][8], g[2][8];
#pragma unroll
        for (int u = 0; u < 2; ++u) { const int m = m0 + u * NGW; if (m < M) { const size_t o = (size_t)m * 512 + c0;
            ld8(ys + o, y[u]); ld8(ops + o, r[u]); ld8(ops + 2 * AS + o, k2[u]); ld8(ops + 3 * AS + o, v[u]); ld8(lo + (size_t)m * 1536 + 1024 + c0, g[u]); } }
#pragma unroll
        for (int u = 0; u < 2; ++u) { const int m = m0 + u * NGW; if (m < M) {
            float s1 = 0.f, sb = 0.f;
#pragma unroll
            for (int j = 0; j < 8; ++j) { s1 += y[u][j]; sb += r[u][j] * k2[u][j] * rk[j]; }
            s1 += __shfl_xor(s1, 1); s1 += __shfl_xor(s1, 2); s1 += __shfl_xor(s1, 4); sb += __shfl_xor(sb, 1); sb += __shfl_xor(sb, 2); sb += __shfl_xor(sb, 4);
            const float mean = s1 * (1.f / 64.f); float s2 = 0.f;
#pragma unroll
            for (int j = 0; j < 8; ++j) { y[u][j] -= mean; s2 += y[u][j] * y[u][j]; }
            s2 += __shfl_xor(s2, 1); s2 += __shfl_xor(s2, 2); s2 += __shfl_xor(s2, 4);
            const float rstd = rsqrtf(s2 * (1.f / 64.f) + 64e-5f); float o8[8];
#pragma unroll
            for (int j = 0; j < 8; ++j) o8[j] = (y[u][j] * rstd * lg[j] + lb[j] + sb * v[u][j]) * g[u][j];
            u32x4 w; w.x = cvt_pk_bf16(o8[0], o8[1]); w.y = cvt_pk_bf16(o8[2], o8[3]); w.z = cvt_pk_bf16(o8[4], o8[5]); w.w = cvt_pk_bf16(o8[6], o8[7]);
            *(u32x4*)(oall + (size_t)m * NBR + 512 + c0) = w; } }
    }
}

__device__ __forceinline__ float ret_lg(int hh) { return logf(1.f - exp2f(-5.f - (float)hh)); }
__device__ __forceinline__ void ph_ret_u(const Params& p, LAS unsigned char* lds, int bi, int nb) {
    PROLOG;
    const bf16_t* z = WSP(bf16_t, WS_Z); const bf16_t* kr = WSP(bf16_t, WS_KR); float* ub = WSP(float, WS_UBUF);
    LAS bf16_t* Vt = (LAS bf16_t*)lds;
    LAS bf16_t* Kt = (LAS bf16_t*)(lds + 256 * 136 * 2);
    const int tid = otid(), wave = tid >> 6, lane = tid & 63, r = lane & 15, q = lane >> 4;
    for (int task = bi; task < 256; task += nb) {
        const int b = task >> 7, hh = (task >> 5) & 3, n = task & 31; const float lgh = ret_lg(hh); const size_t m0 = (size_t)b * SEQ + n * 128;
        __syncthreads();
        for (int idx = tid; idx < 128 * 32; idx += 512) { const int mm = idx & 127, ch = idx >> 7; const u32x4 w = *(const u32x4*)(z + (m0 + mm) * NZ + ZC_RET_V + hh * 256 + ch * 8);
            const unsigned ww[4] = {w.x, w.y, w.z, w.w};
#pragma unroll
            for (int i = 0; i < 4; ++i) { Vt[(ch * 8 + 2 * i) * 136 + mm] = (bf16_t)(ww[i] & 0xffffu); Vt[(ch * 8 + 2 * i + 1) * 136 + mm] = (bf16_t)(ww[i] >> 16); } }
        for (int idx = tid; idx < 128 * 16; idx += 512) { const int mm = idx & 127, ch = idx >> 7; const float zeta = __expf((float)(127 - mm) * lgh);
            const u32x4 w = *(const u32x4*)(kr + (m0 + mm) * 512 + hh * 128 + ch * 8); const unsigned ww[4] = {w.x, w.y, w.z, w.w};
#pragma unroll
            for (int i = 0; i < 4; ++i) { Kt[(ch * 8 + 2 * i) * 136 + mm] = f2bf(__uint_as_float(ww[i] << 16) * zeta); Kt[(ch * 8 + 2 * i + 1) * 136 + mm] = f2bf(__uint_as_float(ww[i] & 0xffff0000u) * zeta); } }
        __syncthreads();
        float* uo = ub + (size_t)task * 256 * 128;
#pragma unroll
        for (int et = 0; et < 2; ++et) { const int e0 = 16 * (2 * wave + et); bf16x8 a[4];
#pragma unroll
            for (int ks = 0; ks < 4; ++ks) a[ks] = *(const LAS bf16x8*)(Vt + (e0 + r) * 136 + 32 * ks + 8 * q);
#pragma unroll
            for (int dt = 0; dt < 8; ++dt) { f32x4 acc = {0.f, 0.f, 0.f, 0.f};
#pragma unroll
                for (int ks = 0; ks < 4; ++ks) { const bf16x8 bb = *(const LAS bf16x8*)(Kt + (16 * dt + r) * 136 + 32 * ks + 8 * q); acc = mma16(acc, a[ks], bb); }
                *(f32x4*)(uo + (size_t)(e0 + r) * 128 + 16 * dt + 4 * q) = acc; } }
    }
}
__device__ __forceinline__ void ph_ret_scan(const Params& p, int bi, int nb) {
    PROLOG;
    const float* ub = WSP(float, WS_UBUF); bf16_t* rp = WSP(bf16_t, WS_RPREV);
    const int gt = bi * 512 + otid(), NT = nb * 512;
    for (int i = gt; i < 8 * 8192; i += NT) { const int bh = i >> 13, e4 = i & 8191, hh = bh & 3; const float cd = __expf(128.f * ret_lg(hh)); f32x4 st = {0.f, 0.f, 0.f, 0.f};
        for (int n0 = 0; n0 < 32; n0 += 8) { f32x4 uu[8];
#pragma unroll
            for (int k = 0; k < 8; ++k) uu[k] = *(const f32x4*)(ub + ((size_t)(bh * 32 + n0 + k) * 8192 + e4) * 4);
#pragma unroll
            for (int k = 0; k < 8; ++k) { u32x2 w; w.x = cvt_pk_bf16(st[0], st[1]); w.y = cvt_pk_bf16(st[2], st[3]); *(u32x2*)(rp + ((size_t)(bh * 32 + n0 + k) * 8192 + e4) * 4) = w; st = st * cd + uu[k]; } } }
}
__device__ __forceinline__ void ret_out_task(const Params& p, LAS unsigned char* lds, const int task) {
    PROLOG;
    const bf16_t* z = WSP(bf16_t, WS_Z); const bf16_t* qr = WSP(bf16_t, WS_QR); const bf16_t* kr = WSP(bf16_t, WS_KR); const bf16_t* rp = WSP(bf16_t, WS_RPREV); bf16_t* oall = WSP(bf16_t, WS_OALL);
    LAS bf16_t* Vt = (LAS bf16_t*)lds;
    const int tid = otid(), wave = tid >> 6, lane = tid & 63, r = lane & 15, q = lane >> 4;
    LAS bf16_t* Sc = (LAS bf16_t*)(lds + 256 * 136 * 2) + wave * 16 * 136;
    {
        const int b = task >> 7, hh = (task >> 5) & 3, n = task & 31; const float lgh = ret_lg(hh); const size_t m0 = (size_t)b * SEQ + n * 128;
        __syncthreads();
        for (int idx = tid; idx < 128 * 32; idx += 512) { const int mm = idx & 127, ch = idx >> 7; const u32x4 w = *(const u32x4*)(z + (m0 + mm) * NZ + ZC_RET_V + hh * 256 + ch * 8);
            const unsigned ww[4] = {w.x, w.y, w.z, w.w};
#pragma unroll
            for (int i = 0; i < 4; ++i) { Vt[(ch * 8 + 2 * i) * 136 + mm] = (bf16_t)(ww[i] & 0xffffu); Vt[(ch * 8 + 2 * i + 1) * 136 + mm] = (bf16_t)(ww[i] >> 16); } }
        __syncthreads();
        const int c = 16 * wave + r; const size_t mrow = m0 + c;
        bf16x8 qa[4];
#pragma unroll
        for (int ks = 0; ks < 4; ++ks) qa[ks] = ldfrag(qr + mrow * 512 + hh * 128 + 32 * ks + 8 * q);
#pragma unroll
        for (int mt = 0; mt < 8; ++mt) { f32x4 s = {0.f, 0.f, 0.f, 0.f};
#pragma unroll
            for (int ks = 0; ks < 4; ++ks) s = mma16(s, qa[ks], ldfrag(kr + (m0 + 16 * mt + r) * 512 + hh * 128 + 32 * ks + 8 * q));
            float v[4];
#pragma unroll
            for (int j = 0; j < 4; ++j) { const int mm = 16 * mt + 4 * q + j; v[j] = (c >= mm) ? s[j] * __expf((float)(c - mm) * lgh) : 0.f; }
            u32x2 w; w.x = cvt_pk_bf16(v[0], v[1]); w.y = cvt_pk_bf16(v[2], v[3]); *(LAS u32x2*)(Sc + r * 136 + 16 * mt + 4 * q) = w; }
        asm volatile("s_waitcnt lgkmcnt(0)" ::: "memory");
        const float xi = __expf((float)(c + 1) * lgh);
        const bf16_t* rpc = rp + (size_t)task * 256 * 128;
        f32x4 acc[16]; bf16x8 sa[4];
#pragma unroll
        for (int ks = 0; ks < 4; ++ks) sa[ks] = *(const LAS bf16x8*)(Sc + r * 136 + 32 * ks + 8 * q);
#pragma unroll
        for (int et = 0; et < 16; ++et) { f32x4 a = {0.f, 0.f, 0.f, 0.f};
#pragma unroll
            for (int ks = 0; ks < 4; ++ks) a = mma16(a, qa[ks], ldfrag(rpc + (size_t)(16 * et + r) * 128 + 32 * ks + 8 * q));
            a = a * xi;
#pragma unroll
            for (int ks = 0; ks < 4; ++ks) a = mma16(a, sa[ks], *(const LAS bf16x8*)(Vt + (16 * et + r) * 136 + 32 * ks + 8 * q));
            acc[et] = a; }
        float s1 = 0.f;
#pragma unroll
        for (int et = 0; et < 16; ++et) s1 += acc[et][0] + acc[et][1] + acc[et][2] + acc[et][3];
        s1 += __shfl_xor(s1, 16); s1 += __shfl_xor(s1, 32); const float mean = s1 * (1.f / 256.f); float s2 = 0.f;
#pragma unroll
        for (int et = 0; et < 16; ++et) { acc[et] = acc[et] - mean; s2 += acc[et][0] * acc[et][0] + acc[et][1] * acc[et][1] + acc[et][2] * acc[et][2] + acc[et][3] * acc[et][3]; }
        s2 += __shfl_xor(s2, 16); s2 += __shfl_xor(s2, 32); const float rstd = rsqrtf(s2 * (1.f / 256.f) + 1e-5f);
#pragma unroll
        for (int et = 0; et < 16; ++et) { const int e = 16 * et + 4 * q; const u32x2 gw = *(const u32x2*)(z + mrow * NZ + ZC_RET_G + hh * 256 + e);
            const float g0 = __uint_as_float(gw.x << 16), g1 = __uint_as_float(gw.x & 0xffff0000u), g2 = __uint_as_float(gw.y << 16), g3 = __uint_as_float(gw.y & 0xffff0000u);
            u32x2 w; w.x = cvt_pk_bf16(acc[et][0] * rstd * g0 * sigmoidf_(g0), acc[et][1] * rstd * g1 * sigmoidf_(g1)); w.y = cvt_pk_bf16(acc[et][2] * rstd * g2 * sigmoidf_(g2), acc[et][3] * rstd * g3 * sigmoidf_(g3));
            *(u32x2*)(oall + mrow * NBR + 1024 + hh * 256 + e) = w; }
    }
}
__device__ __forceinline__ void ph_ret_out(const Params& p, LAS unsigned char* lds, int bi, int nb) { for (int task = bi; task < 256; task += nb) ret_out_task(p, lds, task); }

__device__ __forceinline__ void ph_cmp2(const Params& p, int l, LAS unsigned char* lds, int bi, int nb) {
    PROLOG;
    const bf16_t* hid = WSP(bf16_t, WS_HID); bf16_t* kc = WSP(bf16_t, WS_KCMP); bf16_t* vt = WSP(bf16_t, WS_VCMPT); const int* posi = (const int*)inp(p, 2);
    const float* w2 = INL(25, 2 * 256 * 64);
    const int tid = otid(), wave = tid >> 6, lane = tid & 63, r = lane & 15, q = lane >> 4;
    LAS bf16_t* W2T = (LAS bf16_t*)lds;
    if (bi * 8 < 128) {
        for (int i = tid; i < 2 * 256 * 64; i += 512) { const int ii = i >> 14, k = (i >> 6) & 255, d = i & 63; W2T[(ii * 64 + d) * 264 + k] = f2bf(w2[i]); }
        __syncthreads();
        for (int task = bi * 8 + wave; task < 128; task += nb * 8) {
            const int ii = task >> 6, R0 = (task & 63) * 16, row = R0 + r, bg = row >> 8, c = row & 255;
            const bf16_t* hr = hid + ((size_t)ii * 1024 + row) * 256 + 8 * q;
            f32x4 acc[4];
#pragma unroll
            for (int dt = 0; dt < 4; ++dt) acc[dt] = (f32x4){0.f, 0.f, 0.f, 0.f};
#pragma unroll
            for (int ks = 0; ks < 8; ++ks) { const bf16x8 a = ldfrag(hr + 32 * ks);
#pragma unroll
                for (int dt = 0; dt < 4; ++dt) acc[dt] = mma16(acc[dt], a, *(const LAS bf16x8*)(W2T + (ii * 64 + 16 * dt + r) * 264 + 32 * ks + 8 * q)); }
            if (ii == 0) {
                const float pos = (float)posi[(bg >> 1) * SEQ + 16 * (c < 255 ? c : 254) + 31];
#pragma unroll
                for (int dt = 0; dt < 2; ++dt) { float o1[4], o2[4];
#pragma unroll
                    for (int jj = 0; jj < 4; ++jj) { const int d = 16 * dt + 4 * q + jj; const float inv = __expf(-(float)d * (9.210340371976184f / 32.f)); float sn, cs; sincosf(pos * inv, &sn, &cs);
                        const float x1 = acc[dt][jj], x2 = acc[dt + 2][jj]; o1[jj] = (c < 255) ? x1 * cs - x2 * sn : 0.f; o2[jj] = (c < 255) ? x2 * cs + x1 * sn : 0.f; }
                    u32x2 w; w.x = cvt_pk_bf16(o1[0], o1[1]); w.y = cvt_pk_bf16(o1[2], o1[3]); *(u32x2*)(kc + (size_t)row * 64 + 16 * dt + 4 * q) = w;
                    w.x = cvt_pk_bf16(o2[0], o2[1]); w.y = cvt_pk_bf16(o2[2], o2[3]); *(u32x2*)(kc + (size_t)row * 64 + 32 + 16 * dt + 4 * q) = w; }
            } else {
#pragma unroll
                for (int dt = 0; dt < 4; ++dt)
#pragma unroll
                    for (int jj = 0; jj < 4; ++jj) vt[((size_t)bg * 64 + 16 * dt + 4 * q + jj) * 256 + c] = f2bf(c < 255 ? acc[dt][jj] : 0.f);
            }
        }
    }
}
__device__ __forceinline__ void ph_nsa_cmp(const Params& p, LAS unsigned char* lds, int bi, int nb) {
    PROLOG;
    const bf16_t* qn = WSP(bf16_t, WS_QN); const bf16_t* kc = WSP(bf16_t, WS_KCMP); const bf16_t* vt = WSP(bf16_t, WS_VCMPT); bf16_t* ocmp = WSP(bf16_t, WS_OCMP); u64* selm = WSP(u64, WS_SELM);
    const int tid = otid(), wave = tid >> 6, lane = tid & 63, r = lane & 15, q = lane >> 4, grp = wave >> 2, hh = wave & 3;
    LAS bf16_t* Pl = (LAS bf16_t*)(lds + wave * 8448);
    LAS float* Ip = (LAS float*)(lds + 8 * 8448 + wave * 4096);
    for (int bt = bi; bt < 512; bt += nb) {
        const int task = bt * 2 + grp, bg = task >> 8, b = bg >> 1, g = bg & 1, tt = task & 255, t0 = 16 * tt, t = t0 + r; const size_t mrow = (size_t)b * SEQ + t;
        const int cmax = t >= 31 ? (t - 31) >> 4 : -1;
        __syncthreads();
        {
            const int hd = (g * 4 + hh) * 64;
            bf16x8 qa[2]; qa[0] = ldfrag(qn + mrow * 512 + hd + 8 * q); qa[1] = ldfrag(qn + mrow * 512 + hd + 32 + 8 * q);
            f32x4 s[16]; float mx = -1e30f;
#pragma unroll
            for (int ct = 0; ct < 16; ++ct) { f32x4 a = {0.f, 0.f, 0.f, 0.f}; const bf16_t* kp = kc + ((size_t)bg * 256 + 16 * ct + r) * 64 + 8 * q;
                a = mma16(a, qa[0], ldfrag(kp)); a = mma16(a, qa[1], ldfrag(kp + 32));
#pragma unroll
                for (int j = 0; j < 4; ++j) { const int c = 16 * ct + 4 * q + j; a[j] = (c <= cmax) ? a[j] * 0.125f : -1e30f; mx = fmaxf(mx, a[j]); }
                s[ct] = a; }
            { auto r16 = __builtin_amdgcn_permlane16_swap(__float_as_uint(mx), __float_as_uint(mx), false, false); mx = fmaxf(__uint_as_float(r16[0]), __uint_as_float(r16[1]));
              auto r32 = __builtin_amdgcn_permlane32_swap(__float_as_uint(mx), __float_as_uint(mx), false, false); mx = fmaxf(__uint_as_float(r32[0]), __uint_as_float(r32[1])); }
            float sum = 0.f;
#pragma unroll
            for (int ct = 0; ct < 16; ++ct)
#pragma unroll
                for (int j = 0; j < 4; ++j) { const int c = 16 * ct + 4 * q + j; const float e = (c <= cmax) ? __expf(s[ct][j] - mx) : 0.f; s[ct][j] = e; sum += e; }
            { auto r16 = __builtin_amdgcn_permlane16_swap(__float_as_uint(sum), __float_as_uint(sum), false, false); sum = __uint_as_float(r16[0]) + __uint_as_float(r16[1]);
              auto r32 = __builtin_amdgcn_permlane32_swap(__float_as_uint(sum), __float_as_uint(sum), false, false); sum = __uint_as_float(r32[0]) + __uint_as_float(r32[1]); }
            const float rinv = 1.f / fmaxf(sum, 1e-30f);
            float yprev = 0.f;
#pragma unroll
            for (int ct = 0; ct < 16; ++ct) { s[ct] = s[ct] * rinv;
                const float y = __shfl(s[ct][3], (lane + 48) & 63);
                const float prev = q > 0 ? y : yprev; yprev = y;
                Ip[r * 64 + 4 * ct + q] = (s[ct][0] + s[ct][1]) + (s[ct][2] + s[ct][3]) + prev;
                u32x2 w; w.x = cvt_pk_bf16(s[ct][0], s[ct][1]); w.y = cvt_pk_bf16(s[ct][2], s[ct][3]); *(LAS u32x2*)(Pl + r * 264 + 16 * ct + 4 * q) = w; }
            asm volatile("s_waitcnt lgkmcnt(0)" ::: "memory");
            f32x4 o[4];
#pragma unroll
            for (int dt = 0; dt < 4; ++dt) o[dt] = (f32x4){0.f, 0.f, 0.f, 0.f};
#pragma unroll
            for (int ks = 0; ks < 8; ++ks) { const bf16x8 pa = *(const LAS bf16x8*)(Pl + r * 264 + 32 * ks + 8 * q);
#pragma unroll
                for (int dt = 0; dt < 4; ++dt) o[dt] = mma16(o[dt], pa, ldfrag(vt + ((size_t)bg * 64 + 16 * dt + r) * 256 + 32 * ks + 8 * q)); }
#pragma unroll
            for (int dt = 0; dt < 4; ++dt) { u32x2 w; w.x = cvt_pk_bf16(o[dt][0], o[dt][1]); w.y = cvt_pk_bf16(o[dt][2], o[dt][3]); *(u32x2*)(ocmp + mrow * 512 + hd + 16 * dt + 4 * q) = w; }
        }
        __syncthreads();
        { LAS float* Ig = (LAS float*)(lds + 8 * 8448 + grp * 4 * 4096);
          for (int rr = 4 * hh; rr < 4 * hh + 4; ++rr) {
            const int tq = t0 + rr, cur = tq >> 6; const float v = (Ig[rr * 64 + lane] + Ig[1024 + rr * 64 + lane]) + (Ig[2048 + rr * 64 + lane] + Ig[3072 + rr * 64 + lane]);
            const bool valid = lane <= cur; const bool forced = (lane == 0) || (lane == cur) || (lane == cur - 1);
            const float key = forced ? __builtin_inff() : v; int rank = 0;
            for (int i = 0; i <= cur; ++i) { const float ki = __int_as_float(__builtin_amdgcn_readlane(__float_as_int(key), i)); rank += (ki > key || (ki == key && i < lane)) ? 1 : 0; }
            const u64 msk = __ballot(valid && rank < 16);
            if (lane == 0) selm[(size_t)bg * SEQ + tq] = msk; } }
    }
}
__device__ __forceinline__ void ph_nsa_attn(const Params& p, int l, LAS unsigned char* lds, int bi, int nb) {
    PROLOG;
    const bf16_t* z = WSP(bf16_t, WS_Z); const bf16_t* qn = WSP(bf16_t, WS_QN); const bf16_t* kvg = WSP(bf16_t, WS_KVG); const bf16_t* ocmp = WSP(bf16_t, WS_OCMP); const u64* selm = WSP(u64, WS_SELM); bf16_t* oall = WSP(bf16_t, WS_OALL);
    const int tid = otid(), wave = tid >> 6, lane = tid & 63, r = lane & 15, q = lane >> 4;
    LAS bf16_t* Pl = (LAS bf16_t*)(lds + wave * 4096);
    unsigned* qhead = WSP(unsigned, 1024 + 256 * l);
    for (;;) {
        unsigned tk = 0u; if (lane == 0) tk = __hip_atomic_fetch_add(qhead, 1u, __ATOMIC_RELAXED, __HIP_MEMORY_SCOPE_AGENT);
        const int task = __builtin_amdgcn_readfirstlane((int)tk); if (task >= 4096) break;
        const int tt = 255 - (task >> 4), sub = task & 15;
        const int bg = sub >> 2, hh = sub & 3, b = bg >> 1, g = bg & 1, t0 = 16 * tt, t = t0 + r, cur = t0 >> 6; const size_t mrow = (size_t)b * SEQ + t;
        const int hd = (g * 4 + hh) * 64;
        bf16x8 qa[2]; qa[0] = ldfrag(qn + mrow * 512 + hd + 8 * q); qa[1] = ldfrag(qn + mrow * 512 + hd + 32 + 8 * q);
        const u64 mymask = selm[(size_t)bg * SEQ + t];
        unsigned mlo = (unsigned)mymask, mhi = (unsigned)(mymask >> 32);
#pragma unroll
        for (int o = 1; o < 16; o <<= 1) { mlo |= __shfl_xor(mlo, o); mhi |= __shfl_xor(mhi, o); }
        const u64 umask = ((u64)(unsigned)__builtin_amdgcn_readfirstlane((int)mhi) << 32) | (u64)(unsigned)__builtin_amdgcn_readfirstlane((int)mlo);
        const u64 upto = (cur >= 63) ? ~0ull : ((2ull << cur) - 1ull);
        f32x4 res[4];
#pragma unroll
        for (int br = 0; br < 2; ++br) {
            const bf16_t* Kb = kvg + (br == 0 ? 2 : 4) * KVG_SLAB + (size_t)bg * SEQ * 64 + (size_t)r * 64 + 8 * q;
            const bf16_t* Vtb = kvg + (br == 0 ? 3 : 5) * KVG_SLAB + (size_t)bg * 64 * SEQ + (size_t)r * SEQ + 8 * q;
            const int j0 = (t0 >= 511) ? ((t0 - 511) >> 6) : 0;
            u64 rem = (br == 0) ? (umask & upto) : (upto & ~((1ull << j0) - 1ull));
            float mrun = -1e30f, lrun = 0.f; f32x4 o[4];
#pragma unroll
            for (int dt = 0; dt < 4; ++dt) o[dt] = (f32x4){0.f, 0.f, 0.f, 0.f};
            bf16x8 kA[8], vA[8], kB[8], vB[8];
#define NSA_LOAD(KF, VF, jt) do { _Pragma("unroll") for (int ct = 0; ct < 4; ++ct) { KF[2 * ct] = ldfrag(Kb + (size_t)(64 * (jt) + 16 * ct) * 64); KF[2 * ct + 1] = ldfrag(Kb + (size_t)(64 * (jt) + 16 * ct) * 64 + 32); \
                VF[2 * ct] = ldfrag(Vtb + (size_t)(16 * ct) * SEQ + 64 * (jt)); VF[2 * ct + 1] = ldfrag(Vtb + (size_t)(16 * ct) * SEQ + 64 * (jt) + 32); } } while (0)
            auto tile = [&](const bf16x8 (&kf)[8], const bf16x8 (&vf)[8], const int j) {
                const int k0 = 64 * j; const bool rowsel = br == 0 ? (((mymask >> j) & 1ull) != 0) : true;
                const bool edge = (k0 + 63 > t0) || (br == 1 && t0 + 15 - k0 >= 512);
                f32x4 s[4]; float mx = -1e30f;
#pragma unroll
                for (int ct = 0; ct < 4; ++ct) { f32x4 a = {0.f, 0.f, 0.f, 0.f}; a = mma16(a, qa[0], kf[2 * ct]); a = mma16(a, qa[1], kf[2 * ct + 1]); s[ct] = a; }
                if (edge) {
#pragma unroll
                    for (int ct = 0; ct < 4; ++ct)
#pragma unroll
                        for (int jj = 0; jj < 4; ++jj) { const int key = k0 + 16 * ct + 4 * q + jj; const bool ok = rowsel && key <= t && (br == 0 || t - key < 512); s[ct][jj] = ok ? s[ct][jj] * 0.125f : -1e30f; mx = fmaxf(mx, s[ct][jj]); }
                } else {
#pragma unroll
                    for (int ct = 0; ct < 4; ++ct)
#pragma unroll
                        for (int jj = 0; jj < 4; ++jj) { s[ct][jj] = rowsel ? s[ct][jj] * 0.125f : -1e30f; mx = fmaxf(mx, s[ct][jj]); }
                }
                { auto r16 = __builtin_amdgcn_permlane16_swap(__float_as_uint(mx), __float_as_uint(mx), false, false); mx = fmaxf(__uint_as_float(r16[0]), __uint_as_float(r16[1]));
                  auto r32 = __builtin_amdgcn_permlane32_swap(__float_as_uint(mx), __float_as_uint(mx), false, false); mx = fmaxf(__uint_as_float(r32[0]), __uint_as_float(r32[1])); }
                const float mnew = fmaxf(mrun, mx), alpha = __expf(mrun - mnew); float sum = 0.f;
#pragma unroll
                for (int ct = 0; ct < 4; ++ct) {
#pragma unroll
                    for (int jj = 0; jj < 4; ++jj) { const float e = (s[ct][jj] > -1e29f) ? __expf(s[ct][jj] - mnew) : 0.f; s[ct][jj] = e; sum += e; }
                    u32x2 w; w.x = cvt_pk_bf16(s[ct][0], s[ct][1]); w.y = cvt_pk_bf16(s[ct][2], s[ct][3]); *(LAS u32x2*)(Pl + r * 72 + 16 * ct + 4 * q) = w; }
                { auto r16 = __builtin_amdgcn_permlane16_swap(__float_as_uint(sum), __float_as_uint(sum), false, false); sum = __uint_as_float(r16[0]) + __uint_as_float(r16[1]);
                  auto r32 = __builtin_amdgcn_permlane32_swap(__float_as_uint(sum), __float_as_uint(sum), false, false); sum = __uint_as_float(r32[0]) + __uint_as_float(r32[1]); }
                lrun = lrun * alpha + sum; mrun = mnew;
#pragma unroll
                for (int dt = 0; dt < 4; ++dt) o[dt] = o[dt] * alpha;
                asm volatile("s_waitcnt lgkmcnt(0)" ::: "memory");
                const bf16x8 pa0 = *(const LAS bf16x8*)(Pl + r * 72 + 8 * q), pa1 = *(const LAS bf16x8*)(Pl + r * 72 + 32 + 8 * q);
#pragma unroll
                for (int dt = 0; dt < 4; ++dt) { f32x4 a = o[dt]; a = mma16(a, pa0, vf[2 * dt]); a = mma16(a, pa1, vf[2 * dt + 1]); o[dt] = a; }
            };
            int j = rem ? __builtin_ctzll(rem) : -1; if (rem) rem &= rem - 1ull;
            if (j >= 0) NSA_LOAD(kA, vA, j);
            while (j >= 0) {
                const int j1 = rem ? __builtin_ctzll(rem) : -1; if (rem) rem &= rem - 1ull;
                if (j1 >= 0) NSA_LOAD(kB, vB, j1);
                tile(kA, vA, j);
                if (j1 < 0) break;
                const int j2 = rem ? __builtin_ctzll(rem) : -1; if (rem) rem &= rem - 1ull;
                if (j2 >= 0) NSA_LOAD(kA, vA, j2);
                tile(kB, vB, j1);
                j = j2;
            }
#undef NSA_LOAD
            const float rinv = 1.f / fmaxf(lrun, 1e-30f);
            const float gt = sigmoidf_(zf(z + mrow * NZ, ZC_NSA_GT + (g * 4 + hh) * 3 + 1 + br));
#pragma unroll
            for (int dt = 0; dt < 4; ++dt) { if (br == 0) res[dt] = o[dt] * (rinv * gt); else res[dt] += o[dt] * (rinv * gt); }
        }
        const float g0 = sigmoidf_(zf(z + mrow * NZ, ZC_NSA_GT + (g * 4 + hh) * 3));
#pragma unroll
        for (int dt = 0; dt < 4; ++dt) { const u32x2 cw = *(const u32x2*)(ocmp + mrow * 512 + hd + 16 * dt + 4 * q);
            const float c0 = __uint_as_float(cw.x << 16), c1 = __uint_as_float(cw.x & 0xffff0000u), c2 = __uint_as_float(cw.y << 16), c3 = __uint_as_float(cw.y & 0xffff0000u);
            u32x2 w; w.x = cvt_pk_bf16(res[dt][0] + g0 * c0, res[dt][1] + g0 * c1); w.y = cvt_pk_bf16(res[dt][2] + g0 * c2, res[dt][3] + g0 * c3);
            *(u32x2*)(oall + mrow * NBR + 2048 + hd + 16 * dt + 4 * q) = w; }
    }
}

__device__ __forceinline__ void nsa_attn2_task(const Params& p, LAS unsigned char* lds, const int task) {
    PROLOG;
    const bf16_t* z = WSP(bf16_t, WS_Z); const bf16_t* qn = WSP(bf16_t, WS_QN); const bf16_t* kvg = WSP(bf16_t, WS_KVG); const bf16_t* ocmp = WSP(bf16_t, WS_OCMP); const u64* selm = WSP(u64, WS_SELM); bf16_t* oall = WSP(bf16_t, WS_OALL);
    const int tid = otid(), wave = tid >> 6, lane = tid & 63, r = lane & 15, q = lane >> 4, hh = wave & 3, tsel = wave >> 2;
    constexpr int TP = 72;
    LAS bf16_t* Kt[2] = {(LAS bf16_t*)lds, (LAS bf16_t*)(lds + 2 * 64 * TP * 2)};
    LAS bf16_t* Vt[2] = {(LAS bf16_t*)(lds + 64 * TP * 2), (LAS bf16_t*)(lds + 3 * 64 * TP * 2)};
    LAS bf16_t* Pl = (LAS bf16_t*)(lds + 4 * 64 * TP * 2) + wave * 16 * TP;
    LAS unsigned* ctl = (LAS unsigned*)(lds + 4 * 64 * TP * 2 + 8 * 16 * TP * 2);
    const int srow = tid >> 3, schk = tid & 7;
    {
        __syncthreads();
        const int tt = 127 - (task >> 2), bg = task & 3, b = bg >> 1, g = bg & 1, t0 = 32 * tt + 16 * tsel, t = t0 + r, cur = (32 * tt) >> 6; const size_t mrow = (size_t)b * SEQ + t;
        const int hd = (g * 4 + hh) * 64;
        bf16x8 qa[2]; qa[0] = ldfrag(qn + mrow * 512 + hd + 8 * q); qa[1] = ldfrag(qn + mrow * 512 + hd + 32 + 8 * q);
        const u64 mymask = selm[(size_t)bg * SEQ + t];
        { unsigned mlo = (unsigned)mymask, mhi = (unsigned)(mymask >> 32);
#pragma unroll
          for (int o = 1; o < 16; o <<= 1) { mlo |= __shfl_xor(mlo, o); mhi |= __shfl_xor(mhi, o); }
          if (lane == 0 && hh == 0) { ctl[2 + 2 * tsel] = mlo; ctl[3 + 2 * tsel] = mhi; } }
        __syncthreads();
        const u64 umask = ((u64)(ctl[3] | ctl[5]) << 32) | (u64)(ctl[2] | ctl[4]);
        const u64 upto = (cur >= 63) ? ~0ull : ((2ull << cur) - 1ull);
        f32x4 res[4];
#pragma unroll
        for (int br = 0; br < 2; ++br) {
            const bf16_t* Kg = kvg + (br == 0 ? 2 : 4) * KVG_SLAB + (size_t)bg * SEQ * 64 + (size_t)srow * 64 + schk * 8;
            const bf16_t* Vg = kvg + (br == 0 ? 3 : 5) * KVG_SLAB + (size_t)bg * 64 * SEQ + (size_t)srow * SEQ + schk * 8;
            const int tmin = 32 * tt, j0 = (tmin >= 511) ? ((tmin - 511) >> 6) : 0;
            u64 rem = (br == 0) ? (umask & upto) : (upto & ~((1ull << j0) - 1ull));
            float mrun = -1e30f, lrun = 0.f; f32x4 o[4];
#pragma unroll
            for (int dt = 0; dt < 4; ++dt) o[dt] = (f32x4){0.f, 0.f, 0.f, 0.f};
            int j = __builtin_ctzll(rem); rem &= rem - 1ull;
            { const u32x4 kx = *(const u32x4*)(Kg + (size_t)(64 * j) * 64), vx = *(const u32x4*)(Vg + 64 * j);
              __syncthreads();
              *(LAS u32x4*)(Kt[0] + srow * TP + schk * 8) = kx; *(LAS u32x4*)(Vt[0] + srow * TP + schk * 8) = vx; }
            __syncthreads();
            int pb = 0;
            for (;;) {
                const int jn = rem ? __builtin_ctzll(rem) : -1; if (rem) rem &= rem - 1ull;
                u32x4 kx, vx; if (jn >= 0) { kx = *(const u32x4*)(Kg + (size_t)(64 * jn) * 64); vx = *(const u32x4*)(Vg + 64 * jn); }
                { const int k0 = 64 * j; const bool rowsel = br == 0 ? (((mymask >> j) & 1ull) != 0) : true;
                  const bool edge = (k0 + 63 > tmin) || (br == 1 && tmin + 31 - k0 >= 512);
                  const LAS bf16_t* Kb = Kt[pb]; const LAS bf16_t* Vb = Vt[pb];
                  f32x4 sc[4]; float mx = -1e30f;
#pragma unroll
                  for (int ct = 0; ct < 4; ++ct) { f32x4 a = {0.f, 0.f, 0.f, 0.f}; a = mma16(a, qa[0], *(const LAS bf16x8*)(Kb + (16 * ct + r) * TP + 8 * q)); a = mma16(a, qa[1], *(const LAS bf16x8*)(Kb + (16 * ct + r) * TP + 32 + 8 * q)); sc[ct] = a; }
                  if (edge) {
#pragma unroll
                      for (int ct = 0; ct < 4; ++ct)
#pragma unroll
                          for (int jj = 0; jj < 4; ++jj) { const int key = k0 + 16 * ct + 4 * q + jj; const bool ok = rowsel && key <= t && (br == 0 || t - key < 512); sc[ct][jj] = ok ? sc[ct][jj] * 0.125f : -1e30f; mx = fmaxf(mx, sc[ct][jj]); }
                  } else {
#pragma unroll
                      for (int ct = 0; ct < 4; ++ct)
#pragma unroll
                          for (int jj = 0; jj < 4; ++jj) { sc[ct][jj] = rowsel ? sc[ct][jj] * 0.125f : -1e30f; mx = fmaxf(mx, sc[ct][jj]); }
                  }
                  { auto r16 = __builtin_amdgcn_permlane16_swap(__float_as_uint(mx), __float_as_uint(mx), false, false); mx = fmaxf(__uint_as_float(r16[0]), __uint_as_float(r16[1]));
                    auto r32 = __builtin_amdgcn_permlane32_swap(__float_as_uint(mx), __float_as_uint(mx), false, false); mx = fmaxf(__uint_as_float(r32[0]), __uint_as_float(r32[1])); }
                  const float mnew = fmaxf(mrun, mx), alpha = __expf(mrun - mnew); float sum = 0.f;
#pragma unroll
                  for (int ct = 0; ct < 4; ++ct) {
#pragma unroll
                      for (int jj = 0; jj < 4; ++jj) { const float e = (sc[ct][jj] > -1e29f) ? __expf(sc[ct][jj] - mnew) : 0.f; sc[ct][jj] = e; sum += e; }
                      u32x2 w; w.x = cvt_pk_bf16(sc[ct][0], sc[ct][1]); w.y = cvt_pk_bf16(sc[ct][2], sc[ct][3]); *(LAS u32x2*)(Pl + r * TP + 16 * ct + 4 * q) = w; }
                  { auto r16 = __builtin_amdgcn_permlane16_swap(__float_as_uint(sum), __float_as_uint(sum), false, false); sum = __uint_as_float(r16[0]) + __uint_as_float(r16[1]);
                    auto r32 = __builtin_amdgcn_permlane32_swap(__float_as_uint(sum), __float_as_uint(sum), false, false); sum = __uint_as_float(r32[0]) + __uint_as_float(r32[1]); }
                  lrun = lrun * alpha + sum; mrun = mnew;
#pragma unroll
                  for (int dt = 0; dt < 4; ++dt) o[dt] = o[dt] * alpha;
                  asm volatile("s_waitcnt lgkmcnt(0)" ::: "memory");
                  const bf16x8 pa0 = *(const LAS bf16x8*)(Pl + r * TP + 8 * q), pa1 = *(const LAS bf16x8*)(Pl + r * TP + 32 + 8 * q);
#pragma unroll
                  for (int dt = 0; dt < 4; ++dt) { f32x4 a = o[dt]; a = mma16(a, pa0, *(const LAS bf16x8*)(Vb + (16 * dt + r) * TP + 8 * q)); a = mma16(a, pa1, *(const LAS bf16x8*)(Vb + (16 * dt + r) * TP + 32 + 8 * q)); o[dt] = a; } }
                if (jn < 0) break;
                *(LAS u32x4*)(Kt[pb ^ 1] + srow * TP + schk * 8) = kx; *(LAS u32x4*)(Vt[pb ^ 1] + srow * TP + schk * 8) = vx;
                __syncthreads();
                pb ^= 1; j = jn;
            }
            const float rinv = 1.f / fmaxf(lrun, 1e-30f);
            const float gt = sigmoidf_(zf(z + mrow * NZ, ZC_NSA_GT + (g * 4 + hh) * 3 + 1 + br));
#pragma unroll
            for (int dt = 0; dt < 4; ++dt) { if (br == 0) res[dt] = o[dt] * (rinv * gt); else res[dt] += o[dt] * (rinv * gt); }
        }
        const float g0 = sigmoidf_(zf(z + mrow * NZ, ZC_NSA_GT + (g * 4 + hh) * 3));
#pragma unroll
        for (int dt = 0; dt < 4; ++dt) { const u32x2 cw = *(const u32x2*)(ocmp + mrow * 512 + hd + 16 * dt + 4 * q);
            const float c0 = __uint_as_float(cw.x << 16), c1 = __uint_as_float(cw.x & 0xffff0000u), c2 = __uint_as_float(cw.y << 16), c3 = __uint_as_float(cw.y & 0xffff0000u);
            u32x2 w; w.x = cvt_pk_bf16(res[dt][0] + g0 * c0, res[dt][1] + g0 * c1); w.y = cvt_pk_bf16(res[dt][2] + g0 * c2, res[dt][3] + g0 * c3);
            *(u32x2*)(oall + mrow * NBR + 2048 + hd + 16 * dt + 4 * q) = w; }
    }
}
__device__ __forceinline__ void ph_p7_queue(const Params& p, int l, LAS unsigned char* lds, int bi, int nb) {
    PROLOG;
    unsigned* qhead = WSP(unsigned, 1024 + 256 * l);
    LAS unsigned* qw = (LAS unsigned*)(lds + 120000);
    const int tid = otid();
    for (;;) {
        __syncthreads();
        if (tid == 0) qw[0] = __hip_atomic_fetch_add(qhead, 1u, __ATOMIC_RELAXED, __HIP_MEMORY_SCOPE_AGENT);
        __syncthreads();
        const int task = (int)qw[0]; if (task >= 768) break;
        if (task < 256) ret_out_task(p, lds, task); else nsa_attn2_task(p, lds, task - 256);
    }
}

__device__ __forceinline__ void ph_xsoftmax(const Params& p, int bi, int nb) {
    PROLOG;
    const float* sc = WSP(float, WS_SC); bf16_t* pb = WSP(bf16_t, WS_PB);
    const int tid_ = otid(), lane = tid_ & 63, gw = bi * 8 + (tid_ >> 6), NGW = nb * 8;
    for (int it = gw; it < M * 4; it += NGW) { const f32x4 v = *(const f32x4*)(sc + (size_t)it * 256 + lane * 4);
        float mx = fmaxf(fmaxf(v[0], v[1]), fmaxf(v[2], v[3]));
#pragma unroll
        for (int o = 1; o < 64; o <<= 1) mx = fmaxf(mx, __shfl_xor(mx, o));
        const float e0 = __expf(v[0] - mx), e1 = __expf(v[1] - mx), e2 = __expf(v[2] - mx), e3 = __expf(v[3] - mx);
        const float rinv = 1.f / wave_sum((e0 + e1) + (e2 + e3));
        u32x2 w; w.x = cvt_pk_bf16(e0 * rinv, e1 * rinv); w.y = cvt_pk_bf16(e2 * rinv, e3 * rinv); *(u32x2*)(pb + (size_t)it * 256 + lane * 4) = w; }
}
__device__ __forceinline__ void ph_convact(const Params& p, int l, int bi, int nb) {
    PROLOG;
    const bf16_t* u = WSP(bf16_t, WS_U); bf16_t* ga = WSP(bf16_t, WS_GACT); const float* cw = INL(32, 3 * FFN2); const float* cb = INL(33, FFN2);
    const int gt = bi * 512 + otid(), NT = nb * 512;
    for (int i = gt; i < (M / 16) * (FFN / 8); i += NT) { const int rb = i / (FFN / 8), c8 = (i % (FFN / 8)) * 8, m0 = rb * 16, t0 = m0 & 4095; const int ua = 256 * (c8 >> 7) + (c8 & 127);
        float wa[3][8], wb[3][8], ba[8], bb[8];
#pragma unroll
        for (int k = 0; k < 3; ++k) { ld8(cw + k * FFN2 + c8, wa[k]); ld8(cw + k * FFN2 + FFN + c8, wb[k]); }
        ld8(cb + c8, ba); ld8(cb + FFN + c8, bb);
        float a1[8], a2[8], b1[8], b2[8];
        if (t0 >= 2) { bf8_to_f(*(const u32x4*)(u + (size_t)(m0 - 1) * FFN2 + ua), a1); bf8_to_f(*(const u32x4*)(u + (size_t)(m0 - 2) * FFN2 + ua), a2);
            bf8_to_f(*(const u32x4*)(u + (size_t)(m0 - 1) * FFN2 + ua + 128), b1); bf8_to_f(*(const u32x4*)(u + (size_t)(m0 - 2) * FFN2 + ua + 128), b2); }
        else {
#pragma unroll
            for (int j = 0; j < 8; ++j) { a1[j] = 0.f; a2[j] = 0.f; b1[j] = 0.f; b2[j] = 0.f; } }
#pragma unroll 4
        for (int rr = 0; rr < 16; ++rr) { float a0[8], b0[8]; const bf16_t* ur = u + (size_t)(m0 + rr) * FFN2 + ua; bf8_to_f(*(const u32x4*)ur, a0); bf8_to_f(*(const u32x4*)(ur + 128), b0);
            float o8[8];
#pragma unroll
            for (int j = 0; j < 8; ++j) { const float va = ba[j] + wa[0][j] * a2[j] + wa[1][j] * a1[j] + wa[2][j] * a0[j], vb = bb[j] + wb[0][j] * b2[j] + wb[1][j] * b1[j] + wb[2][j] * b0[j];
                o8[j] = gelu_tanh(va) * vb; a2[j] = a1[j]; a1[j] = a0[j]; b2[j] = b1[j]; b1[j] = b0[j]; }
            u32x4 w; w.x = cvt_pk_bf16(o8[0], o8[1]); w.y = cvt_pk_bf16(o8[2], o8[3]); w.z = cvt_pk_bf16(o8[4], o8[5]); w.w = cvt_pk_bf16(o8[6], o8[7]);
            *(u32x4*)(ga + (size_t)(m0 + rr) * FFN + c8) = w; }
    }
}


#define XB_TMO      128
#define XB_XCNT(j)  (256  + 64 * (j))
#define XB_XSUB(j)  (1280 + 64 * (j))
#define XB_XGEN(j)  (2304 + 64 * (j))
#define XB_TOP      3328
#define XB_TOPGEN   3392
#define XCD_BAR_WORDS 3456
#define XB_SPIN_CAP (1u << 18)
__device__ __forceinline__ unsigned xb_ld(unsigned* p)              { return __hip_atomic_load(p, __ATOMIC_RELAXED, __HIP_MEMORY_SCOPE_AGENT); }
__device__ __forceinline__ unsigned xb_add(unsigned* p, unsigned v) { return __hip_atomic_fetch_add(p, v, __ATOMIC_RELAXED, __HIP_MEMORY_SCOPE_AGENT); }
__device__ __forceinline__ unsigned xb_xcc_id() { return (unsigned)__builtin_amdgcn_s_getreg((3 << 11) | 20) & 0xFu; }
#define XB_SPIN(cond, bar) do { unsigned _sp = 0; while (cond) { __builtin_amdgcn_s_sleep(1); \
    if ((++_sp & 255u) == 0u) { if (xb_ld(&(bar)[XB_TMO])) break; if (_sp > XB_SPIN_CAP) { atomicAdd(&(bar)[XB_TMO], 1u); break; } } } } while (0)
struct XcdBarrier { unsigned* bar; unsigned x; volatile LAS unsigned* st; };
__device__ __forceinline__ XcdBarrier xcd_barrier_post(unsigned* bar, volatile LAS unsigned* st) {
    XcdBarrier b; b.bar = bar; b.x = xb_xcc_id(); b.st = st;
    if (threadIdx.x == 0) (void)xb_add(&bar[XB_XCNT(b.x)], 1u);
    return b;
}
__device__ __forceinline__ void xcd_barrier_complete(unsigned* bar, unsigned x, unsigned& nloc, unsigned& nx) {
    const unsigned G = gridDim.x * gridDim.y * gridDim.z;
    unsigned sum, cnt, mine, sp = 0u;
    for (;;) {
        sum = 0u; cnt = 0u; mine = 0u;
#pragma unroll
        for (unsigned j = 0; j < 16; ++j) { const unsigned c = xb_ld(&bar[XB_XCNT(j)]); sum += c; cnt += (c > 0u) ? 1u : 0u; mine = (j == x) ? c : mine; }
        if (sum == G) break;
        __builtin_amdgcn_s_sleep(1);
        if ((++sp & 255u) == 0u) { if (xb_ld(&bar[XB_TMO])) break; if (sp > XB_SPIN_CAP) { atomicAdd(&bar[XB_TMO], 1u); break; } }
    }
    nloc = mine > 0u ? mine : 1u; nx = cnt > 0u ? cnt : 1u;
}
__device__ __forceinline__ void xcd_barrier(const XcdBarrier& b) {
    asm volatile("s_waitcnt vmcnt(0)" ::: "memory");
    __syncthreads();
    if (threadIdx.x == 0) {
        unsigned* bar = (unsigned*)(ws_lds() + WS_CTL) + 1024;
        __builtin_amdgcn_s_waitcnt(0);
        unsigned nloc = b.st[0], nx = b.st[1];
        if (nloc == 0u) { xcd_barrier_complete(bar, b.x, nloc, nx); b.st[0] = nloc; b.st[1] = nx; }
        const unsigned old = xb_add(&bar[XB_XSUB(b.x)], 1u);
        const unsigned gen = old / nloc;
        if (old + 1u == (gen + 1u) * nloc) {
            __builtin_amdgcn_fence(__ATOMIC_RELEASE, "agent");
            asm volatile("s_waitcnt vmcnt(0)" ::: "memory");
            const unsigned og = xb_add(&bar[XB_TOP], 1u);
            const unsigned tg = og / nx;
            if (og + 1u == (tg + 1u) * nx) xb_add(&bar[XB_TOPGEN], 1u);
            else XB_SPIN(xb_ld(&bar[XB_TOPGEN]) == tg, bar);
            __builtin_amdgcn_fence(__ATOMIC_ACQUIRE, "agent");
            xb_add(&bar[XB_XGEN(b.x)], 1u);
            asm volatile("s_waitcnt vmcnt(0)" ::: "memory");
        } else {
            XB_SPIN(xb_ld(&bar[XB_XGEN(b.x)]) == gen, bar);
            __builtin_amdgcn_fence(__ATOMIC_ACQUIRE, "agent");
            asm volatile("s_waitcnt vmcnt(0)" ::: "memory");
        }
    }
    __syncthreads();
}

enum { PH_CONVERT = 0, PH_MEMKV, PH_NORM1, PH_INPROJ, PH_MIXPREP, PH_LORA_CMP1, PH_RWPREP2_CMP2_RETU, PH_RWCHUNK, PH_RWSERIAL, PH_RETSCAN, PH_NSACMP, PH_RWPOST_RETOUT, PH_NSAATTN,
       PH_P1, PH_P4, PH_P5, PH_P6, PH_P7, PH_P8,
       PH_BRANCH, PH_OUTPROJ, PH_FINISH1, PH_QPROJ, PH_XSCORE, PH_XSOFTMAX, PH_XPV, PH_XO, PH_FINISH2, PH_UP, PH_CONVACT, PH_DOWN, PH_FINISH3, PH_COUNT };

template <int PH> __device__ __forceinline__ void run_phase(const Params& p, int l, LAS unsigned char* lds, int bi, int nb) {
    using namespace pg8;
    PROLOG;
    if constexpr (PH == PH_CONVERT) ph_convert(p, l, lds, bi, nb);
    else if constexpr (PH == PH_MEMKV) {
        { GSched s = make_sched(WSP(bf16_t, WS_MEMN), D, WSP(bf16_t, WS_W_KV), D, 2, 8, D, bi, nb); EpiBf16<0> e{WSP(bf16_t, WS_KMEM), D, nullptr}; gemm_phase(lds, D, D, D, s, e); }
        { GSched s = make_sched(WSP(bf16_t, WS_W_KV) + (size_t)D * D, D, WSP(bf16_t, WS_MEMN), D, 8, 2, 512, bi, nb); EpiBf16<0> e{WSP(bf16_t, WS_VTM), 512, nullptr}; gemm_phase(lds, D, D, D, s, e); }
    }
    else if constexpr (PH == PH_NORM1) ph_norm_rows(l == 0 ? inp(p, 0) : (const float*)OUTP, INL(3, D), WSP(bf16_t, WS_H), M, bi, nb);
    else if constexpr (PH == PH_INPROJ) { GSched s = make_sched(WSP(bf16_t, WS_H), D, WSP(bf16_t, WS_W_IN), D, 32, 64, NZ, bi, nb); EpiZ e{WSP(bf16_t, WS_Z), NZ}; gemm_phase(lds, D, D, D, s, e); }
    else if constexpr (PH == PH_MIXPREP) ph_mix_prep(p, l, lds, bi, nb);
    else if constexpr (PH == PH_LORA_CMP1) {
        { GSched s = make_sched(WSP(bf16_t, WS_ALORA), 512, WSP(bf16_t, WS_W_LORA), 512, 32, 6, 1536, bi, nb); EpiF32 e{WSP(float, WS_LO), 1536, 1.f}; gemm_phase(lds, 512, 512, 512, s, e); }
        { GSched s = make_sched(WSP(bf16_t, WS_KVG), 1024, WSP(bf16_t, WS_W_C1), 2048, 1, 1, 256, bi, nb); s.nZ1 = 2; s.nZ2 = 4; s.a_z1 = (long)KVG_SLAB * 2; s.a_z2 = (long)SEQ * 64 * 2; s.b_z1 = (long)256 * 2048 * 2; s.b_z2 = 0;
          s.o_z1 = 4 * 256 * 256; s.o_z2 = 256 * 256;
          EpiC1 e{WSP(bf16_t, WS_HID), WSP(float, WS_CBIAS)}; gemm_phase(lds, 1024, 2048, 2048, s, e); }
    }
    else if constexpr (PH == PH_RWPREP2_CMP2_RETU) { ph_rw_prep2(p, l, bi, nb); ph_cmp2(p, l, lds, bi, nb); ph_ret_u(p, lds, bi, nb); }
    else if constexpr (PH == PH_RWCHUNK) ph_rw_chunk(p, lds, bi, nb);
    else if constexpr (PH == PH_RWSERIAL) ph_rw_serial(p, lds, bi, nb);
    else if constexpr (PH == PH_RETSCAN) ph_ret_scan(p, bi, nb);
    else if constexpr (PH == PH_NSACMP) ph_nsa_cmp(p, lds, bi, nb);
    else if constexpr (PH == PH_RWPOST_RETOUT) { ph_rw_post(p, l, bi, nb); ph_ret_out(p, lds, bi, nb); }
    else if constexpr (PH == PH_NSAATTN) ph_nsa_attn(p, l, lds, bi, nb);
    else if constexpr (PH == PH_P1) { ph_convert(p, l, lds, bi, nb); if (l == 0) ph_norm_rows(inp(p, 0), INL(3, D), WSP(bf16_t, WS_H), M, bi, nb); }
    else if constexpr (PH == PH_P4) {
        if (bi < 192) { GSched s = make_sched(WSP(bf16_t, WS_ALORA), 512, WSP(bf16_t, WS_W_LORA), 512, 32, 6, 1536, bi, 192); EpiF32 e{WSP(float, WS_LO), 1536, 1.f}; gemm_phase(lds, 512, 512, 512, s, e); }
        else if (bi < 200) { GSched s = make_sched(WSP(bf16_t, WS_KVG), 1024, WSP(bf16_t, WS_W_C1), 2048, 1, 1, 256, bi - 192, 8); s.nZ1 = 2; s.nZ2 = 4; s.a_z1 = (long)KVG_SLAB * 2; s.a_z2 = (long)SEQ * 64 * 2; s.b_z1 = (long)256 * 2048 * 2; s.b_z2 = 0;
            s.o_z1 = 4 * 256 * 256; s.o_z2 = 256 * 256; EpiC1 e{WSP(bf16_t, WS_HID), WSP(float, WS_CBIAS)}; gemm_phase(lds, 1024, 2048, 2048, s, e); }
        else if (bi < 216) { GSched s = make_sched(WSP(bf16_t, WS_MEMN), D, WSP(bf16_t, WS_W_KV), D, 2, 8, D, bi - 200, 16); EpiBf16<0> e{WSP(bf16_t, WS_KMEM), D, nullptr}; gemm_phase(lds, D, D, D, s, e); }
        else if (bi < 232) { GSched s = make_sched(WSP(bf16_t, WS_W_KV) + (size_t)D * D, D, WSP(bf16_t, WS_MEMN), D, 8, 2, 512, bi - 216, 16); EpiBf16<0> e{WSP(bf16_t, WS_VTM), 512, nullptr}; gemm_phase(lds, D, D, D, s, e); }
        if (bi < 192) ph_ret_u(p, lds, bi, 216); else if (bi >= 232) ph_ret_u(p, lds, 192 + (bi - 232), 216);
    }
    else if constexpr (PH == PH_P5) { ph_rw_prep2(p, l, bi, nb); ph_cmp2(p, l, lds, bi, nb); ph_ret_scan(p, bi, nb); }
    else if constexpr (PH == PH_P6) { ph_nsa_cmp(p, lds, bi, nb); __syncthreads(); ph_rw_chunk(p, lds, bi, nb); }
    else if constexpr (PH == PH_P7) { ph_rw_serial(p, lds, bi, nb); ph_p7_queue(p, l, lds, bi, nb); }
    else if constexpr (PH == PH_P8) ph_rw_post(p, l, bi, nb);
    else if constexpr (PH == PH_BRANCH) { BranchSched sc{(const char*)WSP(bf16_t, WS_OALL), (const char*)WSP(bf16_t, WS_W_BR), bi}; EpiBranch2 e{WSP(bf16_t, WS_MERGEDB), WSP(bf16_t, WS_Z) + ZC_GATE}; gemm_phase(lds, NBR, NBR, 512, sc, e); }
    else if constexpr (PH == PH_OUTPROJ) { GSched s = make_sched(WSP(bf16_t, WS_MERGEDB), D, WSP(bf16_t, WS_W_OUT), D, 32, 8, D, bi, nb); EpiF32 e{WSP(float, WS_Y), D, 1.f}; gemm_phase(lds, D, D, D, s, e); }
    else if constexpr (PH == PH_FINISH1) ph_finish(l == 0 ? inp(p, 0) : (const float*)OUTP, WSP(float, WS_Y), INL(4, D), INL(5, D), OUTP, WSP(bf16_t, WS_H), bi, nb);
    else if constexpr (PH == PH_QPROJ) { GSched s = make_sched(WSP(bf16_t, WS_H), D, WSP(bf16_t, WS_W_Q), D, 32, 8, D, bi, nb); EpiBf16<0> e{WSP(bf16_t, WS_QX), D, nullptr}; gemm_phase(lds, D, D, D, s, e); }
    else if constexpr (PH == PH_XSCORE) {
        GSched s = make_sched(WSP(bf16_t, WS_QX), D, WSP(bf16_t, WS_KMEM), D, 16, 1, 1024, bi, nb); s.nZ1 = 2; s.nZ2 = 4; s.a_z1 = (long)SEQ * D * 2; s.a_z2 = 512 * 2; s.b_z1 = (long)MEM * D * 2; s.b_z2 = 512 * 2; s.o_z1 = (long)SEQ * 1024; s.o_z2 = 256;
        EpiF32 e{WSP(float, WS_SC), 1024, 0.04419417382415922f}; gemm_phase(lds, D, D, 512, s, e); }
    else if constexpr (PH == PH_XSOFTMAX) ph_xsoftmax(p, bi, nb);
    else if constexpr (PH == PH_XPV) {
        GSched s = make_sched(WSP(bf16_t, WS_PB), 1024, WSP(bf16_t, WS_VTM), 512, 16, 2, D, bi, nb); s.nZ1 = 2; s.nZ2 = 4; s.a_z1 = (long)SEQ * 1024 * 2; s.a_z2 = 256 * 2; s.b_z1 = 256 * 2; s.b_z2 = (long)512 * 512 * 2; s.o_z1 = (long)SEQ * D; s.o_z2 = 512;
        EpiBf16<0> e{WSP(bf16_t, WS_OX), D, nullptr}; gemm_phase(lds, 1024, 512, 256, s, e); }
    else if constexpr (PH == PH_XO) { GSched s = make_sched(WSP(bf16_t, WS_OX), D, WSP(bf16_t, WS_W_O), D, 32, 8, D, bi, nb); EpiF32 e{WSP(float, WS_Y), D, 1.f}; gemm_phase(lds, D, D, D, s, e); }
    else if constexpr (PH == PH_FINISH2) ph_finish(OUTP, WSP(float, WS_Y), INL(7, D), INL(8, D), OUTP, WSP(bf16_t, WS_H), bi, nb);
    else if constexpr (PH == PH_UP) { GSched s = make_sched(WSP(bf16_t, WS_H), D, WSP(bf16_t, WS_W_UP), D, 32, 44, FFN2, bi, nb); EpiBf16<0> e{WSP(bf16_t, WS_U), FFN2, nullptr}; gemm_phase(lds, D, D, D, s, e); }
    else if constexpr (PH == PH_CONVACT) ph_convact(p, l, bi, nb);
    else if constexpr (PH == PH_DOWN) { GSched s = make_sched(WSP(bf16_t, WS_GACT), FFN, WSP(bf16_t, WS_W_DN), FFN, 32, 8, D, bi, nb); EpiF32 e{WSP(float, WS_Y), D, 1.f}; gemm_phase(lds, FFN, FFN, FFN, s, e); }
    else if constexpr (PH == PH_FINISH3) ph_finish(OUTP, WSP(float, WS_Y), INL(9, D), (l + 1 < DEPTH) ? (inp(p, 3) + (size_t)(l + 1) * D) : nullptr, OUTP, WSP(bf16_t, WS_H), bi, nb);
}

__global__ void __launch_bounds__(512, 2) mega_fwd(Params p) {
    extern __shared__ __attribute__((aligned(16))) unsigned char lds_raw[];
    LAS unsigned char* lds = (LAS unsigned char*)lds_raw;
    volatile LAS unsigned* st = (volatile LAS unsigned*)(lds + LDS_BYTES - 16);
    if (threadIdx.x == 0) { st[0] = 0u; st[1] = 0u; st[2] = (unsigned)(u64)p.ws; st[3] = (unsigned)((u64)p.ws >> 32); }
    __syncthreads();
    if (threadIdx.x == 0) { const float** tab = (const float**)(p.ws + WS_PTRTAB);
#pragma unroll
        for (int i = 0; i < 35; ++i) tab[i] = p.in[i];
        tab[35] = p.out; }
    __syncthreads();
    XcdBarrier bar = xcd_barrier_post((unsigned*)(p.ws + WS_CTL) + 1024, st);
    const int bi = (int)blockIdx.x, nb = (int)gridDim.x;
#define PHASE(PH) do { int l_ = l, bi_ = bi; asm volatile("" : "+s"(l_), "+s"(bi_)); run_phase<PH>(p, l_, lds, bi_, nb); xcd_barrier(bar); } while (0)
    for (int l = 0; l < DEPTH; ++l) {
        PHASE(PH_P1);
        PHASE(PH_INPROJ);
        PHASE(PH_MIXPREP);
        PHASE(PH_P4);
        PHASE(PH_P5);
        PHASE(PH_P6);
        PHASE(PH_P7);
        PHASE(PH_P8);
        PHASE(PH_BRANCH);
        PHASE(PH_OUTPROJ);
        PHASE(PH_FINISH1);
        PHASE(PH_QPROJ);
        PHASE(PH_XSCORE);
        PHASE(PH_XSOFTMAX);
        PHASE(PH_XPV);
        PHASE(PH_XO);
        PHASE(PH_FINISH2);
        PHASE(PH_UP);
        PHASE(PH_CONVACT);
#if DUP == 4
        PHASE(PH_CONVACT);
#endif
        PHASE(PH_DOWN);
        PHASE(PH_FINISH3);
    }
#undef PHASE
}

extern "C" void kernel_launch(void* const* d_in, const int* in_sizes, int n_in, void* d_out, int out_size, void* d_ws, size_t ws_size, hipStream_t stream) {
    if (n_in != 35 || ws_size < WS_END) { fprintf(stderr, "kernel_launch: unexpected n_in %d / ws_size %zu (need %zu)\n", n_in, ws_size, (size_t)WS_END); return; }
    static int grid = 0;
    if (grid == 0) {
        int dev = 0, cus = 0, per_cu = 0;
        (void)hipGetDevice(&dev); (void)hipDeviceGetAttribute(&cus, hipDeviceAttributeMultiprocessorCount, dev);
        (void)hipFuncSetAttribute((const void*)mega_fwd, hipFuncAttributeMaxDynamicSharedMemorySize, LDS_BYTES);
        if (hipOccupancyMaxActiveBlocksPerMultiprocessor(&per_cu, (const void*)mega_fwd, 512, LDS_BYTES) != hipSuccess || per_cu < 1) fprintf(stderr, "kernel_launch: occupancy query says %d blocks per CU\n", per_cu);
        (void)hipGetLastError();
        grid = cus > 0 ? cus : 256;
    }
    (void)hipMemsetAsync((char*)d_ws + WS_CTL, 0, 1 * MiB, stream);
    Params p; memset(&p, 0, sizeof(p));
    for (int i = 0; i < 35; ++i) p.in[i] = (const float*)d_in[i];
    p.out = (float*)d_out; p.ws = (unsigned char*)d_ws;
    hipLaunchKernelGGL(mega_fwd, dim3(grid), dim3(512), LDS_BYTES, stream, p);
}
```

```cpp
#include <hip/hip_runtime.h>
#ifndef DUP
#define DUP 0
#endif
#include <cstdio>
#include <cstdint>
#include <cstring>

#define LAS __attribute__((address_space(3)))
typedef unsigned short bf16_t;
typedef short bf16x8 __attribute__((ext_vector_type(8)));
typedef float f32x4 __attribute__((ext_vector_type(4)));
typedef float f32x2 __attribute__((ext_vector_type(2)));
typedef unsigned u32x4 __attribute__((ext_vector_type(4)));
typedef unsigned u32x2 __attribute__((ext_vector_type(2)));
typedef unsigned long long u64;

constexpr int D = 2048, BATCH = 2, SEQ = 4096, M = BATCH * SEQ, DEPTH = 2;
constexpr int NZC = 16384;
constexpr int NZ = 16384 + 128;
constexpr int N_IN = 16088;
constexpr int ZC_SC_B = 0, ZC_SC_C = 512, ZC_SC_X = 1024;
constexpr int ZC_RW = 1536;
constexpr int ZC_RW_R = 1536, ZC_RW_K = 2048, ZC_RW_V = 2560, ZC_RW_ZW = 3072, ZC_RW_ZA = 3168, ZC_RW_ZG = 3264;
constexpr int ZC_RET_Q = 3584, ZC_RET_K = 4096, ZC_RET_V = 4608, ZC_RET_G = 5632;
constexpr int ZC_NSA_Q = 6656, ZC_NSA_KC = 7168, ZC_NSA_VC = 7296, ZC_NSA_KS = 7424, ZC_NSA_VS = 7552, ZC_NSA_KW = 7680, ZC_NSA_VW = 7808, ZC_NSA_GT = 7936;
constexpr int ZC_GATE = 8192;
constexpr int NBR = 2560;
constexpr int FFN = 5632, FFN2 = 11264;
constexpr int MEM = 256;

constexpr size_t MiB = 1u << 20;
constexpr size_t WS_CTL = 0;
constexpr size_t WS_W_IN = 1 * MiB, WS_W_BR = 65 * MiB, WS_W_OUT = 75 * MiB, WS_W_Q = 83 * MiB, WS_W_KV = 91 * MiB, WS_W_O = 107 * MiB;
constexpr size_t WS_W_UP = 115 * MiB, WS_W_DN = 159 * MiB, WS_W_LORA = 181 * MiB, WS_W_C1 = 183 * MiB;
constexpr size_t WS_CBIAS = 185 * MiB, WS_MEMN = 186 * MiB, WS_KMEM = 188 * MiB, WS_VTM = 190 * MiB;
constexpr size_t WS_H = 192 * MiB, WS_Z = 224 * MiB, WS_OALL = 484 * MiB, WS_MERGED = 524 * MiB, WS_MERGEDB = 588 * MiB, WS_Y = 620 * MiB;
constexpr size_t WS_T = 684 * MiB;
constexpr size_t WS_ALORA = WS_T, WS_LO = WS_T + 8 * MiB, WS_RWOPS = WS_T + 56 * MiB, WS_YSCAN = WS_T + 152 * MiB;
constexpr size_t WS_QR = WS_T + 168 * MiB, WS_KR = WS_T + 176 * MiB, WS_UBUF = WS_T + 184 * MiB, WS_RPREV = WS_T + 216 * MiB;
constexpr size_t WS_QN = WS_T + 232 * MiB, WS_KVG = WS_T + 240 * MiB, WS_HID = WS_T + 253 * MiB, WS_KCMP = WS_T + 254 * MiB, WS_VCMPT = WS_T + 254 * MiB + 512 * 1024;
constexpr size_t WS_OCMP = WS_T + 255 * MiB, WS_SELM = WS_T + 263 * MiB;
constexpr size_t WS_END = WS_T + 264 * MiB;
constexpr size_t WS_QX = WS_Z, WS_SC = WS_Z + 32 * MiB, WS_PB = WS_Z + 64 * MiB, WS_OX = WS_Z + 80 * MiB;
constexpr size_t WS_U = WS_Z, WS_GACT = WS_T;
constexpr size_t WS_RW_PF = WS_MERGED, WS_RW_QF = WS_MERGED + 32 * MiB, WS_RW_RF = WS_MERGED + 96 * MiB, WS_RW_Y0F = WS_MERGED + 104 * MiB;
constexpr size_t KVG_SLAB = (size_t)BATCH * 2 * SEQ * 64;

constexpr int LDS_BYTES = 147456;

struct Params {
    const float* in[35];
    float* out;
    unsigned char* ws;
};

__device__ __forceinline__ int otid() { int t = (int)threadIdx.x; asm volatile("" : "+v"(t)); return t; }
__device__ __forceinline__ float bf2f(bf16_t v) { return __uint_as_float((unsigned)v << 16); }
typedef __bf16 bf16x2_t __attribute__((ext_vector_type(2)));
__device__ __forceinline__ unsigned cvt_pk_bf16(float lo, float hi) { const f32x2 v = {lo, hi}; const bf16x2_t b = __builtin_convertvector(v, bf16x2_t); return __builtin_bit_cast(unsigned, b); }
__device__ __forceinline__ bf16_t f2bf(float f) { return (bf16_t)(cvt_pk_bf16(f, 0.f) & 0xffffu); }
__device__ __forceinline__ float wave_sum(float v) {
#pragma unroll
    for (int o = 1; o < 64; o <<= 1) v += __shfl_xor(v, o);
    return v;
}
__device__ __forceinline__ float sigmoidf_(float x) { return 1.f / (1.f + __expf(-x)); }
__device__ __forceinline__ float gelu_tanh(float x) { const float u = 1.5957691216057308f * (x + 0.044715f * x * x * x); return x / (1.f + __expf(-u)); }
__device__ __forceinline__ f32x4 mma16(f32x4 acc, bf16x8 a_rowfrag, bf16x8 b_colfrag) {
    return __builtin_amdgcn_mfma_f32_16x16x32_bf16(b_colfrag, a_rowfrag, acc, 0, 0, 0);
}
__device__ __forceinline__ bf16x8 ldfrag(const bf16_t* p) { return *(const bf16x8*)p; }

namespace pg8 {
constexpr int BM = 256, BK = 64, HALF = 128, HTB = HALF * BK * 2, STAGE_BYTES = 8 * HTB, NXCD = 8, WGM = 8;
__host__ __device__ __forceinline__ int lds_byte(int r, int c) { const int st = (r >> 4) * 2 + (c >> 5), rr = r & 15, cc = c & 31, ob = rr * 64 + cc * 2; return st * 1024 + (ob ^ (((ob >> 9) & 1) << 5)); }
__host__ __device__ __forceinline__ void stage_rc(int b, int& R, int& C) { const int st = b / 1024, sb = b % 1024, swz = sb ^ (((sb >> 9) & 1) << 5); R = (st >> 1) * 16 + swz / 64; C = (st & 1) * 32 + (swz % 64) / 2; }
__host__ __device__ __forceinline__ int perm32(int rho) { const int n = rho >> 4, i = rho & 15; return 8 * (i >> 2) + 4 * n + (i & 3); }

struct Unit { const char* A; const char* B; size_t ooff; int pm, pn, z, nt; };

struct GSched {
    const char* A; const char* B;
    long a_pm, b_pn;
    long a_z1, a_z2, b_z1, b_z2;
    long o_pm, o_pn, o_z1, o_z2;
    int nM, nN, nZ1, nZ2, G, c, pst;
    __device__ __forceinline__ bool next(int i, Unit& u) const {
        if (pst) {
            const int k = c >> 3, pm = 4 * (c & 7) + (k & 3), pn = 8 * i + (k >> 2); if (pn >= nN) return false;
            u.pm = pm; u.pn = pn; u.z = 0; u.nt = 0; u.A = A + pm * a_pm; u.B = B + pn * b_pn; u.ooff = (size_t)(pm * o_pm + pn * o_pn); return true; }
        const int per = nM * nN; const long L = (long)i * G + c; if (L >= (long)per * nZ1 * nZ2) return false;
        const int zz = (int)(L / per); int wgid = (int)(L % per);
        { const int q = per / NXCD, r = per % NXCD, xcd = wgid % NXCD, off = wgid / NXCD; wgid = (xcd < r ? xcd * (q + 1) : r * (q + 1) + (xcd - r) * q) + off; }
        const int nig = WGM * nN, gid = wgid / nig, fm = gid * WGM, gsz = (nM - fm) < WGM ? (nM - fm) : WGM;
        const int pm = fm + ((wgid % nig) % gsz), pn = (wgid % nig) / gsz;
        const int z1 = zz / nZ2, z2 = zz % nZ2;
        u.pm = pm; u.pn = pn; u.z = zz; u.nt = 0;
        u.A = A + z1 * a_z1 + z2 * a_z2 + pm * a_pm; u.B = B + z1 * b_z1 + z2 * b_z2 + pn * b_pn;
        u.ooff = (size_t)(z1 * o_z1 + z2 * o_z2 + pm * o_pm + pn * o_pn);
        return true;
    }
};
__device__ __forceinline__ GSched make_sched(const void* A, int lda, const void* B, int ldb, int nM, int nN, long ldc, int bi, int nb) {
    GSched s; s.A = (const char*)A; s.B = (const char*)B; s.a_pm = (long)BM * lda * 2; s.b_pn = (long)BM * ldb * 2; s.a_z1 = s.a_z2 = s.b_z1 = s.b_z2 = 0;
    s.o_pm = (long)BM * ldc; s.o_pn = BM; s.o_z1 = s.o_z2 = 0; s.nM = nM; s.nN = nN; s.nZ1 = 1; s.nZ2 = 1; s.G = nb; s.c = bi; s.pst = (nM == 32 && nb == 256) ? 1 : 0; return s;
}

template <class Epi, class Sched>
__device__ __forceinline__ void gemm_phase(LAS unsigned char* lds, const int lda, const int ldb, const int K, const Sched& S, const Epi& E) {
    const int tid = otid(), wid = __builtin_amdgcn_readfirstlane(tid >> 6), lane = tid & 63, wr = wid >> 2, wc = wid & 3, fr = lane & 15, fq = lane >> 4;
    const int ntK = K / BK;
    unsigned voffA[2], voffB[2];
#pragma unroll
    for (int i = 0; i < 2; ++i) { int R, C; stage_rc(tid * 16 + i * 8192, R, C); const int Rb = Epi::PERM ? ((R & ~31) + perm32(R & 31)) : R;
        voffA[i] = (unsigned)(R * lda + C) * 2u; voffB[i] = (unsigned)(Rb * ldb + C) * 2u; }
    const size_t kstep = (size_t)(BK * 2);
    const size_t hstepA = (size_t)HALF * lda * 2, hstepB = (size_t)HALF * ldb * 2;
    const unsigned ldsw = (unsigned)wid * 1024u;
    const int aoff = lds_byte(wr * 64 + fr, fq * 8), boff = lds_byte(wc * 32 + fr, fq * 8);
#define PG8_SA(b, h) (((b) * 2 + (h)) * HTB)
#define PG8_SB(b, h) ((4 + (b) * 2 + (h)) * HTB)
#define PG8_STAGE(bufoff, gbase, voff) do { _Pragma("unroll") for (int _i = 0; _i < 2; ++_i) \
        __builtin_amdgcn_global_load_lds((const unsigned*)((const char*)(gbase) + (voff)[_i]), (LAS unsigned*)(lds + (bufoff) + ldsw + _i * 8192), 16, 0, 0); } while (0)
#define PG8_LDA(dst, b, h) do { _Pragma("unroll") for (int m = 0; m < 4; ++m) _Pragma("unroll") for (int k = 0; k < 2; ++k) dst[m][k] = *(const LAS bf16x8*)(lds + PG8_SA(b, h) + aoff + m * 2048 + k * 1024); } while (0)
#define PG8_LDB(dst, b, h) do { _Pragma("unroll") for (int n = 0; n < 2; ++n) _Pragma("unroll") for (int k = 0; k < 2; ++k) dst[n][k] = *(const LAS bf16x8*)(lds + PG8_SB(b, h) + boff + n * 2048 + k * 1024); } while (0)
#define PG8_MMA(ai, bj, At, Bt) do { __builtin_amdgcn_s_setprio(1); _Pragma("unroll") for (int m = 0; m < 4; ++m) _Pragma("unroll") for (int n = 0; n < 2; ++n) _Pragma("unroll") for (int k = 0; k < 2; ++k) \
        acc[ai][bj][m][n] = __builtin_amdgcn_mfma_f32_16x16x32_bf16(Bt[n][k], At[m][k], acc[ai][bj][m][n], 0, 0, 0); __builtin_amdgcn_s_setprio(0); } while (0)
#define PG8_WAIT_V(n) asm volatile("s_waitcnt vmcnt(" #n ")" ::: "memory")
#define PG8_WAIT_L(n) asm volatile("s_waitcnt lgkmcnt(" #n ")" ::: "memory")
#define PG8_BAR __builtin_amdgcn_s_barrier()
#define PG8_SCHED __builtin_amdgcn_sched_barrier(0)
    Unit cur, nxt; int ui = 0;
    if (!S.next(0, cur)) return;
    f32x4 acc[2][2][4][2];
#pragma unroll
    for (int a = 0; a < 2; ++a)
#pragma unroll
        for (int b = 0; b < 2; ++b)
#pragma unroll
            for (int m = 0; m < 4; ++m)
#pragma unroll
                for (int n = 0; n < 2; ++n) acc[a][b][m][n] = (f32x4){0.f, 0.f, 0.f, 0.f};
    bf16x8 At[4][2], B0[2][2], B1[2][2];
    const char* cA = cur.A; const char* cB = cur.B;
    PG8_STAGE(PG8_SB(0, 0), cB, voffB); PG8_STAGE(PG8_SB(0, 1), cB + hstepB, voffB); PG8_STAGE(PG8_SA(0, 0), cA, voffA); PG8_STAGE(PG8_SA(0, 1), cA + hstepA, voffA);
    if (wr == 1) PG8_BAR;
    PG8_WAIT_V(2); PG8_BAR;
    PG8_STAGE(PG8_SB(1, 0), cB + kstep, voffB); PG8_STAGE(PG8_SA(1, 0), cA + kstep, voffA); PG8_STAGE(PG8_SB(1, 1), cB + hstepB + kstep, voffB);
    PG8_WAIT_V(6); PG8_BAR;
    for (;;) {
        const bool has_next = S.next(ui + 1, nxt);
        const char* nA = has_next ? nxt.A : cA; const char* nB = has_next ? nxt.B : cB;
        const int nt = cur.nt ? cur.nt : ntK;
        for (int t = 0; t < nt; t += 2) {
            const bool last = (t == nt - 2);
            const char* a1 = cA + (size_t)(t + 1) * kstep;
            const char* a2 = last ? nA : cA + (size_t)(t + 2) * kstep; const char* b2 = last ? nB : cB + (size_t)(t + 2) * kstep;
            const char* a3 = a2 + kstep; const char* b3 = b2 + kstep;
            PG8_LDB(B0, 0, 0); PG8_LDB(B1, 0, 1); PG8_SCHED; PG8_LDA(At, 0, 0); PG8_STAGE(PG8_SA(1, 1), a1 + hstepA, voffA);
            PG8_WAIT_V(8); PG8_WAIT_L(0); PG8_BAR; PG8_MMA(0, 0, At, B0); PG8_MMA(0, 1, At, B1); PG8_BAR; PG8_SCHED;
            PG8_LDA(At, 0, 1); PG8_STAGE(PG8_SB(0, 0), b2, voffB); PG8_STAGE(PG8_SB(0, 1), b2 + hstepB, voffB); PG8_STAGE(PG8_SA(0, 0), a2, voffA);
            PG8_WAIT_V(8); PG8_WAIT_L(0); PG8_BAR; PG8_MMA(1, 0, At, B0); PG8_MMA(1, 1, At, B1); PG8_BAR; PG8_SCHED;
            PG8_LDB(B0, 1, 0); PG8_LDB(B1, 1, 1); PG8_SCHED; PG8_LDA(At, 1, 0); PG8_STAGE(PG8_SA(0, 1), a2 + hstepA, voffA);
            PG8_WAIT_V(8); PG8_WAIT_L(0); PG8_BAR; PG8_MMA(0, 0, At, B0); PG8_MMA(0, 1, At, B1); PG8_BAR; PG8_SCHED;
            PG8_LDA(At, 1, 1); PG8_STAGE(PG8_SB(1, 0), b3, voffB); PG8_STAGE(PG8_SB(1, 1), b3 + hstepB, voffB); PG8_STAGE(PG8_SA(1, 0), a3, voffA);
            PG8_WAIT_V(8); PG8_WAIT_L(0); PG8_BAR; PG8_MMA(1, 0, At, B0); PG8_MMA(1, 1, At, B1); PG8_BAR; PG8_SCHED;
        }
        if (wr == 0) PG8_BAR;
        const bool reset = E(acc, cur, wr, wc, fr, fq);
        if (!has_next) break;
        if (reset) {
#pragma unroll
        for (int a = 0; a < 2; ++a)
#pragma unroll
            for (int b = 0; b < 2; ++b)
#pragma unroll
                for (int m = 0; m < 4; ++m)
#pragma unroll
                    for (int n = 0; n < 2; ++n) acc[a][b][m][n] = (f32x4){0.f, 0.f, 0.f, 0.f};
        }
        cur = nxt; cA = nA; cB = nB; ++ui;
        if (wr == 1) PG8_BAR;
    }
    PG8_WAIT_V(0);
    PG8_BAR;
#undef PG8_SA
#undef PG8_SB
#undef PG8_STAGE
#undef PG8_LDA
#undef PG8_LDB
#undef PG8_MMA
#undef PG8_WAIT_V
#undef PG8_WAIT_L
#undef PG8_BAR
#undef PG8_SCHED
}

template <int ACT> struct EpiBf16 {
    static constexpr bool PERM = true;
    bf16_t* O; int ldc; const float* bias;
    __device__ __forceinline__ bool operator()(f32x4 (&acc)[2][2][4][2], const Unit& u, int wr, int wc, int fr, int fq) const {
        bf16_t* base = O + u.ooff; const int col0 = wc * 32 + 8 * fq;
#pragma unroll
        for (int ai = 0; ai < 2; ++ai)
#pragma unroll
            for (int m = 0; m < 4; ++m) { bf16_t* rowp = base + (size_t)(ai * HALF + wr * 64 + m * 16 + fr) * ldc + col0;
#pragma unroll
                for (int bj = 0; bj < 2; ++bj) { f32x4 v0 = acc[ai][bj][m][0], v1 = acc[ai][bj][m][1];
                    if (ACT == 1) { const float* bp = bias + u.pn * BM + col0 + bj * HALF; const f32x4 b0 = *(const f32x4*)bp, b1 = *(const f32x4*)(bp + 4);
                        v0 += b0; v1 += b1;
#pragma unroll
                        for (int j = 0; j < 4; ++j) { v0[j] = gelu_tanh(v0[j]); v1[j] = gelu_tanh(v1[j]); } }
                    u32x4 w; w.x = cvt_pk_bf16(v0[0], v0[1]); w.y = cvt_pk_bf16(v0[2], v0[3]); w.z = cvt_pk_bf16(v1[0], v1[1]); w.w = cvt_pk_bf16(v1[2], v1[3]);
                    *(u32x4*)(rowp + bj * HALF) = w; } }
     return true; }
};
struct EpiF32 {
    static constexpr bool PERM = false;
    float* C; int ldc; float scale;
    __device__ __forceinline__ bool operator()(f32x4 (&acc)[2][2][4][2], const Unit& u, int wr, int wc, int fr, int fq) const {
        float* base = C + u.ooff; const int col0 = wc * 32 + 4 * fq;
#pragma unroll
        for (int ai = 0; ai < 2; ++ai)
#pragma unroll
            for (int m = 0; m < 4; ++m) { float* rowp = base + (size_t)(ai * HALF + wr * 64 + m * 16 + fr) * ldc + col0;
#pragma unroll
                for (int bj = 0; bj < 2; ++bj)
#pragma unroll
                    for (int n = 0; n < 2; ++n) *(f32x4*)(rowp + bj * HALF + n * 16) = acc[ai][bj][m][n] * scale; }
     return true; }
};
struct EpiBranch {
    static constexpr bool PERM = false;
    float* merged; bf16_t* mergedb; const bf16_t* gate; int first, last;
    __device__ __forceinline__ bool operator()(f32x4 (&acc)[2][2][4][2], const Unit& u, int wr, int wc, int fr, int fq) const {
        const int col0 = u.pn * BM + wc * 32 + 4 * fq;
#pragma unroll
        for (int ai = 0; ai < 2; ++ai)
#pragma unroll
            for (int m = 0; m < 4; ++m) { const size_t row = (size_t)(u.pm * BM + ai * HALF + wr * 64 + m * 16 + fr);
#pragma unroll
                for (int bj = 0; bj < 2; ++bj)
#pragma unroll
                    for (int n = 0; n < 2; ++n) { const int col = col0 + bj * HALF + n * 16;
                        const u32x2 gw = *(const u32x2*)(gate + row * NZ + col);
                        f32x4 g; g[0] = sigmoidf_(__uint_as_float(gw.x << 16)); g[1] = sigmoidf_(__uint_as_float(gw.x & 0xffff0000u)); g[2] = sigmoidf_(__uint_as_float(gw.y << 16)); g[3] = sigmoidf_(__uint_as_float(gw.y & 0xffff0000u));
                        f32x4 v = acc[ai][bj][m][n] * g;
                        if (!first) v += *(const f32x4*)(merged + row * D + col);
                        if (last) { u32x2 w; w.x = cvt_pk_bf16(v[0], v[1]); w.y = cvt_pk_bf16(v[2], v[3]); *(u32x2*)(mergedb + row * D + col) = w; }
                        else *(f32x4*)(merged + row * D + col) = v; } }
     return true; }
};

struct EpiZ {
    static constexpr bool PERM = true;
    bf16_t* O; int ldc;
    __device__ __forceinline__ bool operator()(f32x4 (&acc)[2][2][4][2], const Unit& u, int wr, int wc, int fr, int fq) const {
        bf16_t* base = O + u.ooff; const int col0 = wc * 32 + 8 * fq; const bool gate = u.pn >= 32;
#pragma unroll
        for (int ai = 0; ai < 2; ++ai)
#pragma unroll
            for (int m = 0; m < 4; ++m) { bf16_t* rowp = base + (size_t)(ai * HALF + wr * 64 + m * 16 + fr) * ldc + col0;
                f32x4 v00 = acc[ai][0][m][0], v01 = acc[ai][0][m][1], v10 = acc[ai][1][m][0], v11 = acc[ai][1][m][1];
                if (gate) {
#pragma unroll
                    for (int e = 0; e < 4; ++e) { const float ea = __expf(-v00[e]), eb = __expf(-v01[e]), ec = __expf(-v10[e]), ed = __expf(-v11[e]);
                        const float ia = __builtin_amdgcn_rcpf(1.f + ea), ib = __builtin_amdgcn_rcpf(1.f + eb), ic = __builtin_amdgcn_rcpf(1.f + ec), id = __builtin_amdgcn_rcpf(1.f + ed);
                        v00[e] = (1.f + eb) * ia; v01[e] = (1.f + ec) * ib; v10[e] = (1.f + ed) * ic; v11[e] = id; } }
                u32x4 w; w.x = cvt_pk_bf16(v00[0], v00[1]); w.y = cvt_pk_bf16(v00[2], v00[3]); w.z = cvt_pk_bf16(v01[0], v01[1]); w.w = cvt_pk_bf16(v01[2], v01[3]); *(u32x4*)rowp = w;
                w.x = cvt_pk_bf16(v10[0], v10[1]); w.y = cvt_pk_bf16(v10[2], v10[3]); w.z = cvt_pk_bf16(v11[0], v11[1]); w.w = cvt_pk_bf16(v11[2], v11[3]); *(u32x4*)(rowp + HALF) = w; }
        return true;
    }
};
struct BranchSched {
    const char* A; const char* B; int c;
    __device__ __forceinline__ bool next(int i, Unit& u) const {
        if (i >= 4) return false;
        const int k = c >> 3, pm = 4 * (c & 7) + (k & 3), pn = k >> 2, br = i;
        const int koff = br == 0 ? 0 : (br == 1 ? 512 : (br == 2 ? 1024 : 2048));
        u.pm = pm; u.pn = pn; u.z = br; u.nt = (br == 2) ? 16 : 8;
        u.A = A + (size_t)koff * 2 + (size_t)pm * BM * NBR * 2; u.B = B + (size_t)koff * 2 + (size_t)pn * BM * NBR * 2; u.ooff = (size_t)pm * BM * D + (size_t)pn * BM; return true;
    }
};
struct EpiBranch2 {
    static constexpr bool PERM = false;
    bf16_t* mergedb; const bf16_t* zg;
    __device__ __forceinline__ bool operator()(f32x4 (&acc)[2][2][4][2], const Unit& u, int wr, int wc, int fr, int fq) const {
        const int br = u.z; const int gcol = (br >> 1) * 128 + (br & 1) * 4;
#pragma unroll
        for (int ai = 0; ai < 2; ++ai)
#pragma unroll
            for (int m = 0; m < 4; ++m) { const size_t row = (size_t)(u.pm * BM + ai * HALF + wr * 64 + m * 16 + fr);
#pragma unroll
                for (int bj = 0; bj < 2; ++bj)
#pragma unroll
                    for (int n = 0; n < 2; ++n) { const int ch = u.pn * BM + bj * HALF + wc * 32 + n * 16 + 4 * fq;
                        const u32x2 gw = *(const u32x2*)(zg + row * NZ + (ch >> 6) * 256 + ((ch & 63) >> 2) * 8 + gcol);
                        f32x4 g; g[0] = __uint_as_float(gw.x << 16); g[1] = __uint_as_float(gw.x & 0xffff0000u); g[2] = __uint_as_float(gw.y << 16); g[3] = __uint_as_float(gw.y & 0xffff0000u);
                        const f32x4 v = acc[ai][bj][m][n] * g; acc[ai][bj][m][n] = v;
                        if (br == 3) { u32x2 w; w.x = cvt_pk_bf16(v[0], v[1]); w.y = cvt_pk_bf16(v[2], v[3]); *(u32x2*)(mergedb + row * D + ch) = w; } } }
        return br == 3;
    }
};
struct EpiC1 { static constexpr bool PERM = true; bf16_t* O; const float* bias;
    __device__ __forceinline__ bool operator()(f32x4 (&acc)[2][2][4][2], const Unit& u, int wr, int wc, int fr, int fq) const { EpiBf16<1> e{O, 256, bias + (u.z >> 2) * 256}; e(acc, u, wr, wc, fr, fq);  return true; } };
}

__device__ __forceinline__ void ph_norm_rows(const float* x, const float* g, bf16_t* out, int rows, int bi, int nb) {
    const int tid_ = otid(), lane = tid_ & 63, gw = bi * 8 + (tid_ >> 6), NGW = nb * 8;
    for (int m = gw; m < rows; m += NGW) {
        const f32x4* xr = (const f32x4*)(x + (size_t)m * D) + lane; f32x4 v[8]; float s = 0.f;
#pragma unroll
        for (int j = 0; j < 8; ++j) { v[j] = xr[64 * j]; s += v[j][0] * v[j][0] + v[j][1] * v[j][1] + v[j][2] * v[j][2] + v[j][3] * v[j][3]; }
        const float rstd = rsqrtf(wave_sum(s) * (1.f / D) + 1e-6f);
        u32x2* o = (u32x2*)(out + (size_t)m * D) + lane;
#pragma unroll
        for (int j = 0; j < 8; ++j) { const f32x4 gg = ((const f32x4*)g)[lane + 64 * j]; u32x2 w; w.x = cvt_pk_bf16(v[j][0] * rstd * gg[0], v[j][1] * rstd * gg[1]); w.y = cvt_pk_bf16(v[j][2] * rstd * gg[2], v[j][3] * rstd * gg[3]); o[64 * j] = w; }
    }
}
__device__ __forceinline__ void ph_finish(const float* xin, const float* y, const float* g1, const float* g2, float* xout, bf16_t* h, int bi, int nb) {
    const int tid_ = otid(), lane = tid_ & 63, gw = bi * 8 + (tid_ >> 6), NGW = nb * 8;
    for (int m = gw; m < M; m += NGW) {
        const f32x4* yr = (const f32x4*)(y + (size_t)m * D) + lane; const f32x4* xr = (const f32x4*)(xin + (size_t)m * D) + lane; f32x4 v[8]; float s = 0.f;
#pragma unroll
        for (int j = 0; j < 8; ++j) { v[j] = yr[64 * j]; s += v[j][0] * v[j][0] + v[j][1] * v[j][1] + v[j][2] * v[j][2] + v[j][3] * v[j][3]; }
        const float rstd = rsqrtf(wave_sum(s) * (1.f / D) + 1e-6f); float s2 = 0.f;
        f32x4* xo = (f32x4*)(xout + (size_t)m * D) + lane;
#pragma unroll
        for (int j = 0; j < 8; ++j) { const f32x4 gg = ((const f32x4*)g1)[lane + 64 * j]; const f32x4 xv = xr[64 * j];
            v[j] = xv + v[j] * rstd * gg; xo[64 * j] = v[j]; s2 += v[j][0] * v[j][0] + v[j][1] * v[j][1] + v[j][2] * v[j][2] + v[j][3] * v[j][3]; }
        if (g2) { const float r2 = rsqrtf(wave_sum(s2) * (1.f / D) + 1e-6f); u32x2* o = (u32x2*)(h + (size_t)m * D) + lane;
#pragma unroll
            for (int j = 0; j < 8; ++j) { const f32x4 gg = ((const f32x4*)g2)[lane + 64 * j]; u32x2 w; w.x = cvt_pk_bf16(v[j][0] * r2 * gg[0], v[j][1] * r2 * gg[1]); w.y = cvt_pk_bf16(v[j][2] * r2 * gg[2], v[j][3] * r2 * gg[3]); o[64 * j] = w; } }
    }
}

enum { MAP_ID = 0, MAP_WIN = 1, MAP_UP = 2 };
__device__ __forceinline__ int cmap(int kind, int n) {
    if (kind == MAP_ID) return n;
    if (kind == MAP_WIN) { if (n < 3520) return n; if (n < 3584) return -1; if (n < 6656) return n - 64; if (n < 7960) return n - 64; if (n < 8192) return -1;
        { const int g = n - 8192, tile = g >> 8, col = g & 255, bj = col >> 7, q4 = (col & 127) >> 3, nn = (col >> 2) & 1, e = col & 3; return 7896 + (2 * bj + nn) * 2048 + tile * 64 + 4 * q4 + e; } }
    const int j = n >> 8, s = n & 255; return s < 128 ? 128 * j + s : FFN + 128 * j + (s - 128);
}
__device__ __forceinline__ void transpose_item(const float* W, int K, int Nsrc, bf16_t* WT, int kind, LAS unsigned* T, int item, int nblk, int tid) {
    const int kb = item / nblk, nb_ = item % nblk, k0 = 128 * kb, n0 = 128 * nb_;
    { const int cg = tid & 31, r0 = tid >> 5; const int src = cmap(kind, n0 + 4 * cg);
      f32x4 v[8];
#pragma unroll
      for (int i = 0; i < 8; ++i) v[i] = src >= 0 ? *(const f32x4*)(W + (size_t)(k0 + r0 + 16 * i) * Nsrc + src) : (f32x4){0.f, 0.f, 0.f, 0.f};
#pragma unroll
      for (int i = 0; i < 8; ++i) { LAS unsigned* d = T + (r0 + 16 * i) * 65 + 2 * cg; d[0] = cvt_pk_bf16(v[i][0], v[i][1]); d[1] = cvt_pk_bf16(v[i][2], v[i][3]); } }
    __syncthreads();
#pragma unroll
    for (int j = 0; j < 2; ++j) { const int c = tid + 512 * j, np = (c & 7) + 8 * ((c >> 6) & 7), kg = ((c >> 3) & 7) + 8 * (c >> 9);
        unsigned w[8];
#pragma unroll
        for (int e = 0; e < 8; ++e) w[e] = T[(8 * kg + e) * 65 + np];
        u32x4 lo, hi;
        lo.x = (w[0] & 0xffffu) | (w[1] << 16); lo.y = (w[2] & 0xffffu) | (w[3] << 16); lo.z = (w[4] & 0xffffu) | (w[5] << 16); lo.w = (w[6] & 0xffffu) | (w[7] << 16);
        hi.x = (w[0] >> 16) | (w[1] & 0xffff0000u); hi.y = (w[2] >> 16) | (w[3] & 0xffff0000u); hi.z = (w[4] >> 16) | (w[5] & 0xffff0000u); hi.w = (w[6] >> 16) | (w[7] & 0xffff0000u);
        bf16_t* o = WT + (size_t)(n0 + 2 * np) * K + k0 + 8 * kg;
        *(u32x4*)o = lo; *(u32x4*)(o + K) = hi; }
    __syncthreads();
}
__device__ __forceinline__ unsigned char* ws_lds() {
    volatile LAS unsigned* q = (volatile LAS unsigned*)(LDS_BYTES - 8); unsigned lo = q[0], hi = q[1];
    lo = (unsigned)__builtin_amdgcn_readfirstlane((int)lo); hi = (unsigned)__builtin_amdgcn_readfirstlane((int)hi); return (unsigned char*)(__attribute__((address_space(1))) unsigned char*)(((u64)hi << 32) | (u64)lo); }
#define PROLOG unsigned char* const wsl = ws_lds()
#define WS_PTRTAB 256
#define inp(p_, i) ((const float*)(__attribute__((address_space(1))) const float*)(((const u64*)(wsl + WS_PTRTAB))[i]))
#define OUTP ((float*)(__attribute__((address_space(1))) float*)(((const u64*)(wsl + WS_PTRTAB))[35]))
#define WSP(T, off) ((T*)(wsl + (off)))
#define INL(i, per) (inp(p, i) + (size_t)l * (per))

__device__ __forceinline__ void ph_convert(const Params& p, int l, LAS unsigned char* lds, int bi, int nb) {
    PROLOG;
    const int tid = otid();
    LAS unsigned* T = (LAS unsigned*)lds;
    const int I0 = 16 * 128, I1 = 20 * 16, I2 = 16 * 16, I3 = 16 * 32, I4 = 16 * 88, I5 = 44 * 16, I6 = 16 * 2;
    const int NIT = I0 + I1 + 3 * I2 + I3 + I4 + I5 + 2 * I6;
    for (int it = bi; it < NIT; it += nb) {
        int r = it;
        if (r < I0) { transpose_item(INL(10, (size_t)D * N_IN), D, N_IN, WSP(bf16_t, WS_W_IN), MAP_WIN, T, r, 128, tid); continue; } r -= I0;
        if (r < I1) { transpose_item(INL(26, (size_t)NBR * D), NBR, D, WSP(bf16_t, WS_W_BR), MAP_ID, T, r, 16, tid); continue; } r -= I1;
        if (r < I2) { transpose_item(INL(27, (size_t)D * D), D, D, WSP(bf16_t, WS_W_OUT), MAP_ID, T, r, 16, tid); continue; } r -= I2;
        if (r < I2) { transpose_item(INL(28, (size_t)D * D), D, D, WSP(bf16_t, WS_W_Q), MAP_ID, T, r, 16, tid); continue; } r -= I2;
        if (r < I2) { transpose_item(INL(30, (size_t)D * D), D, D, WSP(bf16_t, WS_W_O), MAP_ID, T, r, 16, tid); continue; } r -= I2;
        if (r < I3) { transpose_item(INL(29, (size_t)D * 2 * D), D, 2 * D, WSP(bf16_t, WS_W_KV), MAP_ID, T, r, 32, tid); continue; } r -= I3;
        if (r < I4) { transpose_item(INL(31, (size_t)D * FFN2), D, FFN2, WSP(bf16_t, WS_W_UP), MAP_UP, T, r, 88, tid); continue; } r -= I4;
        if (r < I5) { transpose_item(INL(34, (size_t)FFN * D), FFN, D, WSP(bf16_t, WS_W_DN), MAP_ID, T, r, 16, tid); continue; } r -= I5;
        if (r < I6) { transpose_item(INL(24, (size_t)2 * 2048 * 256), 2048, 256, WSP(bf16_t, WS_W_C1), MAP_ID, T, r, 2, tid); continue; } r -= I6;
        transpose_item(INL(24, (size_t)2 * 2048 * 256) + (size_t)2048 * 256, 2048, 256, WSP(bf16_t, WS_W_C1) + (size_t)256 * 2048, MAP_ID, T, r, 2, tid);
    }
    const int gt = bi * 512 + otid(), NT = nb * 512;
    bf16_t* wl = WSP(bf16_t, WS_W_LORA);
    const float* w2 = INL(14, 96 * 512); const float* a2 = INL(16, 96 * 512); const float* g2 = INL(17, 256 * 512);
    for (int i = gt; i < 1536 * 512; i += NT) { const int n = i >> 9, k = i & 511; float v = 0.f;
        if (n < 512) { if (k < 96) v = w2[k * 512 + n]; } else if (n < 1024) { if (k >= 128 && k < 224) v = a2[(k - 128) * 512 + (n - 512)]; } else { if (k >= 256) v = g2[(k - 256) * 512 + (n - 1024)]; }
        wl[i] = f2bf(v); }
    { float* cbp = WSP(float, WS_CBIAS) + 512; const int lane_ = tid & 63, gwv = bi * 8 + (tid >> 6), NGWV = nb * 8;
      for (int wt = gwv; wt < 128; wt += NGWV) { const int ks = wt & 15, ii = wt >> 6, n = ((wt >> 4) & 3) * 64 + lane_; const float* pos = INL(23, 2 * 32 * 64) + ii * 2048 + ks * 128; const float* w1 = INL(24, (size_t)2 * 2048 * 256) + (size_t)ii * 2048 * 256 + (size_t)ks * 128 * 256; float s0 = 0.f, s1 = 0.f, s2 = 0.f, s3 = 0.f;
          for (int k = 0; k < 128; k += 4) { s0 += pos[k] * w1[(size_t)k * 256 + n]; s1 += pos[k + 1] * w1[(size_t)(k + 1) * 256 + n]; s2 += pos[k + 2] * w1[(size_t)(k + 2) * 256 + n]; s3 += pos[k + 3] * w1[(size_t)(k + 3) * 256 + n]; }
          cbp[ks * 512 + ii * 256 + n] = (s0 + s1) + (s2 + s3); } }
    ph_norm_rows(inp(p, 1), INL(6, D), WSP(bf16_t, WS_MEMN), BATCH * MEM, bi, nb);
}

__device__ __forceinline__ float zf(const bf16_t* zr, int c) { return bf2f(zr[c]); }
__device__ __forceinline__ void bf8_to_f(const u32x4 w, float (&f)[8]) {
    f[0] = __uint_as_float(w.x << 16); f[1] = __uint_as_float(w.x & 0xffff0000u); f[2] = __uint_as_float(w.y << 16); f[3] = __uint_as_float(w.y & 0xffff0000u);
    f[4] = __uint_as_float(w.z << 16); f[5] = __uint_as_float(w.z & 0xffff0000u); f[6] = __uint_as_float(w.w << 16); f[7] = __uint_as_float(w.w & 0xffff0000u); }
__device__ __forceinline__ void ld8(const float* p, float (&f)[8]) { const f32x4 a = *(const f32x4*)p, b = *(const f32x4*)(p + 4); f[0] = a[0]; f[1] = a[1]; f[2] = a[2]; f[3] = a[3]; f[4] = b[0]; f[5] = b[1]; f[6] = b[2]; f[7] = b[3]; }
__device__ __forceinline__ void st8(float* p, const float (&f)[8]) { *(f32x4*)p = (f32x4){f[0], f[1], f[2], f[3]}; *(f32x4*)(p + 4) = (f32x4){f[4], f[5], f[6], f[7]}; }
__device__ __forceinline__ u32x4 pk8(const float (&f)[8]) { u32x4 w; w.x = cvt_pk_bf16(f[0], f[1]); w.y = cvt_pk_bf16(f[2], f[3]); w.z = cvt_pk_bf16(f[4], f[5]); w.w = cvt_pk_bf16(f[6], f[7]); return w; }
__device__ __forceinline__ void ph_mix_prep(const Params& p, int l, LAS unsigned char* lds, int bi, int nb) {
    PROLOG;
    const int tid_ = otid(), lane = tid_ & 63, wave = tid_ >> 6, gw = bi * 8 + wave, NGW = nb * 8;
    const bf16_t* z = WSP(bf16_t, WS_Z); bf16_t* oall = WSP(bf16_t, WS_OALL); bf16_t* alora = WSP(bf16_t, WS_ALORA);
    bf16_t* qr = WSP(bf16_t, WS_QR); bf16_t* kr = WSP(bf16_t, WS_KR); bf16_t* qn = WSP(bf16_t, WS_QN); bf16_t* kvg = WSP(bf16_t, WS_KVG);
    const float* scw = INL(11, 3 * 512); const float* mu = INL(12, 1984); const int* posi = (const int*)inp(p, 2);
    LAS float* tab = (LAS float*)(lds + wave * 1024);
    if (bi == 0) { float* cb = WSP(float, WS_CBIAS); float sacc = 0.f;
        for (int ks = 0; ks < 16; ++ks) sacc += cb[512 + ks * 512 + tid_]; cb[tid_] = sacc; }
    for (int task = gw; task < 2048; task += NGW) {
        const int m0 = (task >> 1) * 8, b = m0 >> 12, t0 = m0 & 4095;
        if ((task & 1) == 0) {
            float w0[8], w1[8], w2[8]; ld8(scw + 8 * lane, w0); ld8(scw + 512 + 8 * lane, w1); ld8(scw + 1024 + 8 * lane, w2);
            float cx1[8], cx2[8];
            if (t0 >= 2) { float c_[8], x_[8]; bf8_to_f(*(const u32x4*)(z + (size_t)(m0 - 1) * NZ + ZC_SC_C + 8 * lane), c_); bf8_to_f(*(const u32x4*)(z + (size_t)(m0 - 1) * NZ + ZC_SC_X + 8 * lane), x_);
#pragma unroll
                for (int j = 0; j < 8; ++j) cx1[j] = c_[j] * x_[j];
                bf8_to_f(*(const u32x4*)(z + (size_t)(m0 - 2) * NZ + ZC_SC_C + 8 * lane), c_); bf8_to_f(*(const u32x4*)(z + (size_t)(m0 - 2) * NZ + ZC_SC_X + 8 * lane), x_);
#pragma unroll
                for (int j = 0; j < 8; ++j) cx2[j] = c_[j] * x_[j]; }
            else {
#pragma unroll
                for (int j = 0; j < 8; ++j) { cx1[j] = 0.f; cx2[j] = 0.f; } }
            int src = -1, kind = 0;
            if (lane < 12) { src = ZC_RW_ZW + 8 * lane; kind = 1; } else if (lane >= 16 && lane < 28) { src = ZC_RW_ZA + 8 * (lane - 16); } else if (lane >= 32) { src = ZC_RW_ZG + 8 * (lane - 32); kind = 2; }
            float mus[8], pv[8];
#pragma unroll
            for (int j = 0; j < 8; ++j) { mus[j] = 0.f; pv[j] = 0.f; }
            if (src >= 0) { ld8(mu + (src - ZC_RW), mus); if (t0 >= 1) bf8_to_f(*(const u32x4*)(z + (size_t)(m0 - 1) * NZ + src), pv); }
#pragma unroll 2
            for (int rr = 0; rr < 8; ++rr) { const size_t m = (size_t)(m0 + rr); const bf16_t* zr = z + m * NZ;
                float b_[8], c_[8], x_[8], o8[8]; bf8_to_f(*(const u32x4*)(zr + ZC_SC_B + 8 * lane), b_); bf8_to_f(*(const u32x4*)(zr + ZC_SC_C + 8 * lane), c_); bf8_to_f(*(const u32x4*)(zr + ZC_SC_X + 8 * lane), x_);
#pragma unroll
                for (int j = 0; j < 8; ++j) { const float cx0 = c_[j] * x_[j]; o8[j] = b_[j] * (w2[j] * cx0 + w1[j] * cx1[j] + w0[j] * cx2[j]); cx2[j] = cx1[j]; cx1[j] = cx0; }
                *(u32x4*)(oall + m * NBR + 8 * lane) = pk8(o8);
                float a8[8];
                if (src >= 0) { float cur[8]; bf8_to_f(*(const u32x4*)(zr + src), cur);
#pragma unroll
                    for (int j = 0; j < 8; ++j) { const float v = cur[j] + (pv[j] - cur[j]) * mus[j]; a8[j] = kind == 1 ? tanhf(v) : (kind == 2 ? sigmoidf_(v) : v); pv[j] = cur[j]; } }
                else {
#pragma unroll
                    for (int j = 0; j < 8; ++j) a8[j] = 0.f; }
                *(u32x4*)(alora + m * 512 + 8 * lane) = pk8(a8);
                if (lane < 32) { const int arr = lane >> 4, L2 = lane & 15, g = L2 >> 3, d0 = (L2 & 7) * 8;
                    *(u32x4*)(kvg + (size_t)arr * KVG_SLAB + ((size_t)(b * 2 + g) * SEQ + (t0 + rr)) * 64 + d0) = *(const u32x4*)(zr + (arr ? ZC_NSA_VC : ZC_NSA_KC) + 8 * L2); }
            }
        } else {
            const float invr = __expf(-(float)lane * (9.210340371976184f / 63.f)), invn = __expf(-(float)(lane & 31) * (9.210340371976184f / 32.f));
            for (int rr = 0; rr < 8; ++rr) { const size_t m = (size_t)(m0 + rr); const bf16_t* zr = z + m * NZ; const float pos = (float)posi[m];
                { float sn, cs; sincosf(pos * invr, &sn, &cs); tab[lane] = cs; tab[64 + lane] = sn; sincosf(pos * invn, &sn, &cs); if (lane < 32) { tab[128 + lane] = cs; tab[160 + lane] = sn; } }
                asm volatile("s_waitcnt lgkmcnt(0)" ::: "memory");
                {
                    const int isk = lane >> 5, L2 = lane & 31, hh = L2 >> 3, j8 = (L2 & 7) * 8; const bf16_t* src = zr + (isk ? ZC_RET_K : ZC_RET_Q) + hh * 128 + j8;
                    float x1[8], x2[8], cs[8], sn[8], o1[8], o2[8]; bf8_to_f(*(const u32x4*)src, x1); bf8_to_f(*(const u32x4*)(src + 64), x2);
                    { const f32x4 a = *(const LAS f32x4*)(tab + j8), c2 = *(const LAS f32x4*)(tab + j8 + 4), d = *(const LAS f32x4*)(tab + 64 + j8), e = *(const LAS f32x4*)(tab + 64 + j8 + 4);
                      cs[0] = a[0]; cs[1] = a[1]; cs[2] = a[2]; cs[3] = a[3]; cs[4] = c2[0]; cs[5] = c2[1]; cs[6] = c2[2]; cs[7] = c2[3]; sn[0] = d[0]; sn[1] = d[1]; sn[2] = d[2]; sn[3] = d[3]; sn[4] = e[0]; sn[5] = e[1]; sn[6] = e[2]; sn[7] = e[3]; }
                    const float sc = isk ? 0.08838834764831845f : 1.f;
#pragma unroll
                    for (int j = 0; j < 8; ++j) { o1[j] = (x1[j] * cs[j] - x2[j] * sn[j]) * sc; o2[j] = (x2[j] * cs[j] + x1[j] * sn[j]) * sc; }
                    bf16_t* dst = (isk ? kr : qr) + m * 512 + hh * 128 + j8; *(u32x4*)dst = pk8(o1); *(u32x4*)(dst + 64) = pk8(o2); }
                if (lane < 48) {
                    const int j8 = (lane & 3) * 8; const bf16_t* src; bf16_t* dst;
                    if (lane < 32) { const int hh = lane >> 2; src = zr + ZC_NSA_Q + hh * 64 + j8; dst = qn + m * 512 + hh * 64 + j8; }
                    else { const int L2 = lane & 7, g = L2 >> 2, isw = (lane >= 40); src = zr + (isw ? ZC_NSA_KW : ZC_NSA_KS) + g * 64 + j8; dst = kvg + (size_t)(isw ? 4 : 2) * KVG_SLAB + ((size_t)(b * 2 + g) * SEQ + (t0 + rr)) * 64 + j8; }
                    float x1[8], x2[8], cs[8], sn[8], o1[8], o2[8]; bf8_to_f(*(const u32x4*)src, x1); bf8_to_f(*(const u32x4*)(src + 32), x2);
                    { const f32x4 a = *(const LAS f32x4*)(tab + 128 + j8), c2 = *(const LAS f32x4*)(tab + 128 + j8 + 4), d = *(const LAS f32x4*)(tab + 160 + j8), e = *(const LAS f32x4*)(tab + 160 + j8 + 4);
                      cs[0] = a[0]; cs[1] = a[1]; cs[2] = a[2]; cs[3] = a[3]; cs[4] = c2[0]; cs[5] = c2[1]; cs[6] = c2[2]; cs[7] = c2[3]; sn[0] = d[0]; sn[1] = d[1]; sn[2] = d[2]; sn[3] = d[3]; sn[4] = e[0]; sn[5] = e[1]; sn[6] = e[2]; sn[7] = e[3]; }
#pragma unroll
                    for (int j = 0; j < 8; ++j) { o1[j] = x1[j] * cs[j] - x2[j] * sn[j]; o2[j] = x2[j] * cs[j] + x1[j] * sn[j]; }
                    *(u32x4*)dst = pk8(o1); *(u32x4*)(dst + 32) = pk8(o2); }
                asm volatile("s_waitcnt lgkmcnt(0)" ::: "memory");
            }
#pragma unroll
            for (int k = 0; k < 4; ++k) { const int c = lane + 64 * k, arr = c >> 7, gd = c & 127, g = gd >> 6, d = gd & 63; const bf16_t* src = z + (size_t)m0 * NZ + (arr ? ZC_NSA_VW : ZC_NSA_VS) + gd;
                unsigned short e[8];
#pragma unroll
                for (int rr = 0; rr < 8; ++rr) e[rr] = src[(size_t)rr * NZ];
                u32x4 w; w.x = (unsigned)e[0] | ((unsigned)e[1] << 16); w.y = (unsigned)e[2] | ((unsigned)e[3] << 16); w.z = (unsigned)e[4] | ((unsigned)e[5] << 16); w.w = (unsigned)e[6] | ((unsigned)e[7] << 16);
                *(u32x4*)(kvg + (size_t)(arr ? 5 : 3) * KVG_SLAB + ((size_t)(b * 2 + g) * 64 + d) * SEQ + t0) = w; }
        }
    }
}

__device__ __forceinline__ void ph_rw_prep2(const Params& p, int l, int bi, int nb) {
    PROLOG;
    const int tid_ = otid(), lane = tid_ & 63, gw = bi * 8 + (tid_ >> 6), NGW = nb * 8;
    const bf16_t* z = WSP(bf16_t, WS_Z); const float* lo = WSP(float, WS_LO); float* ops = WSP(float, WS_RWOPS);
    const float* mu = INL(12, 1984); constexpr size_t AS = (size_t)M * 512; const int c0 = 8 * lane;
    float mur[8], muk[8], muv[8], w0[8], a0[8], kkw[8], kaw[8];
    ld8(mu + c0, mur); ld8(mu + 512 + c0, muk); ld8(mu + 1024 + c0, muv); ld8(INL(13, 512) + c0, w0); ld8(INL(15, 512) + c0, a0); ld8(INL(18, 512) + c0, kkw); ld8(INL(19, 512) + c0, kaw);
    for (int m0 = gw; m0 < M; m0 += 2 * NGW) {
        u32x4 zc[2][3], zp[2][3]; float ld_[2][8], la_[2][8];
#pragma unroll
        for (int u = 0; u < 2; ++u) { const int m = m0 + u * NGW; if (m < M) { const bf16_t* zr = z + (size_t)m * NZ + ZC_RW_R + c0; const bool hp = (m & 4095) >= 1;
#pragma unroll
            for (int a = 0; a < 3; ++a) { zc[u][a] = *(const u32x4*)(zr + 512 * a); zp[u][a] = hp ? *(const u32x4*)(zr + 512 * a - NZ) : (u32x4){0u, 0u, 0u, 0u}; }
            ld8(lo + (size_t)m * 1536 + c0, ld_[u]); ld8(lo + (size_t)m * 1536 + 512 + c0, la_[u]); } }
#pragma unroll
        for (int u = 0; u < 2; ++u) { const int m = m0 + u * NGW; if (m < M) {
            float r[8], k[8], v[8], pr[8], pk[8], pv[8], w[8], kk[8], k2[8], bb[8];
            bf8_to_f(zc[u][0], r); bf8_to_f(zc[u][1], k); bf8_to_f(zc[u][2], v); bf8_to_f(zp[u][0], pr); bf8_to_f(zp[u][1], pk); bf8_to_f(zp[u][2], pv);
            float ss = 0.f;
#pragma unroll
            for (int j = 0; j < 8; ++j) { r[j] += (pr[j] - r[j]) * mur[j]; k[j] += (pk[j] - k[j]) * muk[j]; v[j] += (pv[j] - v[j]) * muv[j];
                w[j] = __expf(-0.6065306597126334f * sigmoidf_(w0[j] + ld_[u][j])); kk[j] = k[j] * kkw[j]; ss += kk[j] * kk[j]; }
            ss += __shfl_xor(ss, 1); ss += __shfl_xor(ss, 2); ss += __shfl_xor(ss, 4);
            const float rn = 1.f / fmaxf(sqrtf(ss), 1e-12f);
#pragma unroll
            for (int j = 0; j < 8; ++j) { const float a = sigmoidf_(a0[j] + la_[u][j]); kk[j] *= rn; k2[j] = k[j] * (1.f + (a - 1.f) * kaw[j]); bb[j] = kk[j] * a; }
            float* o = ops + (size_t)m * 512 + c0;
            st8(o, r); st8(o + AS, w); st8(o + 2 * AS, k2); st8(o + 3 * AS, v); st8(o + 4 * AS, kk); st8(o + 5 * AS, bb); } }
    }
}
#define DPP_ROR_ADD(x, n) (x) += __int_as_float(__builtin_amdgcn_update_dpp(0, __float_as_int(x), 0x120 + (n), 0xf, 0xf, false))
__device__ __forceinline__ float row_allreduce16(float x) { DPP_ROR_ADD(x, 8); DPP_ROR_ADD(x, 4); DPP_ROR_ADD(x, 2); DPP_ROR_ADD(x, 1); return x; }
__device__ __forceinline__ void ph_rw_scan(const Params& p, LAS unsigned char* lds, int bi, int nb) {
    PROLOG;
    const float* ops = WSP(float, WS_RWOPS); float* ys = WSP(float, WS_YSCAN); constexpr size_t AS = (size_t)M * 512; constexpr int TC = 32;
    LAS float* lop = (LAS float*)lds;
    LAS float* ybuf = (LAS float*)(lds + 6 * TC * 64 * 4);
    const int tid = otid(), wave = tid >> 6, lane = tid & 63, Rg = wave * 4 + (lane >> 4), Pc = lane & 15;
    for (int task = bi; task < 16; task += nb) {
        const int b = task >> 3, hh = task & 7;
        float s[4][4];
#pragma unroll
        for (int i = 0; i < 4; ++i)
#pragma unroll
            for (int j = 0; j < 4; ++j) s[i][j] = 0.f;
        for (int t0 = 0; t0 < SEQ; t0 += TC) {
            for (int idx = tid; idx < 6 * TC * 16; idx += 512) { const int arr = idx / (TC * 16), rem = idx % (TC * 16), tt = rem >> 4, c4 = rem & 15;
                *(LAS f32x4*)(lop + (arr * TC + tt) * 64 + c4 * 4) = *(const f32x4*)(ops + arr * AS + (size_t)(b * SEQ + t0 + tt) * 512 + hh * 64 + c4 * 4); }
            __syncthreads();
            if (wave < 4) {
                for (int tt = 0; tt < TC; ++tt) {
                    const f32x4 r4 = *(const LAS f32x4*)(lop + (0 * TC + tt) * 64 + Pc * 4), w4 = *(const LAS f32x4*)(lop + (1 * TC + tt) * 64 + Pc * 4), k4 = *(const LAS f32x4*)(lop + (2 * TC + tt) * 64 + Pc * 4);
                    const f32x4 v4 = *(const LAS f32x4*)(lop + (3 * TC + tt) * 64 + Rg * 4), kk4 = *(const LAS f32x4*)(lop + (4 * TC + tt) * 64 + Pc * 4), b4 = *(const LAS f32x4*)(lop + (5 * TC + tt) * 64 + Pc * 4);
                    float sa[4];
#pragma unroll
                    for (int i = 0; i < 4; ++i) { float x = -(s[i][0] * kk4[0] + s[i][1] * kk4[1] + s[i][2] * kk4[2] + s[i][3] * kk4[3]); sa[i] = row_allreduce16(x); }
                    float y[4];
#pragma unroll
                    for (int i = 0; i < 4; ++i) { float acc = 0.f;
#pragma unroll
                        for (int j = 0; j < 4; ++j) { s[i][j] = s[i][j] * w4[j] + sa[i] * b4[j] + v4[i] * k4[j]; acc += s[i][j] * r4[j]; }
                        y[i] = row_allreduce16(acc); }
                    if (Pc == 0) *(LAS f32x4*)(ybuf + tt * 64 + Rg * 4) = (f32x4){y[0], y[1], y[2], y[3]};
                }
            }
            __syncthreads();
            { const int tt = tid >> 4, c4 = tid & 15; *(f32x4*)(ys + (size_t)(b * SEQ + t0 + tt) * 512 + hh * 64 + c4 * 4) = *(const LAS f32x4*)(ybuf + tt * 64 + c4 * 4); }
        }
        __syncthreads();
    }
}

typedef short bf16x8s __attribute__((ext_vector_type(8)));
__device__ __forceinline__ bf16x8 zfrag() { return (bf16x8){0, 0, 0, 0, 0, 0, 0, 0}; }
__device__ __forceinline__ bf16x8 pack8(f32x4 a, f32x4 b) { u32x4 w; w.x = cvt_pk_bf16(a[0], a[1]); w.y = cvt_pk_bf16(a[2], a[3]); w.z = cvt_pk_bf16(b[0], b[1]); w.w = cvt_pk_bf16(b[2], b[3]); return __builtin_bit_cast(bf16x8, w); }
__device__ __forceinline__ float wave_sum_fast(float x) {
    x = row_allreduce16(x);
    { auto r16 = __builtin_amdgcn_permlane16_swap(__float_as_uint(x), __float_as_uint(x), false, false); x = __uint_as_float(r16[0]) + __uint_as_float(r16[1]);
      auto r32 = __builtin_amdgcn_permlane32_swap(__float_as_uint(x), __float_as_uint(x), false, false); x = __uint_as_float(r32[0]) + __uint_as_float(r32[1]); }
    return x;
}
__device__ __forceinline__ void ph_rw_chunk(const Params& p, int l, LAS unsigned char* lds, int bi, int nb) {
    PROLOG;
    const bf16_t* z = WSP(bf16_t, WS_Z); const float* lo = WSP(float, WS_LO); float* sbon = WSP(float, WS_RWOPS);
    unsigned char* PFg = WSP(unsigned char, WS_RW_PF); unsigned char* QFg = WSP(unsigned char, WS_RW_QF); unsigned char* RFg = WSP(unsigned char, WS_RW_RF); unsigned char* Y0g = WSP(unsigned char, WS_RW_Y0F);
    const int tid = otid(), wave = tid >> 6, lane = tid & 63, r = lane & 15, q = lane >> 4;
    if (wave >= 6) return;
    LAS unsigned char* L = lds + wave * 21760;
    LAS bf16_t* BE = (LAS bf16_t*)(L);
    LAS bf16_t* KA = (LAS bf16_t*)(L + 2048);
    LAS bf16_t* AL = (LAS bf16_t*)(L + 4096);
    LAS bf16_t* RHO = (LAS bf16_t*)(L + 6144);
    LAS bf16_t* ALT = (LAS bf16_t*)(L + 8192);
    LAS bf16_t* BEPT = (LAS bf16_t*)(L + 10240);
    LAS bf16_t* KAPT = (LAS bf16_t*)(L + 12288);
    LAS bf16_t* VT = (LAS bf16_t*)(L + 14336);
    LAS bf16_t* RHOT = (LAS bf16_t*)(L + 16384);
    LAS bf16_t* OM = (LAS bf16_t*)(L);
    LAS bf16_t* VBm = (LAS bf16_t*)(L + 2048);
    LAS bf16_t* MU = (LAS bf16_t*)(L + 4096);
    LAS float* Af = (LAS float*)(L + 18432);
    LAS bf16_t* NT = (LAS bf16_t*)(L + 19456);
    LAS bf16_t* BmT = (LAS bf16_t*)(L + 19968);
    LAS bf16_t* CbT = (LAS bf16_t*)(L + 20480);
    LAS bf16_t* CkT = (LAS bf16_t*)(L + 20992);
    LAS float* GT = (LAS float*)(L + 21504);
    const float* mu = INL(12, 1984);
    const int gw = bi * 6 + wave, NGW = nb * 6;
    for (int task = gw; task < 4096; task += NGW) {
        const int bh = task >> 8, n = task & 255, b = bh >> 3, hh = bh & 7; const int c = hh * 64 + lane; const size_t m0 = (size_t)b * SEQ + 16 * n;
        { const float mur = mu[c], muk = mu[512 + c], muv = mu[1024 + c], w0 = INL(13, 512)[c], a0 = INL(15, 512)[c], kkw = INL(18, 512)[c], kaw = INL(19, 512)[c], rkc = INL(20, 512)[c];
          const bf16_t* zb = z + m0 * NZ + ZC_RW_R + c; const float* lb_ = lo + m0 * 1536 + c;
          bf16_t zr_[17], zk_[17], zv_[17]; float ld_[16], la_[16];
          zr_[0] = n > 0 ? zb[-NZ] : (bf16_t)0; zk_[0] = n > 0 ? zb[512 - NZ] : (bf16_t)0; zv_[0] = n > 0 ? zb[1024 - NZ] : (bf16_t)0;
#pragma unroll
          for (int t = 0; t < 16; ++t) { const bf16_t* zr = zb + (size_t)t * NZ; zr_[t + 1] = zr[0]; zk_[t + 1] = zr[512]; zv_[t + 1] = zr[1024]; ld_[t] = lb_[(size_t)t * 1536]; la_[t] = lb_[(size_t)t * 1536 + 512]; }
          float g = 1.f; float be[16], ka[16], sbv[16];
#pragma unroll
          for (int t = 0; t < 16; ++t) { const float cr = bf2f(zr_[t + 1]), ck = bf2f(zk_[t + 1]), cv = bf2f(zv_[t + 1]), pr = bf2f(zr_[t]), pk = bf2f(zk_[t]), pv = bf2f(zv_[t]);
              const float rr = cr + (pr - cr) * mur, kx = ck + (pk - ck) * muk, vv = cv + (pv - cv) * muv;
              const float ww = __expf(-0.6065306597126334f * sigmoidf_(w0 + ld_[t])), aa = sigmoidf_(a0 + la_[t]);
              float kk = kx * kkw; const float nrm = sqrtf(wave_sum_fast(kk * kk)); kk = kk / fmaxf(nrm, 1e-12f);
              const float k2 = kx * (1.f + (aa - 1.f) * kaw), bb = kk * aa;
              sbv[t] = wave_sum_fast(rr * k2 * rkc);
              const float gprev = g; g *= ww; const float al = gprev * kk, rg = 1.f / g; be[t] = bb * rg; ka[t] = k2 * rg; const float rho = g * rr;
              BE[t * 64 + lane] = f2bf(be[t]); KA[t * 64 + lane] = f2bf(ka[t]); AL[t * 64 + lane] = f2bf(al); RHO[t * 64 + lane] = f2bf(rho);
              ALT[lane * 16 + t] = f2bf(al); VT[lane * 16 + t] = f2bf(vv); RHOT[lane * 16 + t] = f2bf(rho); }
          if (lane < 16) { float sv = sbv[0];
#pragma unroll
              for (int t = 1; t < 16; ++t) sv = (lane == t) ? sbv[t] : sv;
              sbon[(m0 + lane) * 8 + hh] = sv; }
          GT[lane] = g;
#pragma unroll
          for (int t = 0; t < 16; ++t) { BEPT[lane * 16 + t] = f2bf(be[t] * g); KAPT[lane * 16 + t] = f2bf(ka[t] * g); } }
        asm volatile("s_waitcnt lgkmcnt(0)" ::: "memory");
        { bf16x8 xb[2], xk[2], ya[2], yr[2];
#pragma unroll
          for (int ks = 0; ks < 2; ++ks) { xb[ks] = *(const LAS bf16x8*)(BE + r * 64 + 32 * ks + 8 * q); xk[ks] = *(const LAS bf16x8*)(KA + r * 64 + 32 * ks + 8 * q);
              ya[ks] = *(const LAS bf16x8*)(AL + r * 64 + 32 * ks + 8 * q); yr[ks] = *(const LAS bf16x8*)(RHO + r * 64 + 32 * ks + 8 * q); }
          f32x4 A = {0.f, 0.f, 0.f, 0.f}, Bm = A, Cb = A, Ck = A;
#pragma unroll
          for (int ks = 0; ks < 2; ++ks) { A = mma16(A, xb[ks], ya[ks]); Bm = mma16(Bm, xk[ks], ya[ks]); Cb = mma16(Cb, xb[ks], yr[ks]); Ck = mma16(Ck, xk[ks], yr[ks]); }
#pragma unroll
          for (int jj = 0; jj < 4; ++jj) { const int c = 4 * q + jj; const bool lt = r < c, le = r <= c;
              A[jj] = lt ? A[jj] : 0.f; BmT[c * 16 + r] = f2bf(lt ? Bm[jj] : 0.f); CbT[c * 16 + r] = f2bf(le ? Cb[jj] : 0.f); CkT[c * 16 + r] = f2bf(le ? Ck[jj] : 0.f); }
          *(LAS f32x4*)(Af + r * 16 + 4 * q) = A; }
        asm volatile("s_waitcnt lgkmcnt(0)" ::: "memory");
        { float nrow[16];
#pragma unroll
          for (int i = 0; i < 16; ++i) { float sacc = (i == r) ? 1.f : 0.f;
#pragma unroll
              for (int j = 0; j < i; ++j) sacc -= nrow[j] * Af[j * 16 + i];
              nrow[i] = sacc; }
          if (q == 0) {
#pragma unroll
              for (int i = 0; i < 16; ++i) NT[i * 16 + r] = f2bf(nrow[i]); } }
        asm volatile("s_waitcnt lgkmcnt(0)" ::: "memory");
        const bool lo = q < 2; const int q2 = q & 1;
        { const bf16x8 bN = lo ? *(const LAS bf16x8*)(NT + r * 16 + 8 * q2) : zfrag(); const bf16x8 bB = lo ? *(const LAS bf16x8*)(BmT + r * 16 + 8 * q2) : zfrag();
#pragma unroll
          for (int mt = 0; mt < 4; ++mt) { const int row = 16 * mt + r;
              const bf16x8 aA = lo ? *(const LAS bf16x8*)(ALT + row * 16 + 8 * q2) : zfrag(); const bf16x8 aV = lo ? *(const LAS bf16x8*)(VT + row * 16 + 8 * q2) : zfrag();
              f32x4 om = mma16((f32x4){0.f, 0.f, 0.f, 0.f}, aA, bN), vb = mma16((f32x4){0.f, 0.f, 0.f, 0.f}, aV, bB);
              u32x2 w; w.x = cvt_pk_bf16(-om[0], -om[1]); w.y = cvt_pk_bf16(-om[2], -om[3]); *(LAS u32x2*)(OM + row * 16 + 4 * q) = w;
              w.x = cvt_pk_bf16(vb[0], vb[1]); w.y = cvt_pk_bf16(vb[2], vb[3]); *(LAS u32x2*)(VBm + row * 16 + 4 * q) = w; }
          asm volatile("s_waitcnt lgkmcnt(0)" ::: "memory");
#pragma unroll
          for (int mt = 0; mt < 4; ++mt) { const int row = 16 * mt + r; const bf16x8 aB = lo ? *(const LAS bf16x8*)(VBm + row * 16 + 8 * q2) : zfrag();
              f32x4 mu = mma16((f32x4){0.f, 0.f, 0.f, 0.f}, aB, bN);
              u32x2 w; w.x = cvt_pk_bf16(-mu[0], -mu[1]); w.y = cvt_pk_bf16(-mu[2], -mu[3]); *(LAS u32x2*)(MU + row * 16 + 4 * q) = w; } }
        asm volatile("s_waitcnt lgkmcnt(0)" ::: "memory");
        const size_t rec = (size_t)bh * 256 + n;
        { bf16x8 bO[4];
#pragma unroll
          for (int nt = 0; nt < 4; ++nt) bO[nt] = lo ? *(const LAS bf16x8*)(OM + (16 * nt + r) * 16 + 8 * q2) : zfrag();
#pragma unroll
          for (int mt = 0; mt < 4; ++mt) { const bf16x8 a = lo ? *(const LAS bf16x8*)(BEPT + (16 * mt + r) * 16 + 8 * q2) : zfrag(); f32x4 acc[4];
#pragma unroll
              for (int nt = 0; nt < 4; ++nt) acc[nt] = mma16((f32x4){0.f, 0.f, 0.f, 0.f}, a, bO[nt]);
              { const float gd = GT[16 * mt + r];
#pragma unroll
                for (int jj = 0; jj < 4; ++jj) if (4 * q + jj == r) acc[mt][jj] += gd; }
#pragma unroll
              for (int ks = 0; ks < 2; ++ks) *(bf16x8*)(PFg + rec * 8192 + (size_t)((mt * 2 + ks) * 64 + lane) * 16) = pack8(acc[2 * ks], acc[2 * ks + 1]); }
          { bf16x8 a; if (lo) a = *(const LAS bf16x8*)(CbT + r * 16 + 8 * q2); else { a = zfrag();
#pragma unroll
                for (int e = 0; e < 8; ++e) if (8 * q2 + e == r) a[e] = (short)0x3f80; }
            f32x4 acc[4];
#pragma unroll
            for (int nt = 0; nt < 4; ++nt) { const bf16x8 bb = lo ? bO[nt] : *(const LAS bf16x8*)(RHOT + (16 * nt + r) * 16 + 8 * q2); acc[nt] = mma16((f32x4){0.f, 0.f, 0.f, 0.f}, a, bb); }
#pragma unroll
            for (int ks = 0; ks < 2; ++ks) *(bf16x8*)(RFg + rec * 2048 + (size_t)(ks * 64 + lane) * 16) = pack8(acc[2 * ks], acc[2 * ks + 1]); } }
        { bf16x8 bQ[4];
#pragma unroll
          for (int nt = 0; nt < 4; ++nt) bQ[nt] = *(const LAS bf16x8*)((lo ? BEPT : KAPT) + (16 * nt + r) * 16 + 8 * q2);
          const bf16x8 bY = *(const LAS bf16x8*)((lo ? CbT : CkT) + r * 16 + 8 * q2);
#pragma unroll
          for (int mt = 0; mt < 4; ++mt) { const bf16x8 a = *(const LAS bf16x8*)((lo ? MU : VT) + (16 * mt + r) * 16 + 8 * q2);
#pragma unroll
              for (int nt = 0; nt < 4; ++nt) { const f32x4 acc = mma16((f32x4){0.f, 0.f, 0.f, 0.f}, a, bQ[nt]); { u32x2 w; w.x = cvt_pk_bf16(acc[0], acc[1]); w.y = cvt_pk_bf16(acc[2], acc[3]); *(u32x2*)(QFg + rec * 8192 + (size_t)((mt * 4 + nt) * 64 + lane) * 8) = w; } }
              const f32x4 y0 = mma16((f32x4){0.f, 0.f, 0.f, 0.f}, a, bY); { u32x2 w; w.x = cvt_pk_bf16(y0[0], y0[1]); w.y = cvt_pk_bf16(y0[2], y0[3]); *(u32x2*)(Y0g + rec * 4096 + (size_t)(mt * 64 + lane) * 16) = w; } } }
        asm volatile("s_waitcnt lgkmcnt(0)" ::: "memory");
    }
}
__device__ __forceinline__ void ph_rw_serial(const Params& p, LAS unsigned char* lds, int bi, int nb) {
    PROLOG;
    constexpr int NS = 5, DD = 4, REC = 13312, SLOT = 2 * REC;
    const unsigned char* PFg = WSP(unsigned char, WS_RW_PF); const unsigned char* QFg = WSP(unsigned char, WS_RW_QF); const unsigned char* RFg = WSP(unsigned char, WS_RW_RF); const unsigned char* Y0g = WSP(unsigned char, WS_RW_Y0F);
    float* ys = WSP(float, WS_YSCAN);
    const int tid = otid(), wave = __builtin_amdgcn_readfirstlane(tid >> 6), lane = tid & 63, l15 = lane & 15, q = lane >> 4;
    for (int task = bi; task < 64; task += nb) {
        const int bh = task >> 2, w = task & 3, b = bh >> 3, hh = bh & 7;
        const unsigned char* gp[4]; size_t gs[4]; int gr[4], gl[4];
#pragma unroll
        for (int k = 0; k < 4; ++k) { int pidx = 4 * (wave - 1) + k; if (pidx > 25) pidx = 25; if (pidx < 0) pidx = 0; const int rc = pidx / 13, pc = pidx % 13; gr[k] = rc; gl[k] = rc * REC + pc * 1024;
            if (pc < 8) { gp[k] = PFg + (size_t)bh * 256 * 8192 + pc * 1024; gs[k] = 8192; }
            else if (pc < 10) { gp[k] = QFg + (size_t)bh * 256 * 8192 + w * 2048 + (pc - 8) * 1024; gs[k] = 8192; }
            else if (pc < 12) { gp[k] = RFg + (size_t)bh * 256 * 2048 + (pc - 10) * 1024; gs[k] = 2048; }
            else { gp[k] = Y0g + (size_t)bh * 256 * 4096 + w * 1024; gs[k] = 4096; } }
        const bool loader = wave >= 1;
#define RW_ISSUE(step) do { LAS unsigned char* sl_ = lds + ((step) % NS) * SLOT; \
        _Pragma("unroll") for (int k_ = 0; k_ < 4; ++k_) { int c_ = 2 * (step) + gr[k_]; c_ = c_ < 256 ? c_ : 255; \
            __builtin_amdgcn_global_load_lds((const unsigned*)(gp[k_] + (size_t)c_ * gs[k_] + lane * 16), (LAS unsigned*)(sl_ + gl[k_]), 16, 0, 0); } \
        asm volatile("" ::: "memory"); } while (0)
        do { asm volatile("" ::: "memory"); __builtin_amdgcn_s_barrier(); asm volatile("" ::: "memory"); } while (0);
        if (loader) { for (int s0 = 0; s0 < DD; ++s0) RW_ISSUE(s0);
            asm volatile("s_waitcnt vmcnt(12)" ::: "memory"); }
        do { asm volatile("" ::: "memory"); __builtin_amdgcn_s_barrier(); asm volatile("" ::: "memory"); } while (0);
        f32x4 S[4];
#pragma unroll
        for (int mt = 0; mt < 4; ++mt) S[mt] = (f32x4){0.f, 0.f, 0.f, 0.f};
        for (int i = 0; i < 128; ++i) {
            if (loader) { RW_ISSUE(i + DD); asm volatile("s_waitcnt vmcnt(12)" ::: "memory"); }
            else {
#pragma unroll
                for (int rc = 0; rc < 2; ++rc) {
                    const int n = 2 * i + rc; const LAS unsigned char* sl = lds + (i % NS) * SLOT + rc * REC;
                    bf16x8 sf[2]; sf[0] = pack8(S[0], S[1]); sf[1] = pack8(S[2], S[3]);
                    f32x4 y; { const u32x2 yw = *(const LAS u32x2*)(sl + 12288 + lane * 16); y[0] = __uint_as_float(yw.x << 16); y[1] = __uint_as_float(yw.x & 0xffff0000u); y[2] = __uint_as_float(yw.y << 16); y[3] = __uint_as_float(yw.y & 0xffff0000u); }
#pragma unroll
                    for (int ks = 0; ks < 2; ++ks) y = __builtin_amdgcn_mfma_f32_16x16x32_bf16(*(const LAS bf16x8*)(sl + 10240 + (ks * 64 + lane) * 16), sf[ks], y, 0, 0, 0);
#pragma unroll
                    for (int mt = 0; mt < 4; ++mt) { f32x4 a; { const u32x2 qw = *(const LAS u32x2*)(sl + 8192 + (mt * 64 + lane) * 8); a[0] = __uint_as_float(qw.x << 16); a[1] = __uint_as_float(qw.x & 0xffff0000u); a[2] = __uint_as_float(qw.y << 16); a[3] = __uint_as_float(qw.y & 0xffff0000u); }
#pragma unroll
                        for (int ks = 0; ks < 2; ++ks) a = __builtin_amdgcn_mfma_f32_16x16x32_bf16(*(const LAS bf16x8*)(sl + ((mt * 2 + ks) * 64 + lane) * 16), sf[ks], a, 0, 0, 0);
                        S[mt] = a; }
                    float* yo = ys + ((size_t)b * SEQ + 16 * n + 4 * q) * 512 + hh * 64 + 16 * w + l15;
#pragma unroll
                    for (int jj = 0; jj < 4; ++jj) yo[(size_t)jj * 512] = y[jj];
                }
                asm volatile("s_waitcnt lgkmcnt(0)" ::: "memory");
            }
            do { asm volatile("" ::: "memory"); __builtin_amdgcn_s_barrier(); asm volatile("" ::: "memory"); } while (0);
        }
        asm volatile("s_waitcnt vmcnt(0)" ::: "memory");
        do { asm volatile("" ::: "memory"); __builtin_amdgcn_s_barrier(); asm volatile("" ::: "memory"); } while (0);
#undef RW_ISSUE
    }
}

__device__ __forceinline__ void ph_rw_post(const Params& p, int l, int bi, int nb) {
    PROLOG;
    const int tid_ = otid(), lane = tid_ & 63, gw = bi * 8 + (tid_ >> 6), NGW = nb * 8;
    const bf16_t* z = WSP(bf16_t, WS_Z); const float* sbon = WSP(float, WS_RWOPS); const float* ys = WSP(float, WS_YSCAN); const float* lo = WSP(float, WS_LO); bf16_t* oall = WSP(bf16_t, WS_OALL);
    const int c0 = 8 * lane;
    float lg[8], lb[8], muv[8]; ld8(INL(21, 512) + c0, lg); ld8(INL(22, 512) + c0, lb); ld8(INL(12, 1984) + 1024 + c0, muv);
    for (int m0 = gw; m0 < M; m0 += 2 * NGW) {
        float y[2][8], g[2][8], sb[2]; u32x4 vc[2], vp[2];
#pragma unroll
        for (int u = 0; u < 2; ++u) { const int m = m0 + u * NGW; if (m < M) { const size_t o = (size_t)m * 512 + c0; const bf16_t* zv = z + (size_t)m * NZ + ZC_RW_V + c0;
            ld8(ys + o, y[u]); ld8(lo + (size_t)m * 1536 + 1024 + c0, g[u]); sb[u] = sbon[(size_t)m * 8 + (lane >> 3)];
            vc[u] = *(const u32x4*)zv; vp[u] = ((m & 4095) >= 1) ? *(const u32x4*)(zv - NZ) : (u32x4){0u, 0u, 0u, 0u}; } }
#pragma unroll
        for (int u = 0; u < 2; ++u) { const int m = m0 + u * NGW; if (m < M) {
            float v[8], pv[8]; bf8_to_f(vc[u], v); bf8_to_f(vp[u], pv);
            float s1 = 0.f;
#pragma unroll
            for (int j = 0; j < 8; ++j) { s1 += y[u][j]; v[j] += (pv[j] - v[j]) * muv[j]; }
            s1 += __shfl_xor(s1, 1); s1 += __shfl_xor(s1, 2); s1 += __shfl_xor(s1, 4);
            const float mean = s1 * (1.f / 64.f); float s2 = 0.f;
#pragma unroll
            for (int j = 0; j < 8; ++j) { y[u][j] -= mean; s2 += y[u][j] * y[u][j]; }
            s2 += __shfl_xor(s2, 1); s2 += __shfl_xor(s2, 2); s2 += __shfl_xor(s2, 4);
            const float rstd = rsqrtf(s2 * (1.f / 64.f) + 64e-5f); float o8[8];
#pragma unroll
            for (int j = 0; j < 8; ++j) o8[j] = (y[u][j] * rstd * lg[j] + lb[j] + sb[u] * v[j]) * g[u][j];
            *(u32x4*)(oall + (size_t)m * NBR + 512 + c0) = pk8(o8); } }
    }
}

__device__ __forceinline__ float ret_lg(int hh) { return logf(1.f - exp2f(-5.f - (float)hh)); }
__device__ __forceinline__ void ph_ret_u(const Params& p, LAS unsigned char* lds, int bi, int nb) {
    PROLOG;
    const bf16_t* z = WSP(bf16_t, WS_Z); const bf16_t* kr = WSP(bf16_t, WS_KR); float* ub = WSP(float, WS_UBUF);
    LAS bf16_t* Vt = (LAS bf16_t*)lds;
    LAS bf16_t* Kt = (LAS bf16_t*)(lds + 256 * 136 * 2);
    const int tid = otid(), wave = tid >> 6, lane = tid & 63, r = lane & 15, q = lane >> 4;
    for (int task = bi; task < 256; task += nb) {
        const int b = task >> 7, hh = (task >> 5) & 3, n = task & 31; const float lgh = ret_lg(hh); const size_t m0 = (size_t)b * SEQ + n * 128;
        __syncthreads();
        for (int idx = tid; idx < 128 * 32; idx += 512) { const int mm = idx & 127, ch = idx >> 7; const u32x4 w = *(const u32x4*)(z + (m0 + mm) * NZ + ZC_RET_V + hh * 256 + ch * 8);
            const unsigned ww[4] = {w.x, w.y, w.z, w.w};
#pragma unroll
            for (int i = 0; i < 4; ++i) { Vt[(ch * 8 + 2 * i) * 136 + mm] = (bf16_t)(ww[i] & 0xffffu); Vt[(ch * 8 + 2 * i + 1) * 136 + mm] = (bf16_t)(ww[i] >> 16); } }
        for (int idx = tid; idx < 128 * 16; idx += 512) { const int mm = idx & 127, ch = idx >> 7; const float zeta = __expf((float)(127 - mm) * lgh);
            const u32x4 w = *(const u32x4*)(kr + (m0 + mm) * 512 + hh * 128 + ch * 8); const unsigned ww[4] = {w.x, w.y, w.z, w.w};
#pragma unroll
            for (int i = 0; i < 4; ++i) { Kt[(ch * 8 + 2 * i) * 136 + mm] = f2bf(__uint_as_float(ww[i] << 16) * zeta); Kt[(ch * 8 + 2 * i + 1) * 136 + mm] = f2bf(__uint_as_float(ww[i] & 0xffff0000u) * zeta); } }
        __syncthreads();
        float* uo = ub + (size_t)task * 256 * 128;
#pragma unroll
        for (int et = 0; et < 2; ++et) { const int e0 = 16 * (2 * wave + et); bf16x8 a[4];
#pragma unroll
            for (int ks = 0; ks < 4; ++ks) a[ks] = *(const LAS bf16x8*)(Vt + (e0 + r) * 136 + 32 * ks + 8 * q);
#pragma unroll
            for (int dt = 0; dt < 8; ++dt) { f32x4 acc = {0.f, 0.f, 0.f, 0.f};
#pragma unroll
                for (int ks = 0; ks < 4; ++ks) { const bf16x8 bb = *(const LAS bf16x8*)(Kt + (16 * dt + r) * 136 + 32 * ks + 8 * q); acc = mma16(acc, a[ks], bb); }
                *(f32x4*)(uo + (size_t)(e0 + r) * 128 + 16 * dt + 4 * q) = acc; } }
    }
}
__device__ __forceinline__ void ph_ret_scan(const Params& p, int bi, int nb) {
    PROLOG;
    const float* ub = WSP(float, WS_UBUF); bf16_t* rp = WSP(bf16_t, WS_RPREV);
    const int gt = bi * 512 + otid(), NT = nb * 512;
    for (int i = gt; i < 8 * 8192; i += NT) { const int bh = i >> 13, e4 = i & 8191, hh = bh & 3; const float cd = __expf(128.f * ret_lg(hh)); f32x4 st = {0.f, 0.f, 0.f, 0.f};
        for (int n0 = 0; n0 < 32; n0 += 8) { f32x4 uu[8];
#pragma unroll
            for (int k = 0; k < 8; ++k) uu[k] = *(const f32x4*)(ub + ((size_t)(bh * 32 + n0 + k) * 8192 + e4) * 4);
#pragma unroll
            for (int k = 0; k < 8; ++k) { u32x2 w; w.x = cvt_pk_bf16(st[0], st[1]); w.y = cvt_pk_bf16(st[2], st[3]); *(u32x2*)(rp + ((size_t)(bh * 32 + n0 + k) * 8192 + e4) * 4) = w; st = st * cd + uu[k]; } } }
}
__device__ __forceinline__ void ret_out_task(const Params& p, LAS unsigned char* lds, const int task) {
    PROLOG;
    const bf16_t* z = WSP(bf16_t, WS_Z); const bf16_t* qr = WSP(bf16_t, WS_QR); const bf16_t* kr = WSP(bf16_t, WS_KR); const bf16_t* rp = WSP(bf16_t, WS_RPREV); bf16_t* oall = WSP(bf16_t, WS_OALL);
    LAS bf16_t* Vt = (LAS bf16_t*)lds;
    const int tid = otid(), wave = tid >> 6, lane = tid & 63, r = lane & 15, q = lane >> 4;
    LAS bf16_t* Sc = (LAS bf16_t*)(lds + 256 * 136 * 2) + wave * 16 * 136;
    {
        const int b = task >> 7, hh = (task >> 5) & 3, n = task & 31; const float lgh = ret_lg(hh); const size_t m0 = (size_t)b * SEQ + n * 128;
        __syncthreads();
        for (int idx = tid; idx < 128 * 32; idx += 512) { const int mm = idx & 127, ch = idx >> 7; const u32x4 w = *(const u32x4*)(z + (m0 + mm) * NZ + ZC_RET_V + hh * 256 + ch * 8);
            const unsigned ww[4] = {w.x, w.y, w.z, w.w};
#pragma unroll
            for (int i = 0; i < 4; ++i) { Vt[(ch * 8 + 2 * i) * 136 + mm] = (bf16_t)(ww[i] & 0xffffu); Vt[(ch * 8 + 2 * i + 1) * 136 + mm] = (bf16_t)(ww[i] >> 16); } }
        __syncthreads();
        const int c = 16 * wave + r; const size_t mrow = m0 + c;
        bf16x8 qa[4];
#pragma unroll
        for (int ks = 0; ks < 4; ++ks) qa[ks] = ldfrag(qr + mrow * 512 + hh * 128 + 32 * ks + 8 * q);
#pragma unroll
        for (int mt = 0; mt < 8; ++mt) { f32x4 s = {0.f, 0.f, 0.f, 0.f};
#pragma unroll
            for (int ks = 0; ks < 4; ++ks) s = mma16(s, qa[ks], ldfrag(kr + (m0 + 16 * mt + r) * 512 + hh * 128 + 32 * ks + 8 * q));
            float v[4];
#pragma unroll
            for (int j = 0; j < 4; ++j) { const int mm = 16 * mt + 4 * q + j; v[j] = (c >= mm) ? s[j] * __expf((float)(c - mm) * lgh) : 0.f; }
            u32x2 w; w.x = cvt_pk_bf16(v[0], v[1]); w.y = cvt_pk_bf16(v[2], v[3]); *(LAS u32x2*)(Sc + r * 136 + 16 * mt + 4 * q) = w; }
        asm volatile("s_waitcnt lgkmcnt(0)" ::: "memory");
        const float xi = __expf((float)(c + 1) * lgh);
        const bf16_t* rpc = rp + (size_t)task * 256 * 128;
        f32x4 acc[16]; bf16x8 sa[4];
#pragma unroll
        for (int ks = 0; ks < 4; ++ks) sa[ks] = *(const LAS bf16x8*)(Sc + r * 136 + 32 * ks + 8 * q);
#pragma unroll
        for (int et = 0; et < 16; ++et) { f32x4 a = {0.f, 0.f, 0.f, 0.f};
#pragma unroll
            for (int ks = 0; ks < 4; ++ks) a = mma16(a, qa[ks], ldfrag(rpc + (size_t)(16 * et + r) * 128 + 32 * ks + 8 * q));
            a = a * xi;
#pragma unroll
            for (int ks = 0; ks < 4; ++ks) a = mma16(a, sa[ks], *(const LAS bf16x8*)(Vt + (16 * et + r) * 136 + 32 * ks + 8 * q));
            acc[et] = a; }
        float s1 = 0.f;
#pragma unroll
        for (int et = 0; et < 16; ++et) s1 += acc[et][0] + acc[et][1] + acc[et][2] + acc[et][3];
        s1 += __shfl_xor(s1, 16); s1 += __shfl_xor(s1, 32); const float mean = s1 * (1.f / 256.f); float s2 = 0.f;
#pragma unroll
        for (int et = 0; et < 16; ++et) { acc[et] = acc[et] - mean; s2 += acc[et][0] * acc[et][0] + acc[et][1] * acc[et][1] + acc[et][2] * acc[et][2] + acc[et][3] * acc[et][3]; }
        s2 += __shfl_xor(s2, 16); s2 += __shfl_xor(s2, 32); const float rstd = rsqrtf(s2 * (1.f / 256.f) + 1e-5f);
#pragma unroll
        for (int et = 0; et < 16; ++et) { const int e = 16 * et + 4 * q; const u32x2 gw = *(const u32x2*)(z + mrow * NZ + ZC_RET_G + hh * 256 + e);
            const float g0 = __uint_as_float(gw.x << 16), g1 = __uint_as_float(gw.x & 0xffff0000u), g2 = __uint_as_float(gw.y << 16), g3 = __uint_as_float(gw.y & 0xffff0000u);
            u32x2 w; w.x = cvt_pk_bf16(acc[et][0] * rstd * g0 * sigmoidf_(g0), acc[et][1] * rstd * g1 * sigmoidf_(g1)); w.y = cvt_pk_bf16(acc[et][2] * rstd * g2 * sigmoidf_(g2), acc[et][3] * rstd * g3 * sigmoidf_(g3));
            *(u32x2*)(oall + mrow * NBR + 1024 + hh * 256 + e) = w; }
    }
}
__device__ __forceinline__ void ph_ret_out(const Params& p, LAS unsigned char* lds, int bi, int nb) { for (int task = bi; task < 256; task += nb) ret_out_task(p, lds, task); }

__device__ __forceinline__ void ph_cmp2(const Params& p, int l, LAS unsigned char* lds, int bi, int nb) {
    PROLOG;
    const bf16_t* hid = WSP(bf16_t, WS_HID); bf16_t* kc = WSP(bf16_t, WS_KCMP); bf16_t* vt = WSP(bf16_t, WS_VCMPT); const int* posi = (const int*)inp(p, 2);
    const float* w2 = INL(25, 2 * 256 * 64);
    const int tid = otid(), wave = tid >> 6, lane = tid & 63, r = lane & 15, q = lane >> 4;
    LAS bf16_t* W2T = (LAS bf16_t*)lds;
    if (bi * 8 < 128) {
        for (int i = tid; i < 2 * 256 * 64; i += 512) { const int ii = i >> 14, k = (i >> 6) & 255, d = i & 63; W2T[(ii * 64 + d) * 264 + k] = f2bf(w2[i]); }
        __syncthreads();
        for (int task = bi * 8 + wave; task < 128; task += nb * 8) {
            const int ii = task >> 6, R0 = (task & 63) * 16, row = R0 + r, bg = row >> 8, c = row & 255;
            const bf16_t* hr = hid + ((size_t)ii * 1024 + row) * 256 + 8 * q;
            f32x4 acc[4];
#pragma unroll
            for (int dt = 0; dt < 4; ++dt) acc[dt] = (f32x4){0.f, 0.f, 0.f, 0.f};
#pragma unroll
            for (int ks = 0; ks < 8; ++ks) { const bf16x8 a = ldfrag(hr + 32 * ks);
#pragma unroll
                for (int dt = 0; dt < 4; ++dt) acc[dt] = mma16(acc[dt], a, *(const LAS bf16x8*)(W2T + (ii * 64 + 16 * dt + r) * 264 + 32 * ks + 8 * q)); }
            if (ii == 0) {
                const float pos = (float)posi[(bg >> 1) * SEQ + 16 * (c < 255 ? c : 254) + 31];
#pragma unroll
                for (int dt = 0; dt < 2; ++dt) { float o1[4], o2[4];
#pragma unroll
                    for (int jj = 0; jj < 4; ++jj) { const int d = 16 * dt + 4 * q + jj; const float inv = __expf(-(float)d * (9.210340371976184f / 32.f)); float sn, cs; sincosf(pos * inv, &sn, &cs);
                        const float x1 = acc[dt][jj], x2 = acc[dt + 2][jj]; o1[jj] = (c < 255) ? x1 * cs - x2 * sn : 0.f; o2[jj] = (c < 255) ? x2 * cs + x1 * sn : 0.f; }
                    u32x2 w; w.x = cvt_pk_bf16(o1[0], o1[1]); w.y = cvt_pk_bf16(o1[2], o1[3]); *(u32x2*)(kc + (size_t)row * 64 + 16 * dt + 4 * q) = w;
                    w.x = cvt_pk_bf16(o2[0], o2[1]); w.y = cvt_pk_bf16(o2[2], o2[3]); *(u32x2*)(kc + (size_t)row * 64 + 32 + 16 * dt + 4 * q) = w; }
            } else {
#pragma unroll
                for (int dt = 0; dt < 4; ++dt)
#pragma unroll
                    for (int jj = 0; jj < 4; ++jj) vt[((size_t)bg * 64 + 16 * dt + 4 * q + jj) * 256 + c] = f2bf(c < 255 ? acc[dt][jj] : 0.f);
            }
        }
    }
}
__device__ __forceinline__ void ph_nsa_cmp(const Params& p, int l, LAS unsigned char* lds, int bi, int nb) {
    PROLOG;
    unsigned* qhead2 = WSP(unsigned, 1536 + 256 * l); LAS unsigned* qw2 = (LAS unsigned*)(lds + 120000);
    const bf16_t* qn = WSP(bf16_t, WS_QN); const bf16_t* kc = WSP(bf16_t, WS_KCMP); const bf16_t* vt = WSP(bf16_t, WS_VCMPT); bf16_t* ocmp = WSP(bf16_t, WS_OCMP); u64* selm = WSP(u64, WS_SELM);
    const int tid = otid(), wave = tid >> 6, lane = tid & 63, r = lane & 15, q = lane >> 4, grp = wave >> 2, hh = wave & 3;
    LAS bf16_t* Pl = (LAS bf16_t*)(lds + wave * 8448);
    LAS float* Ip = (LAS float*)(lds + 8 * 8448 + wave * 4096);
    for (;;) {
        __syncthreads();
        if (tid == 0) qw2[0] = __hip_atomic_fetch_add(qhead2, 1u, __ATOMIC_RELAXED, __HIP_MEMORY_SCOPE_AGENT);
        __syncthreads();
        const int bt = (int)qw2[0]; if (bt >= 768) break;
        if (bt >= 512) { ret_out_task(p, lds, bt - 512); continue; }
        const int task = bt * 2 + grp, bg = task >> 8, b = bg >> 1, g = bg & 1, tt = task & 255, t0 = 16 * tt, t = t0 + r; const size_t mrow = (size_t)b * SEQ + t;
        const int cmax = t >= 31 ? (t - 31) >> 4 : -1;
        __syncthreads();
        {
            const int hd = (g * 4 + hh) * 64;
            bf16x8 qa[2]; qa[0] = ldfrag(qn + mrow * 512 + hd + 8 * q); qa[1] = ldfrag(qn + mrow * 512 + hd + 32 + 8 * q);
            f32x4 s[16]; float mx = -1e30f;
#pragma unroll
            for (int ct = 0; ct < 16; ++ct) { f32x4 a = {0.f, 0.f, 0.f, 0.f}; const bf16_t* kp = kc + ((size_t)bg * 256 + 16 * ct + r) * 64 + 8 * q;
                a = mma16(a, qa[0], ldfrag(kp)); a = mma16(a, qa[1], ldfrag(kp + 32));
#pragma unroll
                for (int j = 0; j < 4; ++j) { const int c = 16 * ct + 4 * q + j; a[j] = (c <= cmax) ? a[j] * 0.125f : -1e30f; mx = fmaxf(mx, a[j]); }
                s[ct] = a; }
            { auto r16 = __builtin_amdgcn_permlane16_swap(__float_as_uint(mx), __float_as_uint(mx), false, false); mx = fmaxf(__uint_as_float(r16[0]), __uint_as_float(r16[1]));
              auto r32 = __builtin_amdgcn_permlane32_swap(__float_as_uint(mx), __float_as_uint(mx), false, false); mx = fmaxf(__uint_as_float(r32[0]), __uint_as_float(r32[1])); }
            float sum = 0.f;
#pragma unroll
            for (int ct = 0; ct < 16; ++ct)
#pragma unroll
                for (int j = 0; j < 4; ++j) { const int c = 16 * ct + 4 * q + j; const float e = (c <= cmax) ? __expf(s[ct][j] - mx) : 0.f; s[ct][j] = e; sum += e; }
            { auto r16 = __builtin_amdgcn_permlane16_swap(__float_as_uint(sum), __float_as_uint(sum), false, false); sum = __uint_as_float(r16[0]) + __uint_as_float(r16[1]);
              auto r32 = __builtin_amdgcn_permlane32_swap(__float_as_uint(sum), __float_as_uint(sum), false, false); sum = __uint_as_float(r32[0]) + __uint_as_float(r32[1]); }
            const float rinv = 1.f / fmaxf(sum, 1e-30f);
            float yprev = 0.f;
#pragma unroll
            for (int ct = 0; ct < 16; ++ct) { s[ct] = s[ct] * rinv;
                const float y = __shfl(s[ct][3], (lane + 48) & 63);
                const float prev = q > 0 ? y : yprev; yprev = y;
                Ip[r * 64 + 4 * ct + q] = (s[ct][0] + s[ct][1]) + (s[ct][2] + s[ct][3]) + prev;
                u32x2 w; w.x = cvt_pk_bf16(s[ct][0], s[ct][1]); w.y = cvt_pk_bf16(s[ct][2], s[ct][3]); *(LAS u32x2*)(Pl + r * 264 + 16 * ct + 4 * q) = w; }
            asm volatile("s_waitcnt lgkmcnt(0)" ::: "memory");
            f32x4 o[4];
#pragma unroll
            for (int dt = 0; dt < 4; ++dt) o[dt] = (f32x4){0.f, 0.f, 0.f, 0.f};
#pragma unroll
            for (int ks = 0; ks < 8; ++ks) { const bf16x8 pa = *(const LAS bf16x8*)(Pl + r * 264 + 32 * ks + 8 * q);
#pragma unroll
                for (int dt = 0; dt < 4; ++dt) o[dt] = mma16(o[dt], pa, ldfrag(vt + ((size_t)bg * 64 + 16 * dt + r) * 256 + 32 * ks + 8 * q)); }
#pragma unroll
            for (int dt = 0; dt < 4; ++dt) { u32x2 w; w.x = cvt_pk_bf16(o[dt][0], o[dt][1]); w.y = cvt_pk_bf16(o[dt][2], o[dt][3]); *(u32x2*)(ocmp + mrow * 512 + hd + 16 * dt + 4 * q) = w; }
        }
        __syncthreads();
        { LAS float* Ig = (LAS float*)(lds + 8 * 8448 + grp * 4 * 4096);
          for (int rr = 4 * hh; rr < 4 * hh + 4; ++rr) {
            const int tq = t0 + rr, cur = tq >> 6; const float v = (Ig[rr * 64 + lane] + Ig[1024 + rr * 64 + lane]) + (Ig[2048 + rr * 64 + lane] + Ig[3072 + rr * 64 + lane]);
            const bool valid = lane <= cur; const bool forced = (lane == 0) || (lane == cur) || (lane == cur - 1);
            const float key = forced ? __builtin_inff() : v; int rank = 0;
            for (int i = 0; i <= cur; ++i) { const float ki = __int_as_float(__builtin_amdgcn_readlane(__float_as_int(key), i)); rank += (ki > key || (ki == key && i < lane)) ? 1 : 0; }
            const u64 msk = __ballot(valid && rank < 16);
            if (lane == 0) selm[(size_t)bg * SEQ + tq] = msk; } }
    }
}
__device__ __forceinline__ void ph_nsa_attn(const Params& p, int l, LAS unsigned char* lds, int bi, int nb) {
    PROLOG;
    const bf16_t* z = WSP(bf16_t, WS_Z); const bf16_t* qn = WSP(bf16_t, WS_QN); const bf16_t* kvg = WSP(bf16_t, WS_KVG); const bf16_t* ocmp = WSP(bf16_t, WS_OCMP); const u64* selm = WSP(u64, WS_SELM); bf16_t* oall = WSP(bf16_t, WS_OALL);
    const int tid = otid(), wave = tid >> 6, lane = tid & 63, r = lane & 15, q = lane >> 4;
    LAS bf16_t* Pl = (LAS bf16_t*)(lds + wave * 4096);
    unsigned* qhead = WSP(unsigned, 1024 + 256 * l);
    for (;;) {
        unsigned tk = 0u; if (lane == 0) tk = __hip_atomic_fetch_add(qhead, 1u, __ATOMIC_RELAXED, __HIP_MEMORY_SCOPE_AGENT);
        const int task = __builtin_amdgcn_readfirstlane((int)tk); if (task >= 4096) break;
        const int tt = 255 - (task >> 4), sub = task & 15;
        const int bg = sub >> 2, hh = sub & 3, b = bg >> 1, g = bg & 1, t0 = 16 * tt, t = t0 + r, cur = t0 >> 6; const size_t mrow = (size_t)b * SEQ + t;
        const int hd = (g * 4 + hh) * 64;
        bf16x8 qa[2]; qa[0] = ldfrag(qn + mrow * 512 + hd + 8 * q); qa[1] = ldfrag(qn + mrow * 512 + hd + 32 + 8 * q);
        const u64 mymask = selm[(size_t)bg * SEQ + t];
        unsigned mlo = (unsigned)mymask, mhi = (unsigned)(mymask >> 32);
#pragma unroll
        for (int o = 1; o < 16; o <<= 1) { mlo |= __shfl_xor(mlo, o); mhi |= __shfl_xor(mhi, o); }
        const u64 umask = ((u64)(unsigned)__builtin_amdgcn_readfirstlane((int)mhi) << 32) | (u64)(unsigned)__builtin_amdgcn_readfirstlane((int)mlo);
        const u64 upto = (cur >= 63) ? ~0ull : ((2ull << cur) - 1ull);
        f32x4 res[4];
#pragma unroll
        for (int br = 0; br < 2; ++br) {
            const bf16_t* Kb = kvg + (br == 0 ? 2 : 4) * KVG_SLAB + (size_t)bg * SEQ * 64 + (size_t)r * 64 + 8 * q;
            const bf16_t* Vtb = kvg + (br == 0 ? 3 : 5) * KVG_SLAB + (size_t)bg * 64 * SEQ + (size_t)r * SEQ + 8 * q;
            const int j0 = (t0 >= 511) ? ((t0 - 511) >> 6) : 0;
            u64 rem = (br == 0) ? (umask & upto) : (upto & ~((1ull << j0) - 1ull));
            float mrun = -1e30f, lrun = 0.f; f32x4 o[4];
#pragma unroll
            for (int dt = 0; dt < 4; ++dt) o[dt] = (f32x4){0.f, 0.f, 0.f, 0.f};
            bf16x8 kA[8], vA[8], kB[8], vB[8];
#define NSA_LOAD(KF, VF, jt) do { _Pragma("unroll") for (int ct = 0; ct < 4; ++ct) { KF[2 * ct] = ldfrag(Kb + (size_t)(64 * (jt) + 16 * ct) * 64); KF[2 * ct + 1] = ldfrag(Kb + (size_t)(64 * (jt) + 16 * ct) * 64 + 32); \
                VF[2 * ct] = ldfrag(Vtb + (size_t)(16 * ct) * SEQ + 64 * (jt)); VF[2 * ct + 1] = ldfrag(Vtb + (size_t)(16 * ct) * SEQ + 64 * (jt) + 32); } } while (0)
            auto tile = [&](const bf16x8 (&kf)[8], const bf16x8 (&vf)[8], const int j) {
                const int k0 = 64 * j; const bool rowsel = br == 0 ? (((mymask >> j) & 1ull) != 0) : true;
                const bool edge = (k0 + 63 > t0) || (br == 1 && t0 + 15 - k0 >= 512);
                f32x4 s[4]; float mx = -1e30f;
#pragma unroll
                for (int ct = 0; ct < 4; ++ct) { f32x4 a = {0.f, 0.f, 0.f, 0.f}; a = mma16(a, qa[0], kf[2 * ct]); a = mma16(a, qa[1], kf[2 * ct + 1]); s[ct] = a; }
                if (edge) {
#pragma unroll
                    for (int ct = 0; ct < 4; ++ct)
#pragma unroll
                        for (int jj = 0; jj < 4; ++jj) { const int key = k0 + 16 * ct + 4 * q + jj; const bool ok = rowsel && key <= t && (br == 0 || t - key < 512); s[ct][jj] = ok ? s[ct][jj] * 0.125f : -1e30f; mx = fmaxf(mx, s[ct][jj]); }
                } else {
#pragma unroll
                    for (int ct = 0; ct < 4; ++ct)
#pragma unroll
                        for (int jj = 0; jj < 4; ++jj) { s[ct][jj] = rowsel ? s[ct][jj] * 0.125f : -1e30f; mx = fmaxf(mx, s[ct][jj]); }
                }
                { auto r16 = __builtin_amdgcn_permlane16_swap(__float_as_uint(mx), __float_as_uint(mx), false, false); mx = fmaxf(__uint_as_float(r16[0]), __uint_as_float(r16[1]));
                  auto r32 = __builtin_amdgcn_permlane32_swap(__float_as_uint(mx), __float_as_uint(mx), false, false); mx = fmaxf(__uint_as_float(r32[0]), __uint_as_float(r32[1])); }
                const float mnew = fmaxf(mrun, mx), alpha = __expf(mrun - mnew); float sum = 0.f;
#pragma unroll
                for (int ct = 0; ct < 4; ++ct) {
#pragma unroll
                    for (int jj = 0; jj < 4; ++jj) { const float e = (s[ct][jj] > -1e29f) ? __expf(s[ct][jj] - mnew) : 0.f; s[ct][jj] = e; sum += e; }
                    u32x2 w; w.x = cvt_pk_bf16(s[ct][0], s[ct][1]); w.y = cvt_pk_bf16(s[ct][2], s[ct][3]); *(LAS u32x2*)(Pl + r * 72 + 16 * ct + 4 * q) = w; }
                { auto r16 = __builtin_amdgcn_permlane16_swap(__float_as_uint(sum), __float_as_uint(sum), false, false); sum = __uint_as_float(r16[0]) + __uint_as_float(r16[1]);
                  auto r32 = __builtin_amdgcn_permlane32_swap(__float_as_uint(sum), __float_as_uint(sum), false, false); sum = __uint_as_float(r32[0]) + __uint_as_float(r32[1]); }
                lrun = lrun * alpha + sum; mrun = mnew;
#pragma unroll
                for (int dt = 0; dt < 4; ++dt) o[dt] = o[dt] * alpha;
                asm volatile("s_waitcnt lgkmcnt(0)" ::: "memory");
                const bf16x8 pa0 = *(const LAS bf16x8*)(Pl + r * 72 + 8 * q), pa1 = *(const LAS bf16x8*)(Pl + r * 72 + 32 + 8 * q);
#pragma unroll
                for (int dt = 0; dt < 4; ++dt) { f32x4 a = o[dt]; a = mma16(a, pa0, vf[2 * dt]); a = mma16(a, pa1, vf[2 * dt + 1]); o[dt] = a; }
            };
            int j = rem ? __builtin_ctzll(rem) : -1; if (rem) rem &= rem - 1ull;
            if (j >= 0) NSA_LOAD(kA, vA, j);
            while (j >= 0) {
                const int j1 = rem ? __builtin_ctzll(rem) : -1; if (rem) rem &= rem - 1ull;
                if (j1 >= 0) NSA_LOAD(kB, vB, j1);
                tile(kA, vA, j);
                if (j1 < 0) break;
                const int j2 = rem ? __builtin_ctzll(rem) : -1; if (rem) rem &= rem - 1ull;
                if (j2 >= 0) NSA_LOAD(kA, vA, j2);
                tile(kB, vB, j1);
                j = j2;
            }
#undef NSA_LOAD
            const float rinv = 1.f / fmaxf(lrun, 1e-30f);
            const float gt = sigmoidf_(zf(z + mrow * NZ, ZC_NSA_GT + (g * 4 + hh) * 3 + 1 + br));
#pragma unroll
            for (int dt = 0; dt < 4; ++dt) { if (br == 0) res[dt] = o[dt] * (rinv * gt); else res[dt] += o[dt] * (rinv * gt); }
        }
        const float g0 = sigmoidf_(zf(z + mrow * NZ, ZC_NSA_GT + (g * 4 + hh) * 3));
#pragma unroll
        for (int dt = 0; dt < 4; ++dt) { const u32x2 cw = *(const u32x2*)(ocmp + mrow * 512 + hd + 16 * dt + 4 * q);
            const float c0 = __uint_as_float(cw.x << 16), c1 = __uint_as_float(cw.x & 0xffff0000u), c2 = __uint_as_float(cw.y << 16), c3 = __uint_as_float(cw.y & 0xffff0000u);
            u32x2 w; w.x = cvt_pk_bf16(res[dt][0] + g0 * c0, res[dt][1] + g0 * c1); w.y = cvt_pk_bf16(res[dt][2] + g0 * c2, res[dt][3] + g0 * c3);
            *(u32x2*)(oall + mrow * NBR + 2048 + hd + 16 * dt + 4 * q) = w; }
    }
}

__device__ __forceinline__ void nsa_attn2_task(const Params& p, LAS unsigned char* lds, const int task) {
    PROLOG;
    const bf16_t* z = WSP(bf16_t, WS_Z); const bf16_t* qn = WSP(bf16_t, WS_QN); const bf16_t* kvg = WSP(bf16_t, WS_KVG); const bf16_t* ocmp = WSP(bf16_t, WS_OCMP); const u64* selm = WSP(u64, WS_SELM); bf16_t* oall = WSP(bf16_t, WS_OALL);
    const int tid = otid(), wave = tid >> 6, lane = tid & 63, r = lane & 15, q = lane >> 4, hh = wave & 3, tsel = wave >> 2;
    constexpr int TP = 72;
    LAS bf16_t* Kt[2] = {(LAS bf16_t*)lds, (LAS bf16_t*)(lds + 2 * 64 * TP * 2)};
    LAS bf16_t* Vt[2] = {(LAS bf16_t*)(lds + 64 * TP * 2), (LAS bf16_t*)(lds + 3 * 64 * TP * 2)};
    LAS bf16_t* Pl = (LAS bf16_t*)(lds + 4 * 64 * TP * 2) + wave * 16 * TP;
    LAS unsigned* ctl = (LAS unsigned*)(lds + 4 * 64 * TP * 2 + 8 * 16 * TP * 2);
    const int srow = tid >> 3, schk = tid & 7;
    {
        __syncthreads();
        const int tt = 127 - (task >> 2), bg = task & 3, b = bg >> 1, g = bg & 1, t0 = 32 * tt + 16 * tsel, t = t0 + r, cur = (32 * tt) >> 6; const size_t mrow = (size_t)b * SEQ + t;
        const int hd = (g * 4 + hh) * 64;
        bf16x8 qa[2]; qa[0] = ldfrag(qn + mrow * 512 + hd + 8 * q); qa[1] = ldfrag(qn + mrow * 512 + hd + 32 + 8 * q);
        const u64 mymask = selm[(size_t)bg * SEQ + t];
        { unsigned mlo = (unsigned)mymask, mhi = (unsigned)(mymask >> 32);
#pragma unroll
          for (int o = 1; o < 16; o <<= 1) { mlo |= __shfl_xor(mlo, o); mhi |= __shfl_xor(mhi, o); }
          if (lane == 0 && hh == 0) { ctl[2 + 2 * tsel] = mlo; ctl[3 + 2 * tsel] = mhi; } }
        __syncthreads();
        const u64 umask = ((u64)(ctl[3] | ctl[5]) << 32) | (u64)(ctl[2] | ctl[4]);
        const u64 upto = (cur >= 63) ? ~0ull : ((2ull << cur) - 1ull);
        f32x4 res[4];
#pragma unroll
        for (int br = 0; br < 2; ++br) {
            const bf16_t* Kg = kvg + (br == 0 ? 2 : 4) * KVG_SLAB + (size_t)bg * SEQ * 64 + (size_t)srow * 64 + schk * 8;
            const bf16_t* Vg = kvg + (br == 0 ? 3 : 5) * KVG_SLAB + (size_t)bg * 64 * SEQ + (size_t)srow * SEQ + schk * 8;
            const int tmin = 32 * tt, j0 = (tmin >= 511) ? ((tmin - 511) >> 6) : 0;
            u64 rem = (br == 0) ? (umask & upto) : (upto & ~((1ull << j0) - 1ull));
            float mrun = -1e30f, lrun = 0.f; f32x4 o[4];
#pragma unroll
            for (int dt = 0; dt < 4; ++dt) o[dt] = (f32x4){0.f, 0.f, 0.f, 0.f};
            int j = __builtin_ctzll(rem); rem &= rem - 1ull;
            { const u32x4 kx = *(const u32x4*)(Kg + (size_t)(64 * j) * 64), vx = *(const u32x4*)(Vg + 64 * j);
              __syncthreads();
              *(LAS u32x4*)(Kt[0] + srow * TP + schk * 8) = kx; *(LAS u32x4*)(Vt[0] + srow * TP + schk * 8) = vx; }
            __syncthreads();
            int pb = 0;
            for (;;) {
                const int jn = rem ? __builtin_ctzll(rem) : -1; if (rem) rem &= rem - 1ull;
                u32x4 kx, vx; if (jn >= 0) { kx = *(const u32x4*)(Kg + (size_t)(64 * jn) * 64); vx = *(const u32x4*)(Vg + 64 * jn); }
                { const int k0 = 64 * j; const bool rowsel = br == 0 ? (((mymask >> j) & 1ull) != 0) : true;
                  const bool edge = (k0 + 63 > tmin) || (br == 1 && tmin + 31 - k0 >= 512);
                  const LAS bf16_t* Kb = Kt[pb]; const LAS bf16_t* Vb = Vt[pb];
                  f32x4 sc[4]; float mx = -1e30f;
#pragma unroll
                  for (int ct = 0; ct < 4; ++ct) { f32x4 a = {0.f, 0.f, 0.f, 0.f}; a = mma16(a, qa[0], *(const LAS bf16x8*)(Kb + (16 * ct + r) * TP + 8 * q)); a = mma16(a, qa[1], *(const LAS bf16x8*)(Kb + (16 * ct + r) * TP + 32 + 8 * q)); sc[ct] = a; }
                  if (edge) {
#pragma unroll
                      for (int ct = 0; ct < 4; ++ct)
#pragma unroll
                          for (int jj = 0; jj < 4; ++jj) { const int key = k0 + 16 * ct + 4 * q + jj; const bool ok = rowsel && key <= t && (br == 0 || t - key < 512); sc[ct][jj] = ok ? sc[ct][jj] * 0.125f : -1e30f; mx = fmaxf(mx, sc[ct][jj]); }
                  } else {
#pragma unroll
                      for (int ct = 0; ct < 4; ++ct)
#pragma unroll
                          for (int jj = 0; jj < 4; ++jj) { sc[ct][jj] = rowsel ? sc[ct][jj] * 0.125f : -1e30f; mx = fmaxf(mx, sc[ct][jj]); }
                  }
                  { auto r16 = __builtin_amdgcn_permlane16_swap(__float_as_uint(mx), __float_as_uint(mx), false, false); mx = fmaxf(__uint_as_float(r16[0]), __uint_as_float(r16[1]));
                    auto r32 = __builtin_amdgcn_permlane32_swap(__float_as_uint(mx), __float_as_uint(mx), false, false); mx = fmaxf(__uint_as_float(r32[0]), __uint_as_float(r32[1])); }
                  const float mnew = fmaxf(mrun, mx), alpha = __expf(mrun - mnew); float sum = 0.f;
#pragma unroll
                  for (int ct = 0; ct < 4; ++ct) {
#pragma unroll
                      for (int jj = 0; jj < 4; ++jj) { const float e = (sc[ct][jj] > -1e29f) ? __expf(sc[ct][jj] - mnew) : 0.f; sc[ct][jj] = e; sum += e; }
                      u32x2 w; w.x = cvt_pk_bf16(sc[ct][0], sc[ct][1]); w.y = cvt_pk_bf16(sc[ct][2], sc[ct][3]); *(LAS u32x2*)(Pl + r * TP + 16 * ct + 4 * q) = w; }
                  { auto r16 = __builtin_amdgcn_permlane16_swap(__float_as_uint(sum), __float_as_uint(sum), false, false); sum = __uint_as_float(r16[0]) + __uint_as_float(r16[1]);
                    auto r32 = __builtin_amdgcn_permlane32_swap(__float_as_uint(sum), __float_as_uint(sum), false, false); sum = __uint_as_float(r32[0]) + __uint_as_float(r32[1]); }
                  lrun = lrun * alpha + sum; mrun = mnew;
#pragma unroll
                  for (int dt = 0; dt < 4; ++dt) o[dt] = o[dt] * alpha;
                  asm volatile("s_waitcnt lgkmcnt(0)" ::: "memory");
                  const bf16x8 pa0 = *(const LAS bf16x8*)(Pl + r * TP + 8 * q), pa1 = *(const LAS bf16x8*)(Pl + r * TP + 32 + 8 * q);
#pragma unroll
                  for (int dt = 0; dt < 4; ++dt) { f32x4 a = o[dt]; a = mma16(a, pa0, *(const LAS bf16x8*)(Vb + (16 * dt + r) * TP + 8 * q)); a = mma16(a, pa1, *(const LAS bf16x8*)(Vb + (16 * dt + r) * TP + 32 + 8 * q)); o[dt] = a; } }
                if (jn < 0) break;
                *(LAS u32x4*)(Kt[pb ^ 1] + srow * TP + schk * 8) = kx; *(LAS u32x4*)(Vt[pb ^ 1] + srow * TP + schk * 8) = vx;
                __syncthreads();
                pb ^= 1; j = jn;
            }
            const float rinv = 1.f / fmaxf(lrun, 1e-30f);
            const float gt = sigmoidf_(zf(z + mrow * NZ, ZC_NSA_GT + (g * 4 + hh) * 3 + 1 + br));
#pragma unroll
            for (int dt = 0; dt < 4; ++dt) { if (br == 0) res[dt] = o[dt] * (rinv * gt); else res[dt] += o[dt] * (rinv * gt); }
        }
        const float g0 = sigmoidf_(zf(z + mrow * NZ, ZC_NSA_GT + (g * 4 + hh) * 3));
#pragma unroll
        for (int dt = 0; dt < 4; ++dt) { const u32x2 cw = *(const u32x2*)(ocmp + mrow * 512 + hd + 16 * dt + 4 * q);
            const float c0 = __uint_as_float(cw.x << 16), c1 = __uint_as_float(cw.x & 0xffff0000u), c2 = __uint_as_float(cw.y << 16), c3 = __uint_as_float(cw.y & 0xffff0000u);
            u32x2 w; w.x = cvt_pk_bf16(res[dt][0] + g0 * c0, res[dt][1] + g0 * c1); w.y = cvt_pk_bf16(res[dt][2] + g0 * c2, res[dt][3] + g0 * c3);
            *(u32x2*)(oall + mrow * NBR + 2048 + hd + 16 * dt + 4 * q) = w; }
    }
}
__device__ __forceinline__ void ph_p7_queue(const Params& p, int l, LAS unsigned char* lds, int bi, int nb) {
    PROLOG;
    unsigned* qhead = WSP(unsigned, 1024 + 256 * l);
    LAS unsigned* qw = (LAS unsigned*)(lds + 120000);
    const int tid = otid();
    for (;;) {
        __syncthreads();
        if (tid == 0) qw[0] = __hip_atomic_fetch_add(qhead, 1u, __ATOMIC_RELAXED, __HIP_MEMORY_SCOPE_AGENT);
        __syncthreads();
        const int task = (int)qw[0]; if (task >= 512) break;
        nsa_attn2_task(p, lds, task);
    }
}

__device__ __forceinline__ void ph_xsoftmax(const Params& p, int bi, int nb) {
    PROLOG;
    const float* sc = WSP(float, WS_SC); bf16_t* pb = WSP(bf16_t, WS_PB);
    const int tid_ = otid(), lane = tid_ & 63, gw = bi * 8 + (tid_ >> 6), NGW = nb * 8;
    for (int it = gw; it < M * 4; it += NGW) { const f32x4 v = *(const f32x4*)(sc + (size_t)it * 256 + lane * 4);
        float mx = fmaxf(fmaxf(v[0], v[1]), fmaxf(v[2], v[3]));
#pragma unroll
        for (int o = 1; o < 64; o <<= 1) mx = fmaxf(mx, __shfl_xor(mx, o));
        const float e0 = __expf(v[0] - mx), e1 = __expf(v[1] - mx), e2 = __expf(v[2] - mx), e3 = __expf(v[3] - mx);
        const float rinv = 1.f / wave_sum((e0 + e1) + (e2 + e3));
        u32x2 w; w.x = cvt_pk_bf16(e0 * rinv, e1 * rinv); w.y = cvt_pk_bf16(e2 * rinv, e3 * rinv); *(u32x2*)(pb + (size_t)it * 256 + lane * 4) = w; }
}
__device__ __forceinline__ void ph_convact(const Params& p, int l, int bi, int nb) {
    PROLOG;
    const bf16_t* u = WSP(bf16_t, WS_U); bf16_t* ga = WSP(bf16_t, WS_GACT); const float* cw = INL(32, 3 * FFN2); const float* cb = INL(33, FFN2);
    const int gt = bi * 512 + otid(), NT = nb * 512;
    for (int i = gt; i < (M / 16) * (FFN / 8); i += NT) { const int rb = i / (FFN / 8), c8 = (i % (FFN / 8)) * 8, m0 = rb * 16, t0 = m0 & 4095; const int ua = 256 * (c8 >> 7) + (c8 & 127);
        float wa[3][8], wb[3][8], ba[8], bb[8];
#pragma unroll
        for (int k = 0; k < 3; ++k) { ld8(cw + k * FFN2 + c8, wa[k]); ld8(cw + k * FFN2 + FFN + c8, wb[k]); }
        ld8(cb + c8, ba); ld8(cb + FFN + c8, bb);
        float a1[8], a2[8], b1[8], b2[8];
        if (t0 >= 2) { bf8_to_f(*(const u32x4*)(u + (size_t)(m0 - 1) * FFN2 + ua), a1); bf8_to_f(*(const u32x4*)(u + (size_t)(m0 - 2) * FFN2 + ua), a2);
            bf8_to_f(*(const u32x4*)(u + (size_t)(m0 - 1) * FFN2 + ua + 128), b1); bf8_to_f(*(const u32x4*)(u + (size_t)(m0 - 2) * FFN2 + ua + 128), b2); }
        else {
#pragma unroll
            for (int j = 0; j < 8; ++j) { a1[j] = 0.f; a2[j] = 0.f; b1[j] = 0.f; b2[j] = 0.f; } }
#pragma unroll 4
        for (int rr = 0; rr < 16; ++rr) { float a0[8], b0[8]; const bf16_t* ur = u + (size_t)(m0 + rr) * FFN2 + ua; bf8_to_f(*(const u32x4*)ur, a0); bf8_to_f(*(const u32x4*)(ur + 128), b0);
            float o8[8];
#pragma unroll
            for (int j = 0; j < 8; ++j) { const float va = ba[j] + wa[0][j] * a2[j] + wa[1][j] * a1[j] + wa[2][j] * a0[j], vb = bb[j] + wb[0][j] * b2[j] + wb[1][j] * b1[j] + wb[2][j] * b0[j];
                o8[j] = gelu_tanh(va) * vb; a2[j] = a1[j]; a1[j] = a0[j]; b2[j] = b1[j]; b1[j] = b0[j]; }
            u32x4 w; w.x = cvt_pk_bf16(o8[0], o8[1]); w.y = cvt_pk_bf16(o8[2], o8[3]); w.z = cvt_pk_bf16(o8[4], o8[5]); w.w = cvt_pk_bf16(o8[6], o8[7]);
            *(u32x4*)(ga + (size_t)(m0 + rr) * FFN + c8) = w; }
    }
}


#define XB_TMO      128
#define XB_XCNT(j)  (256  + 64 * (j))
#define XB_XSUB(j)  (1280 + 64 * (j))
#define XB_XGEN(j)  (2304 + 64 * (j))
#define XB_TOP      3328
#define XB_TOPGEN   3392
#define XCD_BAR_WORDS 3456
#define XB_SPIN_CAP (1u << 18)
__device__ __forceinline__ unsigned xb_ld(unsigned* p)              { return __hip_atomic_load(p, __ATOMIC_RELAXED, __HIP_MEMORY_SCOPE_AGENT); }
__device__ __forceinline__ unsigned xb_add(unsigned* p, unsigned v) { return __hip_atomic_fetch_add(p, v, __ATOMIC_RELAXED, __HIP_MEMORY_SCOPE_AGENT); }
__device__ __forceinline__ unsigned xb_xcc_id() { return (unsigned)__builtin_amdgcn_s_getreg((3 << 11) | 20) & 0xFu; }
#define XB_SPIN(cond, bar) do { unsigned _sp = 0; while (cond) { __builtin_amdgcn_s_sleep(1); \
    if ((++_sp & 255u) == 0u) { if (xb_ld(&(bar)[XB_TMO])) break; if (_sp > XB_SPIN_CAP) { atomicAdd(&(bar)[XB_TMO], 1u); break; } } } } while (0)
struct XcdBarrier { unsigned* bar; unsigned x; volatile LAS unsigned* st; };
__device__ __forceinline__ XcdBarrier xcd_barrier_post(unsigned* bar, volatile LAS unsigned* st) {
    XcdBarrier b; b.bar = bar; b.x = xb_xcc_id(); b.st = st;
    if (threadIdx.x == 0) (void)xb_add(&bar[XB_XCNT(b.x)], 1u);
    return b;
}
__device__ __forceinline__ void xcd_barrier_complete(unsigned* bar, unsigned x, unsigned& nloc, unsigned& nx) {
    const unsigned G = gridDim.x * gridDim.y * gridDim.z;
    unsigned sum, cnt, mine, sp = 0u;
    for (;;) {
        sum = 0u; cnt = 0u; mine = 0u;
#pragma unroll
        for (unsigned j = 0; j < 16; ++j) { const unsigned c = xb_ld(&bar[XB_XCNT(j)]); sum += c; cnt += (c > 0u) ? 1u : 0u; mine = (j == x) ? c : mine; }
        if (sum == G) break;
        __builtin_amdgcn_s_sleep(1);
        if ((++sp & 255u) == 0u) { if (xb_ld(&bar[XB_TMO])) break; if (sp > XB_SPIN_CAP) { atomicAdd(&bar[XB_TMO], 1u); break; } }
    }
    nloc = mine > 0u ? mine : 1u; nx = cnt > 0u ? cnt : 1u;
}
__device__ __forceinline__ void xcd_barrier(const XcdBarrier& b) {
    asm volatile("s_waitcnt vmcnt(0)" ::: "memory");
    __syncthreads();
    if (threadIdx.x == 0) {
        unsigned* bar = (unsigned*)(ws_lds() + WS_CTL) + 1024;
        __builtin_amdgcn_s_waitcnt(0);
        unsigned nloc = b.st[0], nx = b.st[1];
        if (nloc == 0u) { xcd_barrier_complete(bar, b.x, nloc, nx); b.st[0] = nloc; b.st[1] = nx; }
        const unsigned old = xb_add(&bar[XB_XSUB(b.x)], 1u);
        const unsigned gen = old / nloc;
        if (old + 1u == (gen + 1u) * nloc) {
            __builtin_amdgcn_fence(__ATOMIC_RELEASE, "agent");
            asm volatile("s_waitcnt vmcnt(0)" ::: "memory");
            const unsigned og = xb_add(&bar[XB_TOP], 1u);
            const unsigned tg = og / nx;
            if (og + 1u == (tg + 1u) * nx) xb_add(&bar[XB_TOPGEN], 1u);
            else XB_SPIN(xb_ld(&bar[XB_TOPGEN]) == tg, bar);
            __builtin_amdgcn_fence(__ATOMIC_ACQUIRE, "agent");
            xb_add(&bar[XB_XGEN(b.x)], 1u);
            asm volatile("s_waitcnt vmcnt(0)" ::: "memory");
        } else {
            XB_SPIN(xb_ld(&bar[XB_XGEN(b.x)]) == gen, bar);
            __builtin_amdgcn_fence(__ATOMIC_ACQUIRE, "agent");
            asm volatile("s_waitcnt vmcnt(0)" ::: "memory");
        }
    }
    __syncthreads();
}

enum { PH_CONVERT = 0, PH_MEMKV, PH_NORM1, PH_INPROJ, PH_MIXPREP, PH_LORA_CMP1, PH_RWPREP2_CMP2_RETU, PH_RWCHUNK, PH_RWSERIAL, PH_RETSCAN, PH_NSACMP, PH_RWPOST_RETOUT, PH_NSAATTN,
       PH_P1, PH_P4, PH_P5, PH_P6, PH_P7, PH_P8,
       PH_BRANCH, PH_OUTPROJ, PH_FINISH1, PH_QPROJ, PH_XSCORE, PH_XSOFTMAX, PH_XPV, PH_XO, PH_FINISH2, PH_UP, PH_CONVACT, PH_DOWN, PH_FINISH3, PH_COUNT };

template <int PH> __device__ __forceinline__ void run_phase(const Params& p, int l, LAS unsigned char* lds, int bi, int nb) {
    using namespace pg8;
    PROLOG;
    if constexpr (PH == PH_CONVERT) ph_convert(p, l, lds, bi, nb);
    else if constexpr (PH == PH_MEMKV) {
        { GSched s = make_sched(WSP(bf16_t, WS_MEMN), D, WSP(bf16_t, WS_W_KV), D, 2, 8, D, bi, nb); EpiBf16<0> e{WSP(bf16_t, WS_KMEM), D, nullptr}; gemm_phase(lds, D, D, D, s, e); }
        { GSched s = make_sched(WSP(bf16_t, WS_W_KV) + (size_t)D * D, D, WSP(bf16_t, WS_MEMN), D, 8, 2, 512, bi, nb); EpiBf16<0> e{WSP(bf16_t, WS_VTM), 512, nullptr}; gemm_phase(lds, D, D, D, s, e); }
    }
    else if constexpr (PH == PH_NORM1) ph_norm_rows(l == 0 ? inp(p, 0) : (const float*)OUTP, INL(3, D), WSP(bf16_t, WS_H), M, bi, nb);
    else if constexpr (PH == PH_INPROJ) { GSched s = make_sched(WSP(bf16_t, WS_H), D, WSP(bf16_t, WS_W_IN), D, 32, 64, NZ, bi, nb); EpiZ e{WSP(bf16_t, WS_Z), NZ}; gemm_phase(lds, D, D, D, s, e); }
    else if constexpr (PH == PH_MIXPREP) ph_mix_prep(p, l, lds, bi, nb);
    else if constexpr (PH == PH_LORA_CMP1) {
        { GSched s = make_sched(WSP(bf16_t, WS_ALORA), 512, WSP(bf16_t, WS_W_LORA), 512, 32, 6, 1536, bi, nb); EpiF32 e{WSP(float, WS_LO), 1536, 1.f}; gemm_phase(lds, 512, 512, 512, s, e); }
        { GSched s = make_sched(WSP(bf16_t, WS_KVG), 1024, WSP(bf16_t, WS_W_C1), 2048, 1, 1, 256, bi, nb); s.nZ1 = 2; s.nZ2 = 4; s.a_z1 = (long)KVG_SLAB * 2; s.a_z2 = (long)SEQ * 64 * 2; s.b_z1 = (long)256 * 2048 * 2; s.b_z2 = 0;
          s.o_z1 = 4 * 256 * 256; s.o_z2 = 256 * 256;
          EpiC1 e{WSP(bf16_t, WS_HID), WSP(float, WS_CBIAS)}; gemm_phase(lds, 1024, 2048, 2048, s, e); }
    }
    else if constexpr (PH == PH_RWPREP2_CMP2_RETU) { ph_rw_prep2(p, l, bi, nb); ph_cmp2(p, l, lds, bi, nb); ph_ret_u(p, lds, bi, nb); }
    else if constexpr (PH == PH_RWCHUNK) ph_rw_chunk(p, l, lds, bi, nb);
    else if constexpr (PH == PH_RWSERIAL) ph_rw_serial(p, lds, bi, nb);
    else if constexpr (PH == PH_RETSCAN) ph_ret_scan(p, bi, nb);
    else if constexpr (PH == PH_NSACMP) ph_nsa_cmp(p, l, lds, bi, nb);
    else if constexpr (PH == PH_RWPOST_RETOUT) { ph_rw_post(p, l, bi, nb); ph_ret_out(p, lds, bi, nb); }
    else if constexpr (PH == PH_NSAATTN) ph_nsa_attn(p, l, lds, bi, nb);
    else if constexpr (PH == PH_P1) { ph_convert(p, l, lds, bi, nb); if (l == 0) ph_norm_rows(inp(p, 0), INL(3, D), WSP(bf16_t, WS_H), M, bi, nb); }
    else if constexpr (PH == PH_P4) {
        if (bi < 192) { GSched s = make_sched(WSP(bf16_t, WS_ALORA), 512, WSP(bf16_t, WS_W_LORA), 512, 32, 6, 1536, bi, 192); EpiF32 e{WSP(float, WS_LO), 1536, 1.f}; gemm_phase(lds, 512, 512, 512, s, e); }
        else if (bi < 200) { GSched s = make_sched(WSP(bf16_t, WS_KVG), 1024, WSP(bf16_t, WS_W_C1), 2048, 1, 1, 256, bi - 192, 8); s.nZ1 = 2; s.nZ2 = 4; s.a_z1 = (long)KVG_SLAB * 2; s.a_z2 = (long)SEQ * 64 * 2; s.b_z1 = (long)256 * 2048 * 2; s.b_z2 = 0;
            s.o_z1 = 4 * 256 * 256; s.o_z2 = 256 * 256; EpiC1 e{WSP(bf16_t, WS_HID), WSP(float, WS_CBIAS)}; gemm_phase(lds, 1024, 2048, 2048, s, e); }
        else if (bi < 216) { GSched s = make_sched(WSP(bf16_t, WS_MEMN), D, WSP(bf16_t, WS_W_KV), D, 2, 8, D, bi - 200, 16); EpiBf16<0> e{WSP(bf16_t, WS_KMEM), D, nullptr}; gemm_phase(lds, D, D, D, s, e); }
        else if (bi < 232) { GSched s = make_sched(WSP(bf16_t, WS_W_KV) + (size_t)D * D, D, WSP(bf16_t, WS_MEMN), D, 8, 2, 512, bi - 216, 16); EpiBf16<0> e{WSP(bf16_t, WS_VTM), 512, nullptr}; gemm_phase(lds, D, D, D, s, e); }
        if (bi < 192) ph_ret_u(p, lds, bi, 216); else if (bi >= 232) ph_ret_u(p, lds, 192 + (bi - 232), 216);
    }
    else if constexpr (PH == PH_P5) { ph_cmp2(p, l, lds, bi, nb); ph_ret_scan(p, bi, nb); __syncthreads(); ph_rw_chunk(p, l, lds, bi, nb); }
    else if constexpr (PH == PH_P6) { ph_rw_serial(p, lds, bi, nb); ph_nsa_cmp(p, l, lds, bi, nb); }
    else if constexpr (PH == PH_P7) ph_p7_queue(p, l, lds, bi, nb);
    else if constexpr (PH == PH_P8) ph_rw_post(p, l, bi, nb);
    else if constexpr (PH == PH_BRANCH) { BranchSched sc{(const char*)WSP(bf16_t, WS_OALL), (const char*)WSP(bf16_t, WS_W_BR), bi}; EpiBranch2 e{WSP(bf16_t, WS_MERGEDB), WSP(bf16_t, WS_Z) + ZC_GATE}; gemm_phase(lds, NBR, NBR, 512, sc, e); }
    else if constexpr (PH == PH_OUTPROJ) { GSched s = make_sched(WSP(bf16_t, WS_MERGEDB), D, WSP(bf16_t, WS_W_OUT), D, 32, 8, D, bi, nb); EpiF32 e{WSP(float, WS_Y), D, 1.f}; gemm_phase(lds, D, D, D, s, e); }
    else if constexpr (PH == PH_FINISH1) ph_finish(l == 0 ? inp(p, 0) : (const float*)OUTP, WSP(float, WS_Y), INL(4, D), INL(5, D), OUTP, WSP(bf16_t, WS_H), bi, nb);
    else if constexpr (PH == PH_QPROJ) { GSched s = make_sched(WSP(bf16_t, WS_H), D, WSP(bf16_t, WS_W_Q), D, 32, 8, D, bi, nb); EpiBf16<0> e{WSP(bf16_t, WS_QX), D, nullptr}; gemm_phase(lds, D, D, D, s, e); }
    else if constexpr (PH == PH_XSCORE) {
        GSched s = make_sched(WSP(bf16_t, WS_QX), D, WSP(bf16_t, WS_KMEM), D, 16, 1, 1024, bi, nb); s.nZ1 = 2; s.nZ2 = 4; s.a_z1 = (long)SEQ * D * 2; s.a_z2 = 512 * 2; s.b_z1 = (long)MEM * D * 2; s.b_z2 = 512 * 2; s.o_z1 = (long)SEQ * 1024; s.o_z2 = 256;
        EpiF32 e{WSP(float, WS_SC), 1024, 0.04419417382415922f}; gemm_phase(lds, D, D, 512, s, e); }
    else if constexpr (PH == PH_XSOFTMAX) ph_xsoftmax(p, bi, nb);
    else if constexpr (PH == PH_XPV) {
        GSched s = make_sched(WSP(bf16_t, WS_PB), 1024, WSP(bf16_t, WS_VTM), 512, 16, 2, D, bi, nb); s.nZ1 = 2; s.nZ2 = 4; s.a_z1 = (long)SEQ * 1024 * 2; s.a_z2 = 256 * 2; s.b_z1 = 256 * 2; s.b_z2 = (long)512 * 512 * 2; s.o_z1 = (long)SEQ * D; s.o_z2 = 512;
        EpiBf16<0> e{WSP(bf16_t, WS_OX), D, nullptr}; gemm_phase(lds, 1024, 512, 256, s, e); }
    else if constexpr (PH == PH_XO) { GSched s = make_sched(WSP(bf16_t, WS_OX), D, WSP(bf16_t, WS_W_O), D, 32, 8, D, bi, nb); EpiF32 e{WSP(float, WS_Y), D, 1.f}; gemm_phase(lds, D, D, D, s, e); }
    else if constexpr (PH == PH_FINISH2) ph_finish(OUTP, WSP(float, WS_Y), INL(7, D), INL(8, D), OUTP, WSP(bf16_t, WS_H), bi, nb);
    else if constexpr (PH == PH_UP) { GSched s = make_sched(WSP(bf16_t, WS_H), D, WSP(bf16_t, WS_W_UP), D, 32, 44, FFN2, bi, nb); EpiBf16<0> e{WSP(bf16_t, WS_U), FFN2, nullptr}; gemm_phase(lds, D, D, D, s, e); }
    else if constexpr (PH == PH_CONVACT) ph_convact(p, l, bi, nb);
    else if constexpr (PH == PH_DOWN) { GSched s = make_sched(WSP(bf16_t, WS_GACT), FFN, WSP(bf16_t, WS_W_DN), FFN, 32, 8, D, bi, nb); EpiF32 e{WSP(float, WS_Y), D, 1.f}; gemm_phase(lds, FFN, FFN, FFN, s, e); }
    else if constexpr (PH == PH_FINISH3) ph_finish(OUTP, WSP(float, WS_Y), INL(9, D), (l + 1 < DEPTH) ? (inp(p, 3) + (size_t)(l + 1) * D) : nullptr, OUTP, WSP(bf16_t, WS_H), bi, nb);
}

__global__ void __launch_bounds__(512, 2) mega_fwd(Params p) {
    extern __shared__ __attribute__((aligned(16))) unsigned char lds_raw[];
    LAS unsigned char* lds = (LAS unsigned char*)lds_raw;
    volatile LAS unsigned* st = (volatile LAS unsigned*)(lds + LDS_BYTES - 16);
    if (threadIdx.x == 0) { st[0] = 0u; st[1] = 0u; st[2] = (unsigned)(u64)p.ws; st[3] = (unsigned)((u64)p.ws >> 32); }
    __syncthreads();
    if (threadIdx.x == 0) { const float** tab = (const float**)(p.ws + WS_PTRTAB);
#pragma unroll
        for (int i = 0; i < 35; ++i) tab[i] = p.in[i];
        tab[35] = p.out; }
    __syncthreads();
    XcdBarrier bar = xcd_barrier_post((unsigned*)(p.ws + WS_CTL) + 1024, st);
    const int bi = (int)blockIdx.x, nb = (int)gridDim.x;
#define PHASE(PH) do { int l_ = l, bi_ = bi; asm volatile("" : "+s"(l_), "+s"(bi_)); run_phase<PH>(p, l_, lds, bi_, nb); xcd_barrier(bar); } while (0)
    for (int l = 0; l < DEPTH; ++l) {
        PHASE(PH_P1);
        PHASE(PH_INPROJ);
        PHASE(PH_MIXPREP);
        PHASE(PH_P4);
        PHASE(PH_P5);
        PHASE(PH_P6);
        PHASE(PH_P7);
        PHASE(PH_P8);
        PHASE(PH_BRANCH);
        PHASE(PH_OUTPROJ);
        PHASE(PH_FINISH1);
        PHASE(PH_QPROJ);
        PHASE(PH_XSCORE);
        PHASE(PH_XSOFTMAX);
        PHASE(PH_XPV);
        PHASE(PH_XO);
        PHASE(PH_FINISH2);
        PHASE(PH_UP);
        PHASE(PH_CONVACT);
#if DUP == 4
        PHASE(PH_CONVACT);
#endif
        PHASE(PH_DOWN);
        PHASE(PH_FINISH3);
    }
#undef PHASE
}

extern "C" void kernel_launch(void* const* d_in, const int* in_sizes, int n_in, void* d_out, int out_size, void* d_ws, size_t ws_size, hipStream_t stream) {
    if (n_in != 35 || ws_size < WS_END) { fprintf(stderr, "kernel_launch: unexpected n_in %d / ws_size %zu (need %zu)\n", n_in, ws_size, (size_t)WS_END); return; }
    static int grid = 0;
    if (grid == 0) {
        int dev = 0, cus = 0, per_cu = 0;
        (void)hipGetDevice(&dev); (void)hipDeviceGetAttribute(&cus, hipDeviceAttributeMultiprocessorCount, dev);
        (void)hipFuncSetAttribute((const void*)mega_fwd, hipFuncAttributeMaxDynamicSharedMemorySize, LDS_BYTES);
        if (hipOccupancyMaxActiveBlocksPerMultiprocessor(&per_cu, (const void*)mega_fwd, 512, LDS_BYTES) != hipSuccess || per_cu < 1) fprintf(stderr, "kernel_launch: occupancy query says %d blocks per CU\n", per_cu);
        (void)hipGetLastError();
        grid = cus > 0 ? cus : 256;
    }
    (void)hipMemsetAsync((char*)d_ws + WS_CTL, 0, 1 * MiB, stream);
    Params p; memset(&p, 0, sizeof(p));
    for (int i = 0; i < 35; ++i) p.in[i] = (const float*)d_in[i];
    p.out = (float*)d_out; p.ws = (unsigned char*)d_ws;
    hipLaunchKernelGGL(mega_fwd, dim3(grid), dim3(512), LDS_BYTES, stream, p);
}
```
